# Optimizing an MI355X kernel written in HIP

```python
import jax
import jax.numpy as jnp
from jax import lax

D_MODEL = 1024
BATCH = 2
SEQ = 8192
DEPTH = 1

CHUNK = 64
QBLOCK = 128
EPS = 1e-6

GLA_HEADS = 4
GLA_DK = 64
GLA_DV = 128
GLA_GATE_RANK = 16
GLA_GATE_NORMALIZER = 16.0
GLA_LOG_GATE_MIN = -1.0

MLA_HEADS = 8
MLA_Q_RANK = 256
MLA_KV_RANK = 128
MLA_NOPE = 64
MLA_ROPE = 32
MLA_V = 64
ROPE_BASE = 10000.0

GLA_QK_W = GLA_HEADS * GLA_DK
GLA_V_W = GLA_HEADS * GLA_DV
D_PROJ = 2 * GLA_QK_W + 2 * GLA_V_W + GLA_GATE_RANK + MLA_Q_RANK + MLA_KV_RANK + MLA_ROPE
D_MIX = GLA_V_W + MLA_HEADS * MLA_V

D_FF = 4 * D_MODEL

kernel_name = 'hymba_gla_mla_sqrelu_chunk_causal'


def _rmsnorm(x, g):
    xf = x.astype(jnp.float32)
    y = xf * lax.rsqrt(jnp.mean(xf * xf, axis=-1, keepdims=True) + EPS)
    return (y * g.astype(jnp.float32)).astype(x.dtype)


def _proj_split_points():
    widths = (GLA_QK_W, GLA_QK_W, GLA_V_W, GLA_GATE_RANK, GLA_V_W, MLA_Q_RANK, MLA_KV_RANK)
    pts, acc = [], 0
    for w in widths:
        acc += w
        pts.append(acc)
    return pts


def _gla_chunked(q, k, v, log_a):
    b_, s_, h_, dk = q.shape
    dv = v.shape[-1]
    n = s_ // CHUNK

    def to_chunks(t):
        return t.astype(jnp.float32).reshape(b_, n, CHUNK, h_, t.shape[-1]).transpose(0, 3, 1, 2, 4)

    q, k, v, log_a = to_chunks(q), to_chunks(k), to_chunks(v), to_chunks(log_a)
    cum = jnp.cumsum(log_a, axis=3)
    q_dec = q * (dk ** -0.5) * jnp.exp(cum)
    k_inv = k * jnp.exp(-cum)
    causal = jnp.tril(jnp.ones((CHUNK, CHUNK), dtype=bool))
    scores = jnp.where(causal, jnp.einsum('bhncd,bhnjd->bhncj', q_dec, k_inv), 0.0)
    o_intra = jnp.einsum('bhncj,bhnjv->bhncv', scores, v)

    cum_last = cum[:, :, :, -1, :]
    k_to_end = k * jnp.exp(cum_last[:, :, :, None, :] - cum)
    chunk_kv = jnp.einsum('bhncd,bhncv->bhndv', k_to_end, v)

    def step(state, inp):
        decay, kv = inp
        return jnp.exp(decay)[..., None] * state + kv, state

    init = jnp.zeros((b_, h_, dk, dv), jnp.float32)
    _, prev = lax.scan(step, init, (jnp.moveaxis(cum_last, 2, 0), jnp.moveaxis(chunk_kv, 2, 0)))
    prev = jnp.moveaxis(prev, 0, 2)
    o = o_intra + jnp.einsum('bhncd,bhndv->bhncv', q_dec, prev)
    return o.transpose(0, 2, 3, 1, 4).reshape(b_, s_, h_, dv)


def _rope_tables(positions):
    inv_freq = ROPE_BASE ** (-jnp.arange(0, MLA_ROPE, 2, dtype=jnp.float32) / MLA_ROPE)
    ang = positions.astype(jnp.float32)[..., None] * inv_freq
    return jnp.cos(ang)[:, :, None, :], jnp.sin(ang)[:, :, None, :]


def _apply_rope(x, cos, sin):
    half = MLA_ROPE // 2
    xf = x.astype(jnp.float32)
    x1, x2 = xf[..., :half], xf[..., half:]
    return jnp.concatenate([x1 * cos - x2 * sin, x1 * sin + x2 * cos], axis=-1).astype(x.dtype)


def _chunk_causal_attention(q, k, v):
    b_, s_, h_, dqk = q.shape
    dv = v.shape[-1]
    nb = s_ // QBLOCK
    scale = dqk ** -0.5
    qb = q.reshape(b_, nb, QBLOCK, h_, dqk).transpose(1, 0, 3, 2, 4)
    kh = k.transpose(0, 2, 1, 3)
    vh = v.transpose(0, 2, 1, 3)
    key_chunk = jnp.arange(s_) // CHUNK

    def one_block(args):
        q_blk, blk = args
        s = jnp.einsum('bhqd,bhkd->bhqk', q_blk, kh, preferred_element_type=jnp.float32) * scale
        q_chunk = (blk * QBLOCK + jnp.arange(QBLOCK)) // CHUNK
        mask = key_chunk[None, :] <= q_chunk[:, None]
        p = jax.nn.softmax(jnp.where(mask, s, -1e30), axis=-1)
        return jnp.einsum('bhqk,bhkv->bhqv', p.astype(vh.dtype), vh)

    out = lax.map(one_block, (qb, jnp.arange(nb)))
    return out.transpose(1, 0, 3, 2, 4).reshape(b_, s_, h_ * dv)


def setup_inputs(seed: int = 0) -> dict:
    key = jax.random.key(seed)
    ks = jax.random.split(key, 20)
    f32 = jnp.float32

    def w(k, shape, fan_in):
        return jax.random.normal(k, shape, f32) * fan_in ** -0.5

    def gain(k, shape):
        return 1.0 + 0.05 * jax.random.normal(k, shape, f32)

    x = jax.random.normal(ks[0], (BATCH, SEQ, D_MODEL), f32)
    offset = jax.random.randint(ks[1], (BATCH, 1), 0, 64, dtype=jnp.int32) * CHUNK
    positions = (offset + jnp.arange(SEQ, dtype=jnp.int32)[None, :]).astype(jnp.int32)
    return {
        'x': x,
        'positions': positions,
        'attn_norm': gain(ks[2], (DEPTH, D_MODEL)),
        'w_in': w(ks[3], (DEPTH, D_MODEL, D_PROJ), D_MODEL),
        'w_gate_up': w(ks[4], (DEPTH, GLA_GATE_RANK, GLA_QK_W), GLA_GATE_RANK),
        'b_gate': 0.1 * jax.random.normal(ks[5], (DEPTH, GLA_QK_W), f32),
        'gla_out_norm': gain(ks[6], (DEPTH, GLA_DV)),
        'q_a_norm': gain(ks[7], (DEPTH, MLA_Q_RANK)),
        'w_uq': w(ks[8], (DEPTH, MLA_Q_RANK, MLA_HEADS * (MLA_NOPE + MLA_ROPE)), MLA_Q_RANK),
        'kv_a_norm': gain(ks[9], (DEPTH, MLA_KV_RANK)),
        'w_ukv': w(ks[10], (DEPTH, MLA_KV_RANK, MLA_HEADS * (MLA_NOPE + MLA_V)), MLA_KV_RANK),
        'q_head_norm': gain(ks[11], (DEPTH, MLA_NOPE + MLA_ROPE)),
        'k_head_norm': gain(ks[12], (DEPTH, MLA_NOPE + MLA_ROPE)),
        'w_out': w(ks[13], (DEPTH, D_MIX, D_MODEL), D_MIX),
        'mlp_norm': gain(ks[14], (DEPTH, D_MODEL)),
        'w_up': w(ks[15], (DEPTH, D_MODEL, D_FF), D_MODEL),
        'w_down': w(ks[16], (DEPTH, D_FF, D_MODEL), D_FF),
    }


def reference(x, positions, attn_norm, w_in, w_gate_up, b_gate, gla_out_norm, q_a_norm, w_uq,
              kv_a_norm, w_ukv, q_head_norm, k_head_norm, w_out, mlp_norm, w_up, w_down):
    b_, s_, _ = x.shape
    cos, sin = _rope_tables(positions)
    split_pts = _proj_split_points()
    for l in range(DEPTH):
        h = _rmsnorm(x, attn_norm[l])
        z = h @ w_in[l]
        zq, zk, zv, zgate, zg, zcq, zckv, zkpe = jnp.split(z, split_pts, axis=-1)

        gq = zq.reshape(b_, s_, GLA_HEADS, GLA_DK)
        gk = zk.reshape(b_, s_, GLA_HEADS, GLA_DK)
        gv = zv.reshape(b_, s_, GLA_HEADS, GLA_DV)
        gate_logit = (zgate @ w_gate_up[l] + b_gate[l]).astype(jnp.float32)
        log_a = jnp.maximum(jax.nn.log_sigmoid(gate_logit) / GLA_GATE_NORMALIZER, GLA_LOG_GATE_MIN)
        log_a = log_a.reshape(b_, s_, GLA_HEADS, GLA_DK)
        o_gla = _gla_chunked(gq, gk, gv, log_a).astype(x.dtype)
        o_gla = _rmsnorm(o_gla, gla_out_norm[l]) * jax.nn.silu(zg.reshape(b_, s_, GLA_HEADS, GLA_DV))
        o_gla = o_gla.reshape(b_, s_, GLA_V_W)

        q = (_rmsnorm(zcq, q_a_norm[l]) @ w_uq[l]).reshape(b_, s_, MLA_HEADS, MLA_NOPE + MLA_ROPE)
        kv = (_rmsnorm(zckv, kv_a_norm[l]) @ w_ukv[l]).reshape(b_, s_, MLA_HEADS, MLA_NOPE + MLA_V)
        k_nope, v = kv[..., :MLA_NOPE], kv[..., MLA_NOPE:]
        k_pe = jnp.broadcast_to(zkpe[:, :, None, :], (b_, s_, MLA_HEADS, MLA_ROPE))
        k = jnp.concatenate([k_nope, k_pe], axis=-1)
        q = _rmsnorm(q, q_head_norm[l])
        k = _rmsnorm(k, k_head_norm[l])
        q = jnp.concatenate([q[..., :MLA_NOPE], _apply_rope(q[..., MLA_NOPE:], cos, sin)], axis=-1)
        k = jnp.concatenate([k[..., :MLA_NOPE], _apply_rope(k[..., MLA_NOPE:], cos, sin)], axis=-1)
        o_mla = _chunk_causal_attention(q, k, v)

        x = x + jnp.concatenate([o_gla, o_mla], axis=-1) @ w_out[l]

        h = _rmsnorm(x, mlp_norm[l])
        x = x + jnp.square(jax.nn.relu(h @ w_up[l])) @ w_down[l]
    return x
```

```cpp
#include <hip/hip_runtime.h>
#include <cstdio>
#include <cstdint>

constexpr int BATCH = 2, SEQ = 8192, DM = 1024, M = BATCH * SEQ;
constexpr int DPROJ = 1968, NZ = 2048, DFF = 4096;
constexpr int GH = 4, GDK = 64, GDV = 128, GRANK = 16, NCH = SEQ / 64;
constexpr int MH = 8, QRANK = 256, KVRANK = 128, NOPE = 64, ROPE = 32, MV = 64, DQK = 96;
constexpr float EPS = 1e-6f;
constexpr float QSCALE = 0.10206207261596577f * 1.4426950408889634f;
constexpr int ZC_Q = 0, ZC_K = 256, ZC_V = 512, ZC_G = 1024, ZC_CQ = 1536, ZC_CKV = 1792, ZC_KPE = 1920, ZC_GATE = 1952;

constexpr size_t MiB = 1u << 20;
constexpr size_t WS_CTL = 0;
constexpr size_t WS_WIN = 1 * MiB, WS_WUQ = 5 * MiB, WS_WUKV = 6 * MiB, WS_WO = 7 * MiB, WS_WUP = 9 * MiB, WS_WDN = 17 * MiB;
constexpr size_t WS_SSQ = 25 * MiB, WS_DEC = 25 * MiB + 512 * 1024, WS_COS = 26 * MiB, WS_SIN = 27 * MiB;
constexpr size_t WS_A = 28 * MiB;
constexpr size_t WS_B = 60 * MiB;
constexpr size_t WS_Z = 92 * MiB;
constexpr size_t WS_QF = 156 * MiB, WS_AQ = 156 * MiB, WS_AKV = 164 * MiB, WS_KF = 180 * MiB, WS_VF = 204 * MiB;
constexpr size_t WS_CKV = 220 * MiB;
constexpr size_t WS_H = 92 * MiB;
constexpr size_t WS_END = 252 * MiB;

typedef unsigned short bf16;
typedef float f32x4 __attribute__((ext_vector_type(4)));
typedef unsigned u32x2 __attribute__((ext_vector_type(2)));
typedef unsigned u32x4 __attribute__((ext_vector_type(4)));

__device__ __forceinline__ float bf2f(unsigned b) { return __uint_as_float(b << 16); }
__device__ __forceinline__ unsigned f2bf(float f) { unsigned u = __float_as_uint(f); return (u + 0x7fffu + ((u >> 16) & 1u)) >> 16; }
__device__ __forceinline__ unsigned pk2(float lo, float hi) { return f2bf(lo) | (f2bf(hi) << 16); }
__device__ __forceinline__ float wave_sum(float v) {
#pragma unroll
    for (int o = 1; o < 64; o <<= 1) v += __shfl_xor(v, o);
    return v;
}

struct Ctx {
    const float* x; const int* pos; const float* attn_norm; const float* w_in; const float* w_gate_up; const float* b_gate; const float* gla_out_norm;
    const float* q_a_norm; const float* w_uq; const float* kv_a_norm; const float* w_ukv; const float* q_head_norm; const float* k_head_norm;
    const float* w_out; const float* mlp_norm; const float* w_up; const float* w_down;
    float* out; unsigned char* ws;
};
constexpr int NT = 512;

__device__ __forceinline__ int win_src_col(int n) {
    if (n < 1024) return n;
    if (n < 1536) return n - 1024 + 1040;
    if (n < 1792) return n - 1536 + 1552;
    if (n < 1920) return n - 1792 + 1808;
    if (n < 1952) return n - 1920 + 1936;
    if (n < 1968) return n - 1952 + 1024;
    return -1;
}
__device__ __forceinline__ void p0_prologue(const Ctx& C) {
    const size_t gt = (size_t)blockIdx.x * NT + threadIdx.x, GT = (size_t)gridDim.x * NT;
    bf16* win = (bf16*)(C.ws + WS_WIN); bf16* wuq = (bf16*)(C.ws + WS_WUQ); bf16* wukv = (bf16*)(C.ws + WS_WUKV);
    bf16* wo = (bf16*)(C.ws + WS_WO); bf16* wup = (bf16*)(C.ws + WS_WUP); bf16* wdn = (bf16*)(C.ws + WS_WDN);
    for (size_t i = gt; i < (size_t)NZ * DM; i += GT) { const int n = (int)(i % NZ), k = (int)(i / NZ); const int s = win_src_col(n);
        win[(size_t)n * DM + k] = (bf16)(s >= 0 ? f2bf(C.w_in[(size_t)k * DPROJ + s]) : 0u); }
    for (size_t i = gt; i < (size_t)1024 * QRANK; i += GT) { const int n = (int)(i % 1024), k = (int)(i / 1024); const int h = n >> 7, j = n & 127;
        wuq[(size_t)n * QRANK + k] = (bf16)(j < DQK ? f2bf(C.w_uq[(size_t)k * (MH * DQK) + h * DQK + j]) : 0u); }
    for (size_t i = gt; i < (size_t)1024 * KVRANK; i += GT) { const int n = (int)(i % 1024), k = (int)(i / 1024);
        wukv[(size_t)n * KVRANK + k] = (bf16)f2bf(C.w_ukv[(size_t)k * 1024 + n]); }
    for (size_t i = gt; i < (size_t)DM * DM; i += GT) { const int n = (int)(i % DM), k = (int)(i / DM);
        wo[(size_t)n * DM + k] = (bf16)f2bf(C.w_out[(size_t)k * DM + n]); }
    for (size_t i = gt; i < (size_t)DFF * DM; i += GT) { const int n = (int)(i % DFF), k = (int)(i / DFF);
        wup[(size_t)n * DM + k] = (bf16)f2bf(C.mlp_norm[k] * C.w_up[(size_t)k * DFF + n]); }
    for (size_t i = gt; i < (size_t)DM * DFF; i += GT) { const int n = (int)(i % DM), k = (int)(i / DM);
        wdn[(size_t)n * DFF + k] = (bf16)f2bf(C.w_down[(size_t)k * DM + n]); }
    const int lane = threadIdx.x & 63; const int gw = (int)(gt >> 6), NGW = (int)(GT >> 6);
    bf16* XN = (bf16*)(C.ws + WS_A); float* COS = (float*)(C.ws + WS_COS); float* SIN = (float*)(C.ws + WS_SIN);
    for (int m = gw; m < M; m += NGW) {
        const f32x4* xr = (const f32x4*)(C.x + (size_t)m * DM) + lane; f32x4 v[4]; float s = 0.f;
#pragma unroll
        for (int j = 0; j < 4; ++j) { v[j] = xr[64 * j]; s += (v[j].x * v[j].x + v[j].y * v[j].y) + (v[j].z * v[j].z + v[j].w * v[j].w); }
        const float rstd = rsqrtf(wave_sum(s) * (1.f / DM) + EPS);
        u32x2* o = (u32x2*)(XN + (size_t)m * DM) + lane;
#pragma unroll
        for (int j = 0; j < 4; ++j) { const f32x4 g = ((const f32x4*)C.attn_norm)[lane + 64 * j]; u32x2 w; w.x = pk2(v[j].x * rstd * g.x, v[j].y * rstd * g.y); w.y = pk2(v[j].z * rstd * g.z, v[j].w * rstd * g.w); o[64 * j] = w; }
        if (lane < 16) { const float invf = exp2f(-(float)(2 * lane) * (1.f / 32.f) * 13.287712379549449f);
            const float ang = (float)C.pos[m] * invf; float sn, cs; sincosf(ang, &sn, &cs); COS[(size_t)m * 16 + lane] = cs; SIN[(size_t)m * 16 + lane] = sn; }
    }
}

struct EpiStoreBf16 { bf16* O; int ld;
    __device__ __forceinline__ void operator()(int r, int c, f32x4 v) const { u32x2 w; w.x = pk2(v.x, v.y); w.y = pk2(v.z, v.w); *(u32x2*)(O + (size_t)r * ld + c) = w; } };
struct EpiOutProj { const float* x; float* x1; bf16* x1b;
    __device__ __forceinline__ void operator()(int r, int c, f32x4 v) const { const size_t o = (size_t)r * DM + c; const f32x4 t = *(const f32x4*)(x + o) + v; *(f32x4*)(x1 + o) = t;
        u32x2 w; w.x = pk2(t.x, t.y); w.y = pk2(t.z, t.w); *(u32x2*)(x1b + o) = w; } };
struct EpiUp { const float* ssq; bf16* H;
    __device__ __forceinline__ void operator()(int r, int c, f32x4 v) const { const f32x4 s = *(const f32x4*)(ssq + (size_t)r * 4); const float rstd = rsqrtf(((s.x + s.y) + (s.z + s.w)) * (1.f / DM) + EPS);
        f32x4 t = v * rstd; t.x = fmaxf(t.x, 0.f); t.y = fmaxf(t.y, 0.f); t.z = fmaxf(t.z, 0.f); t.w = fmaxf(t.w, 0.f); t = t * t;
        u32x2 w; w.x = pk2(t.x, t.y); w.y = pk2(t.z, t.w); *(u32x2*)(H + (size_t)r * DFF + c) = w; } };
struct EpiDown { float* out;
    __device__ __forceinline__ void operator()(int r, int c, f32x4 v) const { f32x4* p = (f32x4*)(out + (size_t)r * DM + c); *p = *p + v; } };

template <class Epi>
__device__ __forceinline__ void gemm_naive(const bf16* A, const bf16* Bt, int Mr, int N, int K, float* lds, const Epi& epi) {
    constexpr int LDT = 132;
    float* As = lds; float* Bs = lds + 16 * LDT;
    const int tid = threadIdx.x, tx = tid & 15, ty = tid >> 4;
    const int lr = tid >> 2, lk = (tid & 3) * 4;
    const int ntm = Mr / 128, ntn = N / 128;
    for (int t = blockIdx.x; t < ntm * ntn; t += gridDim.x) {
        const int m0 = (t / ntn) * 128, n0 = (t % ntn) * 128;
        f32x4 acc[4][2];
#pragma unroll
        for (int i = 0; i < 4; ++i) { acc[i][0] = (f32x4){0.f, 0.f, 0.f, 0.f}; acc[i][1] = (f32x4){0.f, 0.f, 0.f, 0.f}; }
        for (int k0 = 0; k0 < K; k0 += 16) {
            const u32x2 av = *(const u32x2*)(A + (size_t)(m0 + lr) * K + k0 + lk);
            const u32x2 bv = *(const u32x2*)(Bt + (size_t)(n0 + lr) * K + k0 + lk);
            __syncthreads();
            As[(lk + 0) * LDT + lr] = bf2f(av.x & 0xffffu); As[(lk + 1) * LDT + lr] = bf2f(av.x >> 16); As[(lk + 2) * LDT + lr] = bf2f(av.y & 0xffffu); As[(lk + 3) * LDT + lr] = bf2f(av.y >> 16);
            Bs[(lk + 0) * LDT + lr] = bf2f(bv.x & 0xffffu); Bs[(lk + 1) * LDT + lr] = bf2f(bv.x >> 16); Bs[(lk + 2) * LDT + lr] = bf2f(bv.y & 0xffffu); Bs[(lk + 3) * LDT + lr] = bf2f(bv.y >> 16);
            __syncthreads();
#pragma unroll
            for (int k = 0; k < 16; ++k) {
                const f32x4 a = *(const f32x4*)(As + k * LDT + ty * 4);
                const f32x4 b0 = *(const f32x4*)(Bs + k * LDT + tx * 4), b1 = *(const f32x4*)(Bs + k * LDT + 64 + tx * 4);
                acc[0][0] += a.x * b0; acc[0][1] += a.x * b1; acc[1][0] += a.y * b0; acc[1][1] += a.y * b1;
                acc[2][0] += a.z * b0; acc[2][1] += a.z * b1; acc[3][0] += a.w * b0; acc[3][1] += a.w * b1;
            }
        }
#pragma unroll
        for (int i = 0; i < 4; ++i) { epi(m0 + ty * 4 + i, n0 + tx * 4, acc[i][0]); epi(m0 + ty * 4 + i, n0 + 64 + tx * 4, acc[i][1]); }
    }
}

__device__ __forceinline__ void p2a_lowrank_norm(const Ctx& C) {
    const int lane = threadIdx.x & 63; const int gw = (blockIdx.x * NT + threadIdx.x) >> 6, NGW = (gridDim.x * NT) >> 6;
    const bf16* Z = (const bf16*)(C.ws + WS_Z); bf16* AQ = (bf16*)(C.ws + WS_AQ); bf16* AKV = (bf16*)(C.ws + WS_AKV);
    for (int m = gw; m < M; m += NGW) {
        const u32x2 q = *((const u32x2*)(Z + (size_t)m * NZ + ZC_CQ) + lane);
        const float q0 = bf2f(q.x & 0xffffu), q1 = bf2f(q.x >> 16), q2 = bf2f(q.y & 0xffffu), q3 = bf2f(q.y >> 16);
        const float rq = rsqrtf(wave_sum((q0 * q0 + q1 * q1) + (q2 * q2 + q3 * q3)) * (1.f / QRANK) + EPS);
        const f32x4 gq = ((const f32x4*)C.q_a_norm)[lane];
        u32x2 w; w.x = pk2(q0 * rq * gq.x, q1 * rq * gq.y); w.y = pk2(q2 * rq * gq.z, q3 * rq * gq.w); *((u32x2*)(AQ + (size_t)m * QRANK) + lane) = w;
        const unsigned kv = *((const unsigned*)(Z + (size_t)m * NZ + ZC_CKV) + lane);
        const float k0 = bf2f(kv & 0xffffu), k1 = bf2f(kv >> 16);
        const float rk = rsqrtf(wave_sum(k0 * k0 + k1 * k1) * (1.f / KVRANK) + EPS);
        *((unsigned*)(AKV + (size_t)m * KVRANK) + lane) = pk2(k0 * rk * C.kv_a_norm[2 * lane], k1 * rk * C.kv_a_norm[2 * lane + 1]);
    }
}

__device__ __forceinline__ void p2c_finalize_qkv(const Ctx& C) {
    const bf16* Z = (const bf16*)(C.ws + WS_Z); const bf16* QR = (const bf16*)(C.ws + WS_A); const bf16* KVR = (const bf16*)(C.ws + WS_B);
    bf16* QF = (bf16*)(C.ws + WS_QF); bf16* KF = (bf16*)(C.ws + WS_KF); bf16* VF = (bf16*)(C.ws + WS_VF);
    const float* COS = (const float*)(C.ws + WS_COS); const float* SIN = (const float*)(C.ws + WS_SIN);
    const int gt = blockIdx.x * NT + threadIdx.x, GT = gridDim.x * NT;
    for (int it = gt; it < M * MH; it += GT) {
        const int m = it >> 3, h = it & 7;
        { const bf16* src = QR + (size_t)m * 1024 + h * 128; float ss = 0.f;
            for (int j = 0; j < DQK; ++j) { const float v = bf2f(src[j]); ss += v * v; }
            const float r = rsqrtf(ss * (1.f / DQK) + EPS) ; bf16* dst = QF + (size_t)m * (MH * DQK) + h * DQK;
            for (int j = 0; j < NOPE; ++j) dst[j] = (bf16)f2bf(bf2f(src[j]) * r * C.q_head_norm[j] * QSCALE);
            for (int i = 0; i < 16; ++i) { const float a = bf2f(src[64 + i]) * r * C.q_head_norm[64 + i], b = bf2f(src[80 + i]) * r * C.q_head_norm[80 + i];
                const float cs = COS[(size_t)m * 16 + i], sn = SIN[(size_t)m * 16 + i];
                dst[64 + i] = (bf16)f2bf((a * cs - b * sn) * QSCALE); dst[80 + i] = (bf16)f2bf((a * sn + b * cs) * QSCALE); } }
        { const bf16* src = KVR + (size_t)m * 1024 + h * 128; const bf16* pe = Z + (size_t)m * NZ + ZC_KPE; float ss = 0.f;
            for (int j = 0; j < NOPE; ++j) { const float v = bf2f(src[j]); ss += v * v; }
            for (int j = 0; j < ROPE; ++j) { const float v = bf2f(pe[j]); ss += v * v; }
            const float r = rsqrtf(ss * (1.f / DQK) + EPS); bf16* dst = KF + (size_t)m * (MH * DQK) + h * DQK;
            for (int j = 0; j < NOPE; ++j) dst[j] = (bf16)f2bf(bf2f(src[j]) * r * C.k_head_norm[j]);
            for (int i = 0; i < 16; ++i) { const float a = bf2f(pe[i]) * r * C.k_head_norm[64 + i], b = bf2f(pe[16 + i]) * r * C.k_head_norm[80 + i];
                const float cs = COS[(size_t)m * 16 + i], sn = SIN[(size_t)m * 16 + i];
                dst[64 + i] = (bf16)f2bf(a * cs - b * sn); dst[80 + i] = (bf16)f2bf(a * sn + b * cs); }
            bf16* vd = VF + (size_t)m * (MH * MV) + h * MV;
            for (int j = 0; j < MV; ++j) vd[j] = src[64 + j]; }
    }
}

__device__ __forceinline__ float log_gate(float gl) { const float ls = fminf(gl, 0.f) - log1pf(expf(-fabsf(gl))); return fmaxf(ls * (1.f / 16.f), -1.f); }
__device__ __forceinline__ void gla_cum(const Ctx& C, const bf16* Z, int row0, int h, float* cum, float* zgt) {
    const int tid = threadIdx.x;
    for (int i = tid; i < 64 * 16; i += NT) { const int c = i >> 4, g = i & 15; zgt[i] = bf2f(Z[(size_t)(row0 + c) * NZ + ZC_GATE + g]); }
    __syncthreads();
    for (int i = tid; i < 64 * 64; i += NT) { const int c = i >> 6, d = i & 63; float gl = C.b_gate[h * 64 + d];
#pragma unroll
        for (int g = 0; g < 16; ++g) gl += zgt[c * 16 + g] * C.w_gate_up[g * 256 + h * 64 + d];
        cum[i] = log_gate(gl); }
    __syncthreads();
    if (tid < 64) { float s = 0.f; for (int c = 0; c < 64; ++c) { s += cum[c * 64 + tid]; cum[c * 64 + tid] = s; } }
    __syncthreads();
}

__device__ __forceinline__ void gla_pass1(const Ctx& C, float* lds) {
    const bf16* Z = (const bf16*)(C.ws + WS_Z); float* CKV = (float*)(C.ws + WS_CKV); float* DEC = (float*)(C.ws + WS_DEC);
    float* cum = lds; float* kk = lds + 4096; float* vv = lds + 8192; float* zgt = lds + 8192 + 8192;
    const int tid = threadIdx.x;
    for (int u = blockIdx.x; u < BATCH * GH * NCH; u += gridDim.x) {
        const int n = u % NCH, h = (u / NCH) % GH, b = u / (NCH * GH); const int row0 = b * SEQ + n * 64;
        __syncthreads();
        for (int i = tid; i < 64 * 64; i += NT) { const int c = i >> 6, d = i & 63; kk[i] = bf2f(Z[(size_t)(row0 + c) * NZ + ZC_K + h * 64 + d]); }
        for (int i = tid; i < 64 * 128; i += NT) { const int c = i >> 7, v = i & 127; vv[i] = bf2f(Z[(size_t)(row0 + c) * NZ + ZC_V + h * 128 + v]); }
        gla_cum(C, Z, row0, h, cum, zgt);
        for (int i = tid; i < 64 * 64; i += NT) { const int c = i >> 6, d = i & 63; kk[i] *= expf(cum[63 * 64 + d] - cum[c * 64 + d]); }
        if (tid < 64) DEC[(size_t)u * 64 + tid] = expf(cum[63 * 64 + tid]);
        __syncthreads();
        const int d = tid & 63, vb = tid >> 6; float acc[16];
#pragma unroll
        for (int i = 0; i < 16; ++i) acc[i] = 0.f;
        for (int c = 0; c < 64; ++c) { const float kv = kk[c * 64 + d];
#pragma unroll
            for (int i = 0; i < 16; ++i) acc[i] += vv[c * 128 + vb + 8 * i] * kv; }
#pragma unroll
        for (int i = 0; i < 16; ++i) CKV[((size_t)u * 128 + vb + 8 * i) * 64 + d] = acc[i];
    }
}

__device__ __forceinline__ void gla_scan(const Ctx& C) {
    const float* CKV = (const float*)(C.ws + WS_CKV); const float* DEC = (const float*)(C.ws + WS_DEC); bf16* PREV = (bf16*)(C.ws + WS_A);
    const int gt = blockIdx.x * NT + threadIdx.x, GT = gridDim.x * NT;
    for (int e = gt; e < BATCH * GH * 128 * 64; e += GT) {
        const int d = e & 63, v = (e >> 6) & 127, bh = e >> 13; float st = 0.f;
        for (int n = 0; n < NCH; ++n) { const size_t u = (size_t)bh * NCH + n;
            PREV[(u * 128 + v) * 64 + d] = (bf16)f2bf(st);
            st = DEC[u * 64 + d] * st + CKV[(u * 128 + v) * 64 + d]; }
    }
}

__device__ __forceinline__ void gla_pass2(const Ctx& C, float* lds) {
    const bf16* Z = (const bf16*)(C.ws + WS_Z); const bf16* PREV = (const bf16*)(C.ws + WS_A); bf16* MIX = (bf16*)(C.ws + WS_B);
    float* cum = lds; float* qq = lds + 4096; float* kk = qq + 64 * 65; float* vv = kk + 64 * 65; float* zgt = vv + 8192; float* pv = zgt + 1024;
    const int tid = threadIdx.x;
    for (int u = blockIdx.x; u < BATCH * GH * NCH; u += gridDim.x) {
        const int n = u % NCH, h = (u / NCH) % GH, b = u / (NCH * GH); const int row0 = b * SEQ + n * 64;
        __syncthreads();
        for (int i = tid; i < 64 * 64; i += NT) { const int c = i >> 6, d = i & 63; qq[c * 65 + d] = bf2f(Z[(size_t)(row0 + c) * NZ + ZC_Q + h * 64 + d]); kk[c * 65 + d] = bf2f(Z[(size_t)(row0 + c) * NZ + ZC_K + h * 64 + d]); }
        for (int i = tid; i < 64 * 128; i += NT) { const int c = i >> 7, v = i & 127; vv[i] = bf2f(Z[(size_t)(row0 + c) * NZ + ZC_V + h * 128 + v]); }
        for (int i = tid; i < 128 * 64; i += NT) { const int v = i >> 6, d = i & 63; pv[v * 65 + d] = bf2f(PREV[((size_t)u * 128 + v) * 64 + d]); }
        gla_cum(C, Z, row0, h, cum, zgt);
        for (int i = tid; i < 64 * 64; i += NT) { const int c = i >> 6, d = i & 63; const float cu = cum[i]; qq[c * 65 + d] *= 0.125f * expf(cu); kk[c * 65 + d] *= expf(-cu); }
        __syncthreads();
        const int c = tid >> 3, t8 = tid & 7;
        { float s[8];
#pragma unroll
            for (int i = 0; i < 8; ++i) s[i] = 0.f;
            for (int d = 0; d < 64; ++d) { const float q = qq[c * 65 + d];
#pragma unroll
                for (int i = 0; i < 8; ++i) s[i] += q * kk[(t8 + 8 * i) * 65 + d]; }
            __syncthreads();
#pragma unroll
            for (int i = 0; i < 8; ++i) { const int j = t8 + 8 * i; cum[c * 64 + j] = (j <= c) ? s[i] : 0.f; } }
        __syncthreads();
        float o[16];
#pragma unroll
        for (int i = 0; i < 16; ++i) o[i] = 0.f;
        for (int j = 0; j < 64; ++j) { const float p = cum[c * 64 + j];
#pragma unroll
            for (int i = 0; i < 16; ++i) o[i] += p * vv[j * 128 + t8 + 8 * i]; }
        for (int d = 0; d < 64; ++d) { const float q = qq[c * 65 + d];
#pragma unroll
            for (int i = 0; i < 16; ++i) o[i] += q * pv[(t8 + 8 * i) * 65 + d]; }
        float ss = 0.f;
#pragma unroll
        for (int i = 0; i < 16; ++i) ss += o[i] * o[i];
        ss += __shfl_xor(ss, 1); ss += __shfl_xor(ss, 2); ss += __shfl_xor(ss, 4);
        const float r = rsqrtf(ss * (1.f / GDV) + EPS);
        const size_t row = (size_t)(row0 + c);
#pragma unroll
        for (int i = 0; i < 16; ++i) { const int v = t8 + 8 * i; const float g = bf2f(Z[row * NZ + ZC_G + h * 128 + v]); const float sl = g / (1.f + expf(-g));
            MIX[row * DM + h * 128 + v] = (bf16)f2bf(o[i] * r * C.gla_out_norm[v] * sl); }
    }
}

__device__ __forceinline__ void attn_naive(const Ctx& C, float* lds) {
    const bf16* QF = (const bf16*)(C.ws + WS_QF); const bf16* KF = (const bf16*)(C.ws + WS_KF); const bf16* VF = (const bf16*)(C.ws + WS_VF); bf16* MIX = (bf16*)(C.ws + WS_B);
    float* qs = lds; float* ks = qs + 64 * 97; float* vs = ks + 64 * 97; float* ps = vs + 64 * 64;
    const int tid = threadIdx.x, r = tid >> 3, t8 = tid & 7;
    for (int u = blockIdx.x; u < BATCH * MH * NCH; u += gridDim.x) {
        const int h = u % MH, qc = (u / MH) % NCH, b = u / (NCH * MH); const int row0 = b * SEQ + qc * 64;
        __syncthreads();
        for (int i = tid; i < 64 * 96; i += NT) { const int c = i / 96, d = i % 96; qs[c * 97 + d] = bf2f(QF[(size_t)(row0 + c) * 768 + h * 96 + d]); }
        float m = -INFINITY, l = 0.f, o[8];
#pragma unroll
        for (int i = 0; i < 8; ++i) o[i] = 0.f;
        for (int kc = 0; kc <= qc; ++kc) {
            const int k0 = b * SEQ + kc * 64;
            __syncthreads();
            for (int i = tid; i < 64 * 96; i += NT) { const int c = i / 96, d = i % 96; ks[c * 97 + d] = bf2f(KF[(size_t)(k0 + c) * 768 + h * 96 + d]); }
            for (int i = tid; i < 64 * 64; i += NT) { const int c = i >> 6, d = i & 63; vs[i] = bf2f(VF[(size_t)(k0 + c) * 512 + h * 64 + d]); }
            __syncthreads();
            float s[8];
#pragma unroll
            for (int i = 0; i < 8; ++i) s[i] = 0.f;
            for (int d = 0; d < 96; ++d) { const float q = qs[r * 97 + d];
#pragma unroll
                for (int i = 0; i < 8; ++i) s[i] += q * ks[(t8 + 8 * i) * 97 + d]; }
            float mx = s[0];
#pragma unroll
            for (int i = 1; i < 8; ++i) mx = fmaxf(mx, s[i]);
            mx = fmaxf(mx, __shfl_xor(mx, 1)); mx = fmaxf(mx, __shfl_xor(mx, 2)); mx = fmaxf(mx, __shfl_xor(mx, 4));
            const float mn = fmaxf(m, mx), alpha = exp2f(m - mn); float rs = 0.f;
#pragma unroll
            for (int i = 0; i < 8; ++i) { const float p = exp2f(s[i] - mn); rs += p; ps[r * 65 + t8 + 8 * i] = p; }
            rs += __shfl_xor(rs, 1); rs += __shfl_xor(rs, 2); rs += __shfl_xor(rs, 4);
            l = l * alpha + rs; m = mn;
#pragma unroll
            for (int i = 0; i < 8; ++i) o[i] *= alpha;
            __syncthreads();
            for (int j = 0; j < 64; ++j) { const float p = ps[r * 65 + j];
#pragma unroll
                for (int i = 0; i < 8; ++i) o[i] += p * vs[j * 64 + t8 + 8 * i]; }
        }
        const float il = 1.f / l;
#pragma unroll
        for (int i = 0; i < 8; ++i) MIX[(size_t)(row0 + r) * DM + 512 + h * 64 + t8 + 8 * i] = (bf16)f2bf(o[i] * il);
    }
}

__device__ __forceinline__ void p4b_ssq(const Ctx& C) {
    const int lane = threadIdx.x & 63; const int gw = (blockIdx.x * NT + threadIdx.x) >> 6, NGW = (gridDim.x * NT) >> 6;
    float* SSQ = (float*)(C.ws + WS_SSQ);
    for (int m = gw; m < M; m += NGW) {
        const f32x4* xr = (const f32x4*)(C.out + (size_t)m * DM) + lane;
#pragma unroll
        for (int j = 0; j < 4; ++j) { const f32x4 v = xr[64 * j]; const float s = wave_sum((v.x * v.x + v.y * v.y) + (v.z * v.z + v.w * v.w)); if (lane == 0) SSQ[(size_t)m * 4 + j] = s; }
    }
}

constexpr int LDS_BYTES = 147456;
__global__ void __launch_bounds__(NT, 2) k_stage(Ctx C, int stage) {
    extern __shared__ __attribute__((aligned(16))) unsigned char lds_raw[];
    float* lds = (float*)lds_raw;
    unsigned char* ws = C.ws;
    switch (stage) {
    case 0: p0_prologue(C); break;
    case 1: gemm_naive((const bf16*)(ws + WS_A), (const bf16*)(ws + WS_WIN), M, NZ, DM, lds, EpiStoreBf16{(bf16*)(ws + WS_Z), NZ}); break;
    case 2: p2a_lowrank_norm(C); break;
    case 3: gemm_naive((const bf16*)(ws + WS_AQ), (const bf16*)(ws + WS_WUQ), M, 1024, QRANK, lds, EpiStoreBf16{(bf16*)(ws + WS_A), 1024}); break;
    case 4: gemm_naive((const bf16*)(ws + WS_AKV), (const bf16*)(ws + WS_WUKV), M, 1024, KVRANK, lds, EpiStoreBf16{(bf16*)(ws + WS_B), 1024}); break;
    case 5: gla_pass1(C, lds); break;
    case 6: p2c_finalize_qkv(C); break;
    case 7: gla_scan(C); break;
    case 8: attn_naive(C, lds); break;
    case 9: gla_pass2(C, lds); break;
    case 10: gemm_naive((const bf16*)(ws + WS_B), (const bf16*)(ws + WS_WO), M, DM, DM, lds, EpiOutProj{C.x, C.out, (bf16*)(ws + WS_A)}); break;
    case 11: p4b_ssq(C); break;
    case 12: gemm_naive((const bf16*)(ws + WS_A), (const bf16*)(ws + WS_WUP), M, DFF, DM, lds, EpiUp{(const float*)(ws + WS_SSQ), (bf16*)(ws + WS_H)}); break;
    case 13: gemm_naive((const bf16*)(ws + WS_H), (const bf16*)(ws + WS_WDN), M, DM, DFF, lds, EpiDown{C.out}); break;
    default: break;
    }
}

extern "C" void kernel_launch(void* const* d_in, const int* in_sizes, int n_in, void* d_out, int out_size, void* d_ws, size_t ws_size, hipStream_t stream) {
    static int ready = 0;
    if (!ready) {
        if (n_in != 17 || in_sizes[0] != M * DM || out_size != M * DM || ws_size < WS_END) { fprintf(stderr, "kernel_launch: unexpected shapes (n_in %d in0 %d out %d ws %zu)\n", n_in, n_in > 0 ? in_sizes[0] : -1, out_size, ws_size); ready = -1; return; }
        if (hipFuncSetAttribute((const void*)k_stage, hipFuncAttributeMaxDynamicSharedMemorySize, LDS_BYTES) != hipSuccess) { fprintf(stderr, "kernel_launch: hipFuncSetAttribute failed\n"); ready = -1; return; }
        ready = 1;
    }
    if (ready < 0) return;
    Ctx C{};
    C.x = (const float*)d_in[0]; C.pos = (const int*)d_in[1]; C.attn_norm = (const float*)d_in[2]; C.w_in = (const float*)d_in[3]; C.w_gate_up = (const float*)d_in[4];
    C.b_gate = (const float*)d_in[5]; C.gla_out_norm = (const float*)d_in[6]; C.q_a_norm = (const float*)d_in[7]; C.w_uq = (const float*)d_in[8]; C.kv_a_norm = (const float*)d_in[9];
    C.w_ukv = (const float*)d_in[10]; C.q_head_norm = (const float*)d_in[11]; C.k_head_norm = (const float*)d_in[12]; C.w_out = (const float*)d_in[13]; C.mlp_norm = (const float*)d_in[14];
    C.w_up = (const float*)d_in[15]; C.w_down = (const float*)d_in[16]; C.out = (float*)d_out; C.ws = (unsigned char*)d_ws;
    for (int s = 0; s < 14; ++s) hipLaunchKernelGGL(k_stage, dim3(256), dim3(NT), LDS_BYTES, stream, C, s);
}
```

```cpp
#include <hip/hip_runtime.h>
#include <cstdio>
#include <cstdint>
#ifndef DUP_MASK
#define DUP_MASK 0u
#endif
#define DUPL(k) (((DUP_MASK) >> (k)) & 1u)

constexpr int BATCH = 2, SEQ = 8192, DM = 1024, M = BATCH * SEQ;
constexpr int DPROJ = 1968, NZ = 2048, DFF = 4096;
constexpr int GH = 4, GDK = 64, GDV = 128, GRANK = 16, NCH = SEQ / 64;
constexpr int MH = 8, QRANK = 256, KVRANK = 128, NOPE = 64, ROPE = 32, MV = 64, DQK = 96;
constexpr float EPS = 1e-6f;
constexpr float QSCALE = 0.10206207261596577f * 1.4426950408889634f;
constexpr int ZC_Q = 0, ZC_K = 256, ZC_V = 512, ZC_G = 1024, ZC_CQ = 1536, ZC_CKV = 1792, ZC_KPE = 1920, ZC_GATE = 1952;
__host__ __device__ __forceinline__ size_t ztile(size_t r, int c) { return ((r >> 4) * 64 + (size_t)(c >> 5)) * 512 + (r & 15) * 32 + (c & 31); }

constexpr size_t MiB = 1u << 20;
constexpr size_t WS_CTL = 0;
constexpr size_t WS_WIN = 1 * MiB, WS_WUQ = 5 * MiB, WS_WUKV = 6 * MiB, WS_WO = 7 * MiB, WS_WUP = 9 * MiB, WS_WDN = 17 * MiB;
constexpr size_t WS_SSQ = 25 * MiB, WS_DEC = 512 * 1024, WS_COS = 26 * MiB, WS_SIN = 27 * MiB;
constexpr size_t CTL_ZERO_BYTES = 64 * 1024;
constexpr size_t WS_SSQQ = 5 * MiB + 512 * 1024, WS_SSQKV = 5 * MiB + 768 * 1024, WS_SSQPE = 6 * MiB + 512 * 1024;
constexpr size_t WS_A = 28 * MiB;
constexpr size_t WS_B = 60 * MiB;
constexpr size_t WS_Z = 92 * MiB;
constexpr size_t WS_QF = 156 * MiB, WS_AQ = 156 * MiB, WS_AKV = 164 * MiB, WS_KF = 180 * MiB, WS_VF = 204 * MiB;
constexpr size_t WS_CKV = 220 * MiB;
constexpr size_t WS_H = 92 * MiB;
constexpr size_t WS_END = 252 * MiB;

typedef unsigned short bf16;
typedef float f32x4 __attribute__((ext_vector_type(4)));
typedef unsigned u32x2 __attribute__((ext_vector_type(2)));
typedef unsigned u32x4 __attribute__((ext_vector_type(4)));

__device__ __forceinline__ float bf2f(unsigned b) { return __uint_as_float(b << 16); }
__device__ __forceinline__ unsigned f2bf(float f) { unsigned u = __float_as_uint(f); return (u + 0x7fffu + ((u >> 16) & 1u)) >> 16; }
typedef float f32x2c_t __attribute__((ext_vector_type(2))); typedef __bf16 bf16x2c_t __attribute__((ext_vector_type(2)));
__device__ __forceinline__ unsigned pk2(float lo, float hi) { f32x2c_t v = {lo, hi}; bf16x2c_t b = __builtin_convertvector(v, bf16x2c_t); return __builtin_bit_cast(unsigned, b); }
__device__ __forceinline__ float wave_sum(float v) {
#pragma unroll
    for (int o = 1; o < 64; o <<= 1) v += __shfl_xor(v, o);
    return v;
}

__device__ __forceinline__ unsigned otid() { unsigned t = threadIdx.x; asm volatile("" : "+v"(t)); return t; }

struct Ctx {
    const float* x; const int* pos; const float* attn_norm; const float* w_in; const float* w_gate_up; const float* b_gate; const float* gla_out_norm;
    const float* q_a_norm; const float* w_uq; const float* kv_a_norm; const float* w_ukv; const float* q_head_norm; const float* k_head_norm;
    const float* w_out; const float* mlp_norm; const float* w_up; const float* w_down;
    float* out; unsigned char* ws;
};
constexpr int NT = 512;

__device__ __forceinline__ int win_src_col(int n) {
    if (n < 1024) return n;
    if (n < 1536) return n - 1024 + 1040;
    if (n < 1792) return n - 1536 + 1552;
    if (n < 1920) return n - 1792 + 1808;
    if (n < 1952) return n - 1920 + 1936;
    if (n < 1968) return n - 1952 + 1024;
    return -1;
}
struct MapWin { __device__ __forceinline__ int operator()(int n) const { return win_src_col(n); } };
struct MapUq  { __device__ __forceinline__ int operator()(int n) const { const int h = n >> 7, j = n & 127; return j < DQK ? h * DQK + j : -1; } };
struct MapId  { __device__ __forceinline__ int operator()(int n) const { return n; } };
template <bool GAIN, class CMap>
__device__ __forceinline__ void p0_transpose_item(const float* W, int K, int Nsrc, int N, bf16* WT, const float* kgain, float* scr, int item, int lane, const CMap& cmap) {
    const int nblk = N / 32, kb = item / nblk, nb = item % nblk, k0 = 64 * kb, n0 = 32 * nb;
    const int sc = cmap(n0 + (lane & 31)); const float keep = sc >= 0 ? 1.f : 0.f; const int scc = sc >= 0 ? sc : 0;
    const float* wp = W + (size_t)(k0 + (lane >> 5)) * Nsrc + scc;
    float v[32];
#pragma unroll
    for (int i = 0; i < 32; ++i) v[i] = wp[(size_t)(2 * i) * Nsrc];
#pragma unroll
    for (int i = 0; i < 32; ++i) { const int kk = 2 * i + (lane >> 5); float t = v[i] * keep; if (GAIN) t *= kgain[k0 + kk]; scr[kk * 33 + (lane & 31)] = t; }
    asm volatile("s_waitcnt lgkmcnt(0)" ::: "memory");
    const int c = lane & 7;
#pragma unroll
    for (int j = 0; j < 4; ++j) { const int n = (lane >> 3) + 8 * j; const float* s = scr + (8 * c) * 33 + n;
        u32x4 o; o.x = pk2(s[0 * 33], s[1 * 33]); o.y = pk2(s[2 * 33], s[3 * 33]); o.z = pk2(s[4 * 33], s[5 * 33]); o.w = pk2(s[6 * 33], s[7 * 33]);
        *(u32x4*)(WT + ((size_t)((n0 + n) >> 4) * (K >> 5) + ((k0 + 8 * c) >> 5)) * 512 + ((n0 + n) & 15) * 32 + ((k0 + 8 * c) & 31)) = o; }
    asm volatile("s_waitcnt lgkmcnt(0)" ::: "memory");
}
__device__ __forceinline__ void p0_prologue(const Ctx& C, float* lds) {
    const size_t gt = (size_t)blockIdx.x * NT + otid(), GT = (size_t)gridDim.x * NT;
    bf16* win = (bf16*)(C.ws + WS_WIN); bf16* wuq = (bf16*)(C.ws + WS_WUQ); bf16* wukv = (bf16*)(C.ws + WS_WUKV);
    bf16* wo = (bf16*)(C.ws + WS_WO); bf16* wup = (bf16*)(C.ws + WS_WUP); bf16* wdn = (bf16*)(C.ws + WS_WDN);
    {   const int lane_ = otid() & 63, wv = otid() >> 6; float* scr = lds + wv * (64 * 33 + 32);
        const int gw_ = (int)(gt >> 6), NGW_ = (int)(GT >> 6);
        constexpr int I_IN = (DM / 64) * (NZ / 32), I_UQ = (QRANK / 64) * (1024 / 32), I_UKV = (KVRANK / 64) * (1024 / 32), I_O = (DM / 64) * (DM / 32), I_UP = (DM / 64) * (DFF / 32), I_DN = (DFF / 64) * (DM / 32);
        constexpr int NITEMS = I_IN + I_UQ + I_UKV + I_O + I_UP + I_DN;
        for (int it = gw_; it < NITEMS; it += NGW_) {
            int r = it;
            if (r < I_UP) { p0_transpose_item<true>(C.w_up, DM, DFF, DFF, wup, C.mlp_norm, scr, r, lane_, MapId{}); continue; } r -= I_UP;
            if (r < I_DN) { p0_transpose_item<false>(C.w_down, DFF, DM, DM, wdn, nullptr, scr, r, lane_, MapId{}); continue; } r -= I_DN;
            if (r < I_IN) { p0_transpose_item<false>(C.w_in, DM, DPROJ, NZ, win, nullptr, scr, r, lane_, MapWin{}); continue; } r -= I_IN;
            if (r < I_O) { p0_transpose_item<false>(C.w_out, DM, DM, DM, wo, nullptr, scr, r, lane_, MapId{}); continue; } r -= I_O;
            if (r < I_UQ) { p0_transpose_item<true>(C.w_uq, QRANK, MH * DQK, 1024, wuq, C.q_a_norm, scr, r, lane_, MapUq{}); continue; } r -= I_UQ;
            p0_transpose_item<true>(C.w_ukv, KVRANK, 1024, 1024, wukv, C.kv_a_norm, scr, r, lane_, MapId{});
        }
    }
    const int lane = otid() & 63; const int gw = (int)(gt >> 6), NGW = (int)(GT >> 6);
    bf16* XN = (bf16*)(C.ws + WS_A); float* COS = (float*)(C.ws + WS_COS); float* SIN = (float*)(C.ws + WS_SIN);
    f32x4 gn[4];
#pragma unroll
    for (int j = 0; j < 4; ++j) gn[j] = ((const f32x4*)C.attn_norm)[lane + 64 * j];
    for (int m = gw; m < M; m += 2 * NGW) {
        const int m2 = m + NGW;
        const f32x4* xa = (const f32x4*)(C.x + (size_t)m * DM) + lane; const f32x4* xb = (const f32x4*)(C.x + (size_t)(m2 < M ? m2 : m) * DM) + lane;
        f32x4 va[4], vb[4]; float sa = 0.f, sb = 0.f;
#pragma unroll
        for (int j = 0; j < 4; ++j) { va[j] = xa[64 * j]; vb[j] = xb[64 * j]; }
#pragma unroll
        for (int j = 0; j < 4; ++j) { sa += (va[j].x * va[j].x + va[j].y * va[j].y) + (va[j].z * va[j].z + va[j].w * va[j].w); sb += (vb[j].x * vb[j].x + vb[j].y * vb[j].y) + (vb[j].z * vb[j].z + vb[j].w * vb[j].w); }
        const float ra = rsqrtf(wave_sum(sa) * (1.f / DM) + EPS), rb = rsqrtf(wave_sum(sb) * (1.f / DM) + EPS);
        u32x2* oa = (u32x2*)(XN + (size_t)m * DM) + lane; u32x2* ob = (u32x2*)(XN + (size_t)m2 * DM) + lane;
#pragma unroll
        for (int j = 0; j < 4; ++j) { u32x2 w; w.x = pk2(va[j].x * ra * gn[j].x, va[j].y * ra * gn[j].y); w.y = pk2(va[j].z * ra * gn[j].z, va[j].w * ra * gn[j].w); oa[64 * j] = w; }
        if (m2 < M) {
#pragma unroll
            for (int j = 0; j < 4; ++j) { u32x2 w; w.x = pk2(vb[j].x * rb * gn[j].x, vb[j].y * rb * gn[j].y); w.y = pk2(vb[j].z * rb * gn[j].z, vb[j].w * rb * gn[j].w); ob[64 * j] = w; } }
    }
    for (size_t i = gt; i < (size_t)M * 16; i += GT) { const int m = (int)(i >> 4), f = (int)(i & 15);
        const float invf = exp2f(-(float)(2 * f) * (1.f / 32.f) * 13.287712379549449f);
        const float ang = (float)C.pos[m] * invf; float sn, cs; sincosf(ang, &sn, &cs); COS[i] = cs; SIN[i] = sn; }
}

__device__ __forceinline__ void unpack8(const u32x4 w, float (&v)[8]) { v[0] = bf2f(w.x & 0xffffu); v[1] = bf2f(w.x >> 16); v[2] = bf2f(w.y & 0xffffu); v[3] = bf2f(w.y >> 16);
    v[4] = bf2f(w.z & 0xffffu); v[5] = bf2f(w.z >> 16); v[6] = bf2f(w.w & 0xffffu); v[7] = bf2f(w.w >> 16); }
__device__ __forceinline__ u32x4 pack8(const float (&v)[8]) { u32x4 w; w.x = pk2(v[0], v[1]); w.y = pk2(v[2], v[3]); w.z = pk2(v[4], v[5]); w.w = pk2(v[6], v[7]); return w; }
constexpr float LOG2E = 1.4426950408889634f, LN2 = 0.6931471805599453f;
__device__ __forceinline__ float fexp(float x) { return __builtin_amdgcn_exp2f(x * LOG2E); }
__device__ __forceinline__ float log_gate(float gl) { const float ls = fminf(gl, 0.f) - LN2 * __builtin_amdgcn_logf(1.f + fexp(-fabsf(gl))); return fmaxf(ls * (1.f / 16.f), -1.f); }
__device__ __forceinline__ float silu_f(float g) { return g * __builtin_amdgcn_rcpf(1.f + fexp(-g)); }
__device__ __forceinline__ void gla_scan(const Ctx& C) {
    const float* CKV = (const float*)(C.ws + WS_CKV); const float* DEC = (const float*)(C.ws + WS_DEC); bf16* PREV = (bf16*)(C.ws + WS_A);
    if (otid() >= 256) return;
    for (int e = blockIdx.x * 256 + otid(); e < BATCH * GH * 128 * 64; e += gridDim.x * 256) {
        const int d = e & 63, v = (e >> 6) & 127, bh = e >> 13; float st = 0.f;
        for (int n0 = 0; n0 < NCH; n0 += 16) {
            float cv[16], dv[16];
#pragma unroll
            for (int i = 0; i < 16; ++i) { const size_t u = (size_t)bh * NCH + n0 + i; cv[i] = CKV[(u * 128 + v) * 64 + d]; dv[i] = DEC[u * 64 + d]; }
#pragma unroll
            for (int i = 0; i < 16; ++i) { const size_t u = (size_t)bh * NCH + n0 + i; PREV[(u * 128 + v) * 64 + d] = (bf16)f2bf(st); st = dv[i] * st + cv[i]; }
        }
    }
}

namespace att {
typedef short bf16x8 __attribute__((ext_vector_type(8)));
typedef short s16x4 __attribute__((ext_vector_type(4)));
typedef float f32x16 __attribute__((ext_vector_type(16)));
typedef __attribute__((address_space(3))) const char* lds_cptr;
constexpr int KSLOT = 12288, VSLOT = 8192, LDS_K = 0, LDS_V = 3 * KSLOT, LDS_WS = LDS_V + 3 * VSLOT, LDS_OST = LDS_WS + 8 * 256, LDS_TOTAL = LDS_OST + 8 * 4096;
constexpr int QP = MH * DQK, VP = MH * MV;
#define ATT_SBAR() __builtin_amdgcn_sched_barrier(0)
__device__ __forceinline__ int crow(int r, int hi) { return (r & 3) + 8 * (r >> 2) + 4 * hi; }
__device__ __forceinline__ void glds16(const void* gsrc, unsigned lds_dst) { unsigned keep;
    asm volatile("s_mov_b32 %0, m0\n\ts_mov_b32 m0, %2\n\ts_nop 0\n\tglobal_load_lds_dwordx4 %1, off\n\ts_mov_b32 m0, %0" : "=&s"(keep) : "v"(gsrc), "s"(lds_dst) : "memory"); }
typedef float f32x2_t __attribute__((ext_vector_type(2))); typedef __bf16 bf16x2_t __attribute__((ext_vector_type(2)));
__device__ __forceinline__ unsigned cvtpk_s(float lo, float hi) { f32x2_t v = {lo, hi}; bf16x2_t b = __builtin_convertvector(v, bf16x2_t); return __builtin_bit_cast(unsigned, b); }
typedef short att_v4i16 __attribute__((ext_vector_type(4)));
__device__ __forceinline__ s16x4 vtr(lds_cptr p) { return __builtin_bit_cast(s16x4, __builtin_amdgcn_ds_read_tr16_b64_v4i16((__attribute__((address_space(3))) att_v4i16*)p)); }
#define ATT_MX3(a, b, c) __builtin_fmaxf(__builtin_fmaxf((a), (b)), (c))
__device__ __forceinline__ float rowmax(const f32x16& p0, const f32x16& p1) {
    float a = ATT_MX3(p0[0], p0[1], p1[0]), b = ATT_MX3(p0[2], p0[3], p1[1]); a = ATT_MX3(a, p1[2], p1[3]);
#pragma unroll
    for (int r = 4; r < 16; r += 4) { a = ATT_MX3(a, p0[r], p0[r + 1]); b = ATT_MX3(b, p0[r + 2], p0[r + 3]); a = ATT_MX3(a, p1[r], p1[r + 1]); b = ATT_MX3(b, p1[r + 2], p1[r + 3]); }
    float m = __builtin_fmaxf(a, b); auto rr = __builtin_amdgcn_permlane32_swap(__float_as_uint(m), __float_as_uint(m), false, false);
    return __builtin_fmaxf(__uint_as_float(rr[0]), __uint_as_float(rr[1])); }
__device__ __forceinline__ void pv(f32x16* o, int vb, bf16x8 pa0, bf16x8 pa1, bf16x8 pa2, bf16x8 pa3) {
#pragma unroll
    for (int d0 = 0; d0 < 2; ++d0) { s16x4 lo[4], hi[4];
#pragma unroll
        for (int ks = 0; ks < 4; ++ks) {
            asm volatile("ds_read_b64_tr_b16 %0,%1 offset:%c2" : "=&v"(lo[ks]) : "v"(vb), "i"(d0 * 4096 + ks * 1024) : "memory");
            asm volatile("ds_read_b64_tr_b16 %0,%1 offset:%c2" : "=&v"(hi[ks]) : "v"(vb), "i"(d0 * 4096 + ks * 1024 + 512) : "memory"); }
        asm volatile("s_waitcnt lgkmcnt(0)" ::: "memory"); ATT_SBAR();
#define ATT_PK(k) (bf16x8){lo[k][0], lo[k][1], lo[k][2], lo[k][3], hi[k][0], hi[k][1], hi[k][2], hi[k][3]}
        o[d0] = __builtin_amdgcn_mfma_f32_32x32x16_bf16(pa0, ATT_PK(0), o[d0], 0, 0, 0);
        o[d0] = __builtin_amdgcn_mfma_f32_32x32x16_bf16(pa1, ATT_PK(1), o[d0], 0, 0, 0);
        o[d0] = __builtin_amdgcn_mfma_f32_32x32x16_bf16(pa2, ATT_PK(2), o[d0], 0, 0, 0);
        o[d0] = __builtin_amdgcn_mfma_f32_32x32x16_bf16(pa3, ATT_PK(3), o[d0], 0, 0, 0);
#undef ATT_PK
    }
}
#define ATT_WAIT_BAR0() asm volatile("s_waitcnt vmcnt(0) lgkmcnt(0)\n\ts_barrier" ::: "memory")
template <int THRL>
__device__ __forceinline__ void attn_unit(int b, int h, int qb, const bf16* Q, const bf16* K, const bf16* V, bf16* O, char* shm) {
    const int tid = threadIdx.x, lane = tid & 63, r32 = lane & 31, hi = lane >> 5; const int wid = __builtin_amdgcn_readfirstlane(tid >> 6);
    const long rowbase = (long)b * SEQ; const int q0 = qb * 256; const int NTL = 4 * qb + 4, tmax = 4 * qb + (wid >> 1);
    const bf16* Qw = Q + (rowbase + q0 + wid * 32) * QP + h * DQK;
    const long bh = (long)b * MH + h;
    const bf16* ksrc0 = K + (bh * 128 * 12 + wid) * 512 + lane * 8;
    const bf16* ksrc1 = K + (bh * 128 * 12 + 8 + (wid & 3)) * 512 + lane * 8;
    const bf16* vsrc = V + (bh * 128 * 2 + (wid >> 2)) * 2048 + (16 * (wid & 3) + (lane >> 2)) * 32 + (lane & 3) * 8;
    const unsigned lds0 = (unsigned)(uintptr_t)shm;
    const unsigned kdst0 = lds0 + LDS_K + wid * 1024, kdst1 = lds0 + LDS_K + (8 + (wid & 3)) * 1024, vdst = lds0 + LDS_V + wid * 1024;
    float* wsf = (float*)(shm + LDS_WS) + wid * 64;
#define ATT_DMA(t, s) do { glds16(ksrc0 + (long)(t) * 6144, (unsigned)__builtin_amdgcn_readfirstlane(kdst0 + (s) * KSLOT)); \
        if (wid < 4) glds16(ksrc1 + (long)(t) * 6144, (unsigned)__builtin_amdgcn_readfirstlane(kdst1 + (s) * KSLOT)); \
        glds16(vsrc + (long)(t) * 4096, (unsigned)__builtin_amdgcn_readfirstlane(vdst + (s) * VSLOT)); } while (0)
    ATT_DMA(0, 0);
    bf16x8 qr[6];
#pragma unroll
    for (int d0 = 0; d0 < 6; ++d0) qr[d0] = *reinterpret_cast<const bf16x8*>(&Qw[(long)r32 * QP + d0 * 16 + hi * 8]);
    float mhat = 0.f, l_reg = 0.f; f32x16 o[2]; o[0] = f32x16{}; o[1] = f32x16{}; f32x16 negm = f32x16{}; asm volatile("" : "+v"(negm));
    const lds_cptr shm3 = (lds_cptr)shm;
    const int vlane = ((lane >> 4) & 1) * 32 + (lane & 3) * 8 + (4 * hi + ((lane & 15) >> 2)) * 64;
    u32x4 pw0 = (u32x4){0u, 0u, 0u, 0u}, pw1 = pw0, pw2 = pw0, pw3 = pw0;
    s16x4 vlo[8], vhi[8];
#define ATT_KRD(slot, d0) do { ka[slot] = *(const __attribute__((address_space(3))) bf16x8*)(kp + (d0) * 2048); kb[slot] = *(const __attribute__((address_space(3))) bf16x8*)(kp + (d0) * 2048 + 512); } while (0)
#define ATT_VRD(i) do { vlo[i] = vtr(vp + (((i) >> 2) * 4096 + ((i) & 3) * 1024)); vhi[i] = vtr(vp + (((i) >> 2) * 4096 + ((i) & 3) * 1024 + 512)); } while (0)
#define ATT_QKSM(t, s) do { \
        const lds_cptr kp = shm3 + LDS_K + (s) * KSLOT + hi * 1024 + r32 * 16; const lds_cptr vp = shm3 + LDS_V + (s) * VSLOT + vlane; \
        f32x16 p0, p1; bf16x8 ka[3], kb[3]; \
        ATT_KRD(0, 0); ATT_KRD(1, 1); ATT_SBAR(); \
        ATT_KRD(2, 2); p0 = __builtin_amdgcn_mfma_f32_32x32x16_bf16(ka[0], qr[0], negm, 0, 0, 0); p1 = __builtin_amdgcn_mfma_f32_32x32x16_bf16(kb[0], qr[0], negm, 0, 0, 0); ATT_VRD(0); ATT_VRD(1); ATT_SBAR(); \
        ATT_KRD(0, 3); p0 = __builtin_amdgcn_mfma_f32_32x32x16_bf16(ka[1], qr[1], p0, 0, 0, 0); p1 = __builtin_amdgcn_mfma_f32_32x32x16_bf16(kb[1], qr[1], p1, 0, 0, 0); ATT_VRD(2); ATT_VRD(3); ATT_SBAR(); \
        ATT_KRD(1, 4); p0 = __builtin_amdgcn_mfma_f32_32x32x16_bf16(ka[2], qr[2], p0, 0, 0, 0); p1 = __builtin_amdgcn_mfma_f32_32x32x16_bf16(kb[2], qr[2], p1, 0, 0, 0); ATT_VRD(4); ATT_VRD(5); ATT_SBAR(); \
        ATT_KRD(2, 5); p0 = __builtin_amdgcn_mfma_f32_32x32x16_bf16(ka[0], qr[3], p0, 0, 0, 0); p1 = __builtin_amdgcn_mfma_f32_32x32x16_bf16(kb[0], qr[3], p1, 0, 0, 0); ATT_VRD(6); ATT_VRD(7); ATT_SBAR(); \
        p0 = __builtin_amdgcn_mfma_f32_32x32x16_bf16(ka[1], qr[4], p0, 0, 0, 0); p1 = __builtin_amdgcn_mfma_f32_32x32x16_bf16(kb[1], qr[4], p1, 0, 0, 0); ATT_SBAR(); \
        p0 = __builtin_amdgcn_mfma_f32_32x32x16_bf16(ka[2], qr[5], p0, 0, 0, 0); p1 = __builtin_amdgcn_mfma_f32_32x32x16_bf16(kb[2], qr[5], p1, 0, 0, 0); ATT_SBAR(); \
        const float rm = rowmax(p0, p1); \
        if ((t) == 0) { mhat = rm; \
            _Pragma("unroll") for (int r = 0; r < 16; ++r) { p0[r] -= rm; p1[r] -= rm; } \
            _Pragma("unroll") for (int r = 0; r < 16; ++r) negm[r] = -mhat; \
            asm volatile("" : "+v"(negm)); \
        } else if (__any(rm > (float)THRL)) { const float dl = __builtin_fmaxf(rm, 0.f); mhat += dl; \
            _Pragma("unroll") for (int r = 0; r < 16; ++r) { p0[r] -= dl; p1[r] -= dl; } \
            _Pragma("unroll") for (int r = 0; r < 16; ++r) negm[r] = -mhat; \
            asm volatile("" : "+v"(negm)); \
            const float f = __builtin_amdgcn_exp2f(-dl); l_reg *= f; if (hi == 0) wsf[r32] = f; \
            asm volatile("s_waitcnt lgkmcnt(0)" ::: "memory"); \
            _Pragma("unroll") for (int d_ = 0; d_ < 2; ++d_) _Pragma("unroll") for (int r = 0; r < 16; ++r) o[d_][r] *= wsf[crow(r, hi)]; } \
        float sacc = 0.f; \
        _Pragma("unroll") for (int r = 0; r < 16; ++r) { p0[r] = __builtin_amdgcn_exp2f(p0[r]); p1[r] = __builtin_amdgcn_exp2f(p1[r]); sacc += p0[r] + p1[r]; } \
        l_reg += sacc; \
        pw0 = (u32x4){cvtpk_s(p0[0], p0[1]), cvtpk_s(p0[2], p0[3]), cvtpk_s(p0[4], p0[5]), cvtpk_s(p0[6], p0[7])}; \
        pw1 = (u32x4){cvtpk_s(p0[8], p0[9]), cvtpk_s(p0[10], p0[11]), cvtpk_s(p0[12], p0[13]), cvtpk_s(p0[14], p0[15])}; \
        pw2 = (u32x4){cvtpk_s(p1[0], p1[1]), cvtpk_s(p1[2], p1[3]), cvtpk_s(p1[4], p1[5]), cvtpk_s(p1[6], p1[7])}; \
        pw3 = (u32x4){cvtpk_s(p1[8], p1[9]), cvtpk_s(p1[10], p1[11]), cvtpk_s(p1[12], p1[13]), cvtpk_s(p1[14], p1[15])}; \
    } while (0)
#define ATT_VFR(i) (bf16x8){vlo[i][0], vlo[i][1], vlo[i][2], vlo[i][3], vhi[i][0], vhi[i][1], vhi[i][2], vhi[i][3]}
#define ATT_PV(s) do { ATT_SBAR(); \
        o[0] = __builtin_amdgcn_mfma_f32_32x32x16_bf16(__builtin_bit_cast(bf16x8, pw0), ATT_VFR(0), o[0], 0, 0, 0); o[1] = __builtin_amdgcn_mfma_f32_32x32x16_bf16(__builtin_bit_cast(bf16x8, pw0), ATT_VFR(4), o[1], 0, 0, 0); \
        o[0] = __builtin_amdgcn_mfma_f32_32x32x16_bf16(__builtin_bit_cast(bf16x8, pw1), ATT_VFR(1), o[0], 0, 0, 0); o[1] = __builtin_amdgcn_mfma_f32_32x32x16_bf16(__builtin_bit_cast(bf16x8, pw1), ATT_VFR(5), o[1], 0, 0, 0); \
        o[0] = __builtin_amdgcn_mfma_f32_32x32x16_bf16(__builtin_bit_cast(bf16x8, pw2), ATT_VFR(2), o[0], 0, 0, 0); o[1] = __builtin_amdgcn_mfma_f32_32x32x16_bf16(__builtin_bit_cast(bf16x8, pw2), ATT_VFR(6), o[1], 0, 0, 0); \
        o[0] = __builtin_amdgcn_mfma_f32_32x32x16_bf16(__builtin_bit_cast(bf16x8, pw3), ATT_VFR(3), o[0], 0, 0, 0); o[1] = __builtin_amdgcn_mfma_f32_32x32x16_bf16(__builtin_bit_cast(bf16x8, pw3), ATT_VFR(7), o[1], 0, 0, 0); \
    } while (0)
    int s_cur = 0, s_prev = 2;
    if (wid < 4) {
        for (int t = 0; t < NTL; ++t) {
            ATT_WAIT_BAR0();
            const int s_next = (s_cur == 2) ? 0 : s_cur + 1;
            if (t + 1 < NTL) ATT_DMA(t + 1, s_next);
            if (t <= tmax) { ATT_QKSM(t, s_cur); ATT_PV(s_cur); }
            s_prev = s_cur; s_cur = s_next;
        }
    } else {
        for (int t = 0; t < NTL; ++t) {
            ATT_WAIT_BAR0();
            const int s_next = (s_cur == 2) ? 0 : s_cur + 1;
            if (t + 1 < NTL) ATT_DMA(t + 1, s_next);
            if (t >= 1 && t - 1 <= tmax) ATT_PV(s_prev);
            if (t <= tmax) ATT_QKSM(t, s_cur);
            s_prev = s_cur; s_cur = s_next;
        }
        if (NTL - 1 <= tmax) ATT_PV(s_prev);
    }
    { auto rr = __builtin_amdgcn_permlane32_swap(__float_as_uint(l_reg), __float_as_uint(l_reg), false, false); l_reg = __uint_as_float(rr[0]) + __uint_as_float(rr[1]); }
    if (hi == 0) wsf[32 + r32] = l_reg;
    asm volatile("s_waitcnt lgkmcnt(0)" ::: "memory");
    float rli[16];
#pragma unroll
    for (int r = 0; r < 16; ++r) rli[r] = __builtin_amdgcn_rcpf(wsf[32 + crow(r, hi)]);
    const long orow0 = rowbase + q0 + wid * 32; const int ocol0 = 512 + h * MV;
    { bf16* stg = (bf16*)(shm + LDS_OST) + wid * 2048;
#pragma unroll
        for (int r = 0; r < 16; ++r) { const int orow = crow(r, hi);
#pragma unroll
            for (int d0 = 0; d0 < 2; ++d0) stg[orow * 64 + d0 * 32 + r32] = (bf16)f2bf(o[d0][r] * rli[r]); }
        asm volatile("s_waitcnt lgkmcnt(0)" ::: "memory");
#pragma unroll
        for (int i = 0; i < 4; ++i) { const int row = i * 8 + (lane >> 3), ch = lane & 7; const u32x4 v = *(const u32x4*)(stg + row * 64 + ch * 8); const long r = orow0 + row; const int c = ocol0 + ch * 8;
            *(u32x4*)(O + ((r >> 4) * 32 + (c >> 5)) * 512 + (r & 15) * 32 + (c & 31)) = v; } }
    asm volatile("s_waitcnt lgkmcnt(0)\n\ts_barrier" ::: "memory");
#undef ATT_DMA
#undef ATT_QKSM
#undef ATT_KRD
#undef ATT_VRD
#undef ATT_VFR
#undef ATT_PV
}
__device__ __forceinline__ void attn_phase(const Ctx& C, char* lds) {
    const bf16* QF = (const bf16*)(C.ws + WS_QF); const bf16* KF = (const bf16*)(C.ws + WS_KF); const bf16* VF = (const bf16*)(C.ws + WS_VF); bf16* O = (bf16*)(C.ws + WS_B);
    const int G = (int)gridDim.x, bx = (int)blockIdx.x; const int vcu = (G % 8 == 0) ? (bx % 8) * (G / 8) + bx / 8 : bx;
    for (int i = vcu; i < BATCH * MH * 32; i += G) { const int bh = (i & 255) >> 4, s = i & 15, qb = (i < 256) ? 31 - s : s;
        attn_unit<8>(bh >> 3, bh & 7, qb, QF, KF, VF, O, lds); }
    __syncthreads();
}
}

namespace gla {
using att::bf16x8; using att::s16x4; using att::f32x16; using att::lds_cptr; using att::crow; using att::cvtpk_s;
constexpr int L_VIMG = 0, L_QIMG = 16384, L_KIMG = 24576, L_WT = 32768, L_OBUF = 36864, OLD = 132, L_WG = 73728, L_BG = L_WG + 16384;
#define GLA_BAR() asm volatile("s_waitcnt lgkmcnt(0)\n\ts_barrier" ::: "memory")
__device__ __forceinline__ void stage_gate(const Ctx& C, unsigned char* lds) {
    const int tid = threadIdx.x;
#pragma unroll
    for (int i = 0; i < 2; ++i) *(f32x4*)(lds + L_WG + (tid + NT * i) * 16) = *(const f32x4*)(C.w_gate_up + (tid + NT * i) * 4);
    if (tid < 64) *(f32x4*)(lds + L_BG + tid * 16) = *(const f32x4*)(C.b_gate + tid * 4);
}
__device__ __forceinline__ void cum_rows(const u32x4 g0, const u32x4 g1, int h, const unsigned char* lds, float (&cum)[8], float (&tot)[8]) {
    const int tid = threadIdx.x, lane = tid & 63; const int wv = __builtin_amdgcn_readfirstlane(tid >> 6);
    float zg[16];
    { float a[8], b[8]; unpack8(g0, a); unpack8(g1, b);
#pragma unroll
      for (int j = 0; j < 8; ++j) { zg[j] = a[j]; zg[8 + j] = b[j]; } }
    float x[8];
    { const f32x4 b0 = *(const f32x4*)(lds + L_BG + (h * 64 + 8 * wv) * 4), b1 = *(const f32x4*)(lds + L_BG + (h * 64 + 8 * wv + 4) * 4);
      x[0] = b0.x; x[1] = b0.y; x[2] = b0.z; x[3] = b0.w; x[4] = b1.x; x[5] = b1.y; x[6] = b1.z; x[7] = b1.w; }
#pragma unroll
    for (int gh = 0; gh < 2; ++gh) { f32x4 w0[8], w1[8];
#pragma unroll
        for (int g = 0; g < 8; ++g) { w0[g] = *(const f32x4*)(lds + L_WG + ((gh * 8 + g) * 256 + h * 64 + 8 * wv) * 4); w1[g] = *(const f32x4*)(lds + L_WG + ((gh * 8 + g) * 256 + h * 64 + 8 * wv + 4) * 4); }
#pragma unroll
        for (int g = 0; g < 8; ++g) { const float z = zg[gh * 8 + g];
            x[0] += z * w0[g].x; x[1] += z * w0[g].y; x[2] += z * w0[g].z; x[3] += z * w0[g].w; x[4] += z * w1[g].x; x[5] += z * w1[g].y; x[6] += z * w1[g].z; x[7] += z * w1[g].w; } }
#pragma unroll
    for (int j = 0; j < 8; ++j) x[j] = log_gate(x[j]);
#define GLA_DPP(v, ctrl, rmask) __builtin_bit_cast(float, __builtin_amdgcn_update_dpp(0, __builtin_bit_cast(int, (v)), (ctrl), (rmask), 0xF, true))
#pragma unroll
    for (int j = 0; j < 8; ++j) { float v = x[j];
        v += GLA_DPP(v, 0x111, 0xF); v += GLA_DPP(v, 0x112, 0xF); v += GLA_DPP(v, 0x114, 0xF); v += GLA_DPP(v, 0x118, 0xF);
        v += GLA_DPP(v, 0x142, 0xA); v += GLA_DPP(v, 0x143, 0xC);
        cum[j] = v; tot[j] = __builtin_bit_cast(float, __builtin_amdgcn_readlane(__builtin_bit_cast(int, v), 63)); }
#undef GLA_DPP
}
__device__ __forceinline__ void trfrag4(int base, bf16x8 (&f)[4]) {
    s16x4 lo[4], hi[4];
#pragma unroll
    for (int ks = 0; ks < 4; ++ks) {
        asm volatile("ds_read_b64_tr_b16 %0,%1 offset:%c2" : "=&v"(lo[ks]) : "v"(base), "i"(ks * 1024) : "memory");
        asm volatile("ds_read_b64_tr_b16 %0,%1 offset:%c2" : "=&v"(hi[ks]) : "v"(base), "i"(ks * 1024 + 512) : "memory"); }
    asm volatile("s_waitcnt lgkmcnt(0)" ::: "memory"); __builtin_amdgcn_sched_barrier(0);
#pragma unroll
    for (int ks = 0; ks < 4; ++ks) f[ks] = (bf16x8){lo[ks][0], lo[ks][1], lo[ks][2], lo[ks][3], hi[ks][0], hi[ks][1], hi[ks][2], hi[ks][3]};
}
struct Raw { u32x4 q, k, v0, v1, g0, g1, z0, z1; bf16x8 pf[4]; };
template <bool P2>
__device__ __forceinline__ void load_raw(const Ctx& C, int u, Raw& R) {
    const bf16* Z = (const bf16*)(C.ws + WS_Z); const bf16* PREV = (const bf16*)(C.ws + WS_A);
    const int tid = threadIdx.x, lane = tid & 63, r32 = lane & 31, hi = lane >> 5, c = tid >> 3, dc = tid & 7; const int wv = __builtin_amdgcn_readfirstlane(tid >> 6);
    const int n = u % NCH, h = (u / NCH) % GH, b = u / (NCH * GH); const int row0 = b * SEQ + n * 64;
    const size_t rl_ = (size_t)(row0 + lane);
    R.k = *(const u32x4*)(Z + ztile(rl_, ZC_K + h * 64 + 8 * wv)); R.g0 = *(const u32x4*)(Z + ztile(rl_, ZC_GATE)); R.g1 = *(const u32x4*)(Z + ztile(rl_, ZC_GATE + 8));
    { const int j = tid >> 4, cc = tid & 15; R.v0 = *(const u32x4*)(Z + ztile((size_t)(row0 + j), ZC_V + h * 128 + cc * 8)); R.v1 = *(const u32x4*)(Z + ztile((size_t)(row0 + 32 + j), ZC_V + h * 128 + cc * 8)); }
    if (P2) { R.q = *(const u32x4*)(Z + ztile(rl_, ZC_Q + h * 64 + 8 * wv)); const size_t rc_ = (size_t)(row0 + c); R.z0 = *(const u32x4*)(Z + ztile(rc_, ZC_G + h * 128 + 16 * dc)); R.z1 = *(const u32x4*)(Z + ztile(rc_, ZC_G + h * 128 + 16 * dc + 8));
        const int cb = wv & 3;
#pragma unroll
        for (int s = 0; s < 4; ++s) R.pf[s] = *(const bf16x8*)(PREV + ((size_t)u * 128 + 32 * cb + r32) * 64 + 16 * s + 8 * hi); }
}
__device__ __forceinline__ void store_vimg(const Raw& R, unsigned char* lds) {
    const int tid = threadIdx.x, j = tid >> 4, cc = tid & 15;
    *(u32x4*)(lds + L_VIMG + (cc >> 2) * 4096 + j * 64 + (cc & 3) * 16) = R.v0; *(u32x4*)(lds + L_VIMG + (cc >> 2) * 4096 + (32 + j) * 64 + (cc & 3) * 16) = R.v1;
}
__device__ __forceinline__ void pass1(const Ctx& C, unsigned char* lds) {
    float* CKV = (float*)(C.ws + WS_CKV); float* DEC = (float*)(C.ws + WS_DEC);
    const int tid = threadIdx.x, lane = tid & 63, r32 = lane & 31, hi = lane >> 5, c = tid >> 3, dc = tid & 7; const int wv = __builtin_amdgcn_readfirstlane(tid >> 6);
    const unsigned lds0 = (unsigned)(uintptr_t)lds; const int lpart = ((lane >> 4) & 1) * 32 + (lane & 3) * 8 + (4 * hi + ((lane & 15) >> 2)) * 64;
    const int NU = BATCH * GH * NCH, G = (int)gridDim.x;
    __syncthreads(); stage_gate(C, lds);
    Raw cur; if ((int)blockIdx.x < NU) load_raw<false>(C, (int)blockIdx.x, cur);
    for (int u = blockIdx.x; u < NU; u += G) {
        const int h = (u / NCH) % GH;
        Raw nxt = cur; if (u + G < NU) load_raw<false>(C, u + G, nxt);
        GLA_BAR();
        store_vimg(cur, lds);
        float kv[8]; unpack8(cur.k, kv);
        float cum[8], tot[8]; cum_rows(cur.g0, cur.g1, h, lds, cum, tot);
#pragma unroll
        for (int j = 0; j < 8; ++j) kv[j] *= fexp(tot[j] - cum[j]);
        *(u32x4*)(lds + L_QIMG + (wv >> 2) * 4096 + lane * 64 + (wv & 3) * 16) = pack8(kv);
        if (lane == 63) {
#pragma unroll
            for (int j = 0; j < 8; ++j) DEC[(size_t)u * 64 + 8 * wv + j] = fexp(tot[j]); }
        GLA_BAR();
        const int vb = wv >> 1, db = wv & 1;
        bf16x8 af[4], bfr[4]; trfrag4((int)(lds0 + L_VIMG + vb * 4096) + lpart, af); trfrag4((int)(lds0 + L_QIMG + db * 4096) + lpart, bfr);
        f32x16 o = f32x16{};
#pragma unroll
        for (int ks = 0; ks < 4; ++ks) o = __builtin_amdgcn_mfma_f32_32x32x16_bf16(af[ks], bfr[ks], o, 0, 0, 0);
#pragma unroll
        for (int r = 0; r < 16; ++r) CKV[((size_t)u * 128 + 32 * vb + crow(r, hi)) * 64 + 32 * db + r32] = o[r];
        cur = nxt;
    }
    __syncthreads();
}
__device__ __forceinline__ void pass2(const Ctx& C, unsigned char* lds) {
    bf16* MIX = (bf16*)(C.ws + WS_B);
    const int tid = threadIdx.x, lane = tid & 63, r32 = lane & 31, hi = lane >> 5, c = tid >> 3, dc = tid & 7; const int wv = __builtin_amdgcn_readfirstlane(tid >> 6);
    const unsigned lds0 = (unsigned)(uintptr_t)lds; const int lpart = ((lane >> 4) & 1) * 32 + (lane & 3) * 8 + (4 * hi + ((lane & 15) >> 2)) * 64;
    const lds_cptr L3 = (lds_cptr)lds; float* obuf = (float*)(lds + L_OBUF);
    const int rb = wv >> 2, cb = wv & 3;
    const int NU = BATCH * GH * NCH, G = (int)gridDim.x;
    f32x4 gn[4];
#pragma unroll
    for (int i = 0; i < 4; ++i) gn[i] = *(const f32x4*)(C.gla_out_norm + 16 * dc + 4 * i);
    __syncthreads(); stage_gate(C, lds);
    Raw cur; if ((int)blockIdx.x < NU) load_raw<true>(C, (int)blockIdx.x, cur);
    for (int u = blockIdx.x; u < NU; u += G) {
        const int n = u % NCH, h = (u / NCH) % GH, b = u / (NCH * GH); const int row0 = b * SEQ + n * 64;
        Raw nxt = cur; if (u + G < NU) load_raw<true>(C, u + G, nxt);
        GLA_BAR();
        store_vimg(cur, lds);
        float qv[8], kv[8]; unpack8(cur.q, qv); unpack8(cur.k, kv);
        float cum[8], tot[8]; cum_rows(cur.g0, cur.g1, h, lds, cum, tot);
#pragma unroll
        for (int j = 0; j < 8; ++j) { qv[j] *= 0.125f * fexp(cum[j]); kv[j] *= fexp(-cum[j]); }
        *(u32x4*)(lds + L_QIMG + wv * 1024 + lane * 16) = pack8(qv); *(u32x4*)(lds + L_KIMG + wv * 1024 + lane * 16) = pack8(kv);
        GLA_BAR();
        bf16x8 qr[4];
#pragma unroll
        for (int s = 0; s < 4; ++s) qr[s] = *(const __attribute__((address_space(3))) bf16x8*)(L3 + L_QIMG + (2 * s + hi) * 1024 + (32 * rb + r32) * 16);
        f32x16 p0 = f32x16{}, p1 = f32x16{};
#pragma unroll
        for (int s = 0; s < 4; ++s) { const lds_cptr kp = L3 + L_KIMG + (2 * s + hi) * 1024 + r32 * 16;
            const bf16x8 a0 = *(const __attribute__((address_space(3))) bf16x8*)(kp), a1 = *(const __attribute__((address_space(3))) bf16x8*)(kp + 512);
            p0 = __builtin_amdgcn_mfma_f32_32x32x16_bf16(a0, qr[s], p0, 0, 0, 0); p1 = __builtin_amdgcn_mfma_f32_32x32x16_bf16(a1, qr[s], p1, 0, 0, 0); }
        const int cq = 32 * rb + r32;
#pragma unroll
        for (int r = 0; r < 16; ++r) { const int j = crow(r, hi); p0[r] = (j <= cq) ? p0[r] : 0.f; p1[r] = (j + 32 <= cq) ? p1[r] : 0.f; }
        u32x4 pw0, pw1, pw2, pw3;
        pw0 = (u32x4){cvtpk_s(p0[0], p0[1]), cvtpk_s(p0[2], p0[3]), cvtpk_s(p0[4], p0[5]), cvtpk_s(p0[6], p0[7])};
        pw1 = (u32x4){cvtpk_s(p0[8], p0[9]), cvtpk_s(p0[10], p0[11]), cvtpk_s(p0[12], p0[13]), cvtpk_s(p0[14], p0[15])};
        pw2 = (u32x4){cvtpk_s(p1[0], p1[1]), cvtpk_s(p1[2], p1[3]), cvtpk_s(p1[4], p1[5]), cvtpk_s(p1[6], p1[7])};
        pw3 = (u32x4){cvtpk_s(p1[8], p1[9]), cvtpk_s(p1[10], p1[11]), cvtpk_s(p1[12], p1[13]), cvtpk_s(p1[14], p1[15])};
        __builtin_amdgcn_sched_barrier(0);
        bf16x8 vf[4]; trfrag4((int)(lds0 + L_VIMG + cb * 4096) + lpart, vf);
        f32x16 o = f32x16{};
        o = __builtin_amdgcn_mfma_f32_32x32x16_bf16(__builtin_bit_cast(bf16x8, pw0), vf[0], o, 0, 0, 0);
        o = __builtin_amdgcn_mfma_f32_32x32x16_bf16(__builtin_bit_cast(bf16x8, pw1), vf[1], o, 0, 0, 0);
        o = __builtin_amdgcn_mfma_f32_32x32x16_bf16(__builtin_bit_cast(bf16x8, pw2), vf[2], o, 0, 0, 0);
        o = __builtin_amdgcn_mfma_f32_32x32x16_bf16(__builtin_bit_cast(bf16x8, pw3), vf[3], o, 0, 0, 0);
#pragma unroll
        for (int s = 0; s < 4; ++s) o = __builtin_amdgcn_mfma_f32_32x32x16_bf16(qr[s], cur.pf[s], o, 0, 0, 0);
#pragma unroll
        for (int r = 0; r < 16; ++r) obuf[(32 * rb + crow(r, hi)) * OLD + 32 * cb + r32] = o[r];
        GLA_BAR();
        { float ov[16];
#pragma unroll
            for (int i = 0; i < 4; ++i) { const f32x4 t = *(const f32x4*)(obuf + c * OLD + 16 * dc + 4 * i); ov[4 * i] = t.x; ov[4 * i + 1] = t.y; ov[4 * i + 2] = t.z; ov[4 * i + 3] = t.w; }
            float ss = 0.f;
#pragma unroll
            for (int i = 0; i < 16; ++i) ss += ov[i] * ov[i];
            ss += __shfl_xor(ss, 1); ss += __shfl_xor(ss, 2); ss += __shfl_xor(ss, 4);
            const float rn = rsqrtf(ss * (1.f / GDV) + EPS); const size_t row = (size_t)(row0 + c);
            float g0[8], g1[8]; unpack8(cur.z0, g0); unpack8(cur.z1, g1);
            const float gv[16] = {gn[0].x, gn[0].y, gn[0].z, gn[0].w, gn[1].x, gn[1].y, gn[1].z, gn[1].w, gn[2].x, gn[2].y, gn[2].z, gn[2].w, gn[3].x, gn[3].y, gn[3].z, gn[3].w};
            float w0[8], w1[8];
#pragma unroll
            for (int i = 0; i < 8; ++i) { w0[i] = ov[i] * rn * gv[i] * silu_f(g0[i]); w1[i] = ov[8 + i] * rn * gv[8 + i] * silu_f(g1[i]); }
            { const int c0 = h * 128 + 16 * dc; bf16* mp = MIX + ((row >> 4) * 32 + (c0 >> 5)) * 512 + (row & 15) * 32 + (c0 & 31);
              *(u32x4*)mp = pack8(w0); *(u32x4*)(mp + 8) = pack8(w1); } }
        cur = nxt;
    }
    __syncthreads();
}
#undef GLA_BAR
}

namespace pg8 {
#define PG8_LAS __attribute__((address_space(3)))
typedef unsigned short bf16_t;
typedef short bf16x8 __attribute__((ext_vector_type(8)));
typedef float f32x4 __attribute__((ext_vector_type(4)));
typedef unsigned u32x4 __attribute__((ext_vector_type(4)));
constexpr int BM = 256, BK = 64, HALF = 128, HTB = HALF * BK * 2  , STAGE_BYTES = 8 * HTB, NXCD = 8, WGM = 8;

__host__ __device__ __forceinline__ int lds_byte(int r, int c) { const int st = (r >> 4) * 2 + (c >> 5), rr = r & 15, cc = c & 31, ob = rr * 64 + cc * 2; return st * 1024 + (ob ^ (((ob >> 9) & 1) << 5)); }
__host__ __device__ __forceinline__ void stage_rc(int b, int& R, int& C) { const int st = b / 1024, sb = b % 1024, swz = sb ^ (((sb >> 9) & 1) << 5); R = (st >> 1) * 16 + swz / 64; C = (st & 1) * 32 + (swz % 64) / 2; }
__host__ __device__ __forceinline__ int perm32(int rho) { const int n = rho >> 4, i = rho & 15; return 8 * (i >> 2) + 4 * n + (i & 3); }

struct Unit { int pm, pn; };
struct Gemm { const bf16_t* A; const bf16_t* Bt; int M, N, K, lda; bool ta, tb; };

struct StaticOrder {
    int nM, nN, nwg, G, c;
    __host__ __device__ void init(int M, int N, int G_, int c_) { nM = M / BM; nN = N / BM; nwg = nM * nN; G = G_; c = c_; }
    __host__ __device__ bool next(int i, Unit& u) const {
        const long L = (long)i * G + c; if (L >= nwg) return false;
        int wgid = (int)L; { const int q = nwg / NXCD, r = nwg % NXCD, xcd = wgid % NXCD, off = wgid / NXCD; wgid = (xcd < r ? xcd * (q + 1) : r * (q + 1) + (xcd - r) * q) + off; }
        const int nig = WGM * nN, gid = wgid / nig, fm = gid * WGM, gsz = (nM - fm) < WGM ? (nM - fm) : WGM;
        u.pm = fm + ((wgid % nig) % gsz); u.pn = (wgid % nig) / gsz; return true;
    }
    __device__ __forceinline__ void a_ready(const Unit&) const {}
    __device__ __forceinline__ void done(const Unit&) const {}
};

__device__ __forceinline__ unsigned cvt_pk_bf16(float lo, float hi) { unsigned r; asm volatile("v_cvt_pk_bf16_f32 %0, %1, %2" : "=v"(r) : "v"(lo), "v"(hi)); return r; }
typedef float f32x2 __attribute__((ext_vector_type(2)));
typedef unsigned u32x2v __attribute__((ext_vector_type(2)));
struct EpiBf16 {
    static constexpr bool PERM = true, AFTER_DRAIN = false; static constexpr int PROBE_BIT = 26;
    bf16_t* O; int ldc;
    __device__ __forceinline__ void operator()(const f32x4 (&acc)[2][2][4][2], const Unit& u, int wr, int wc, int fr, int fq) const {
        const int row0 = u.pm * BM + wr * 64 + fr, col0 = u.pn * BM + wc * 32 + 8 * fq;
#pragma unroll
        for (int ai = 0; ai < 2; ++ai)
#pragma unroll
            for (int m = 0; m < 4; ++m) { bf16_t* rowp = O + (size_t)(row0 + ai * HALF + m * 16) * ldc + col0;
#pragma unroll
                for (int bj = 0; bj < 2; ++bj) { const f32x4 v0 = acc[ai][bj][m][0], v1 = acc[ai][bj][m][1];
                    u32x4 w; w.x = cvt_pk_bf16(v0[0], v0[1]); w.y = cvt_pk_bf16(v0[2], v0[3]); w.z = cvt_pk_bf16(v1[0], v1[1]); w.w = cvt_pk_bf16(v1[2], v1[3]);
                    *(u32x4*)(rowp + bj * HALF) = w; } }
    }
};
struct EpiZ {
    static constexpr bool PERM = true, AFTER_DRAIN = false; static constexpr int PROBE_BIT = 27;
    bf16_t* O; int ldc; float* ssqq; float* ssqkv; float* ssqpe;
    __device__ __forceinline__ void operator()(const f32x4 (&acc)[2][2][4][2], const Unit& u, int wr, int wc, int fr, int fq) const {
        const int row0 = u.pm * BM + wr * 64 + fr, col0 = u.pn * BM + wc * 32 + 8 * fq;
#pragma unroll
        for (int ai = 0; ai < 2; ++ai)
#pragma unroll
            for (int m = 0; m < 4; ++m) { const int r = row0 + ai * HALF + m * 16; bf16_t* rowp = O + ((size_t)(r >> 4) * (ldc >> 5) + (col0 >> 5)) * 512 + (r & 15) * 32 + (col0 & 31); float sq[2];
#pragma unroll
                for (int bj = 0; bj < 2; ++bj) { const f32x4 v0 = acc[ai][bj][m][0], v1 = acc[ai][bj][m][1];
                    u32x4 w; w.x = cvt_pk_bf16(v0[0], v0[1]); w.y = cvt_pk_bf16(v0[2], v0[3]); w.z = cvt_pk_bf16(v1[0], v1[1]); w.w = cvt_pk_bf16(v1[2], v1[3]);
                    *(u32x4*)(rowp + bj * 4 * 512) = w;
                    sq[bj] = ((v0[0] * v0[0] + v0[1] * v0[1]) + (v0[2] * v0[2] + v0[3] * v0[3])) + ((v1[0] * v1[0] + v1[1] * v1[1]) + (v1[2] * v1[2] + v1[3] * v1[3])); }
                if (u.pn == 6) { float s = sq[0] + sq[1]; s += __shfl_xor(s, 16); s += __shfl_xor(s, 32); if (fq == 0) ssqq[(size_t)r * 4 + wc] = s; }
                else if (u.pn == 7) { float s = sq[0]; s += __shfl_xor(s, 16); s += __shfl_xor(s, 32); if (fq == 0) ssqkv[(size_t)r * 4 + wc] = s;
                    if (wc == 0) { float t = sq[1]; t += __shfl_xor(t, 16); t += __shfl_xor(t, 32); if (fq == 0) ssqpe[r] = t; } } }
    }
};
struct EpiQ {
    static constexpr bool PERM = false, AFTER_DRAIN = true; static constexpr int PROBE_BIT = 25;
    const float* ssqq; const float* gq; const float* cosT; const float* sinT; bf16_t* QF; float eps, qscale;
    __device__ __forceinline__ void fused(f32x4 (&acc)[2][2][4][2], const Unit& u, int wr, int wc, int fr, int fq, PG8_LAS unsigned char* lds, int wid, int lane) const {
        PG8_LAS float* P = (PG8_LAS float*)lds;
        f32x4 s4A[2][4];
#pragma unroll
        for (int ai = 0; ai < 2; ++ai)
#pragma unroll
            for (int m = 0; m < 4; ++m) s4A[ai][m] = *(const f32x4*)(ssqq + (size_t)(u.pm * BM + ai * HALF + wr * 64 + m * 16 + fr) * 4);
        __builtin_amdgcn_sched_barrier(0);
#pragma unroll
        for (int ai = 0; ai < 2; ++ai)
#pragma unroll
            for (int m = 0; m < 4; ++m) { const int rl = ai * HALF + wr * 64 + m * 16 + fr; const f32x4 s4 = s4A[ai][m];
                const float ra = __builtin_amdgcn_rsqf(((s4[0] + s4[1]) + (s4[2] + s4[3])) * (1.0f / 256.0f) + eps);
#pragma unroll
                for (int bj = 0; bj < 2; ++bj) { float s = 0.f;
#pragma unroll
                    for (int n = 0; n < 2; ++n) { const f32x4 v = acc[ai][bj][m][n] * ra; acc[ai][bj][m][n] = v; s += (v[0] * v[0] + v[1] * v[1]) + (v[2] * v[2] + v[3] * v[3]); }
                    s += __shfl_xor(s, 16); s += __shfl_xor(s, 32);
                    if (fq == 0) P[(rl * 2 + bj) * 4 + wc] = s; } }
        asm volatile("s_waitcnt lgkmcnt(0)" ::: "memory"); __builtin_amdgcn_s_barrier(); asm volatile("" ::: "memory");
        PG8_LAS unsigned char* ST = lds + 8192;
        if (wc < 3) {
            const int j0 = wc * 32 + 4 * fq; const f32x4 g0 = *(const f32x4*)(gq + j0), g1 = *(const f32x4*)(gq + j0 + 16);
            f32x4 csA[2][4], snA[2][4];
#pragma unroll
            for (int ai = 0; ai < 2; ++ai)
#pragma unroll
                for (int m = 0; m < 4; ++m) { const size_t r = (size_t)(u.pm * BM + ai * HALF + wr * 64 + m * 16 + fr); csA[ai][m] = (f32x4){1.f, 1.f, 1.f, 1.f}; snA[ai][m] = (f32x4){0.f, 0.f, 0.f, 0.f};
                    if (wc == 2) { csA[ai][m] = *(const f32x4*)(cosT + r * 16 + 4 * fq); snA[ai][m] = *(const f32x4*)(sinT + r * 16 + 4 * fq); } }
            __builtin_amdgcn_sched_barrier(0);
#pragma unroll
            for (int ai = 0; ai < 2; ++ai)
#pragma unroll
                for (int m = 0; m < 4; ++m) { const int rl = ai * HALF + wr * 64 + m * 16 + fr; const f32x4 cs = csA[ai][m], sn = snA[ai][m];
#pragma unroll
                    for (int bj = 0; bj < 2; ++bj) { const f32x4 p = *(const PG8_LAS f32x4*)(P + (rl * 2 + bj) * 4);
                        const float rh = qscale * __builtin_amdgcn_rsqf(((p[0] + p[1]) + (p[2] + p[3])) * (1.0f / 96.0f) + eps);
                        const f32x4 a = acc[ai][bj][m][0] * rh * g0, b = acc[ai][bj][m][1] * rh * g1;
                        f32x4 o0 = a, o1 = b; if (wc == 2) { o0 = a * cs - b * sn; o1 = a * sn + b * cs; }
                        PG8_LAS unsigned char* dst = ST + rl * 400 + (bj * 96 + j0) * 2;
                        u32x2v w0, w1; w0.x = cvt_pk_bf16(o0[0], o0[1]); w0.y = cvt_pk_bf16(o0[2], o0[3]); w1.x = cvt_pk_bf16(o1[0], o1[1]); w1.y = cvt_pk_bf16(o1[2], o1[3]);
                        *(PG8_LAS u32x2v*)dst = w0; *(PG8_LAS u32x2v*)(dst + 32) = w1; }
                    }
        }
        asm volatile("s_waitcnt lgkmcnt(0)" ::: "memory"); __builtin_amdgcn_s_barrier(); asm volatile("" ::: "memory");
        { const int tid = wid * 64 + lane;
#pragma unroll
            for (int i = 0; i < 12; ++i) { const int idx = tid + 512 * i, row = idx / 24, ch = idx - row * 24;
                *(u32x4*)(QF + (size_t)(u.pm * BM + row) * 768 + (2 * u.pn) * 96 + ch * 8) = *(const PG8_LAS u32x4*)(ST + row * 400 + ch * 16); } }
    }
};
struct EpiKV {
    static constexpr bool PERM = false, AFTER_DRAIN = true; static constexpr int PROBE_BIT = 24;
    const float* ssqkv; const float* ssqpe; const float* gk; const float* cosT; const float* sinT; const bf16_t* Z; bf16_t* KF; bf16_t* VF; float eps;
    __device__ __forceinline__ void fused(f32x4 (&acc)[2][2][4][2], const Unit& u, int wr, int wc, int fr, int fq, PG8_LAS unsigned char* lds, int wid, int lane) const {
        PG8_LAS float* P = (PG8_LAS float*)lds;
        f32x4 s4A[2][4];
#pragma unroll
        for (int ai = 0; ai < 2; ++ai)
#pragma unroll
            for (int m = 0; m < 4; ++m) s4A[ai][m] = *(const f32x4*)(ssqkv + (size_t)(u.pm * BM + ai * HALF + wr * 64 + m * 16 + fr) * 4);
        __builtin_amdgcn_sched_barrier(0);
#pragma unroll
        for (int ai = 0; ai < 2; ++ai)
#pragma unroll
            for (int m = 0; m < 4; ++m) { const int rl = ai * HALF + wr * 64 + m * 16 + fr; const f32x4 s4 = s4A[ai][m];
                const float ra = __builtin_amdgcn_rsqf(((s4[0] + s4[1]) + (s4[2] + s4[3])) * (1.0f / 128.0f) + eps);
#pragma unroll
                for (int bj = 0; bj < 2; ++bj) { float s = 0.f;
#pragma unroll
                    for (int n = 0; n < 2; ++n) { const f32x4 v = acc[ai][bj][m][n] * ra; acc[ai][bj][m][n] = v; s += (v[0] * v[0] + v[1] * v[1]) + (v[2] * v[2] + v[3] * v[3]); }
                    if (wc < 2) { s += __shfl_xor(s, 16); s += __shfl_xor(s, 32); if (fq == 0) P[(rl * 2 + bj) * 2 + wc] = s; } } }
        asm volatile("s_waitcnt lgkmcnt(0)" ::: "memory"); __builtin_amdgcn_s_barrier(); asm volatile("" ::: "memory");
        const int j0 = wc * 32 + 4 * fq;
        PG8_LAS unsigned char* ST = lds + 8192;
        if (wc < 2) {
            const f32x4 g0 = *(const f32x4*)(gk + j0), g1 = *(const f32x4*)(gk + j0 + 16);
            float pesA[2][4];
#pragma unroll
            for (int ai = 0; ai < 2; ++ai)
#pragma unroll
                for (int m = 0; m < 4; ++m) pesA[ai][m] = ssqpe[(size_t)(u.pm * BM + ai * HALF + wr * 64 + m * 16 + fr)];
            __builtin_amdgcn_sched_barrier(0);
#pragma unroll
            for (int ai = 0; ai < 2; ++ai)
#pragma unroll
                for (int m = 0; m < 4; ++m) { const int rl = ai * HALF + wr * 64 + m * 16 + fr; const float pes = pesA[ai][m];
#pragma unroll
                    for (int bj = 0; bj < 2; ++bj) { const float rk = __builtin_amdgcn_rsqf((P[(rl * 2 + bj) * 2] + P[(rl * 2 + bj) * 2 + 1] + pes) * (1.0f / 96.0f) + eps);
                        const f32x4 o0 = acc[ai][bj][m][0] * rk * g0, o1 = acc[ai][bj][m][1] * rk * g1; PG8_LAS unsigned char* dst = ST + rl * 400 + (bj * 96 + j0) * 2;
                        u32x2v w0, w1; w0.x = cvt_pk_bf16(o0[0], o0[1]); w0.y = cvt_pk_bf16(o0[2], o0[3]); w1.x = cvt_pk_bf16(o1[0], o1[1]); w1.y = cvt_pk_bf16(o1[2], o1[3]);
                        *(PG8_LAS u32x2v*)dst = w0; *(PG8_LAS u32x2v*)(dst + 32) = w1; }
                    asm volatile("" ::: "memory"); }
        } else {
#pragma unroll
            for (int ai = 0; ai < 2; ++ai)
#pragma unroll
                for (int m = 0; m < 4; ++m) { const int rl = ai * HALF + wr * 64 + m * 16 + fr; const size_t r = (size_t)(u.pm * BM + rl);
#pragma unroll
                    for (int bj = 0; bj < 2; ++bj) { const f32x4 o0 = acc[ai][bj][m][0], o1 = acc[ai][bj][m][1];
                        bf16_t* dst = VF + (((((size_t)(u.pm >> 5) * 8 + 2 * u.pn + bj) * 128 + (u.pm & 31) * 4 + (rl >> 6)) * 2 + (wc - 2)) * 64 + (rl & 63)) * 32 + 4 * fq;
                        u32x2v w0, w1; w0.x = cvt_pk_bf16(o0[0], o0[1]); w0.y = cvt_pk_bf16(o0[2], o0[3]); w1.x = cvt_pk_bf16(o1[0], o1[1]); w1.y = cvt_pk_bf16(o1[2], o1[3]);
                        *(u32x2v*)dst = w0; *(u32x2v*)(dst + 16) = w1; }
                    asm volatile("" ::: "memory"); }
            if (wc == 2) {
                const f32x4 g0 = *(const f32x4*)(gk + 64 + 4 * fq), g1 = *(const f32x4*)(gk + 80 + 4 * fq);
#pragma unroll
                for (int ai = 0; ai < 2; ++ai) {
                    float pesB[4]; u32x2v xaB[4], xbB[4]; f32x4 csB[4], snB[4];
#pragma unroll
                    for (int m = 0; m < 4; ++m) { const size_t r = (size_t)(u.pm * BM + ai * HALF + wr * 64 + m * 16 + fr); pesB[m] = ssqpe[r];
                        xaB[m] = *(const u32x2v*)(Z + ((r >> 4) * 64 + 60) * 512 + (r & 15) * 32 + 4 * fq); xbB[m] = *(const u32x2v*)(Z + ((r >> 4) * 64 + 60) * 512 + (r & 15) * 32 + 16 + 4 * fq);
                        csB[m] = *(const f32x4*)(cosT + r * 16 + 4 * fq); snB[m] = *(const f32x4*)(sinT + r * 16 + 4 * fq); }
                    __builtin_amdgcn_sched_barrier(0);
#pragma unroll
                    for (int m = 0; m < 4; ++m) { const int rl = ai * HALF + wr * 64 + m * 16 + fr; const float pes = pesB[m];
                        const u32x2v xa = xaB[m], xb = xbB[m];
                        const f32x4 x1 = (f32x4){__uint_as_float(xa.x << 16), __uint_as_float(xa.x & 0xffff0000u), __uint_as_float(xa.y << 16), __uint_as_float(xa.y & 0xffff0000u)};
                        const f32x4 x2 = (f32x4){__uint_as_float(xb.x << 16), __uint_as_float(xb.x & 0xffff0000u), __uint_as_float(xb.y << 16), __uint_as_float(xb.y & 0xffff0000u)};
                        const f32x4 cs = csB[m], sn = snB[m];
#pragma unroll
                        for (int bj = 0; bj < 2; ++bj) { const float rk = __builtin_amdgcn_rsqf((P[(rl * 2 + bj) * 2] + P[(rl * 2 + bj) * 2 + 1] + pes) * (1.0f / 96.0f) + eps);
                            const f32x4 a = x1 * rk * g0, b = x2 * rk * g1, o0 = a * cs - b * sn, o1 = a * sn + b * cs; PG8_LAS unsigned char* dst = ST + rl * 400 + (bj * 96 + 64 + 4 * fq) * 2;
                            u32x2v w0, w1; w0.x = cvt_pk_bf16(o0[0], o0[1]); w0.y = cvt_pk_bf16(o0[2], o0[3]); w1.x = cvt_pk_bf16(o1[0], o1[1]); w1.y = cvt_pk_bf16(o1[2], o1[3]);
                            *(PG8_LAS u32x2v*)dst = w0; *(PG8_LAS u32x2v*)(dst + 32) = w1; } }
                    asm volatile("" ::: "memory"); }
            }
        }
        asm volatile("s_waitcnt lgkmcnt(0)" ::: "memory"); __builtin_amdgcn_s_barrier(); asm volatile("" ::: "memory");
        { const int tid = wid * 64 + lane;
#pragma unroll
            for (int i = 0; i < 12; ++i) { const int idx = tid + 512 * i, ch = idx >> 8, row = idx & 255, hd = 2 * u.pn + (ch >= 12 ? 1 : 0), c = ch >= 12 ? ch - 12 : ch;
                *(u32x4*)(KF + (((((size_t)(u.pm >> 5) * 8 + hd) * 128 + (u.pm & 31) * 4 + (row >> 6)) * 12 + c) * 64 + (row & 63)) * 8) = *(const PG8_LAS u32x4*)(ST + row * 400 + ch * 16); } }
    }
};
struct EpiOutProjG {
    static constexpr bool PERM = false, AFTER_DRAIN = false; static constexpr int PROBE_BIT = 28;
    const float* x; float* x1; bf16_t* x1b; float* ssq;
    __device__ __forceinline__ void operator()(const f32x4 (&acc)[2][2][4][2], const Unit& u, int wr, int wc, int fr, int fq) const {
        const int col0 = u.pn * BM + wc * 32 + 4 * fq;
#pragma unroll
        for (int ai = 0; ai < 2; ++ai) {
            f32x4 xr[4][2][2];
#pragma unroll
            for (int m = 0; m < 4; ++m) { const size_t off = (size_t)(u.pm * BM + ai * HALF + wr * 64 + m * 16 + fr) * 1024 + col0;
#pragma unroll
                for (int bj = 0; bj < 2; ++bj)
#pragma unroll
                    for (int n = 0; n < 2; ++n) xr[m][bj][n] = *(const f32x4*)(x + off + bj * HALF + n * 16); }
            __builtin_amdgcn_sched_barrier(0);
#pragma unroll
            for (int m = 0; m < 4; ++m) { const int r = u.pm * BM + ai * HALF + wr * 64 + m * 16 + fr; const size_t off = (size_t)r * 1024 + col0; float s = 0.f;
#pragma unroll
                for (int bj = 0; bj < 2; ++bj)
#pragma unroll
                    for (int n = 0; n < 2; ++n) { const f32x4 t = xr[m][bj][n] + acc[ai][bj][m][n];
                        u32x2v w; w.x = cvt_pk_bf16(t[0], t[1]); w.y = cvt_pk_bf16(t[2], t[3]);
                        *(u32x2v*)(x1b + ((size_t)(r >> 4) * 32 + ((col0 >> 5) + 4 * bj)) * 512 + (r & 15) * 32 + (col0 & 31) + 16 * n) = w;
                        s += (t[0] * t[0] + t[1] * t[1]) + (t[2] * t[2] + t[3] * t[3]); }
                s += __shfl_xor(s, 16); s += __shfl_xor(s, 32);
                if (fq == 0) ssq[(size_t)r * 16 + u.pn * 4 + wc] = s; }
            asm volatile("" ::: "memory"); }
    }
};
struct EpiUpG {
    static constexpr bool PERM = true, AFTER_DRAIN = false; static constexpr int PROBE_BIT = 29;
    const PG8_LAS float* rtab; bf16_t* H;
    __device__ __forceinline__ void operator()(const f32x4 (&acc)[2][2][4][2], const Unit& u, int wr, int wc, int fr, int fq) const { (*this)(acc, u, wr, wc, fr, fq, 0); }
    __device__ __forceinline__ void operator()(const f32x4 (&acc)[2][2][4][2], const Unit& u, int wr, int wc, int fr, int fq, int ui) const {
        const int row0 = u.pm * BM + wr * 64 + fr, col0 = u.pn * BM + wc * 32 + 8 * fq;
#pragma unroll
        for (int ai = 0; ai < 2; ++ai)
#pragma unroll
            for (int m = 0; m < 4; ++m) { const int r = row0 + ai * HALF + m * 16;
                const float rstd = rtab[(ui & 3) * 256 + wr * 64 + fr + ai * HALF + m * 16];
                bf16_t* rowp = H + ((size_t)(r >> 4) * 128 + (col0 >> 5)) * 512 + (r & 15) * 32 + (col0 & 31);
#pragma unroll
                for (int bj = 0; bj < 2; ++bj) { f32x4 v0 = acc[ai][bj][m][0] * rstd, v1 = acc[ai][bj][m][1] * rstd;
#pragma unroll
                    for (int e = 0; e < 4; ++e) { v0[e] = __builtin_fmaxf(v0[e], 0.f); v1[e] = __builtin_fmaxf(v1[e], 0.f); }
                    v0 = v0 * v0; v1 = v1 * v1;
                    u32x4 w; w.x = cvt_pk_bf16(v0[0], v0[1]); w.y = cvt_pk_bf16(v0[2], v0[3]); w.z = cvt_pk_bf16(v1[0], v1[1]); w.w = cvt_pk_bf16(v1[2], v1[3]);
                    *(u32x4*)(rowp + bj * 4 * 512) = w; } }
    }
};
struct EpiDownG {
    static constexpr bool PERM = false, AFTER_DRAIN = false; static constexpr int PROBE_BIT = 30;
    const bf16_t* x1b; float* out;
    __device__ __forceinline__ void operator()(const f32x4 (&acc)[2][2][4][2], const Unit& u, int wr, int wc, int fr, int fq) const {
        const int col0 = u.pn * BM + wc * 32 + 4 * fq;
        u32x2v xw[2][4][2][2];
#pragma unroll
        for (int ai = 0; ai < 2; ++ai)
#pragma unroll
            for (int m = 0; m < 4; ++m) { const size_t off = (size_t)(u.pm * BM + ai * HALF + wr * 64 + m * 16 + fr) * 1024 + col0;
#pragma unroll
                for (int bj = 0; bj < 2; ++bj)
#pragma unroll
                    for (int n = 0; n < 2; ++n) { const int r_ = u.pm * BM + ai * HALF + wr * 64 + m * 16 + fr; xw[ai][m][bj][n] = *(const u32x2v*)(x1b + ((size_t)(r_ >> 4) * 32 + ((col0 >> 5) + 4 * bj)) * 512 + (r_ & 15) * 32 + (col0 & 31) + 16 * n); } }
        __builtin_amdgcn_sched_barrier(0);
#pragma unroll
        for (int ai = 0; ai < 2; ++ai)
#pragma unroll
            for (int m = 0; m < 4; ++m) { const size_t off = (size_t)(u.pm * BM + ai * HALF + wr * 64 + m * 16 + fr) * 1024 + col0;
#pragma unroll
                for (int bj = 0; bj < 2; ++bj)
#pragma unroll
                    for (int n = 0; n < 2; ++n) { const u32x2v w = xw[ai][m][bj][n];
                        const f32x4 xr = (f32x4){__uint_as_float(w.x << 16), __uint_as_float(w.x & 0xffff0000u), __uint_as_float(w.y << 16), __uint_as_float(w.y & 0xffff0000u)};
                        *(f32x4*)(out + off + bj * HALF + n * 16) = xr + acc[ai][bj][m][n]; } }
    }
};
template <class Epi, class Sched, bool ALIGN_EPI = false, bool SP2 = false>
__device__ __forceinline__ void gemm_phase(PG8_LAS unsigned char* lds, const Gemm g, const Sched& S, const Epi& E) {
    const int tid = threadIdx.x, wid = __builtin_amdgcn_readfirstlane(tid >> 6), lane = tid & 63, wr = wid >> 2, wc = wid & 3, fr = lane & 15, fq = lane >> 4;
    const int K = g.K, nt = K / BK;
    unsigned voffA[2], voffB[2];
#pragma unroll
    for (int i = 0; i < 2; ++i) { int R, C; stage_rc(tid * 16 + i * 8192, R, C); const int Rb = Epi::PERM ? ((R & ~31) + perm32(R & 31)) : R;
        voffA[i] = g.ta ? (unsigned)(((R >> 4) * (g.lda >> 5) + (C >> 5)) * 1024 + (R & 15) * 64 + (C & 31) * 2) : (unsigned)(R * g.lda + C) * 2u;
        voffB[i] = g.tb ? (unsigned)(((Rb >> 4) * (K >> 5) + (C >> 5)) * 1024 + (Rb & 15) * 64 + (C & 31) * 2) : (unsigned)(Rb * K + C) * 2u; }
    const size_t kstepA = g.ta ? (size_t)2048 : (size_t)(BK * 2), kstepB = g.tb ? (size_t)2048 : (size_t)(BK * 2);
    const size_t hstepB = (size_t)HALF * K * 2, hstepA = (size_t)HALF * g.lda * 2;
    const size_t tstepB = 2 * hstepB, tstepA = 2 * hstepA;
    const unsigned ldsw = (unsigned)wid * 1024u;
    const int aoff = lds_byte(wr * 64 + fr, fq * 8), boff = lds_byte(wc * 32 + fr, fq * 8);
#define PG8_SA(b, h) (((b) * 2 + (h)) * HTB)
#define PG8_SB(b, h) ((4 + (b) * 2 + (h)) * HTB)
#define PG8_STAGE(bufoff, gbase, voff) do { _Pragma("unroll") for (int _i = 0; _i < 2; ++_i) \
        __builtin_amdgcn_global_load_lds((const unsigned*)((const char*)(gbase) + (voff)[_i]), (PG8_LAS unsigned*)(lds + (bufoff) + ldsw + _i * 8192), 16, 0, 0); } while (0)
#define PG8_LDA(dst, b, h) do { _Pragma("unroll") for (int m = 0; m < 4; ++m) _Pragma("unroll") for (int k = 0; k < 2; ++k) dst[m][k] = *(const PG8_LAS bf16x8*)(lds + PG8_SA(b, h) + aoff + m * 2048 + k * 1024); } while (0)
#define PG8_LDB(dst, b, h) do { _Pragma("unroll") for (int n = 0; n < 2; ++n) _Pragma("unroll") for (int k = 0; k < 2; ++k) dst[n][k] = *(const PG8_LAS bf16x8*)(lds + PG8_SB(b, h) + boff + n * 2048 + k * 1024); } while (0)
#define PG8_MMA(ai, bj, At, Bt) do { __builtin_amdgcn_s_setprio(1); _Pragma("unroll") for (int m = 0; m < 4; ++m) _Pragma("unroll") for (int n = 0; n < 2; ++n) _Pragma("unroll") for (int k = 0; k < 2; ++k) \
        acc[ai][bj][m][n] = __builtin_amdgcn_mfma_f32_16x16x32_bf16(Bt[n][k], At[m][k], acc[ai][bj][m][n], 0, 0, 0); __builtin_amdgcn_s_setprio(0); } while (0)
#define PG8_WAIT_V(n) asm volatile("s_waitcnt vmcnt(" #n ")" ::: "memory")
#define PG8_WAIT_L(n) asm volatile("s_waitcnt lgkmcnt(" #n ")" ::: "memory")
#define PG8_BAR __builtin_amdgcn_s_barrier()
#define PG8_SCHED __builtin_amdgcn_sched_barrier(0)
    Unit cur, nxt; int ui = 0;
    if (!S.next(0, cur)) return;
    f32x4 acc[2][2][4][2];
#pragma unroll
    for (int a = 0; a < 2; ++a)
#pragma unroll
        for (int b = 0; b < 2; ++b)
#pragma unroll
            for (int m = 0; m < 4; ++m)
#pragma unroll
                for (int n = 0; n < 2; ++n) acc[a][b][m][n] = (f32x4){0.f, 0.f, 0.f, 0.f};
    bf16x8 At[4][2], B0[2][2], B1[2][2];
    const char* cA = (const char*)g.A + (size_t)cur.pm * tstepA; const char* cB = (const char*)g.Bt + (size_t)cur.pn * tstepB;
    S.a_ready(cur);
    if constexpr (SP2) {
        PG8_STAGE(PG8_SB(0, 0), cB, voffB); PG8_STAGE(PG8_SB(0, 1), cB + hstepB, voffB); PG8_STAGE(PG8_SA(0, 0), cA, voffA); PG8_STAGE(PG8_SA(0, 1), cA + hstepA, voffA);
        if (wr == 1) PG8_BAR;
        PG8_WAIT_V(2); PG8_BAR;
        PG8_STAGE(PG8_SB(1, 0), cB + kstepB, voffB); PG8_STAGE(PG8_SA(1, 0), cA + kstepA, voffA); PG8_STAGE(PG8_SB(1, 1), cB + hstepB + kstepB, voffB);
        PG8_WAIT_V(6); PG8_BAR;
    } else {
        PG8_STAGE(PG8_SB(0, 0), cB, voffB); PG8_STAGE(PG8_SA(0, 0), cA, voffA); PG8_STAGE(PG8_SB(0, 1), cB + hstepB, voffB); PG8_STAGE(PG8_SA(0, 1), cA + hstepA, voffA);
        if (wr == 1) PG8_BAR;
        PG8_WAIT_V(4); PG8_BAR;
        PG8_STAGE(PG8_SB(1, 0), cB + kstepB, voffB); PG8_STAGE(PG8_SA(1, 0), cA + kstepA, voffA); PG8_STAGE(PG8_SB(1, 1), cB + hstepB + kstepB, voffB);
        PG8_WAIT_V(6); PG8_BAR;
    }
    for (;;) {
        const bool has_next = S.next(ui + 1, nxt);
        const char* nA = has_next ? (const char*)g.A + (size_t)nxt.pm * tstepA : cA; const char* nB = has_next ? (const char*)g.Bt + (size_t)nxt.pn * tstepB : cB;
        for (int t = 0; t < nt; t += 2) {
            const bool last = (t == nt - 2);
            const char* a1 = cA + (size_t)(t + 1) * kstepA;
            const char* a2 = last ? nA : cA + (size_t)(t + 2) * kstepA; const char* b2 = last ? nB : cB + (size_t)(t + 2) * kstepB;
            const char* a3 = a2 + kstepA; const char* b3 = b2 + kstepB;
            if (last && has_next) S.a_ready(nxt);
            if constexpr (SP2) {
            PG8_LDB(B0, 0, 0); PG8_LDB(B1, 0, 1); PG8_SCHED; PG8_LDA(At, 0, 0); PG8_STAGE(PG8_SA(1, 1), a1 + hstepA, voffA);
            PG8_WAIT_V(8); PG8_WAIT_L(0); PG8_BAR; PG8_MMA(0, 0, At, B0); PG8_MMA(0, 1, At, B1); PG8_BAR; PG8_SCHED;
            PG8_LDA(At, 0, 1); PG8_STAGE(PG8_SB(0, 0), b2, voffB); PG8_STAGE(PG8_SB(0, 1), b2 + hstepB, voffB); PG8_STAGE(PG8_SA(0, 0), a2, voffA);
            PG8_WAIT_V(8); PG8_WAIT_L(0); PG8_BAR; PG8_MMA(1, 0, At, B0); PG8_MMA(1, 1, At, B1); PG8_BAR; PG8_SCHED;
            PG8_LDB(B0, 1, 0); PG8_LDB(B1, 1, 1); PG8_SCHED; PG8_LDA(At, 1, 0); PG8_STAGE(PG8_SA(0, 1), a2 + hstepA, voffA);
            PG8_WAIT_V(8); PG8_WAIT_L(0); PG8_BAR; PG8_MMA(0, 0, At, B0); PG8_MMA(0, 1, At, B1); PG8_BAR; PG8_SCHED;
            PG8_LDA(At, 1, 1); PG8_STAGE(PG8_SB(1, 0), b3, voffB); PG8_STAGE(PG8_SB(1, 1), b3 + hstepB, voffB); PG8_STAGE(PG8_SA(1, 0), a3, voffA);
            PG8_WAIT_V(8); PG8_WAIT_L(0); PG8_BAR; PG8_MMA(1, 0, At, B0); PG8_MMA(1, 1, At, B1); PG8_BAR; PG8_SCHED;
            } else {
            PG8_LDB(B0, 0, 0); PG8_SCHED; PG8_LDA(At, 0, 0); PG8_STAGE(PG8_SA(1, 1), a1 + hstepA, voffA);
            PG8_WAIT_L(8); PG8_BAR; PG8_WAIT_L(0); PG8_MMA(0, 0, At, B0); PG8_BAR; PG8_SCHED;
            PG8_LDB(B1, 0, 1); PG8_STAGE(PG8_SB(0, 0), b2, voffB);
            PG8_BAR; PG8_WAIT_L(0); PG8_MMA(0, 1, At, B1); PG8_BAR;
            PG8_LDA(At, 0, 1); PG8_STAGE(PG8_SA(0, 0), a2, voffA);
            PG8_BAR; PG8_WAIT_L(0); PG8_MMA(1, 0, At, B0); PG8_BAR; PG8_SCHED;
            PG8_STAGE(PG8_SB(0, 1), b2 + hstepB, voffB);
            PG8_WAIT_V(6); PG8_BAR; PG8_MMA(1, 1, At, B1); PG8_BAR;
            PG8_LDB(B0, 1, 0); PG8_SCHED; PG8_LDA(At, 1, 0); PG8_STAGE(PG8_SA(0, 1), a2 + hstepA, voffA);
            PG8_WAIT_L(8); PG8_BAR; PG8_WAIT_L(0); PG8_MMA(0, 0, At, B0); PG8_BAR; PG8_SCHED;
            PG8_LDB(B1, 1, 1); PG8_STAGE(PG8_SB(1, 0), b3, voffB);
            PG8_BAR; PG8_WAIT_L(0); PG8_MMA(0, 1, At, B1); PG8_BAR;
            PG8_LDA(At, 1, 1); PG8_STAGE(PG8_SA(1, 0), a3, voffA);
            PG8_BAR; PG8_WAIT_L(0); PG8_MMA(1, 0, At, B0); PG8_BAR; PG8_SCHED;
            PG8_STAGE(PG8_SB(1, 1), b3 + hstepB, voffB);
            PG8_WAIT_V(6); PG8_BAR; PG8_MMA(1, 1, At, B1); PG8_BAR;
            }
        }
        if constexpr (ALIGN_EPI) { if (wr == 0) PG8_BAR; }
        if constexpr (!Epi::AFTER_DRAIN) { if constexpr (Epi::PROBE_BIT == 29) E(acc, cur, wr, wc, fr, fq, ui); else E(acc, cur, wr, wc, fr, fq); if (DUPL(Epi::PROBE_BIT)) E(acc, cur, wr, wc, fr, fq); S.done(cur); }
        if (!has_next) break;
#pragma unroll
        for (int a = 0; a < 2; ++a)
#pragma unroll
            for (int b = 0; b < 2; ++b)
#pragma unroll
                for (int m = 0; m < 4; ++m)
#pragma unroll
                    for (int n = 0; n < 2; ++n) acc[a][b][m][n] = (f32x4){0.f, 0.f, 0.f, 0.f};
        cur = nxt; cA = nA; cB = nB; ++ui;
        if constexpr (ALIGN_EPI) { if (wr == 1) PG8_BAR; }
    }
    PG8_WAIT_V(0);
    if constexpr (!ALIGN_EPI) { if (wr == 0) PG8_BAR; }
    PG8_BAR;
    if constexpr (Epi::AFTER_DRAIN) { E.fused(acc, cur, wr, wc, fr, fq, lds, wid, lane); if (DUPL(Epi::PROBE_BIT)) { asm volatile("s_waitcnt lgkmcnt(0)" ::: "memory"); __builtin_amdgcn_s_barrier(); E.fused(acc, cur, wr, wc, fr, fq, lds, wid, lane); } S.done(cur); }
#undef PG8_SA
#undef PG8_SB
#undef PG8_STAGE
#undef PG8_LDA
#undef PG8_LDB
#undef PG8_MMA
#undef PG8_WAIT_V
#undef PG8_WAIT_L
#undef PG8_BAR
#undef PG8_SCHED
}
}

#define GAS __attribute__((address_space(1)))
#define LAS __attribute__((address_space(3)))
#define XB_TMO      128
#define XB_XCNT(j)  (256  + 64 * (j))
#define XB_XSUB(j)  (1280 + 64 * (j))
#define XB_XGEN(j)  (2304 + 64 * (j))
#define XB_TOP      3328
#define XB_TOPGEN   3392
#define XCD_BAR_WORDS 3456
#define XB_SPIN_CAP (1u << 18)
__device__ __forceinline__ unsigned xb_ld(unsigned* p)              { return __hip_atomic_load(p, __ATOMIC_RELAXED, __HIP_MEMORY_SCOPE_AGENT); }
__device__ __forceinline__ unsigned xb_add(unsigned* p, unsigned v) { return __hip_atomic_fetch_add(p, v, __ATOMIC_RELAXED, __HIP_MEMORY_SCOPE_AGENT); }
__device__ __forceinline__ unsigned xb_xcc_id() { return (unsigned)__builtin_amdgcn_s_getreg((3 << 11) | 20) & 0xFu; }
#define XB_SPIN(cond, bar) do { unsigned _sp = 0; while (cond) { __builtin_amdgcn_s_sleep(1); \
    if ((++_sp & 255u) == 0u) { if (xb_ld(&(bar)[XB_TMO])) break; if (_sp > XB_SPIN_CAP) { atomicAdd(&(bar)[XB_TMO], 1u); break; } } } } while (0)
struct XcdBarrier { unsigned* bar; unsigned x; volatile LAS unsigned* st; };
__device__ __forceinline__ XcdBarrier xcd_barrier_post(unsigned* bar, volatile LAS unsigned* st) {
    XcdBarrier b; b.bar = bar; b.x = xb_xcc_id(); b.st = st;
    if (threadIdx.x == 0) (void)xb_add(&bar[XB_XCNT(b.x)], 1u);
    return b;
}
__device__ __forceinline__ void xcd_barrier_complete(unsigned* bar, unsigned x, unsigned& nloc, unsigned& nx) {
    const unsigned G = gridDim.x * gridDim.y * gridDim.z;
    unsigned sum, cnt, mine, sp = 0u;
    for (;;) {
        sum = 0u; cnt = 0u; mine = 0u;
#pragma unroll
        for (unsigned j = 0; j < 16; ++j) { const unsigned c = xb_ld(&bar[XB_XCNT(j)]); sum += c; cnt += (c > 0u) ? 1u : 0u; mine = (j == x) ? c : mine; }
        if (sum == G) break;
        __builtin_amdgcn_s_sleep(1);
        if ((++sp & 255u) == 0u) { if (xb_ld(&bar[XB_TMO])) break; if (sp > XB_SPIN_CAP) { atomicAdd(&bar[XB_TMO], 1u); break; } }
    }
    nloc = mine > 0u ? mine : 1u; nx = cnt > 0u ? cnt : 1u;
}
__device__ __forceinline__ void xcd_barrier(const XcdBarrier& b) {
    asm volatile("s_waitcnt vmcnt(0)" ::: "memory");
    __syncthreads();
    if (threadIdx.x == 0) {
        unsigned* bar = b.bar;
        __builtin_amdgcn_s_waitcnt(0);
        unsigned nloc = b.st[0], nx = b.st[1];
        if (nloc == 0u) { xcd_barrier_complete(bar, b.x, nloc, nx); b.st[0] = nloc; b.st[1] = nx; }
        const unsigned old = xb_add(&bar[XB_XSUB(b.x)], 1u);
        const unsigned gen = old / nloc;
        if (old + 1u == (gen + 1u) * nloc) {
            __builtin_amdgcn_fence(__ATOMIC_RELEASE, "agent");
            asm volatile("s_waitcnt vmcnt(0)" ::: "memory");
            const unsigned og = xb_add(&bar[XB_TOP], 1u);
            const unsigned tg = og / nx;
            if (og + 1u == (tg + 1u) * nx) xb_add(&bar[XB_TOPGEN], 1u);
            else XB_SPIN(xb_ld(&bar[XB_TOPGEN]) == tg, bar);
            __builtin_amdgcn_fence(__ATOMIC_ACQUIRE, "agent");
            xb_add(&bar[XB_XGEN(b.x)], 1u);
            asm volatile("s_waitcnt vmcnt(0)" ::: "memory");
        } else {
            XB_SPIN(xb_ld(&bar[XB_XGEN(b.x)]) == gen, bar);
            __builtin_amdgcn_fence(__ATOMIC_ACQUIRE, "agent");
            asm volatile("s_waitcnt vmcnt(0)" ::: "memory");
        }
    }
    __syncthreads();
}

constexpr int LDS_BYTES = 147456;
constexpr int MISC_OFF = 131072 + 320;
constexpr int CW_BAR = 4096;
#ifndef MK_SINGLE
#define MK_SINGLE 1
#endif
constexpr int NPHASE = 11;
struct Args { Ctx C; int ph_lo, ph_hi; };
__global__ void __launch_bounds__(NT, 2) fwd_mega(Args args) {
    extern __shared__ __attribute__((aligned(16))) unsigned char lds_raw[];
    float* lds = (float*)lds_raw;
    PG8_LAS unsigned char* L3 = (PG8_LAS unsigned char*)lds_raw;
    const Ctx& C = args.C;
    unsigned char* ws = C.ws;
    volatile LAS unsigned* MISC = (volatile LAS unsigned*)((LAS unsigned char*)lds_raw + MISC_OFF);
    if (threadIdx.x < 32) MISC[threadIdx.x] = 0u;
    __syncthreads();
    XcdBarrier bar; bar.bar = (unsigned*)(ws + WS_CTL) + CW_BAR; bar.x = 0; bar.st = nullptr;
    if (MK_SINGLE) bar = xcd_barrier_post((unsigned*)(ws + WS_CTL) + CW_BAR, MISC + 8);
    const int lo = args.ph_lo, hi = args.ph_hi;
#define IN(k) (lo <= (k) && (k) < hi)
#define SEAM(k) do { if (IN(k) && IN((k) + 1)) { xcd_barrier(bar); if (DUPL(31)) xcd_barrier(bar); } } while (0)
#define PH(k, BODY) do { if (IN(k)) { BODY; if (DUPL(k)) { BODY; } } } while (0)
#define GEMM_PH(EPI, EINIT, AP, BP, NN, KK, LDA, AL) GEMM_PH2(EPI, EINIT, AP, BP, NN, KK, LDA, AL, false)
#define GEMM_PH2(EPI, EINIT, AP, BP, NN, KK, LDA, AL, TA) do { pg8::Gemm g{(const bf16*)(AP), (const bf16*)(BP), M, NN, KK, LDA, TA, true}; pg8::StaticOrder S; S.init(M, NN, (int)gridDim.x, (int)blockIdx.x); \
        pg8::EPI E EINIT; pg8::gemm_phase<pg8::EPI, pg8::StaticOrder, AL, true>(L3, g, S, E); } while (0)
    const float* COS = (const float*)(ws + WS_COS); const float* SIN = (const float*)(ws + WS_SIN);
    PH(0, p0_prologue(C, lds));
    SEAM(0);
    PH(1, GEMM_PH(EpiZ, ({(bf16*)(ws + WS_Z), NZ, (float*)(ws + WS_SSQQ), (float*)(ws + WS_SSQKV), (float*)(ws + WS_SSQPE)}), ws + WS_A, ws + WS_WIN, NZ, DM, DM, true));
    SEAM(1);
    PH(2, GEMM_PH2(EpiQ, ({(const float*)(ws + WS_SSQQ), C.q_head_norm, COS, SIN, (bf16*)(ws + WS_QF), EPS, QSCALE}), (const bf16*)(ws + WS_Z) + (ZC_CQ >> 5) * 512, ws + WS_WUQ, 1024, QRANK, NZ, false, true));
    __syncthreads();
    PH(3, GEMM_PH2(EpiKV, ({(const float*)(ws + WS_SSQKV), (const float*)(ws + WS_SSQPE), C.k_head_norm, COS, SIN, (const bf16*)(ws + WS_Z), (bf16*)(ws + WS_KF), (bf16*)(ws + WS_VF), EPS}), (const bf16*)(ws + WS_Z) + (ZC_CKV >> 5) * 512, ws + WS_WUKV, 1024, KVRANK, NZ, false, true));
    __syncthreads();
    PH(4, gla::pass1(C, lds_raw));
    SEAM(4);
    PH(5, gla_scan(C));
    SEAM(5);
    PH(6, att::attn_phase(C, (char*)lds_raw));
    PH(7, gla::pass2(C, lds_raw));
    SEAM(7);
    PH(8, GEMM_PH2(EpiOutProjG, ({C.x, C.out, (bf16*)(ws + WS_A), (float*)(ws + WS_SSQ)}), ws + WS_B, ws + WS_WO, DM, DM, DM, true, true));
    SEAM(8);
    if (IN(9)) {
        PG8_LAS float* rtab = (PG8_LAS float*)(L3 + 131072 + 1024);
        pg8::StaticOrder So; So.init(M, DFF, (int)gridDim.x, (int)blockIdx.x);
        for (int idx = threadIdx.x; idx < 4 * 256; idx += NT) { pg8::Unit uu; const int i = idx >> 8, row = idx & 255;
            if (So.next(i, uu)) { const f32x4* sp = (const f32x4*)(ws + WS_SSQ) + (size_t)(uu.pm * 256 + row) * 4; const f32x4 s4 = (sp[0] + sp[1]) + (sp[2] + sp[3]);
                rtab[idx] = __builtin_amdgcn_rsqf(((s4[0] + s4[1]) + (s4[2] + s4[3])) * (1.0f / DM) + EPS); } }
        __syncthreads();
    }
    PH(9, GEMM_PH2(EpiUpG, ({(const PG8_LAS float*)(L3 + 131072 + 1024), (bf16*)(ws + WS_H)}), ws + WS_A, ws + WS_WUP, DFF, DM, DM, true, true));
    SEAM(9);
    PH(10, GEMM_PH2(EpiDownG, ({(const bf16*)(ws + WS_A), C.out}), ws + WS_H, ws + WS_WDN, DM, DFF, DFF, true, true));

#undef IN
#undef SEAM
}

extern "C" void kernel_launch(void* const* d_in, const int* in_sizes, int n_in, void* d_out, int out_size, void* d_ws, size_t ws_size, hipStream_t stream) {
    static int grid = 0;
    if (grid == 0) {
        if (n_in != 17 || in_sizes[0] != M * DM || out_size != M * DM || ws_size < WS_END) { fprintf(stderr, "kernel_launch: unexpected shapes (n_in %d in0 %d out %d ws %zu)\n", n_in, n_in > 0 ? in_sizes[0] : -1, out_size, ws_size); grid = -1; return; }
        int dev = 0, cus = 0, per_cu = 0;
        if (hipGetDevice(&dev) != hipSuccess || hipDeviceGetAttribute(&cus, hipDeviceAttributeMultiprocessorCount, dev) != hipSuccess) { fprintf(stderr, "kernel_launch: device query failed\n"); grid = -1; return; }
        if (hipFuncSetAttribute((const void*)fwd_mega, hipFuncAttributeMaxDynamicSharedMemorySize, LDS_BYTES) != hipSuccess) { fprintf(stderr, "kernel_launch: hipFuncSetAttribute failed\n"); grid = -1; return; }
        if (hipOccupancyMaxActiveBlocksPerMultiprocessor(&per_cu, (const void*)fwd_mega, NT, LDS_BYTES) != hipSuccess || per_cu < 1) fprintf(stderr, "kernel_launch: note: occupancy query reports %d workgroups per CU\n", per_cu);
        (void)hipGetLastError();
        grid = cus;
    }
    if (grid < 0) return;
    Args a{};
    Ctx& C = a.C;
    C.x = (const float*)d_in[0]; C.pos = (const int*)d_in[1]; C.attn_norm = (const float*)d_in[2]; C.w_in = (const float*)d_in[3]; C.w_gate_up = (const float*)d_in[4];
    C.b_gate = (const float*)d_in[5]; C.gla_out_norm = (const float*)d_in[6]; C.q_a_norm = (const float*)d_in[7]; C.w_uq = (const float*)d_in[8]; C.kv_a_norm = (const float*)d_in[9];
    C.w_ukv = (const float*)d_in[10]; C.q_head_norm = (const float*)d_in[11]; C.k_head_norm = (const float*)d_in[12]; C.w_out = (const float*)d_in[13]; C.mlp_norm = (const float*)d_in[14];
    C.w_up = (const float*)d_in[15]; C.w_down = (const float*)d_in[16]; C.out = (float*)d_out; C.ws = (unsigned char*)d_ws;
    if (MK_SINGLE) {
        if (hipMemsetAsync((char*)d_ws + WS_CTL, 0, CTL_ZERO_BYTES, stream) != hipSuccess) { fprintf(stderr, "kernel_launch: memset failed\n"); return; }
        a.ph_lo = 0; a.ph_hi = NPHASE;
        hipLaunchKernelGGL(fwd_mega, dim3(grid), dim3(NT), LDS_BYTES, stream, a);
        if (DUPL(23)) { (void)hipMemsetAsync((char*)d_ws + WS_CTL, 0, CTL_ZERO_BYTES, stream); hipLaunchKernelGGL(fwd_mega, dim3(grid), dim3(NT), LDS_BYTES, stream, a); }
    } else {
        for (int s = 0; s < NPHASE; ++s) { a.ph_lo = s; a.ph_hi = s + 1; hipLaunchKernelGGL(fwd_mega, dim3(grid), dim3(NT), LDS_BYTES, stream, a); }
    }
}
```

```cpp
#include <hip/hip_runtime.h>
#include <cstdio>
#include <cstdint>
#ifndef DUP_MASK
#define DUP_MASK 0u
#endif
#define DUPL(k) (((DUP_MASK) >> (k)) & 1u)

constexpr int BATCH = 2, SEQ = 8192, DM = 1024, M = BATCH * SEQ;
constexpr int DPROJ = 1968, NZ = 2048, DFF = 4096;
constexpr int GH = 4, GDK = 64, GDV = 128, GRANK = 16, NCH = SEQ / 64;
constexpr int MH = 8, QRANK = 256, KVRANK = 128, NOPE = 64, ROPE = 32, MV = 64, DQK = 96;
constexpr float EPS = 1e-6f;
constexpr float QSCALE = 0.10206207261596577f * 1.4426950408889634f;
constexpr int ZC_Q = 0, ZC_K = 256, ZC_V = 512, ZC_G = 1024, ZC_CQ = 1536, ZC_CKV = 1792, ZC_KPE = 1920, ZC_GATE = 1952;
__host__ __device__ __forceinline__ size_t ztile(size_t r, int c) { return ((r >> 4) * 64 + (size_t)(c >> 5)) * 512 + (r & 15) * 32 + (c & 31); }

constexpr size_t MiB = 1u << 20;
constexpr size_t WS_CTL = 0;
constexpr size_t WS_WIN = 1 * MiB, WS_WUQ = 5 * MiB, WS_WUKV = 6 * MiB, WS_WO = 7 * MiB, WS_WUP = 9 * MiB, WS_WDN = 17 * MiB;
constexpr size_t WS_SSQ = 25 * MiB, WS_DEC = 512 * 1024, WS_COS = 26 * MiB, WS_SIN = 27 * MiB;
constexpr size_t CTL_ZERO_BYTES = 64 * 1024;
constexpr size_t WS_SSQQ = 5 * MiB + 512 * 1024, WS_SSQKV = 5 * MiB + 768 * 1024, WS_SSQPE = 6 * MiB + 512 * 1024;
constexpr size_t WS_A = 28 * MiB;
constexpr size_t WS_B = 60 * MiB;
constexpr size_t WS_Z = 92 * MiB;
constexpr size_t WS_QF = 156 * MiB, WS_AQ = 156 * MiB, WS_AKV = 164 * MiB, WS_KF = 180 * MiB, WS_VF = 204 * MiB;
constexpr size_t WS_CKV = 220 * MiB;
constexpr size_t WS_H = 92 * MiB;
constexpr size_t WS_END = 252 * MiB;

typedef unsigned short bf16;
typedef float f32x4 __attribute__((ext_vector_type(4)));
typedef unsigned u32x2 __attribute__((ext_vector_type(2)));
typedef unsigned u32x4 __attribute__((ext_vector_type(4)));

__device__ __forceinline__ float bf2f(unsigned b) { return __uint_as_float(b << 16); }
__device__ __forceinline__ unsigned f2bf(float f) { unsigned u = __float_as_uint(f); return (u + 0x7fffu + ((u >> 16) & 1u)) >> 16; }
typedef float f32x2c_t __attribute__((ext_vector_type(2))); typedef __bf16 bf16x2c_t __attribute__((ext_vector_type(2)));
__device__ __forceinline__ unsigned pk2(float lo, float hi) { f32x2c_t v = {lo, hi}; bf16x2c_t b = __builtin_convertvector(v, bf16x2c_t); return __builtin_bit_cast(unsigned, b); }
__device__ __forceinline__ float wave_sum(float v) {
#pragma unroll
    for (int o = 1; o < 64; o <<= 1) v += __shfl_xor(v, o);
    return v;
}

__device__ __forceinline__ unsigned otid() { unsigned t = threadIdx.x; asm volatile("" : "+v"(t)); return t; }

struct Ctx {
    const float* x; const int* pos; const float* attn_norm; const float* w_in; const float* w_gate_up; const float* b_gate; const float* gla_out_norm;
    const float* q_a_norm; const float* w_uq; const float* kv_a_norm; const float* w_ukv; const float* q_head_norm; const float* k_head_norm;
    const float* w_out; const float* mlp_norm; const float* w_up; const float* w_down;
    float* out; unsigned char* ws;
};
constexpr int NT = 512;

__device__ __forceinline__ int win_src_col(int n) {
    if (n < 1024) return n;
    if (n < 1536) return n - 1024 + 1040;
    if (n < 1792) return n - 1536 + 1552;
    if (n < 1920) return n - 1792 + 1808;
    if (n < 1952) return n - 1920 + 1936;
    if (n < 1968) return n - 1952 + 1024;
    return -1;
}
struct MapWin { __device__ __forceinline__ int operator()(int n) const { return win_src_col(n); } };
struct MapUq  { __device__ __forceinline__ int operator()(int n) const { const int h = n >> 7, j = n & 127; return j < DQK ? h * DQK + j : -1; } };
struct MapId  { __device__ __forceinline__ int operator()(int n) const { return n; } };
template <bool GAIN, class CMap>
__device__ __forceinline__ void p0_transpose_item(const float* W, int K, int Nsrc, int N, bf16* WT, const float* kgain, float* scr, int item, int lane, const CMap& cmap) {
    const int nblk = N / 32, kb = item / nblk, nb = item % nblk, k0 = 64 * kb, n0 = 32 * nb;
    const int sc = cmap(n0 + (lane & 31)); const float keep = sc >= 0 ? 1.f : 0.f; const int scc = sc >= 0 ? sc : 0;
    const float* wp = W + (size_t)(k0 + (lane >> 5)) * Nsrc + scc;
    float v[32];
#pragma unroll
    for (int i = 0; i < 32; ++i) v[i] = wp[(size_t)(2 * i) * Nsrc];
#pragma unroll
    for (int i = 0; i < 32; ++i) { const int kk = 2 * i + (lane >> 5); float t = v[i] * keep; if (GAIN) t *= kgain[k0 + kk]; scr[kk * 33 + (lane & 31)] = t; }
    asm volatile("s_waitcnt lgkmcnt(0)" ::: "memory");
    const int c = lane & 7;
#pragma unroll
    for (int j = 0; j < 4; ++j) { const int n = (lane >> 3) + 8 * j; const float* s = scr + (8 * c) * 33 + n;
        u32x4 o; o.x = pk2(s[0 * 33], s[1 * 33]); o.y = pk2(s[2 * 33], s[3 * 33]); o.z = pk2(s[4 * 33], s[5 * 33]); o.w = pk2(s[6 * 33], s[7 * 33]);
        *(u32x4*)(WT + ((size_t)((n0 + n) >> 4) * (K >> 5) + ((k0 + 8 * c) >> 5)) * 512 + ((n0 + n) & 15) * 32 + ((k0 + 8 * c) & 31)) = o; }
    asm volatile("s_waitcnt lgkmcnt(0)" ::: "memory");
}
__device__ __forceinline__ void p0_prologue(const Ctx& C, float* lds) {
    const size_t gt = (size_t)blockIdx.x * NT + otid(), GT = (size_t)gridDim.x * NT;
    bf16* win = (bf16*)(C.ws + WS_WIN); bf16* wuq = (bf16*)(C.ws + WS_WUQ); bf16* wukv = (bf16*)(C.ws + WS_WUKV);
    bf16* wo = (bf16*)(C.ws + WS_WO); bf16* wup = (bf16*)(C.ws + WS_WUP); bf16* wdn = (bf16*)(C.ws + WS_WDN);
    {   const int lane_ = otid() & 63, wv = otid() >> 6; float* scr = lds + wv * (64 * 33 + 32);
        const int gw_ = (int)(gt >> 6), NGW_ = (int)(GT >> 6);
        constexpr int I_IN = (DM / 64) * (NZ / 32), I_UQ = (QRANK / 64) * (1024 / 32), I_UKV = (KVRANK / 64) * (1024 / 32), I_O = (DM / 64) * (DM / 32), I_UP = (DM / 64) * (DFF / 32), I_DN = (DFF / 64) * (DM / 32);
        constexpr int NITEMS = I_IN + I_UQ + I_UKV + I_O + I_UP + I_DN;
        for (int it = gw_; it < NITEMS; it += NGW_) {
            int r = it;
            if (r < I_UP) { p0_transpose_item<true>(C.w_up, DM, DFF, DFF, wup, C.mlp_norm, scr, r, lane_, MapId{}); continue; } r -= I_UP;
            if (r < I_DN) { p0_transpose_item<false>(C.w_down, DFF, DM, DM, wdn, nullptr, scr, r, lane_, MapId{}); continue; } r -= I_DN;
            if (r < I_IN) { p0_transpose_item<false>(C.w_in, DM, DPROJ, NZ, win, nullptr, scr, r, lane_, MapWin{}); continue; } r -= I_IN;
            if (r < I_O) { p0_transpose_item<false>(C.w_out, DM, DM, DM, wo, nullptr, scr, r, lane_, MapId{}); continue; } r -= I_O;
            if (r < I_UQ) { p0_transpose_item<true>(C.w_uq, QRANK, MH * DQK, 1024, wuq, C.q_a_norm, scr, r, lane_, MapUq{}); continue; } r -= I_UQ;
            p0_transpose_item<true>(C.w_ukv, KVRANK, 1024, 1024, wukv, C.kv_a_norm, scr, r, lane_, MapId{});
        }
    }
    const int lane = otid() & 63; const int gw = (int)(gt >> 6), NGW = (int)(GT >> 6);
    bf16* XN = (bf16*)(C.ws + WS_A); float* COS = (float*)(C.ws + WS_COS); float* SIN = (float*)(C.ws + WS_SIN);
    f32x4 gn[4];
#pragma unroll
    for (int j = 0; j < 4; ++j) gn[j] = ((const f32x4*)C.attn_norm)[lane + 64 * j];
    for (int m = gw; m < M; m += 2 * NGW) {
        const int m2 = m + NGW;
        const f32x4* xa = (const f32x4*)(C.x + (size_t)m * DM) + lane; const f32x4* xb = (const f32x4*)(C.x + (size_t)(m2 < M ? m2 : m) * DM) + lane;
        f32x4 va[4], vb[4]; float sa = 0.f, sb = 0.f;
#pragma unroll
        for (int j = 0; j < 4; ++j) { va[j] = xa[64 * j]; vb[j] = xb[64 * j]; }
#pragma unroll
        for (int j = 0; j < 4; ++j) { sa += (va[j].x * va[j].x + va[j].y * va[j].y) + (va[j].z * va[j].z + va[j].w * va[j].w); sb += (vb[j].x * vb[j].x + vb[j].y * vb[j].y) + (vb[j].z * vb[j].z + vb[j].w * vb[j].w); }
        const float ra = rsqrtf(wave_sum(sa) * (1.f / DM) + EPS), rb = rsqrtf(wave_sum(sb) * (1.f / DM) + EPS);
        u32x2* oa = (u32x2*)(XN + (size_t)m * DM) + lane; u32x2* ob = (u32x2*)(XN + (size_t)m2 * DM) + lane;
#pragma unroll
        for (int j = 0; j < 4; ++j) { u32x2 w; w.x = pk2(va[j].x * ra * gn[j].x, va[j].y * ra * gn[j].y); w.y = pk2(va[j].z * ra * gn[j].z, va[j].w * ra * gn[j].w); oa[64 * j] = w; }
        if (m2 < M) {
#pragma unroll
            for (int j = 0; j < 4; ++j) { u32x2 w; w.x = pk2(vb[j].x * rb * gn[j].x, vb[j].y * rb * gn[j].y); w.y = pk2(vb[j].z * rb * gn[j].z, vb[j].w * rb * gn[j].w); ob[64 * j] = w; } }
    }
    for (size_t i = gt; i < (size_t)M * 16; i += GT) { const int m = (int)(i >> 4), f = (int)(i & 15);
        const float invf = exp2f(-(float)(2 * f) * (1.f / 32.f) * 13.287712379549449f);
        const float ang = (float)C.pos[m] * invf; float sn, cs; sincosf(ang, &sn, &cs); COS[i] = cs; SIN[i] = sn; }
}

__device__ __forceinline__ void unpack8(const u32x4 w, float (&v)[8]) { v[0] = bf2f(w.x & 0xffffu); v[1] = bf2f(w.x >> 16); v[2] = bf2f(w.y & 0xffffu); v[3] = bf2f(w.y >> 16);
    v[4] = bf2f(w.z & 0xffffu); v[5] = bf2f(w.z >> 16); v[6] = bf2f(w.w & 0xffffu); v[7] = bf2f(w.w >> 16); }
__device__ __forceinline__ u32x4 pack8(const float (&v)[8]) { u32x4 w; w.x = pk2(v[0], v[1]); w.y = pk2(v[2], v[3]); w.z = pk2(v[4], v[5]); w.w = pk2(v[6], v[7]); return w; }
constexpr float LOG2E = 1.4426950408889634f, LN2 = 0.6931471805599453f;
__device__ __forceinline__ float fexp(float x) { return __builtin_amdgcn_exp2f(x * LOG2E); }
__device__ __forceinline__ float log_gate(float gl) { const float ls = fminf(gl, 0.f) - LN2 * __builtin_amdgcn_logf(1.f + fexp(-fabsf(gl))); return fmaxf(ls * (1.f / 16.f), -1.f); }
__device__ __forceinline__ float silu_f(float g) { return g * __builtin_amdgcn_rcpf(1.f + fexp(-g)); }
__device__ __forceinline__ void gla_scan(const Ctx& C) {
    const float* CKV = (const float*)(C.ws + WS_CKV); const float* DEC = (const float*)(C.ws + WS_DEC); bf16* PREV = (bf16*)(C.ws + WS_A);
    if (otid() >= 256) return;
    for (int e = blockIdx.x * 256 + otid(); e < BATCH * GH * 128 * 64; e += gridDim.x * 256) {
        const int d = e & 63, v = (e >> 6) & 127, bh = e >> 13; float st = 0.f;
        for (int n0 = 0; n0 < NCH; n0 += 16) {
            float cv[16], dv[16];
#pragma unroll
            for (int i = 0; i < 16; ++i) { const size_t u = (size_t)bh * NCH + n0 + i; cv[i] = CKV[(u * 128 + v) * 64 + d]; dv[i] = DEC[u * 64 + d]; }
#pragma unroll
            for (int i = 0; i < 16; ++i) { const size_t u = (size_t)bh * NCH + n0 + i; PREV[(u * 128 + v) * 64 + d] = (bf16)f2bf(st); st = dv[i] * st + cv[i]; }
        }
    }
}

namespace att {
typedef short bf16x8 __attribute__((ext_vector_type(8)));
typedef short s16x4 __attribute__((ext_vector_type(4)));
typedef float f32x16 __attribute__((ext_vector_type(16)));
typedef __attribute__((address_space(3))) const char* lds_cptr;
constexpr int KSLOT = 12288, VSLOT = 8192, LDS_K = 0, LDS_V = 3 * KSLOT, LDS_WS = LDS_V + 3 * VSLOT, LDS_OST = LDS_WS + 8 * 256, LDS_TOTAL = LDS_OST + 8 * 4096;
constexpr int QP = MH * DQK, VP = MH * MV;
#define ATT_SBAR() __builtin_amdgcn_sched_barrier(0)
__device__ __forceinline__ int crow(int r, int hi) { return (r & 3) + 8 * (r >> 2) + 4 * hi; }
__device__ __forceinline__ void glds16(const void* gsrc, unsigned lds_dst) { unsigned keep;
    asm volatile("s_mov_b32 %0, m0\n\ts_mov_b32 m0, %2\n\ts_nop 0\n\tglobal_load_lds_dwordx4 %1, off\n\ts_mov_b32 m0, %0" : "=&s"(keep) : "v"(gsrc), "s"(lds_dst) : "memory"); }
typedef float f32x2_t __attribute__((ext_vector_type(2))); typedef __bf16 bf16x2_t __attribute__((ext_vector_type(2)));
__device__ __forceinline__ unsigned cvtpk_s(float lo, float hi) { f32x2_t v = {lo, hi}; bf16x2_t b = __builtin_convertvector(v, bf16x2_t); return __builtin_bit_cast(unsigned, b); }
typedef short att_v4i16 __attribute__((ext_vector_type(4)));
__device__ __forceinline__ s16x4 vtr(lds_cptr p) { return __builtin_bit_cast(s16x4, __builtin_amdgcn_ds_read_tr16_b64_v4i16((__attribute__((address_space(3))) att_v4i16*)p)); }
#define ATT_MX3(a, b, c) __builtin_fmaxf(__builtin_fmaxf((a), (b)), (c))
__device__ __forceinline__ float rowmax(const f32x16& p0, const f32x16& p1) {
    float a = ATT_MX3(p0[0], p0[1], p1[0]), b = ATT_MX3(p0[2], p0[3], p1[1]); a = ATT_MX3(a, p1[2], p1[3]);
#pragma unroll
    for (int r = 4; r < 16; r += 4) { a = ATT_MX3(a, p0[r], p0[r + 1]); b = ATT_MX3(b, p0[r + 2], p0[r + 3]); a = ATT_MX3(a, p1[r], p1[r + 1]); b = ATT_MX3(b, p1[r + 2], p1[r + 3]); }
    float m = __builtin_fmaxf(a, b); auto rr = __builtin_amdgcn_permlane32_swap(__float_as_uint(m), __float_as_uint(m), false, false);
    return __builtin_fmaxf(__uint_as_float(rr[0]), __uint_as_float(rr[1])); }
__device__ __forceinline__ void pv(f32x16* o, int vb, bf16x8 pa0, bf16x8 pa1, bf16x8 pa2, bf16x8 pa3) {
#pragma unroll
    for (int d0 = 0; d0 < 2; ++d0) { s16x4 lo[4], hi[4];
#pragma unroll
        for (int ks = 0; ks < 4; ++ks) {
            asm volatile("ds_read_b64_tr_b16 %0,%1 offset:%c2" : "=&v"(lo[ks]) : "v"(vb), "i"(d0 * 4096 + ks * 1024) : "memory");
            asm volatile("ds_read_b64_tr_b16 %0,%1 offset:%c2" : "=&v"(hi[ks]) : "v"(vb), "i"(d0 * 4096 + ks * 1024 + 512) : "memory"); }
        asm volatile("s_waitcnt lgkmcnt(0)" ::: "memory"); ATT_SBAR();
#define ATT_PK(k) (bf16x8){lo[k][0], lo[k][1], lo[k][2], lo[k][3], hi[k][0], hi[k][1], hi[k][2], hi[k][3]}
        o[d0] = __builtin_amdgcn_mfma_f32_32x32x16_bf16(pa0, ATT_PK(0), o[d0], 0, 0, 0);
        o[d0] = __builtin_amdgcn_mfma_f32_32x32x16_bf16(pa1, ATT_PK(1), o[d0], 0, 0, 0);
        o[d0] = __builtin_amdgcn_mfma_f32_32x32x16_bf16(pa2, ATT_PK(2), o[d0], 0, 0, 0);
        o[d0] = __builtin_amdgcn_mfma_f32_32x32x16_bf16(pa3, ATT_PK(3), o[d0], 0, 0, 0);
#undef ATT_PK
    }
}
#define ATT_WAIT_BAR0() asm volatile("s_waitcnt vmcnt(0) lgkmcnt(0)\n\ts_barrier" ::: "memory")
template <int THRL>
__device__ __forceinline__ void attn_unit(int b, int h, int qb, const bf16* Q, const bf16* K, const bf16* V, bf16* O, char* shm) {
    const int tid = threadIdx.x, lane = tid & 63, r32 = lane & 31, hi = lane >> 5; const int wid = __builtin_amdgcn_readfirstlane(tid >> 6);
    const long rowbase = (long)b * SEQ; const int q0 = qb * 256; const int NTL = 4 * qb + 4, tmax = 4 * qb + (wid >> 1);
    const bf16* Qw = Q + (rowbase + q0 + wid * 32) * QP + h * DQK;
    const long bh = (long)b * MH + h;
    const bf16* ksrc0 = K + (bh * 128 * 12 + wid) * 512 + lane * 8;
    const bf16* ksrc1 = K + (bh * 128 * 12 + 8 + (wid & 3)) * 512 + lane * 8;
    const bf16* vsrc = V + (bh * 128 * 2 + (wid >> 2)) * 2048 + (16 * (wid & 3) + (lane >> 2)) * 32 + (lane & 3) * 8;
    const unsigned lds0 = (unsigned)(uintptr_t)shm;
    const unsigned kdst0 = lds0 + LDS_K + wid * 1024, kdst1 = lds0 + LDS_K + (8 + (wid & 3)) * 1024, vdst = lds0 + LDS_V + wid * 1024;
    float* wsf = (float*)(shm + LDS_WS) + wid * 64;
#define ATT_DMA(t, s) do { glds16(ksrc0 + (long)(t) * 6144, (unsigned)__builtin_amdgcn_readfirstlane(kdst0 + (s) * KSLOT)); \
        if (wid < 4) glds16(ksrc1 + (long)(t) * 6144, (unsigned)__builtin_amdgcn_readfirstlane(kdst1 + (s) * KSLOT)); \
        glds16(vsrc + (long)(t) * 4096, (unsigned)__builtin_amdgcn_readfirstlane(vdst + (s) * VSLOT)); } while (0)
    ATT_DMA(0, 0);
    bf16x8 qr[6];
#pragma unroll
    for (int d0 = 0; d0 < 6; ++d0) qr[d0] = *reinterpret_cast<const bf16x8*>(&Qw[(long)r32 * QP + d0 * 16 + hi * 8]);
    float mhat = 0.f, l_reg = 0.f; f32x16 o[2]; o[0] = f32x16{}; o[1] = f32x16{}; f32x16 negm = f32x16{}; asm volatile("" : "+v"(negm));
    const lds_cptr shm3 = (lds_cptr)shm;
    const int vlane = ((lane >> 4) & 1) * 32 + (lane & 3) * 8 + (4 * hi + ((lane & 15) >> 2)) * 64;
    u32x4 pw0 = (u32x4){0u, 0u, 0u, 0u}, pw1 = pw0, pw2 = pw0, pw3 = pw0;
    s16x4 vlo[8], vhi[8];
#define ATT_KRD(slot, d0) do { ka[slot] = *(const __attribute__((address_space(3))) bf16x8*)(kp + (d0) * 2048); kb[slot] = *(const __attribute__((address_space(3))) bf16x8*)(kp + (d0) * 2048 + 512); } while (0)
#define ATT_VRD(i) do { vlo[i] = vtr(vp + (((i) >> 2) * 4096 + ((i) & 3) * 1024)); vhi[i] = vtr(vp + (((i) >> 2) * 4096 + ((i) & 3) * 1024 + 512)); } while (0)
#define ATT_QKSM(t, s) do { \
        const lds_cptr kp = shm3 + LDS_K + (s) * KSLOT + hi * 1024 + r32 * 16; const lds_cptr vp = shm3 + LDS_V + (s) * VSLOT + vlane; \
        f32x16 p0, p1; bf16x8 ka[3], kb[3]; \
        ATT_KRD(0, 0); ATT_KRD(1, 1); ATT_SBAR(); \
        ATT_KRD(2, 2); p0 = __builtin_amdgcn_mfma_f32_32x32x16_bf16(ka[0], qr[0], negm, 0, 0, 0); p1 = __builtin_amdgcn_mfma_f32_32x32x16_bf16(kb[0], qr[0], negm, 0, 0, 0); ATT_VRD(0); ATT_VRD(1); ATT_SBAR(); \
        ATT_KRD(0, 3); p0 = __builtin_amdgcn_mfma_f32_32x32x16_bf16(ka[1], qr[1], p0, 0, 0, 0); p1 = __builtin_amdgcn_mfma_f32_32x32x16_bf16(kb[1], qr[1], p1, 0, 0, 0); ATT_VRD(2); ATT_VRD(3); ATT_SBAR(); \
        ATT_KRD(1, 4); p0 = __builtin_amdgcn_mfma_f32_32x32x16_bf16(ka[2], qr[2], p0, 0, 0, 0); p1 = __builtin_amdgcn_mfma_f32_32x32x16_bf16(kb[2], qr[2], p1, 0, 0, 0); ATT_VRD(4); ATT_VRD(5); ATT_SBAR(); \
        ATT_KRD(2, 5); p0 = __builtin_amdgcn_mfma_f32_32x32x16_bf16(ka[0], qr[3], p0, 0, 0, 0); p1 = __builtin_amdgcn_mfma_f32_32x32x16_bf16(kb[0], qr[3], p1, 0, 0, 0); ATT_VRD(6); ATT_VRD(7); ATT_SBAR(); \
        p0 = __builtin_amdgcn_mfma_f32_32x32x16_bf16(ka[1], qr[4], p0, 0, 0, 0); p1 = __builtin_amdgcn_mfma_f32_32x32x16_bf16(kb[1], qr[4], p1, 0, 0, 0); ATT_SBAR(); \
        p0 = __builtin_amdgcn_mfma_f32_32x32x16_bf16(ka[2], qr[5], p0, 0, 0, 0); p1 = __builtin_amdgcn_mfma_f32_32x32x16_bf16(kb[2], qr[5], p1, 0, 0, 0); ATT_SBAR(); \
        const float rm = rowmax(p0, p1); \
        if ((t) == 0) { mhat = rm; \
            _Pragma("unroll") for (int r = 0; r < 16; ++r) { p0[r] -= rm; p1[r] -= rm; } \
            _Pragma("unroll") for (int r = 0; r < 16; ++r) negm[r] = -mhat; \
            asm volatile("" : "+v"(negm)); \
        } else if (__any(rm > (float)THRL)) { const float dl = __builtin_fmaxf(rm, 0.f); mhat += dl; \
            _Pragma("unroll") for (int r = 0; r < 16; ++r) { p0[r] -= dl; p1[r] -= dl; } \
            _Pragma("unroll") for (int r = 0; r < 16; ++r) negm[r] = -mhat; \
            asm volatile("" : "+v"(negm)); \
            const float f = __builtin_amdgcn_exp2f(-dl); l_reg *= f; if (hi == 0) wsf[r32] = f; \
            asm volatile("s_waitcnt lgkmcnt(0)" ::: "memory"); \
            _Pragma("unroll") for (int d_ = 0; d_ < 2; ++d_) _Pragma("unroll") for (int r = 0; r < 16; ++r) o[d_][r] *= wsf[crow(r, hi)]; } \
        float sacc = 0.f; \
        _Pragma("unroll") for (int r = 0; r < 16; ++r) { p0[r] = __builtin_amdgcn_exp2f(p0[r]); p1[r] = __builtin_amdgcn_exp2f(p1[r]); sacc += p0[r] + p1[r]; } \
        l_reg += sacc; \
        pw0 = (u32x4){cvtpk_s(p0[0], p0[1]), cvtpk_s(p0[2], p0[3]), cvtpk_s(p0[4], p0[5]), cvtpk_s(p0[6], p0[7])}; \
        pw1 = (u32x4){cvtpk_s(p0[8], p0[9]), cvtpk_s(p0[10], p0[11]), cvtpk_s(p0[12], p0[13]), cvtpk_s(p0[14], p0[15])}; \
        pw2 = (u32x4){cvtpk_s(p1[0], p1[1]), cvtpk_s(p1[2], p1[3]), cvtpk_s(p1[4], p1[5]), cvtpk_s(p1[6], p1[7])}; \
        pw3 = (u32x4){cvtpk_s(p1[8], p1[9]), cvtpk_s(p1[10], p1[11]), cvtpk_s(p1[12], p1[13]), cvtpk_s(p1[14], p1[15])}; \
    } while (0)
#define ATT_VFR(i) (bf16x8){vlo[i][0], vlo[i][1], vlo[i][2], vlo[i][3], vhi[i][0], vhi[i][1], vhi[i][2], vhi[i][3]}
#define ATT_PV(s) do { ATT_SBAR(); \
        o[0] = __builtin_amdgcn_mfma_f32_32x32x16_bf16(__builtin_bit_cast(bf16x8, pw0), ATT_VFR(0), o[0], 0, 0, 0); o[1] = __builtin_amdgcn_mfma_f32_32x32x16_bf16(__builtin_bit_cast(bf16x8, pw0), ATT_VFR(4), o[1], 0, 0, 0); \
        o[0] = __builtin_amdgcn_mfma_f32_32x32x16_bf16(__builtin_bit_cast(bf16x8, pw1), ATT_VFR(1), o[0], 0, 0, 0); o[1] = __builtin_amdgcn_mfma_f32_32x32x16_bf16(__builtin_bit_cast(bf16x8, pw1), ATT_VFR(5), o[1], 0, 0, 0); \
        o[0] = __builtin_amdgcn_mfma_f32_32x32x16_bf16(__builtin_bit_cast(bf16x8, pw2), ATT_VFR(2), o[0], 0, 0, 0); o[1] = __builtin_amdgcn_mfma_f32_32x32x16_bf16(__builtin_bit_cast(bf16x8, pw2), ATT_VFR(6), o[1], 0, 0, 0); \
        o[0] = __builtin_amdgcn_mfma_f32_32x32x16_bf16(__builtin_bit_cast(bf16x8, pw3), ATT_VFR(3), o[0], 0, 0, 0); o[1] = __builtin_amdgcn_mfma_f32_32x32x16_bf16(__builtin_bit_cast(bf16x8, pw3), ATT_VFR(7), o[1], 0, 0, 0); \
    } while (0)
    int s_cur = 0, s_prev = 2;
    if (wid < 4) {
        for (int t = 0; t < NTL; ++t) {
            ATT_WAIT_BAR0();
            const int s_next = (s_cur == 2) ? 0 : s_cur + 1;
            if (t + 1 < NTL) ATT_DMA(t + 1, s_next);
            if (t <= tmax) { ATT_QKSM(t, s_cur); ATT_PV(s_cur); }
            s_prev = s_cur; s_cur = s_next;
        }
    } else {
        for (int t = 0; t < NTL; ++t) {
            ATT_WAIT_BAR0();
            const int s_next = (s_cur == 2) ? 0 : s_cur + 1;
            if (t + 1 < NTL) ATT_DMA(t + 1, s_next);
            if (t >= 1 && t - 1 <= tmax) ATT_PV(s_prev);
            if (t <= tmax) ATT_QKSM(t, s_cur);
            s_prev = s_cur; s_cur = s_next;
        }
        if (NTL - 1 <= tmax) ATT_PV(s_prev);
    }
    { auto rr = __builtin_amdgcn_permlane32_swap(__float_as_uint(l_reg), __float_as_uint(l_reg), false, false); l_reg = __uint_as_float(rr[0]) + __uint_as_float(rr[1]); }
    if (hi == 0) wsf[32 + r32] = l_reg;
    asm volatile("s_waitcnt lgkmcnt(0)" ::: "memory");
    float rli[16];
#pragma unroll
    for (int r = 0; r < 16; ++r) rli[r] = __builtin_amdgcn_rcpf(wsf[32 + crow(r, hi)]);
    const long orow0 = rowbase + q0 + wid * 32; const int ocol0 = 512 + h * MV;
    { bf16* stg = (bf16*)(shm + LDS_OST) + wid * 2048;
#pragma unroll
        for (int r = 0; r < 16; ++r) { const int orow = crow(r, hi);
#pragma unroll
            for (int d0 = 0; d0 < 2; ++d0) stg[orow * 64 + d0 * 32 + r32] = (bf16)f2bf(o[d0][r] * rli[r]); }
        asm volatile("s_waitcnt lgkmcnt(0)" ::: "memory");
#pragma unroll
        for (int i = 0; i < 4; ++i) { const int row = i * 8 + (lane >> 3), ch = lane & 7; const u32x4 v = *(const u32x4*)(stg + row * 64 + ch * 8); const long r = orow0 + row; const int c = ocol0 + ch * 8;
            *(u32x4*)(O + ((r >> 4) * 32 + (c >> 5)) * 512 + (r & 15) * 32 + (c & 31)) = v; } }
    asm volatile("s_waitcnt lgkmcnt(0)\n\ts_barrier" ::: "memory");
#undef ATT_DMA
#undef ATT_QKSM
#undef ATT_KRD
#undef ATT_VRD
#undef ATT_VFR
#undef ATT_PV
}
__device__ __forceinline__ void attn_phase(const Ctx& C, char* lds) {
    const bf16* QF = (const bf16*)(C.ws + WS_QF); const bf16* KF = (const bf16*)(C.ws + WS_KF); const bf16* VF = (const bf16*)(C.ws + WS_VF); bf16* O = (bf16*)(C.ws + WS_B);
    const int G = (int)gridDim.x, bx = (int)blockIdx.x; const int vcu = (G % 8 == 0) ? (bx % 8) * (G / 8) + bx / 8 : bx;
    for (int i = vcu; i < BATCH * MH * 32; i += G) { const int bh = (i & 255) >> 4, s = i & 15, qb = (i < 256) ? 31 - s : s;
        attn_unit<8>(bh >> 3, bh & 7, qb, QF, KF, VF, O, lds); }
    __syncthreads();
}
}

namespace gla {
using att::bf16x8; using att::s16x4; using att::f32x16; using att::lds_cptr; using att::crow; using att::cvtpk_s;
constexpr int L_VIMG = 0, L_QIMG = 16384, L_KIMG = 24576, L_WT = 32768, L_OBUF = 36864, OLD = 132, L_WG = 73728, L_BG = L_WG + 16384;
#define GLA_BAR() asm volatile("s_waitcnt lgkmcnt(0)\n\ts_barrier" ::: "memory")
__device__ __forceinline__ void stage_gate(const Ctx& C, unsigned char* lds) {
    const int tid = threadIdx.x;
#pragma unroll
    for (int i = 0; i < 2; ++i) *(f32x4*)(lds + L_WG + (tid + NT * i) * 16) = *(const f32x4*)(C.w_gate_up + (tid + NT * i) * 4);
    if (tid < 64) *(f32x4*)(lds + L_BG + tid * 16) = *(const f32x4*)(C.b_gate + tid * 4);
}
__device__ __forceinline__ void cum_rows(const u32x4 g0, const u32x4 g1, int h, const unsigned char* lds, float (&cum)[8], float (&tot)[8]) {
    const int tid = threadIdx.x, lane = tid & 63; const int wv = __builtin_amdgcn_readfirstlane(tid >> 6);
    float zg[16];
    { float a[8], b[8]; unpack8(g0, a); unpack8(g1, b);
#pragma unroll
      for (int j = 0; j < 8; ++j) { zg[j] = a[j]; zg[8 + j] = b[j]; } }
    float x[8];
    { const f32x4 b0 = *(const f32x4*)(lds + L_BG + (h * 64 + 8 * wv) * 4), b1 = *(const f32x4*)(lds + L_BG + (h * 64 + 8 * wv + 4) * 4);
      x[0] = b0.x; x[1] = b0.y; x[2] = b0.z; x[3] = b0.w; x[4] = b1.x; x[5] = b1.y; x[6] = b1.z; x[7] = b1.w; }
#pragma unroll
    for (int gh = 0; gh < 2; ++gh) { f32x4 w0[8], w1[8];
#pragma unroll
        for (int g = 0; g < 8; ++g) { w0[g] = *(const f32x4*)(lds + L_WG + ((gh * 8 + g) * 256 + h * 64 + 8 * wv) * 4); w1[g] = *(const f32x4*)(lds + L_WG + ((gh * 8 + g) * 256 + h * 64 + 8 * wv + 4) * 4); }
#pragma unroll
        for (int g = 0; g < 8; ++g) { const float z = zg[gh * 8 + g];
            x[0] += z * w0[g].x; x[1] += z * w0[g].y; x[2] += z * w0[g].z; x[3] += z * w0[g].w; x[4] += z * w1[g].x; x[5] += z * w1[g].y; x[6] += z * w1[g].z; x[7] += z * w1[g].w; } }
#pragma unroll
    for (int j = 0; j < 8; ++j) x[j] = log_gate(x[j]);
#define GLA_DPP(v, ctrl, rmask) __builtin_bit_cast(float, __builtin_amdgcn_update_dpp(0, __builtin_bit_cast(int, (v)), (ctrl), (rmask), 0xF, true))
#pragma unroll
    for (int j = 0; j < 8; ++j) { float v = x[j];
        v += GLA_DPP(v, 0x111, 0xF); v += GLA_DPP(v, 0x112, 0xF); v += GLA_DPP(v, 0x114, 0xF); v += GLA_DPP(v, 0x118, 0xF);
        v += GLA_DPP(v, 0x142, 0xA); v += GLA_DPP(v, 0x143, 0xC);
        cum[j] = v; tot[j] = __builtin_bit_cast(float, __builtin_amdgcn_readlane(__builtin_bit_cast(int, v), 63)); }
#undef GLA_DPP
}
__device__ __forceinline__ void trfrag4(int base, bf16x8 (&f)[4]) {
    s16x4 lo[4], hi[4];
#pragma unroll
    for (int ks = 0; ks < 4; ++ks) {
        asm volatile("ds_read_b64_tr_b16 %0,%1 offset:%c2" : "=&v"(lo[ks]) : "v"(base), "i"(ks * 1024) : "memory");
        asm volatile("ds_read_b64_tr_b16 %0,%1 offset:%c2" : "=&v"(hi[ks]) : "v"(base), "i"(ks * 1024 + 512) : "memory"); }
    asm volatile("s_waitcnt lgkmcnt(0)" ::: "memory"); __builtin_amdgcn_sched_barrier(0);
#pragma unroll
    for (int ks = 0; ks < 4; ++ks) f[ks] = (bf16x8){lo[ks][0], lo[ks][1], lo[ks][2], lo[ks][3], hi[ks][0], hi[ks][1], hi[ks][2], hi[ks][3]};
}
struct Raw { u32x4 q, k, v0, v1, g0, g1, z0, z1; bf16x8 pf[4]; };
template <bool P2>
__device__ __forceinline__ void load_raw(const Ctx& C, int u, Raw& R) {
    const bf16* Z = (const bf16*)(C.ws + WS_Z); const bf16* PREV = (const bf16*)(C.ws + WS_A);
    const int tid = threadIdx.x, lane = tid & 63, r32 = lane & 31, hi = lane >> 5, c = tid >> 3, dc = tid & 7; const int wv = __builtin_amdgcn_readfirstlane(tid >> 6);
    const int n = u % NCH, h = (u / NCH) % GH, b = u / (NCH * GH); const int row0 = b * SEQ + n * 64;
    const size_t rl_ = (size_t)(row0 + lane);
    R.k = *(const u32x4*)(Z + ztile(rl_, ZC_K + h * 64 + 8 * wv)); R.g0 = *(const u32x4*)(Z + ztile(rl_, ZC_GATE)); R.g1 = *(const u32x4*)(Z + ztile(rl_, ZC_GATE + 8));
    { const int j = tid >> 4, cc = tid & 15; R.v0 = *(const u32x4*)(Z + ztile((size_t)(row0 + j), ZC_V + h * 128 + cc * 8)); R.v1 = *(const u32x4*)(Z + ztile((size_t)(row0 + 32 + j), ZC_V + h * 128 + cc * 8)); }
    if (P2) { R.q = *(const u32x4*)(Z + ztile(rl_, ZC_Q + h * 64 + 8 * wv)); const size_t rc_ = (size_t)(row0 + c); R.z0 = *(const u32x4*)(Z + ztile(rc_, ZC_G + h * 128 + 16 * dc)); R.z1 = *(const u32x4*)(Z + ztile(rc_, ZC_G + h * 128 + 16 * dc + 8));
        const int cb = wv & 3;
#pragma unroll
        for (int s = 0; s < 4; ++s) R.pf[s] = *(const bf16x8*)(PREV + ((size_t)u * 128 + 32 * cb + r32) * 64 + 16 * s + 8 * hi); }
}
__device__ __forceinline__ void store_vimg(const Raw& R, unsigned char* lds) {
    const int tid = threadIdx.x, j = tid >> 4, cc = tid & 15;
    *(u32x4*)(lds + L_VIMG + (cc >> 2) * 4096 + j * 64 + (cc & 3) * 16) = R.v0; *(u32x4*)(lds + L_VIMG + (cc >> 2) * 4096 + (32 + j) * 64 + (cc & 3) * 16) = R.v1;
}
__device__ __forceinline__ void pass1(const Ctx& C, unsigned char* lds) {
    float* CKV = (float*)(C.ws + WS_CKV); float* DEC = (float*)(C.ws + WS_DEC);
    const int tid = threadIdx.x, lane = tid & 63, r32 = lane & 31, hi = lane >> 5, c = tid >> 3, dc = tid & 7; const int wv = __builtin_amdgcn_readfirstlane(tid >> 6);
    const unsigned lds0 = (unsigned)(uintptr_t)lds; const int lpart = ((lane >> 4) & 1) * 32 + (lane & 3) * 8 + (4 * hi + ((lane & 15) >> 2)) * 64;
    const int NU = BATCH * GH * NCH, G = (int)gridDim.x;
    __syncthreads(); stage_gate(C, lds);
    Raw cur; if ((int)blockIdx.x < NU) load_raw<false>(C, (int)blockIdx.x, cur);
    for (int u = blockIdx.x; u < NU; u += G) {
        const int h = (u / NCH) % GH;
        Raw nxt = cur; if (u + G < NU) load_raw<false>(C, u + G, nxt);
        GLA_BAR();
        store_vimg(cur, lds);
        float kv[8]; unpack8(cur.k, kv);
        float cum[8], tot[8]; cum_rows(cur.g0, cur.g1, h, lds, cum, tot);
#pragma unroll
        for (int j = 0; j < 8; ++j) kv[j] *= fexp(tot[j] - cum[j]);
        *(u32x4*)(lds + L_QIMG + (wv >> 2) * 4096 + lane * 64 + (wv & 3) * 16) = pack8(kv);
        if (lane == 63) {
#pragma unroll
            for (int j = 0; j < 8; ++j) DEC[(size_t)u * 64 + 8 * wv + j] = fexp(tot[j]); }
        GLA_BAR();
        const int vb = wv >> 1, db = wv & 1;
        bf16x8 af[4], bfr[4]; trfrag4((int)(lds0 + L_VIMG + vb * 4096) + lpart, af); trfrag4((int)(lds0 + L_QIMG + db * 4096) + lpart, bfr);
        f32x16 o = f32x16{};
#pragma unroll
        for (int ks = 0; ks < 4; ++ks) o = __builtin_amdgcn_mfma_f32_32x32x16_bf16(af[ks], bfr[ks], o, 0, 0, 0);
#pragma unroll
        for (int r = 0; r < 16; ++r) CKV[((size_t)u * 128 + 32 * vb + crow(r, hi)) * 64 + 32 * db + r32] = o[r];
        cur = nxt;
    }
    __syncthreads();
}
__device__ __forceinline__ void pass2(const Ctx& C, unsigned char* lds) {
    bf16* MIX = (bf16*)(C.ws + WS_B);
    const int tid = threadIdx.x, lane = tid & 63, r32 = lane & 31, hi = lane >> 5, c = tid >> 3, dc = tid & 7; const int wv = __builtin_amdgcn_readfirstlane(tid >> 6);
    const unsigned lds0 = (unsigned)(uintptr_t)lds; const int lpart = ((lane >> 4) & 1) * 32 + (lane & 3) * 8 + (4 * hi + ((lane & 15) >> 2)) * 64;
    const lds_cptr L3 = (lds_cptr)lds; float* obuf = (float*)(lds + L_OBUF);
    const int rb = wv >> 2, cb = wv & 3;
    const int NU = BATCH * GH * NCH, G = (int)gridDim.x;
    f32x4 gn[4];
#pragma unroll
    for (int i = 0; i < 4; ++i) gn[i] = *(const f32x4*)(C.gla_out_norm + 16 * dc + 4 * i);
    __syncthreads(); stage_gate(C, lds);
    Raw cur; if ((int)blockIdx.x < NU) load_raw<true>(C, (int)blockIdx.x, cur);
    for (int u = blockIdx.x; u < NU; u += G) {
        const int n = u % NCH, h = (u / NCH) % GH, b = u / (NCH * GH); const int row0 = b * SEQ + n * 64;
        Raw nxt = cur; if (u + G < NU) load_raw<true>(C, u + G, nxt);
        GLA_BAR();
        store_vimg(cur, lds);
        float qv[8], kv[8]; unpack8(cur.q, qv); unpack8(cur.k, kv);
        float cum[8], tot[8]; cum_rows(cur.g0, cur.g1, h, lds, cum, tot);
#pragma unroll
        for (int j = 0; j < 8; ++j) { qv[j] *= 0.125f * fexp(cum[j]); kv[j] *= fexp(-cum[j]); }
        *(u32x4*)(lds + L_QIMG + wv * 1024 + lane * 16) = pack8(qv); *(u32x4*)(lds + L_KIMG + wv * 1024 + lane * 16) = pack8(kv);
        GLA_BAR();
        bf16x8 qr[4];
#pragma unroll
        for (int s = 0; s < 4; ++s) qr[s] = *(const __attribute__((address_space(3))) bf16x8*)(L3 + L_QIMG + (2 * s + hi) * 1024 + (32 * rb + r32) * 16);
        f32x16 p0 = f32x16{}, p1 = f32x16{};
#pragma unroll
        for (int s = 0; s < 4; ++s) { const lds_cptr kp = L3 + L_KIMG + (2 * s + hi) * 1024 + r32 * 16;
            const bf16x8 a0 = *(const __attribute__((address_space(3))) bf16x8*)(kp), a1 = *(const __attribute__((address_space(3))) bf16x8*)(kp + 512);
            p0 = __builtin_amdgcn_mfma_f32_32x32x16_bf16(a0, qr[s], p0, 0, 0, 0); p1 = __builtin_amdgcn_mfma_f32_32x32x16_bf16(a1, qr[s], p1, 0, 0, 0); }
        const int cq = 32 * rb + r32;
#pragma unroll
        for (int r = 0; r < 16; ++r) { const int j = crow(r, hi); p0[r] = (j <= cq) ? p0[r] : 0.f; p1[r] = (j + 32 <= cq) ? p1[r] : 0.f; }
        u32x4 pw0, pw1, pw2, pw3;
        pw0 = (u32x4){cvtpk_s(p0[0], p0[1]), cvtpk_s(p0[2], p0[3]), cvtpk_s(p0[4], p0[5]), cvtpk_s(p0[6], p0[7])};
        pw1 = (u32x4){cvtpk_s(p0[8], p0[9]), cvtpk_s(p0[10], p0[11]), cvtpk_s(p0[12], p0[13]), cvtpk_s(p0[14], p0[15])};
        pw2 = (u32x4){cvtpk_s(p1[0], p1[1]), cvtpk_s(p1[2], p1[3]), cvtpk_s(p1[4], p1[5]), cvtpk_s(p1[6], p1[7])};
        pw3 = (u32x4){cvtpk_s(p1[8], p1[9]), cvtpk_s(p1[10], p1[11]), cvtpk_s(p1[12], p1[13]), cvtpk_s(p1[14], p1[15])};
        __builtin_amdgcn_sched_barrier(0);
        bf16x8 vf[4]; trfrag4((int)(lds0 + L_VIMG + cb * 4096) + lpart, vf);
        f32x16 o = f32x16{};
        o = __builtin_amdgcn_mfma_f32_32x32x16_bf16(__builtin_bit_cast(bf16x8, pw0), vf[0], o, 0, 0, 0);
        o = __builtin_amdgcn_mfma_f32_32x32x16_bf16(__builtin_bit_cast(bf16x8, pw1), vf[1], o, 0, 0, 0);
        o = __builtin_amdgcn_mfma_f32_32x32x16_bf16(__builtin_bit_cast(bf16x8, pw2), vf[2], o, 0, 0, 0);
        o = __builtin_amdgcn_mfma_f32_32x32x16_bf16(__builtin_bit_cast(bf16x8, pw3), vf[3], o, 0, 0, 0);
#pragma unroll
        for (int s = 0; s < 4; ++s) o = __builtin_amdgcn_mfma_f32_32x32x16_bf16(qr[s], cur.pf[s], o, 0, 0, 0);
#pragma unroll
        for (int r = 0; r < 16; ++r) obuf[(32 * rb + crow(r, hi)) * OLD + 32 * cb + r32] = o[r];
        GLA_BAR();
        { float ov[16];
#pragma unroll
            for (int i = 0; i < 4; ++i) { const f32x4 t = *(const f32x4*)(obuf + c * OLD + 16 * dc + 4 * i); ov[4 * i] = t.x; ov[4 * i + 1] = t.y; ov[4 * i + 2] = t.z; ov[4 * i + 3] = t.w; }
            float ss = 0.f;
#pragma unroll
            for (int i = 0; i < 16; ++i) ss += ov[i] * ov[i];
            ss += __shfl_xor(ss, 1); ss += __shfl_xor(ss, 2); ss += __shfl_xor(ss, 4);
            const float rn = rsqrtf(ss * (1.f / GDV) + EPS); const size_t row = (size_t)(row0 + c);
            float g0[8], g1[8]; unpack8(cur.z0, g0); unpack8(cur.z1, g1);
            const float gv[16] = {gn[0].x, gn[0].y, gn[0].z, gn[0].w, gn[1].x, gn[1].y, gn[1].z, gn[1].w, gn[2].x, gn[2].y, gn[2].z, gn[2].w, gn[3].x, gn[3].y, gn[3].z, gn[3].w};
            float w0[8], w1[8];
#pragma unroll
            for (int i = 0; i < 8; ++i) { w0[i] = ov[i] * rn * gv[i] * silu_f(g0[i]); w1[i] = ov[8 + i] * rn * gv[8 + i] * silu_f(g1[i]); }
            { const int c0 = h * 128 + 16 * dc; bf16* mp = MIX + ((row >> 4) * 32 + (c0 >> 5)) * 512 + (row & 15) * 32 + (c0 & 31);
              *(u32x4*)mp = pack8(w0); *(u32x4*)(mp + 8) = pack8(w1); } }
        cur = nxt;
    }
    __syncthreads();
}
#undef GLA_BAR
}

namespace pg8 {
#define PG8_LAS __attribute__((address_space(3)))
typedef unsigned short bf16_t;
typedef short bf16x8 __attribute__((ext_vector_type(8)));
typedef float f32x4 __attribute__((ext_vector_type(4)));
typedef unsigned u32x4 __attribute__((ext_vector_type(4)));
constexpr int BM = 256, BK = 64, HALF = 128, HTB = HALF * BK * 2  , STAGE_BYTES = 8 * HTB, NXCD = 8, WGM = 8;

__host__ __device__ __forceinline__ int lds_byte(int r, int c) { const int st = (r >> 4) * 2 + (c >> 5), rr = r & 15, cc = c & 31, ob = rr * 64 + cc * 2; return st * 1024 + (ob ^ (((ob >> 9) & 1) << 5)); }
__host__ __device__ __forceinline__ void stage_rc(int b, int& R, int& C) { const int st = b / 1024, sb = b % 1024, swz = sb ^ (((sb >> 9) & 1) << 5); R = (st >> 1) * 16 + swz / 64; C = (st & 1) * 32 + (swz % 64) / 2; }
__host__ __device__ __forceinline__ int perm32(int rho) { const int n = rho >> 4, i = rho & 15; return 8 * (i >> 2) + 4 * n + (i & 3); }

struct Unit { int pm, pn; };
struct Gemm { const bf16_t* A; const bf16_t* Bt; int M, N, K, lda; bool ta, tb; };

struct StaticOrder {
    int nM, nN, nwg, G, c;
    __host__ __device__ void init(int M, int N, int G_, int c_) { nM = M / BM; nN = N / BM; nwg = nM * nN; G = G_; c = c_; }
    __host__ __device__ bool next(int i, Unit& u) const {
        const long L = (long)i * G + c; if (L >= nwg) return false;
        int wgid = (int)L; { const int q = nwg / NXCD, r = nwg % NXCD, xcd = wgid % NXCD, off = wgid / NXCD; wgid = (xcd < r ? xcd * (q + 1) : r * (q + 1) + (xcd - r) * q) + off; }
        const int nig = WGM * nN, gid = wgid / nig, fm = gid * WGM, gsz = (nM - fm) < WGM ? (nM - fm) : WGM;
        u.pm = fm + ((wgid % nig) % gsz); u.pn = (wgid % nig) / gsz; return true;
    }
    __device__ __forceinline__ void a_ready(const Unit&) const {}
    __device__ __forceinline__ void done(const Unit&) const {}
};

__device__ __forceinline__ unsigned cvt_pk_bf16(float lo, float hi) { unsigned r; asm volatile("v_cvt_pk_bf16_f32 %0, %1, %2" : "=v"(r) : "v"(lo), "v"(hi)); return r; }
typedef float f32x2 __attribute__((ext_vector_type(2)));
typedef unsigned u32x2v __attribute__((ext_vector_type(2)));
struct EpiBf16 {
    static constexpr bool PERM = true, AFTER_DRAIN = false; static constexpr int PROBE_BIT = 26;
    bf16_t* O; int ldc;
    __device__ __forceinline__ void operator()(const f32x4 (&acc)[2][2][4][2], const Unit& u, int wr, int wc, int fr, int fq) const {
        const int row0 = u.pm * BM + wr * 64 + fr, col0 = u.pn * BM + wc * 32 + 8 * fq;
#pragma unroll
        for (int ai = 0; ai < 2; ++ai)
#pragma unroll
            for (int m = 0; m < 4; ++m) { bf16_t* rowp = O + (size_t)(row0 + ai * HALF + m * 16) * ldc + col0;
#pragma unroll
                for (int bj = 0; bj < 2; ++bj) { const f32x4 v0 = acc[ai][bj][m][0], v1 = acc[ai][bj][m][1];
                    u32x4 w; w.x = cvt_pk_bf16(v0[0], v0[1]); w.y = cvt_pk_bf16(v0[2], v0[3]); w.z = cvt_pk_bf16(v1[0], v1[1]); w.w = cvt_pk_bf16(v1[2], v1[3]);
                    *(u32x4*)(rowp + bj * HALF) = w; } }
    }
};
struct EpiZ {
    static constexpr bool PERM = true, AFTER_DRAIN = false; static constexpr int PROBE_BIT = 27;
    bf16_t* O; int ldc; float* ssqq; float* ssqkv; float* ssqpe;
    __device__ __forceinline__ void operator()(const f32x4 (&acc)[2][2][4][2], const Unit& u, int wr, int wc, int fr, int fq) const {
        const int row0 = u.pm * BM + wr * 64 + fr, col0 = u.pn * BM + wc * 32 + 8 * fq;
#pragma unroll
        for (int ai = 0; ai < 2; ++ai)
#pragma unroll
            for (int m = 0; m < 4; ++m) { const int r = row0 + ai * HALF + m * 16; bf16_t* rowp = O + ((size_t)(r >> 4) * (ldc >> 5) + (col0 >> 5)) * 512 + (r & 15) * 32 + (col0 & 31); float sq[2];
#pragma unroll
                for (int bj = 0; bj < 2; ++bj) { const f32x4 v0 = acc[ai][bj][m][0], v1 = acc[ai][bj][m][1];
                    u32x4 w; w.x = cvt_pk_bf16(v0[0], v0[1]); w.y = cvt_pk_bf16(v0[2], v0[3]); w.z = cvt_pk_bf16(v1[0], v1[1]); w.w = cvt_pk_bf16(v1[2], v1[3]);
                    *(u32x4*)(rowp + bj * 4 * 512) = w;
                    sq[bj] = ((v0[0] * v0[0] + v0[1] * v0[1]) + (v0[2] * v0[2] + v0[3] * v0[3])) + ((v1[0] * v1[0] + v1[1] * v1[1]) + (v1[2] * v1[2] + v1[3] * v1[3])); }
                if (u.pn == 6) { float s = sq[0] + sq[1]; s += __shfl_xor(s, 16); s += __shfl_xor(s, 32); if (fq == 0) ssqq[(size_t)r * 4 + wc] = s; }
                else if (u.pn == 7) { float s = sq[0]; s += __shfl_xor(s, 16); s += __shfl_xor(s, 32); if (fq == 0) ssqkv[(size_t)r * 4 + wc] = s;
                    if (wc == 0) { float t = sq[1]; t += __shfl_xor(t, 16); t += __shfl_xor(t, 32); if (fq == 0) ssqpe[r] = t; } } }
    }
};
struct EpiQ {
    static constexpr bool PERM = false, AFTER_DRAIN = true; static constexpr int PROBE_BIT = 25;
    const float* ssqq; const float* gq; const float* cosT; const float* sinT; bf16_t* QF; float eps, qscale;
    __device__ __forceinline__ void fused(f32x4 (&acc)[2][2][4][2], const Unit& u, int wr, int wc, int fr, int fq, PG8_LAS unsigned char* lds, int wid, int lane) const {
        PG8_LAS float* P = (PG8_LAS float*)lds;
        f32x4 s4A[2][4];
#pragma unroll
        for (int ai = 0; ai < 2; ++ai)
#pragma unroll
            for (int m = 0; m < 4; ++m) s4A[ai][m] = *(const f32x4*)(ssqq + (size_t)(u.pm * BM + ai * HALF + wr * 64 + m * 16 + fr) * 4);
        __builtin_amdgcn_sched_barrier(0);
#pragma unroll
        for (int ai = 0; ai < 2; ++ai)
#pragma unroll
            for (int m = 0; m < 4; ++m) { const int rl = ai * HALF + wr * 64 + m * 16 + fr; const f32x4 s4 = s4A[ai][m];
                const float ra = __builtin_amdgcn_rsqf(((s4[0] + s4[1]) + (s4[2] + s4[3])) * (1.0f / 256.0f) + eps);
#pragma unroll
                for (int bj = 0; bj < 2; ++bj) { float s = 0.f;
#pragma unroll
                    for (int n = 0; n < 2; ++n) { const f32x4 v = acc[ai][bj][m][n] * ra; acc[ai][bj][m][n] = v; s += (v[0] * v[0] + v[1] * v[1]) + (v[2] * v[2] + v[3] * v[3]); }
                    s += __shfl_xor(s, 16); s += __shfl_xor(s, 32);
                    if (fq == 0) P[(rl * 2 + bj) * 4 + wc] = s; } }
        asm volatile("s_waitcnt lgkmcnt(0)" ::: "memory"); __builtin_amdgcn_s_barrier(); asm volatile("" ::: "memory");
        PG8_LAS unsigned char* ST = lds + 8192;
        if (wc < 3) {
            const int j0 = wc * 32 + 4 * fq; const f32x4 g0 = *(const f32x4*)(gq + j0), g1 = *(const f32x4*)(gq + j0 + 16);
            f32x4 csA[2][4], snA[2][4];
#pragma unroll
            for (int ai = 0; ai < 2; ++ai)
#pragma unroll
                for (int m = 0; m < 4; ++m) { const size_t r = (size_t)(u.pm * BM + ai * HALF + wr * 64 + m * 16 + fr); csA[ai][m] = (f32x4){1.f, 1.f, 1.f, 1.f}; snA[ai][m] = (f32x4){0.f, 0.f, 0.f, 0.f};
                    if (wc == 2) { csA[ai][m] = *(const f32x4*)(cosT + r * 16 + 4 * fq); snA[ai][m] = *(const f32x4*)(sinT + r * 16 + 4 * fq); } }
            __builtin_amdgcn_sched_barrier(0);
#pragma unroll
            for (int ai = 0; ai < 2; ++ai)
#pragma unroll
                for (int m = 0; m < 4; ++m) { const int rl = ai * HALF + wr * 64 + m * 16 + fr; const f32x4 cs = csA[ai][m], sn = snA[ai][m];
#pragma unroll
                    for (int bj = 0; bj < 2; ++bj) { const f32x4 p = *(const PG8_LAS f32x4*)(P + (rl * 2 + bj) * 4);
                        const float rh = qscale * __builtin_amdgcn_rsqf(((p[0] + p[1]) + (p[2] + p[3])) * (1.0f / 96.0f) + eps);
                        const f32x4 a = acc[ai][bj][m][0] * rh * g0, b = acc[ai][bj][m][1] * rh * g1;
                        f32x4 o0 = a, o1 = b; if (wc == 2) { o0 = a * cs - b * sn; o1 = a * sn + b * cs; }
                        PG8_LAS unsigned char* dst = ST + rl * 400 + (bj * 96 + j0) * 2;
                        u32x2v w0, w1; w0.x = cvt_pk_bf16(o0[0], o0[1]); w0.y = cvt_pk_bf16(o0[2], o0[3]); w1.x = cvt_pk_bf16(o1[0], o1[1]); w1.y = cvt_pk_bf16(o1[2], o1[3]);
                        *(PG8_LAS u32x2v*)dst = w0; *(PG8_LAS u32x2v*)(dst + 32) = w1; }
                    }
        }
        asm volatile("s_waitcnt lgkmcnt(0)" ::: "memory"); __builtin_amdgcn_s_barrier(); asm volatile("" ::: "memory");
        { const int tid = wid * 64 + lane;
#pragma unroll
            for (int i = 0; i < 12; ++i) { const int idx = tid + 512 * i, row = idx / 24, ch = idx - row * 24;
                *(u32x4*)(QF + (size_t)(u.pm * BM + row) * 768 + (2 * u.pn) * 96 + ch * 8) = *(const PG8_LAS u32x4*)(ST + row * 400 + ch * 16); } }
    }
};
struct EpiKV {
    static constexpr bool PERM = false, AFTER_DRAIN = true; static constexpr int PROBE_BIT = 24;
    const float* ssqkv; const float* ssqpe; const float* gk; const float* cosT; const float* sinT; const bf16_t* Z; bf16_t* KF; bf16_t* VF; float eps;
    __device__ __forceinline__ void fused(f32x4 (&acc)[2][2][4][2], const Unit& u, int wr, int wc, int fr, int fq, PG8_LAS unsigned char* lds, int wid, int lane) const {
        PG8_LAS float* P = (PG8_LAS float*)lds;
        f32x4 s4A[2][4];
#pragma unroll
        for (int ai = 0; ai < 2; ++ai)
#pragma unroll
            for (int m = 0; m < 4; ++m) s4A[ai][m] = *(const f32x4*)(ssqkv + (size_t)(u.pm * BM + ai * HALF + wr * 64 + m * 16 + fr) * 4);
        __builtin_amdgcn_sched_barrier(0);
#pragma unroll
        for (int ai = 0; ai < 2; ++ai)
#pragma unroll
            for (int m = 0; m < 4; ++m) { const int rl = ai * HALF + wr * 64 + m * 16 + fr; const f32x4 s4 = s4A[ai][m];
                const float ra = __builtin_amdgcn_rsqf(((s4[0] + s4[1]) + (s4[2] + s4[3])) * (1.0f / 128.0f) + eps);
#pragma unroll
                for (int bj = 0; bj < 2; ++bj) { float s = 0.f;
#pragma unroll
                    for (int n = 0; n < 2; ++n) { const f32x4 v = acc[ai][bj][m][n] * ra; acc[ai][bj][m][n] = v; s += (v[0] * v[0] + v[1] * v[1]) + (v[2] * v[2] + v[3] * v[3]); }
                    if (wc < 2) { s += __shfl_xor(s, 16); s += __shfl_xor(s, 32); if (fq == 0) P[(rl * 2 + bj) * 2 + wc] = s; } } }
        asm volatile("s_waitcnt lgkmcnt(0)" ::: "memory"); __builtin_amdgcn_s_barrier(); asm volatile("" ::: "memory");
        const int j0 = wc * 32 + 4 * fq;
        PG8_LAS unsigned char* ST = lds + 8192;
        if (wc < 2) {
            const f32x4 g0 = *(const f32x4*)(gk + j0), g1 = *(const f32x4*)(gk + j0 + 16);
            float pesA[2][4];
#pragma unroll
            for (int ai = 0; ai < 2; ++ai)
#pragma unroll
                for (int m = 0; m < 4; ++m) pesA[ai][m] = ssqpe[(size_t)(u.pm * BM + ai * HALF + wr * 64 + m * 16 + fr)];
            __builtin_amdgcn_sched_barrier(0);
#pragma unroll
            for (int ai = 0; ai < 2; ++ai)
#pragma unroll
                for (int m = 0; m < 4; ++m) { const int rl = ai * HALF + wr * 64 + m * 16 + fr; const float pes = pesA[ai][m];
#pragma unroll
                    for (int bj = 0; bj < 2; ++bj) { const float rk = __builtin_amdgcn_rsqf((P[(rl * 2 + bj) * 2] + P[(rl * 2 + bj) * 2 + 1] + pes) * (1.0f / 96.0f) + eps);
                        const f32x4 o0 = acc[ai][bj][m][0] * rk * g0, o1 = acc[ai][bj][m][1] * rk * g1; PG8_LAS unsigned char* dst = ST + rl * 400 + (bj * 96 + j0) * 2;
                        u32x2v w0, w1; w0.x = cvt_pk_bf16(o0[0], o0[1]); w0.y = cvt_pk_bf16(o0[2], o0[3]); w1.x = cvt_pk_bf16(o1[0], o1[1]); w1.y = cvt_pk_bf16(o1[2], o1[3]);
                        *(PG8_LAS u32x2v*)dst = w0; *(PG8_LAS u32x2v*)(dst + 32) = w1; }
                    asm volatile("" ::: "memory"); }
        } else {
#pragma unroll
            for (int ai = 0; ai < 2; ++ai)
#pragma unroll
                for (int m = 0; m < 4; ++m) { const int rl = ai * HALF + wr * 64 + m * 16 + fr; const size_t r = (size_t)(u.pm * BM + rl);
#pragma unroll
                    for (int bj = 0; bj < 2; ++bj) { const f32x4 o0 = acc[ai][bj][m][0], o1 = acc[ai][bj][m][1];
                        bf16_t* dst = VF + (((((size_t)(u.pm >> 5) * 8 + 2 * u.pn + bj) * 128 + (u.pm & 31) * 4 + (rl >> 6)) * 2 + (wc - 2)) * 64 + (rl & 63)) * 32 + 4 * fq;
                        u32x2v w0, w1; w0.x = cvt_pk_bf16(o0[0], o0[1]); w0.y = cvt_pk_bf16(o0[2], o0[3]); w1.x = cvt_pk_bf16(o1[0], o1[1]); w1.y = cvt_pk_bf16(o1[2], o1[3]);
                        *(u32x2v*)dst = w0; *(u32x2v*)(dst + 16) = w1; }
                    asm volatile("" ::: "memory"); }
            if (wc == 2) {
                const f32x4 g0 = *(const f32x4*)(gk + 64 + 4 * fq), g1 = *(const f32x4*)(gk + 80 + 4 * fq);
#pragma unroll
                for (int ai = 0; ai < 2; ++ai) {
                    float pesB[4]; u32x2v xaB[4], xbB[4]; f32x4 csB[4], snB[4];
#pragma unroll
                    for (int m = 0; m < 4; ++m) { const size_t r = (size_t)(u.pm * BM + ai * HALF + wr * 64 + m * 16 + fr); pesB[m] = ssqpe[r];
                        xaB[m] = *(const u32x2v*)(Z + ((r >> 4) * 64 + 60) * 512 + (r & 15) * 32 + 4 * fq); xbB[m] = *(const u32x2v*)(Z + ((r >> 4) * 64 + 60) * 512 + (r & 15) * 32 + 16 + 4 * fq);
                        csB[m] = *(const f32x4*)(cosT + r * 16 + 4 * fq); snB[m] = *(const f32x4*)(sinT + r * 16 + 4 * fq); }
                    __builtin_amdgcn_sched_barrier(0);
#pragma unroll
                    for (int m = 0; m < 4; ++m) { const int rl = ai * HALF + wr * 64 + m * 16 + fr; const float pes = pesB[m];
                        const u32x2v xa = xaB[m], xb = xbB[m];
                        const f32x4 x1 = (f32x4){__uint_as_float(xa.x << 16), __uint_as_float(xa.x & 0xffff0000u), __uint_as_float(xa.y << 16), __uint_as_float(xa.y & 0xffff0000u)};
                        const f32x4 x2 = (f32x4){__uint_as_float(xb.x << 16), __uint_as_float(xb.x & 0xffff0000u), __uint_as_float(xb.y << 16), __uint_as_float(xb.y & 0xffff0000u)};
                        const f32x4 cs = csB[m], sn = snB[m];
#pragma unroll
                        for (int bj = 0; bj < 2; ++bj) { const float rk = __builtin_amdgcn_rsqf((P[(rl * 2 + bj) * 2] + P[(rl * 2 + bj) * 2 + 1] + pes) * (1.0f / 96.0f) + eps);
                            const f32x4 a = x1 * rk * g0, b = x2 * rk * g1, o0 = a * cs - b * sn, o1 = a * sn + b * cs; PG8_LAS unsigned char* dst = ST + rl * 400 + (bj * 96 + 64 + 4 * fq) * 2;
                            u32x2v w0, w1; w0.x = cvt_pk_bf16(o0[0], o0[1]); w0.y = cvt_pk_bf16(o0[2], o0[3]); w1.x = cvt_pk_bf16(o1[0], o1[1]); w1.y = cvt_pk_bf16(o1[2], o1[3]);
                            *(PG8_LAS u32x2v*)dst = w0; *(PG8_LAS u32x2v*)(dst + 32) = w1; } }
                    asm volatile("" ::: "memory"); }
            }
        }
        asm volatile("s_waitcnt lgkmcnt(0)" ::: "memory"); __builtin_amdgcn_s_barrier(); asm volatile("" ::: "memory");
        { const int tid = wid * 64 + lane;
#pragma unroll
            for (int i = 0; i < 12; ++i) { const int idx = tid + 512 * i, ch = idx >> 8, row = idx & 255, hd = 2 * u.pn + (ch >= 12 ? 1 : 0), c = ch >= 12 ? ch - 12 : ch;
                *(u32x4*)(KF + (((((size_t)(u.pm >> 5) * 8 + hd) * 128 + (u.pm & 31) * 4 + (row >> 6)) * 12 + c) * 64 + (row & 63)) * 8) = *(const PG8_LAS u32x4*)(ST + row * 400 + ch * 16); } }
    }
};
struct EpiOutProjG {
    static constexpr bool PERM = false, AFTER_DRAIN = false; static constexpr int PROBE_BIT = 28;
    const float* x; float* x1; bf16_t* x1b; float* ssq;
    __device__ __forceinline__ void operator()(const f32x4 (&acc)[2][2][4][2], const Unit& u, int wr, int wc, int fr, int fq) const {
        const int col0 = u.pn * BM + wc * 32 + 4 * fq;
#pragma unroll
        for (int ai = 0; ai < 2; ++ai) {
            f32x4 xr[4][2][2];
#pragma unroll
            for (int m = 0; m < 4; ++m) { const size_t off = (size_t)(u.pm * BM + ai * HALF + wr * 64 + m * 16 + fr) * 1024 + col0;
#pragma unroll
                for (int bj = 0; bj < 2; ++bj)
#pragma unroll
                    for (int n = 0; n < 2; ++n) xr[m][bj][n] = *(const f32x4*)(x + off + bj * HALF + n * 16); }
            __builtin_amdgcn_sched_barrier(0);
#pragma unroll
            for (int m = 0; m < 4; ++m) { const int r = u.pm * BM + ai * HALF + wr * 64 + m * 16 + fr; const size_t off = (size_t)r * 1024 + col0; float s = 0.f;
#pragma unroll
                for (int bj = 0; bj < 2; ++bj)
#pragma unroll
                    for (int n = 0; n < 2; ++n) { const f32x4 t = xr[m][bj][n] + acc[ai][bj][m][n];
                        u32x2v w; w.x = cvt_pk_bf16(t[0], t[1]); w.y = cvt_pk_bf16(t[2], t[3]);
                        *(u32x2v*)(x1b + ((size_t)(r >> 4) * 32 + ((col0 >> 5) + 4 * bj)) * 512 + (r & 15) * 32 + (col0 & 31) + 16 * n) = w;
                        s += (t[0] * t[0] + t[1] * t[1]) + (t[2] * t[2] + t[3] * t[3]); }
                s += __shfl_xor(s, 16); s += __shfl_xor(s, 32);
                if (fq == 0) ssq[(size_t)r * 16 + u.pn * 4 + wc] = s; }
            asm volatile("" ::: "memory"); }
    }
};
struct EpiUpG {
    static constexpr bool PERM = true, AFTER_DRAIN = false; static constexpr int PROBE_BIT = 29;
    const PG8_LAS float* rtab; bf16_t* H;
    __device__ __forceinline__ void operator()(const f32x4 (&acc)[2][2][4][2], const Unit& u, int wr, int wc, int fr, int fq) const { (*this)(acc, u, wr, wc, fr, fq, 0); }
    __device__ __forceinline__ void operator()(const f32x4 (&acc)[2][2][4][2], const Unit& u, int wr, int wc, int fr, int fq, int ui) const {
        const int row0 = u.pm * BM + wr * 64 + fr, col0 = u.pn * BM + wc * 32 + 8 * fq;
#pragma unroll
        for (int ai = 0; ai < 2; ++ai)
#pragma unroll
            for (int m = 0; m < 4; ++m) { const int r = row0 + ai * HALF + m * 16;
                const float rstd = rtab[(ui & 3) * 256 + wr * 64 + fr + ai * HALF + m * 16];
                bf16_t* rowp = H + ((size_t)(r >> 4) * 128 + (col0 >> 5)) * 512 + (r & 15) * 32 + (col0 & 31);
#pragma unroll
                for (int bj = 0; bj < 2; ++bj) { f32x4 v0 = acc[ai][bj][m][0] * rstd, v1 = acc[ai][bj][m][1] * rstd;
#pragma unroll
                    for (int e = 0; e < 4; ++e) { v0[e] = __builtin_fmaxf(v0[e], 0.f); v1[e] = __builtin_fmaxf(v1[e], 0.f); }
                    v0 = v0 * v0; v1 = v1 * v1;
                    u32x4 w; w.x = cvt_pk_bf16(v0[0], v0[1]); w.y = cvt_pk_bf16(v0[2], v0[3]); w.z = cvt_pk_bf16(v1[0], v1[1]); w.w = cvt_pk_bf16(v1[2], v1[3]);
                    *(u32x4*)(rowp + bj * 4 * 512) = w; } }
    }
};
struct EpiDownG {
    static constexpr bool PERM = false, AFTER_DRAIN = false; static constexpr int PROBE_BIT = 30;
    const bf16_t* x1b; float* out;
    __device__ __forceinline__ void operator()(const f32x4 (&acc)[2][2][4][2], const Unit& u, int wr, int wc, int fr, int fq) const {
        const int col0 = u.pn * BM + wc * 32 + 4 * fq;
        u32x2v xw[2][4][2][2];
#pragma unroll
        for (int ai = 0; ai < 2; ++ai)
#pragma unroll
            for (int m = 0; m < 4; ++m) { const size_t off = (size_t)(u.pm * BM + ai * HALF + wr * 64 + m * 16 + fr) * 1024 + col0;
#pragma unroll
                for (int bj = 0; bj < 2; ++bj)
#pragma unroll
                    for (int n = 0; n < 2; ++n) { const int r_ = u.pm * BM + ai * HALF + wr * 64 + m * 16 + fr; xw[ai][m][bj][n] = *(const u32x2v*)(x1b + ((size_t)(r_ >> 4) * 32 + ((col0 >> 5) + 4 * bj)) * 512 + (r_ & 15) * 32 + (col0 & 31) + 16 * n); } }
        __builtin_amdgcn_sched_barrier(0);
#pragma unroll
        for (int ai = 0; ai < 2; ++ai)
#pragma unroll
            for (int m = 0; m < 4; ++m) { const size_t off = (size_t)(u.pm * BM + ai * HALF + wr * 64 + m * 16 + fr) * 1024 + col0;
#pragma unroll
                for (int bj = 0; bj < 2; ++bj)
#pragma unroll
                    for (int n = 0; n < 2; ++n) { const u32x2v w = xw[ai][m][bj][n];
                        const f32x4 xr = (f32x4){__uint_as_float(w.x << 16), __uint_as_float(w.x & 0xffff0000u), __uint_as_float(w.y << 16), __uint_as_float(w.y & 0xffff0000u)};
                        *(f32x4*)(out + off + bj * HALF + n * 16) = xr + acc[ai][bj][m][n]; } }
    }
};
template <class Epi, class Sched, bool ALIGN_EPI = false, bool SP2 = false>
__device__ __forceinline__ void gemm_phase(PG8_LAS unsigned char* lds, const Gemm g, const Sched& S, const Epi& E) {
    const int tid = threadIdx.x, wid = __builtin_amdgcn_readfirstlane(tid >> 6), lane = tid & 63, wr = wid >> 2, wc = wid & 3, fr = lane & 15, fq = lane >> 4;
    const int K = g.K, nt = K / BK;
    unsigned voffA[2], voffB[2];
#pragma unroll
    for (int i = 0; i < 2; ++i) { int R, C; stage_rc(tid * 16 + i * 8192, R, C); const int Rb = Epi::PERM ? ((R & ~31) + perm32(R & 31)) : R;
        voffA[i] = g.ta ? (unsigned)(((R >> 4) * (g.lda >> 5) + (C >> 5)) * 1024 + (R & 15) * 64 + (C & 31) * 2) : (unsigned)(R * g.lda + C) * 2u;
        voffB[i] = g.tb ? (unsigned)(((Rb >> 4) * (K >> 5) + (C >> 5)) * 1024 + (Rb & 15) * 64 + (C & 31) * 2) : (unsigned)(Rb * K + C) * 2u; }
    const size_t kstepA = g.ta ? (size_t)2048 : (size_t)(BK * 2), kstepB = g.tb ? (size_t)2048 : (size_t)(BK * 2);
    const size_t hstepB = (size_t)HALF * K * 2, hstepA = (size_t)HALF * g.lda * 2;
    const size_t tstepB = 2 * hstepB, tstepA = 2 * hstepA;
    const unsigned ldsw = (unsigned)wid * 1024u;
    const int aoff = lds_byte(wr * 64 + fr, fq * 8), boff = lds_byte(wc * 32 + fr, fq * 8);
#define PG8_SA(b, h) (((b) * 2 + (h)) * HTB)
#define PG8_SB(b, h) ((4 + (b) * 2 + (h)) * HTB)
#define PG8_STAGE(bufoff, gbase, voff) do { _Pragma("unroll") for (int _i = 0; _i < 2; ++_i) \
        __builtin_amdgcn_global_load_lds((const unsigned*)((const char*)(gbase) + (voff)[_i]), (PG8_LAS unsigned*)(lds + (bufoff) + ldsw + _i * 8192), 16, 0, 0); } while (0)
#define PG8_LDA(dst, b, h) do { _Pragma("unroll") for (int m = 0; m < 4; ++m) _Pragma("unroll") for (int k = 0; k < 2; ++k) dst[m][k] = *(const PG8_LAS bf16x8*)(lds + PG8_SA(b, h) + aoff + m * 2048 + k * 1024); } while (0)
#define PG8_LDB(dst, b, h) do { _Pragma("unroll") for (int n = 0; n < 2; ++n) _Pragma("unroll") for (int k = 0; k < 2; ++k) dst[n][k] = *(const PG8_LAS bf16x8*)(lds + PG8_SB(b, h) + boff + n * 2048 + k * 1024); } while (0)
#define PG8_MMA(ai, bj, At, Bt) do { __builtin_amdgcn_s_setprio(1); _Pragma("unroll") for (int m = 0; m < 4; ++m) _Pragma("unroll") for (int n = 0; n < 2; ++n) _Pragma("unroll") for (int k = 0; k < 2; ++k) \
        acc[ai][bj][m][n] = __builtin_amdgcn_mfma_f32_16x16x32_bf16(Bt[n][k], At[m][k], acc[ai][bj][m][n], 0, 0, 0); __builtin_amdgcn_s_setprio(0); } while (0)
#define PG8_WAIT_V(n) asm volatile("s_waitcnt vmcnt(" #n ")" ::: "memory")
#define PG8_WAIT_L(n) asm volatile("s_waitcnt lgkmcnt(" #n ")" ::: "memory")
#define PG8_BAR __builtin_amdgcn_s_barrier()
#define PG8_SCHED __builtin_amdgcn_sched_barrier(0)
    Unit cur, nxt; int ui = 0;
    if (!S.next(0, cur)) return;
    f32x4 acc[2][2][4][2];
#pragma unroll
    for (int a = 0; a < 2; ++a)
#pragma unroll
        for (int b = 0; b < 2; ++b)
#pragma unroll
            for (int m = 0; m < 4; ++m)
#pragma unroll
                for (int n = 0; n < 2; ++n) acc[a][b][m][n] = (f32x4){0.f, 0.f, 0.f, 0.f};
    bf16x8 At[4][2], B0[2][2], B1[2][2];
    const char* cA = (const char*)g.A + (size_t)cur.pm * tstepA; const char* cB = (const char*)g.Bt + (size_t)cur.pn * tstepB;
    S.a_ready(cur);
    if constexpr (SP2) {
        PG8_STAGE(PG8_SB(0, 0), cB, voffB); PG8_STAGE(PG8_SB(0, 1), cB + hstepB, voffB); PG8_STAGE(PG8_SA(0, 0), cA, voffA); PG8_STAGE(PG8_SA(0, 1), cA + hstepA, voffA);
        if (wr == 1) PG8_BAR;
        PG8_WAIT_V(2); PG8_BAR;
        PG8_STAGE(PG8_SB(1, 0), cB + kstepB, voffB); PG8_STAGE(PG8_SA(1, 0), cA + kstepA, voffA); PG8_STAGE(PG8_SB(1, 1), cB + hstepB + kstepB, voffB);
        PG8_WAIT_V(6); PG8_BAR;
    } else {
        PG8_STAGE(PG8_SB(0, 0), cB, voffB); PG8_STAGE(PG8_SA(0, 0), cA, voffA); PG8_STAGE(PG8_SB(0, 1), cB + hstepB, voffB); PG8_STAGE(PG8_SA(0, 1), cA + hstepA, voffA);
        if (wr == 1) PG8_BAR;
        PG8_WAIT_V(4); PG8_BAR;
        PG8_STAGE(PG8_SB(1, 0), cB + kstepB, voffB); PG8_STAGE(PG8_SA(1, 0), cA + kstepA, voffA); PG8_STAGE(PG8_SB(1, 1), cB + hstepB + kstepB, voffB);
        PG8_WAIT_V(6); PG8_BAR;
    }
    for (;;) {
        const bool has_next = S.next(ui + 1, nxt);
        const char* nA = has_next ? (const char*)g.A + (size_t)nxt.pm * tstepA : cA; const char* nB = has_next ? (const char*)g.Bt + (size_t)nxt.pn * tstepB : cB;
        for (int t = 0; t < nt; t += 2) {
            const bool last = (t == nt - 2);
            const char* a1 = cA + (size_t)(t + 1) * kstepA;
            const char* a2 = last ? nA : cA + (size_t)(t + 2) * kstepA; const char* b2 = last ? nB : cB + (size_t)(t + 2) * kstepB;
            const char* a3 = a2 + kstepA; const char* b3 = b2 + kstepB;
            if (last && has_next) S.a_ready(nxt);
            if constexpr (SP2) {
            PG8_LDB(B0, 0, 0); PG8_LDB(B1, 0, 1); PG8_SCHED; PG8_LDA(At, 0, 0); PG8_STAGE(PG8_SA(1, 1), a1 + hstepA, voffA);
            PG8_WAIT_V(8); PG8_WAIT_L(0); PG8_BAR; PG8_MMA(0, 0, At, B0); PG8_MMA(0, 1, At, B1); PG8_BAR; PG8_SCHED;
            PG8_LDA(At, 0, 1); PG8_STAGE(PG8_SB(0, 0), b2, voffB); PG8_STAGE(PG8_SB(0, 1), b2 + hstepB, voffB); PG8_STAGE(PG8_SA(0, 0), a2, voffA);
            PG8_WAIT_V(8); PG8_WAIT_L(0); PG8_BAR; PG8_MMA(1, 0, At, B0); PG8_MMA(1, 1, At, B1); PG8_BAR; PG8_SCHED;
            PG8_LDB(B0, 1, 0); PG8_LDB(B1, 1, 1); PG8_SCHED; PG8_LDA(At, 1, 0); PG8_STAGE(PG8_SA(0, 1), a2 + hstepA, voffA);
            PG8_WAIT_V(8); PG8_WAIT_L(0); PG8_BAR; PG8_MMA(0, 0, At, B0); PG8_MMA(0, 1, At, B1); PG8_BAR; PG8_SCHED;
            PG8_LDA(At, 1, 1); PG8_STAGE(PG8_SB(1, 0), b3, voffB); PG8_STAGE(PG8_SB(1, 1), b3 + hstepB, voffB); PG8_STAGE(PG8_SA(1, 0), a3, voffA);
            PG8_WAIT_V(8); PG8_WAIT_L(0); PG8_BAR; PG8_MMA(1, 0, At, B0); PG8_MMA(1, 1, At, B1); PG8_BAR; PG8_SCHED;
            } else {
            PG8_LDB(B0, 0, 0); PG8_SCHED; PG8_LDA(At, 0, 0); PG8_STAGE(PG8_SA(1, 1), a1 + hstepA, voffA);
            PG8_WAIT_L(8); PG8_BAR; PG8_WAIT_L(0); PG8_MMA(0, 0, At, B0); PG8_BAR; PG8_SCHED;
            PG8_LDB(B1, 0, 1); PG8_STAGE(PG8_SB(0, 0), b2, voffB);
            PG8_BAR; PG8_WAIT_L(0); PG8_MMA(0, 1, At, B1); PG8_BAR;
            PG8_LDA(At, 0, 1); PG8_STAGE(PG8_SA(0, 0), a2, voffA);
            PG8_BAR; PG8_WAIT_L(0); PG8_MMA(1, 0, At, B0); PG8_BAR; PG8_SCHED;
            PG8_STAGE(PG8_SB(0, 1), b2 + hstepB, voffB);
            PG8_WAIT_V(6); PG8_BAR; PG8_MMA(1, 1, At, B1); PG8_BAR;
            PG8_LDB(B0, 1, 0); PG8_SCHED; PG8_LDA(At, 1, 0); PG8_STAGE(PG8_SA(0, 1), a2 + hstepA, voffA);
            PG8_WAIT_L(8); PG8_BAR; PG8_WAIT_L(0); PG8_MMA(0, 0, At, B0); PG8_BAR; PG8_SCHED;
            PG8_LDB(B1, 1, 1); PG8_STAGE(PG8_SB(1, 0), b3, voffB);
            PG8_BAR; PG8_WAIT_L(0); PG8_MMA(0, 1, At, B1); PG8_BAR;
            PG8_LDA(At, 1, 1); PG8_STAGE(PG8_SA(1, 0), a3, voffA);
            PG8_BAR; PG8_WAIT_L(0); PG8_MMA(1, 0, At, B0); PG8_BAR; PG8_SCHED;
            PG8_STAGE(PG8_SB(1, 1), b3 + hstepB, voffB);
            PG8_WAIT_V(6); PG8_BAR; PG8_MMA(1, 1, At, B1); PG8_BAR;
            }
        }
        if constexpr (ALIGN_EPI) { if (wr == 0) PG8_BAR; }
        if constexpr (!Epi::AFTER_DRAIN) { if constexpr (Epi::PROBE_BIT == 29) E(acc, cur, wr, wc, fr, fq, ui); else E(acc, cur, wr, wc, fr, fq); if (DUPL(Epi::PROBE_BIT)) E(acc, cur, wr, wc, fr, fq); S.done(cur); }
        if (!has_next) break;
#pragma unroll
        for (int a = 0; a < 2; ++a)
#pragma unroll
            for (int b = 0; b < 2; ++b)
#pragma unroll
                for (int m = 0; m < 4; ++m)
#pragma unroll
                    for (int n = 0; n < 2; ++n) acc[a][b][m][n] = (f32x4){0.f, 0.f, 0.f, 0.f};
        cur = nxt; cA = nA; cB = nB; ++ui;
        if constexpr (ALIGN_EPI) { if (wr == 1) PG8_BAR; }
    }
    PG8_WAIT_V(0);
    if constexpr (!ALIGN_EPI) { if (wr == 0) PG8_BAR; }
    PG8_BAR;
    if constexpr (Epi::AFTER_DRAIN) { E.fused(acc, cur, wr, wc, fr, fq, lds, wid, lane); if (DUPL(Epi::PROBE_BIT)) { asm volatile("s_waitcnt lgkmcnt(0)" ::: "memory"); __builtin_amdgcn_s_barrier(); E.fused(acc, cur, wr, wc, fr, fq, lds, wid, lane); } S.done(cur); }
#undef PG8_SA
#undef PG8_SB
#undef PG8_STAGE
#undef PG8_LDA
#undef PG8_LDB
#undef PG8_MMA
#undef PG8_WAIT_V
#undef PG8_WAIT_L
#undef PG8_BAR
#undef PG8_SCHED
}
}

#define GAS __attribute__((address_space(1)))
#define LAS __attribute__((address_space(3)))
#define XB_TMO      128
#define XB_XCNT(j)  (256  + 64 * (j))
#define XB_XSUB(j)  (1280 + 64 * (j))
#define XB_XGEN(j)  (2304 + 64 * (j))
#define XB_TOP      3328
#define XB_TOPGEN   3392
#define XCD_BAR_WORDS 3456
#define XB_SPIN_CAP (1u << 18)
__device__ __forceinline__ unsigned xb_ld(unsigned* p)              { return __hip_atomic_load(p, __ATOMIC_RELAXED, __HIP_MEMORY_SCOPE_AGENT); }
__device__ __forceinline__ unsigned xb_add(unsigned* p, unsigned v) { return __hip_atomic_fetch_add(p, v, __ATOMIC_RELAXED, __HIP_MEMORY_SCOPE_AGENT); }
__device__ __forceinline__ unsigned xb_xcc_id() { return (unsigned)__builtin_amdgcn_s_getreg((3 << 11) | 20) & 0xFu; }
#define XB_SPIN(cond, bar) do { unsigned _sp = 0; while (cond) { __builtin_amdgcn_s_sleep(1); \
    if ((++_sp & 255u) == 0u) { if (xb_ld(&(bar)[XB_TMO])) break; if (_sp > XB_SPIN_CAP) { atomicAdd(&(bar)[XB_TMO], 1u); break; } } } } while (0)
struct XcdBarrier { unsigned* bar; unsigned x; volatile LAS unsigned* st; };
__device__ __forceinline__ XcdBarrier xcd_barrier_post(unsigned* bar, volatile LAS unsigned* st) {
    XcdBarrier b; b.bar = bar; b.x = xb_xcc_id(); b.st = st;
    if (threadIdx.x == 0) (void)xb_add(&bar[XB_XCNT(b.x)], 1u);
    return b;
}
__device__ __forceinline__ void xcd_barrier_complete(unsigned* bar, unsigned x, unsigned& nloc, unsigned& nx) {
    const unsigned G = gridDim.x * gridDim.y * gridDim.z;
    unsigned sum, cnt, mine, sp = 0u;
    for (;;) {
        sum = 0u; cnt = 0u; mine = 0u;
#pragma unroll
        for (unsigned j = 0; j < 16; ++j) { const unsigned c = xb_ld(&bar[XB_XCNT(j)]); sum += c; cnt += (c > 0u) ? 1u : 0u; mine = (j == x) ? c : mine; }
        if (sum == G) break;
        __builtin_amdgcn_s_sleep(1);
        if ((++sp & 255u) == 0u) { if (xb_ld(&bar[XB_TMO])) break; if (sp > XB_SPIN_CAP) { atomicAdd(&bar[XB_TMO], 1u); break; } }
    }
    nloc = mine > 0u ? mine : 1u; nx = cnt > 0u ? cnt : 1u;
}
__device__ __forceinline__ void xcd_barrier(const XcdBarrier& b) {
    asm volatile("s_waitcnt vmcnt(0)" ::: "memory");
    __syncthreads();
    if (threadIdx.x == 0) {
        unsigned* bar = b.bar;
        __builtin_amdgcn_s_waitcnt(0);
        unsigned nloc = b.st[0], nx = b.st[1];
        if (nloc == 0u) { xcd_barrier_complete(bar, b.x, nloc, nx); b.st[0] = nloc; b.st[1] = nx; }
        const unsigned old = xb_add(&bar[XB_XSUB(b.x)], 1u);
        const unsigned gen = old / nloc;
        if (old + 1u == (gen + 1u) * nloc) {
            __builtin_amdgcn_fence(__ATOMIC_RELEASE, "agent");
            asm volatile("s_waitcnt vmcnt(0)" ::: "memory");
            const unsigned og = xb_add(&bar[XB_TOP], 1u);
            const unsigned tg = og / nx;
            if (og + 1u == (tg + 1u) * nx) xb_add(&bar[XB_TOPGEN], 1u);
            else XB_SPIN(xb_ld(&bar[XB_TOPGEN]) == tg, bar);
            __builtin_amdgcn_fence(__ATOMIC_ACQUIRE, "agent");
            xb_add(&bar[XB_XGEN(b.x)], 1u);
            asm volatile("s_waitcnt vmcnt(0)" ::: "memory");
        } else {
            XB_SPIN(xb_ld(&bar[XB_XGEN(b.x)]) == gen, bar);
            __builtin_amdgcn_fence(__ATOMIC_ACQUIRE, "agent");
            asm volatile("s_waitcnt vmcnt(0)" ::: "memory");
        }
    }
    __syncthreads();
}

constexpr int LDS_BYTES = 147456;
constexpr int MISC_OFF = 131072 + 320;
constexpr int CW_BAR = 4096;
#ifndef MK_SINGLE
#define MK_SINGLE 1
#endif
constexpr int NPHASE = 11;
struct Args { Ctx C; int ph_lo, ph_hi; };
__global__ void __launch_bounds__(NT, 2) fwd_mega(Args args) {
    extern __shared__ __attribute__((aligned(16))) unsigned char lds_raw[];
    float* lds = (float*)lds_raw;
    PG8_LAS unsigned char* L3 = (PG8_LAS unsigned char*)lds_raw;
    const Ctx& C = args.C;
    unsigned char* ws = C.ws;
    volatile LAS unsigned* MISC = (volatile LAS unsigned*)((LAS unsigned char*)lds_raw + MISC_OFF);
    if (threadIdx.x < 32) MISC[threadIdx.x] = 0u;
    __syncthreads();
    XcdBarrier bar; bar.bar = (unsigned*)(ws + WS_CTL) + CW_BAR; bar.x = 0; bar.st = nullptr;
    if (MK_SINGLE) bar = xcd_barrier_post((unsigned*)(ws + WS_CTL) + CW_BAR, MISC + 8);
    const int lo = args.ph_lo, hi = args.ph_hi;
#define IN(k) (lo <= (k) && (k) < hi)
#define SEAM(k) do { if (IN(k) && IN((k) + 1)) { xcd_barrier(bar); if (DUPL(31)) xcd_barrier(bar); } } while (0)
#define PH(k, BODY) do { if (IN(k)) { BODY; if (DUPL(k)) { BODY; } } } while (0)
#define GEMM_PH(EPI, EINIT, AP, BP, NN, KK, LDA, AL) GEMM_PH2(EPI, EINIT, AP, BP, NN, KK, LDA, AL, false)
#define GEMM_PH2(EPI, EINIT, AP, BP, NN, KK, LDA, AL, TA) do { pg8::Gemm g{(const bf16*)(AP), (const bf16*)(BP), M, NN, KK, LDA, TA, true}; pg8::StaticOrder S; S.init(M, NN, (int)gridDim.x, (int)blockIdx.x); \
        pg8::EPI E EINIT; pg8::gemm_phase<pg8::EPI, pg8::StaticOrder, AL, true>(L3, g, S, E); } while (0)
    const float* COS = (const float*)(ws + WS_COS); const float* SIN = (const float*)(ws + WS_SIN);
    PH(0, p0_prologue(C, lds));
    SEAM(0);
    PH(1, GEMM_PH(EpiZ, ({(bf16*)(ws + WS_Z), NZ, (float*)(ws + WS_SSQQ), (float*)(ws + WS_SSQKV), (float*)(ws + WS_SSQPE)}), ws + WS_A, ws + WS_WIN, NZ, DM, DM, true));
    SEAM(1);
    const bool p1_first = ((blockIdx.x >> 3) & 1) != 0;
    if (p1_first) { PH(4, gla::pass1(C, lds_raw)); }
    PH(2, GEMM_PH2(EpiQ, ({(const float*)(ws + WS_SSQQ), C.q_head_norm, COS, SIN, (bf16*)(ws + WS_QF), EPS, QSCALE}), (const bf16*)(ws + WS_Z) + (ZC_CQ >> 5) * 512, ws + WS_WUQ, 1024, QRANK, NZ, false, true));
    __syncthreads();
    PH(3, GEMM_PH2(EpiKV, ({(const float*)(ws + WS_SSQKV), (const float*)(ws + WS_SSQPE), C.k_head_norm, COS, SIN, (const bf16*)(ws + WS_Z), (bf16*)(ws + WS_KF), (bf16*)(ws + WS_VF), EPS}), (const bf16*)(ws + WS_Z) + (ZC_CKV >> 5) * 512, ws + WS_WUKV, 1024, KVRANK, NZ, false, true));
    __syncthreads();
    if (!p1_first) { PH(4, gla::pass1(C, lds_raw)); }
    SEAM(4);
    PH(5, gla_scan(C));
    SEAM(5);
    PH(6, att::attn_phase(C, (char*)lds_raw));
    PH(7, gla::pass2(C, lds_raw));
    SEAM(7);
    PH(8, GEMM_PH2(EpiOutProjG, ({C.x, C.out, (bf16*)(ws + WS_A), (float*)(ws + WS_SSQ)}), ws + WS_B, ws + WS_WO, DM, DM, DM, true, true));
    SEAM(8);
    if (IN(9)) {
        PG8_LAS float* rtab = (PG8_LAS float*)(L3 + 131072 + 1024);
        pg8::StaticOrder So; So.init(M, DFF, (int)gridDim.x, (int)blockIdx.x);
        for (int idx = threadIdx.x; idx < 4 * 256; idx += NT) { pg8::Unit uu; const int i = idx >> 8, row = idx & 255;
            if (So.next(i, uu)) { const f32x4* sp = (const f32x4*)(ws + WS_SSQ) + (size_t)(uu.pm * 256 + row) * 4; const f32x4 s4 = (sp[0] + sp[1]) + (sp[2] + sp[3]);
                rtab[idx] = __builtin_amdgcn_rsqf(((s4[0] + s4[1]) + (s4[2] + s4[3])) * (1.0f / DM) + EPS); } }
        __syncthreads();
    }
    PH(9, GEMM_PH2(EpiUpG, ({(const PG8_LAS float*)(L3 + 131072 + 1024), (bf16*)(ws + WS_H)}), ws + WS_A, ws + WS_WUP, DFF, DM, DM, true, true));
    SEAM(9);
    PH(10, GEMM_PH2(EpiDownG, ({(const bf16*)(ws + WS_A), C.out}), ws + WS_H, ws + WS_WDN, DM, DFF, DFF, true, true));

#undef IN
#undef SEAM
}

extern "C" void kernel_launch(void* const* d_in, const int* in_sizes, int n_in, void* d_out, int out_size, void* d_ws, size_t ws_size, hipStream_t stream) {
    static int grid = 0;
    if (grid == 0) {
        if (n_in != 17 || in_sizes[0] != M * DM || out_size != M * DM || ws_size < WS_END) { fprintf(stderr, "kernel_launch: unexpected shapes (n_in %d in0 %d out %d ws %zu)\n", n_in, n_in > 0 ? in_sizes[0] : -1, out_size, ws_size); grid = -1; return; }
        int dev = 0, cus = 0, per_cu = 0;
        if (hipGetDevice(&dev) != hipSuccess || hipDeviceGetAttribute(&cus, hipDeviceAttributeMultiprocessorCount, dev) != hipSuccess) { fprintf(stderr, "kernel_launch: device query failed\n"); grid = -1; return; }
        if (hipFuncSetAttribute((const void*)fwd_mega, hipFuncAttributeMaxDynamicSharedMemorySize, LDS_BYTES) != hipSuccess) { fprintf(stderr, "kernel_launch: hipFuncSetAttribute failed\n"); grid = -1; return; }
        if (hipOccupancyMaxActiveBlocksPerMultiprocessor(&per_cu, (const void*)fwd_mega, NT, LDS_BYTES) != hipSuccess || per_cu < 1) fprintf(stderr, "kernel_launch: note: occupancy query reports %d workgroups per CU\n", per_cu);
        (void)hipGetLastError();
        grid = cus;
    }
    if (grid < 0) return;
    Args a{};
    Ctx& C = a.C;
    C.x = (const float*)d_in[0]; C.pos = (const int*)d_in[1]; C.attn_norm = (const float*)d_in[2]; C.w_in = (const float*)d_in[3]; C.w_gate_up = (const float*)d_in[4];
    C.b_gate = (const float*)d_in[5]; C.gla_out_norm = (const float*)d_in[6]; C.q_a_norm = (const float*)d_in[7]; C.w_uq = (const float*)d_in[8]; C.kv_a_norm = (const float*)d_in[9];
    C.w_ukv = (const float*)d_in[10]; C.q_head_norm = (const float*)d_in[11]; C.k_head_norm = (const float*)d_in[12]; C.w_out = (const float*)d_in[13]; C.mlp_norm = (const float*)d_in[14];
    C.w_up = (const float*)d_in[15]; C.w_down = (const float*)d_in[16]; C.out = (float*)d_out; C.ws = (unsigned char*)d_ws;
    if (MK_SINGLE) {
        if (hipMemsetAsync((char*)d_ws + WS_CTL, 0, CTL_ZERO_BYTES, stream) != hipSuccess) { fprintf(stderr, "kernel_launch: memset failed\n"); return; }
        a.ph_lo = 0; a.ph_hi = NPHASE;
        hipLaunchKernelGGL(fwd_mega, dim3(grid), dim3(NT), LDS_BYTES, stream, a);
        if (DUPL(23)) { (void)hipMemsetAsync((char*)d_ws + WS_CTL, 0, CTL_ZERO_BYTES, stream); hipLaunchKernelGGL(fwd_mega, dim3(grid), dim3(NT), LDS_BYTES, stream, a); }
    } else {
        for (int s = 0; s < NPHASE; ++s) { a.ph_lo = s; a.ph_hi = s + 1; hipLaunchKernelGGL(fwd_mega, dim3(grid), dim3(NT), LDS_BYTES, stream, a); }
    }
}
```

```cpp
#include <hip/hip_runtime.h>
#include <cstdio>
#include <cstdint>
#ifndef DUP_MASK
#define DUP_MASK 0u
#endif
#define DUPL(k) (((DUP_MASK) >> (k)) & 1u)

constexpr int BATCH = 2, SEQ = 8192, DM = 1024, M = BATCH * SEQ;
constexpr int DPROJ = 1968, NZ = 2048, DFF = 4096;
constexpr int GH = 4, GDK = 64, GDV = 128, GRANK = 16, NCH = SEQ / 64;
constexpr int MH = 8, QRANK = 256, KVRANK = 128, NOPE = 64, ROPE = 32, MV = 64, DQK = 96;
constexpr float EPS = 1e-6f;
constexpr float QSCALE = 0.10206207261596577f * 1.4426950408889634f;
constexpr int ZC_Q = 0, ZC_K = 256, ZC_V = 512, ZC_G = 1024, ZC_CQ = 1536, ZC_CKV = 1792, ZC_KPE = 1920, ZC_GATE = 1952;
__host__ __device__ __forceinline__ size_t ztile(size_t r, int c) { return ((r >> 4) * 64 + (size_t)(c >> 5)) * 512 + (r & 15) * 32 + (c & 31); }

constexpr size_t MiB = 1u << 20;
constexpr size_t WS_CTL = 0;
constexpr size_t WS_WIN = 1 * MiB, WS_WUQ = 5 * MiB, WS_WUKV = 6 * MiB, WS_WO = 7 * MiB, WS_WUP = 9 * MiB, WS_WDN = 17 * MiB;
constexpr size_t WS_SSQ = 25 * MiB, WS_DEC = 512 * 1024, WS_COS = 26 * MiB, WS_SIN = 27 * MiB;
constexpr size_t CTL_ZERO_BYTES = 64 * 1024;
constexpr size_t WS_SSQQ = 5 * MiB + 512 * 1024, WS_SSQKV = 5 * MiB + 768 * 1024, WS_SSQPE = 6 * MiB + 512 * 1024;
constexpr size_t WS_A = 28 * MiB;
constexpr size_t WS_B = 60 * MiB;
constexpr size_t WS_Z = 92 * MiB;
constexpr size_t WS_QF = 156 * MiB, WS_AQ = 156 * MiB, WS_AKV = 164 * MiB, WS_KF = 180 * MiB, WS_VF = 204 * MiB;
constexpr size_t WS_CKV = 220 * MiB;
constexpr size_t WS_H = 92 * MiB;
constexpr size_t WS_END = 252 * MiB;

typedef unsigned short bf16;
typedef float f32x4 __attribute__((ext_vector_type(4)));
typedef unsigned u32x2 __attribute__((ext_vector_type(2)));
typedef unsigned u32x4 __attribute__((ext_vector_type(4)));

__device__ __forceinline__ float bf2f(unsigned b) { return __uint_as_float(b << 16); }
__device__ __forceinline__ unsigned f2bf(float f) { unsigned u = __float_as_uint(f); return (u + 0x7fffu + ((u >> 16) & 1u)) >> 16; }
typedef float f32x2c_t __attribute__((ext_vector_type(2))); typedef __bf16 bf16x2c_t __attribute__((ext_vector_type(2)));
__device__ __forceinline__ unsigned pk2(float lo, float hi) { f32x2c_t v = {lo, hi}; bf16x2c_t b = __builtin_convertvector(v, bf16x2c_t); return __builtin_bit_cast(unsigned, b); }
__device__ __forceinline__ float wave_sum(float v) {
#pragma unroll
    for (int o = 1; o < 64; o <<= 1) v += __shfl_xor(v, o);
    return v;
}

__device__ __forceinline__ unsigned otid() { unsigned t = threadIdx.x; asm volatile("" : "+v"(t)); return t; }

struct Ctx {
    const float* x; const int* pos; const float* attn_norm; const float* w_in; const float* w_gate_up; const float* b_gate; const float* gla_out_norm;
    const float* q_a_norm; const float* w_uq; const float* kv_a_norm; const float* w_ukv; const float* q_head_norm; const float* k_head_norm;
    const float* w_out; const float* mlp_norm; const float* w_up; const float* w_down;
    float* out; unsigned char* ws;
};
constexpr int NT = 512;

__device__ __forceinline__ int win_src_col(int n) {
    if (n < 1024) return n;
    if (n < 1536) return n - 1024 + 1040;
    if (n < 1792) return n - 1536 + 1552;
    if (n < 1920) return n - 1792 + 1808;
    if (n < 1952) return n - 1920 + 1936;
    if (n < 1968) return n - 1952 + 1024;
    return -1;
}
struct MapWin { __device__ __forceinline__ int operator()(int n) const { return win_src_col(n); } };
struct MapUq  { __device__ __forceinline__ int operator()(int n) const { const int h = n >> 7, j = n & 127; return j < DQK ? h * DQK + j : -1; } };
struct MapId  { __device__ __forceinline__ int operator()(int n) const { return n; } };
template <bool GAIN, class CMap>
__device__ __forceinline__ void p0_transpose_item(const float* W, int K, int Nsrc, int N, bf16* WT, const float* kgain, float* scr, int item, int lane, const CMap& cmap) {
    const int nblk = N / 32, kb = item / nblk, nb = item % nblk, k0 = 64 * kb, n0 = 32 * nb;
    const int sc = cmap(n0 + (lane & 31)); const float keep = sc >= 0 ? 1.f : 0.f; const int scc = sc >= 0 ? sc : 0;
    const float* wp = W + (size_t)(k0 + (lane >> 5)) * Nsrc + scc;
    float v[32];
#pragma unroll
    for (int i = 0; i < 32; ++i) v[i] = wp[(size_t)(2 * i) * Nsrc];
#pragma unroll
    for (int i = 0; i < 32; ++i) { const int kk = 2 * i + (lane >> 5); float t = v[i] * keep; if (GAIN) t *= kgain[k0 + kk]; scr[kk * 33 + (lane & 31)] = t; }
    asm volatile("s_waitcnt lgkmcnt(0)" ::: "memory");
    const int c = lane & 7;
#pragma unroll
    for (int j = 0; j < 4; ++j) { const int n = (lane >> 3) + 8 * j; const float* s = scr + (8 * c) * 33 + n;
        u32x4 o; o.x = pk2(s[0 * 33], s[1 * 33]); o.y = pk2(s[2 * 33], s[3 * 33]); o.z = pk2(s[4 * 33], s[5 * 33]); o.w = pk2(s[6 * 33], s[7 * 33]);
        *(u32x4*)(WT + ((size_t)((n0 + n) >> 4) * (K >> 5) + ((k0 + 8 * c) >> 5)) * 512 + ((n0 + n) & 15) * 32 + ((k0 + 8 * c) & 31)) = o; }
    asm volatile("s_waitcnt lgkmcnt(0)" ::: "memory");
}
__device__ __forceinline__ void p0_prologue(const Ctx& C, float* lds) {
    const size_t gt = (size_t)blockIdx.x * NT + otid(), GT = (size_t)gridDim.x * NT;
    bf16* win = (bf16*)(C.ws + WS_WIN); bf16* wuq = (bf16*)(C.ws + WS_WUQ); bf16* wukv = (bf16*)(C.ws + WS_WUKV);
    bf16* wo = (bf16*)(C.ws + WS_WO); bf16* wup = (bf16*)(C.ws + WS_WUP); bf16* wdn = (bf16*)(C.ws + WS_WDN);
    {   const int lane_ = otid() & 63, wv = otid() >> 6; float* scr = lds + wv * (64 * 33 + 32);
        const int gw_ = (int)(gt >> 6), NGW_ = (int)(GT >> 6);
        constexpr int I_IN = (DM / 64) * (NZ / 32), I_UQ = (QRANK / 64) * (1024 / 32), I_UKV = (KVRANK / 64) * (1024 / 32), I_O = (DM / 64) * (DM / 32), I_UP = (DM / 64) * (DFF / 32), I_DN = (DFF / 64) * (DM / 32);
        constexpr int NITEMS = I_IN + I_UQ + I_UKV;
        (void)wo; (void)wup; (void)wdn; (void)I_O; (void)I_UP; (void)I_DN;
        for (int it = gw_; it < NITEMS; it += NGW_) {
            int r = it;
            if (r < I_IN) { p0_transpose_item<false>(C.w_in, DM, DPROJ, NZ, win, nullptr, scr, r, lane_, MapWin{}); continue; } r -= I_IN;
            if (r < I_UQ) { p0_transpose_item<true>(C.w_uq, QRANK, MH * DQK, 1024, wuq, C.q_a_norm, scr, r, lane_, MapUq{}); continue; } r -= I_UQ;
            p0_transpose_item<true>(C.w_ukv, KVRANK, 1024, 1024, wukv, C.kv_a_norm, scr, r, lane_, MapId{});
        }
    }
    const int lane = otid() & 63; const int gw = (int)(gt >> 6), NGW = (int)(GT >> 6);
    bf16* XN = (bf16*)(C.ws + WS_A); float* COS = (float*)(C.ws + WS_COS); float* SIN = (float*)(C.ws + WS_SIN);
    f32x4 gn[4];
#pragma unroll
    for (int j = 0; j < 4; ++j) gn[j] = ((const f32x4*)C.attn_norm)[lane + 64 * j];
    for (int m = gw; m < M; m += 2 * NGW) {
        const int m2 = m + NGW;
        const f32x4* xa = (const f32x4*)(C.x + (size_t)m * DM) + lane; const f32x4* xb = (const f32x4*)(C.x + (size_t)(m2 < M ? m2 : m) * DM) + lane;
        f32x4 va[4], vb[4]; float sa = 0.f, sb = 0.f;
#pragma unroll
        for (int j = 0; j < 4; ++j) { va[j] = xa[64 * j]; vb[j] = xb[64 * j]; }
#pragma unroll
        for (int j = 0; j < 4; ++j) { sa += (va[j].x * va[j].x + va[j].y * va[j].y) + (va[j].z * va[j].z + va[j].w * va[j].w); sb += (vb[j].x * vb[j].x + vb[j].y * vb[j].y) + (vb[j].z * vb[j].z + vb[j].w * vb[j].w); }
        const float ra = rsqrtf(wave_sum(sa) * (1.f / DM) + EPS), rb = rsqrtf(wave_sum(sb) * (1.f / DM) + EPS);
        u32x2* oa = (u32x2*)(XN + (size_t)m * DM) + lane; u32x2* ob = (u32x2*)(XN + (size_t)m2 * DM) + lane;
#pragma unroll
        for (int j = 0; j < 4; ++j) { u32x2 w; w.x = pk2(va[j].x * ra * gn[j].x, va[j].y * ra * gn[j].y); w.y = pk2(va[j].z * ra * gn[j].z, va[j].w * ra * gn[j].w); oa[64 * j] = w; }
        if (m2 < M) {
#pragma unroll
            for (int j = 0; j < 4; ++j) { u32x2 w; w.x = pk2(vb[j].x * rb * gn[j].x, vb[j].y * rb * gn[j].y); w.y = pk2(vb[j].z * rb * gn[j].z, vb[j].w * rb * gn[j].w); ob[64 * j] = w; } }
    }
    for (size_t i = gt; i < (size_t)M * 16; i += GT) { const int m = (int)(i >> 4), f = (int)(i & 15);
        const float invf = exp2f(-(float)(2 * f) * (1.f / 32.f) * 13.287712379549449f);
        const float ang = (float)C.pos[m] * invf; float sn, cs; sincosf(ang, &sn, &cs); COS[i] = cs; SIN[i] = sn; }
}

__device__ __forceinline__ void p0_late_weights(const Ctx& C, float* lds) {
    const unsigned t = otid(); if (t < 256) return;
    bf16* wo = (bf16*)(C.ws + WS_WO); bf16* wup = (bf16*)(C.ws + WS_WUP); bf16* wdn = (bf16*)(C.ws + WS_WDN);
    const int lane_ = t & 63, wv = (t >> 6) - 4; float* scr = lds + wv * (64 * 33 + 32);
    const int gw_ = (int)blockIdx.x * 4 + wv, NGW_ = (int)gridDim.x * 4;
    constexpr int I_O = (DM / 64) * (DM / 32), I_UP = (DM / 64) * (DFF / 32), I_DN = (DFF / 64) * (DM / 32);
    for (int it = gw_; it < I_O + I_UP + I_DN; it += NGW_) {
        int r = it;
        if (r < I_UP) { p0_transpose_item<true>(C.w_up, DM, DFF, DFF, wup, C.mlp_norm, scr, r, lane_, MapId{}); continue; } r -= I_UP;
        if (r < I_DN) { p0_transpose_item<false>(C.w_down, DFF, DM, DM, wdn, nullptr, scr, r, lane_, MapId{}); continue; } r -= I_DN;
        p0_transpose_item<false>(C.w_out, DM, DM, DM, wo, nullptr, scr, r, lane_, MapId{});
    }
}

__device__ __forceinline__ void unpack8(const u32x4 w, float (&v)[8]) { v[0] = bf2f(w.x & 0xffffu); v[1] = bf2f(w.x >> 16); v[2] = bf2f(w.y & 0xffffu); v[3] = bf2f(w.y >> 16);
    v[4] = bf2f(w.z & 0xffffu); v[5] = bf2f(w.z >> 16); v[6] = bf2f(w.w & 0xffffu); v[7] = bf2f(w.w >> 16); }
__device__ __forceinline__ u32x4 pack8(const float (&v)[8]) { u32x4 w; w.x = pk2(v[0], v[1]); w.y = pk2(v[2], v[3]); w.z = pk2(v[4], v[5]); w.w = pk2(v[6], v[7]); return w; }
constexpr float LOG2E = 1.4426950408889634f, LN2 = 0.6931471805599453f;
__device__ __forceinline__ float fexp(float x) { return __builtin_amdgcn_exp2f(x * LOG2E); }
__device__ __forceinline__ float log_gate(float gl) { const float ls = fminf(gl, 0.f) - LN2 * __builtin_amdgcn_logf(1.f + fexp(-fabsf(gl))); return fmaxf(ls * (1.f / 16.f), -1.f); }
__device__ __forceinline__ float silu_f(float g) { return g * __builtin_amdgcn_rcpf(1.f + fexp(-g)); }
__device__ __forceinline__ void gla_scan(const Ctx& C) {
    const float* CKV = (const float*)(C.ws + WS_CKV); const float* DEC = (const float*)(C.ws + WS_DEC); bf16* PREV = (bf16*)(C.ws + WS_A);
    if (otid() >= 256) return;
    for (int e = blockIdx.x * 256 + otid(); e < BATCH * GH * 128 * 64; e += gridDim.x * 256) {
        const int d = e & 63, v = (e >> 6) & 127, bh = e >> 13; float st = 0.f;
        for (int n0 = 0; n0 < NCH; n0 += 16) {
            float cv[16], dv[16];
#pragma unroll
            for (int i = 0; i < 16; ++i) { const size_t u = (size_t)bh * NCH + n0 + i; cv[i] = CKV[(u * 128 + v) * 64 + d]; dv[i] = DEC[u * 64 + d]; }
#pragma unroll
            for (int i = 0; i < 16; ++i) { const size_t u = (size_t)bh * NCH + n0 + i; PREV[(u * 128 + v) * 64 + d] = (bf16)f2bf(st); st = dv[i] * st + cv[i]; }
        }
    }
}

namespace att {
typedef short bf16x8 __attribute__((ext_vector_type(8)));
typedef short s16x4 __attribute__((ext_vector_type(4)));
typedef float f32x16 __attribute__((ext_vector_type(16)));
typedef __attribute__((address_space(3))) const char* lds_cptr;
constexpr int KSLOT = 12288, VSLOT = 8192, LDS_K = 0, LDS_V = 3 * KSLOT, LDS_WS = LDS_V + 3 * VSLOT, LDS_OST = LDS_WS + 8 * 256, LDS_TOTAL = LDS_OST + 8 * 4096;
constexpr int QP = MH * DQK, VP = MH * MV;
#define ATT_SBAR() __builtin_amdgcn_sched_barrier(0)
__device__ __forceinline__ int crow(int r, int hi) { return (r & 3) + 8 * (r >> 2) + 4 * hi; }
__device__ __forceinline__ void glds16(const void* gsrc, unsigned lds_dst) { unsigned keep;
    asm volatile("s_mov_b32 %0, m0\n\ts_mov_b32 m0, %2\n\ts_nop 0\n\tglobal_load_lds_dwordx4 %1, off\n\ts_mov_b32 m0, %0" : "=&s"(keep) : "v"(gsrc), "s"(lds_dst) : "memory"); }
typedef float f32x2_t __attribute__((ext_vector_type(2))); typedef __bf16 bf16x2_t __attribute__((ext_vector_type(2)));
__device__ __forceinline__ unsigned cvtpk_s(float lo, float hi) { f32x2_t v = {lo, hi}; bf16x2_t b = __builtin_convertvector(v, bf16x2_t); return __builtin_bit_cast(unsigned, b); }
typedef short att_v4i16 __attribute__((ext_vector_type(4)));
__device__ __forceinline__ s16x4 vtr(lds_cptr p) { return __builtin_bit_cast(s16x4, __builtin_amdgcn_ds_read_tr16_b64_v4i16((__attribute__((address_space(3))) att_v4i16*)p)); }
#define ATT_MX3(a, b, c) __builtin_fmaxf(__builtin_fmaxf((a), (b)), (c))
__device__ __forceinline__ float rowmax(const f32x16& p0, const f32x16& p1) {
    float a = ATT_MX3(p0[0], p0[1], p1[0]), b = ATT_MX3(p0[2], p0[3], p1[1]); a = ATT_MX3(a, p1[2], p1[3]);
#pragma unroll
    for (int r = 4; r < 16; r += 4) { a = ATT_MX3(a, p0[r], p0[r + 1]); b = ATT_MX3(b, p0[r + 2], p0[r + 3]); a = ATT_MX3(a, p1[r], p1[r + 1]); b = ATT_MX3(b, p1[r + 2], p1[r + 3]); }
    float m = __builtin_fmaxf(a, b); auto rr = __builtin_amdgcn_permlane32_swap(__float_as_uint(m), __float_as_uint(m), false, false);
    return __builtin_fmaxf(__uint_as_float(rr[0]), __uint_as_float(rr[1])); }
__device__ __forceinline__ void pv(f32x16* o, int vb, bf16x8 pa0, bf16x8 pa1, bf16x8 pa2, bf16x8 pa3) {
#pragma unroll
    for (int d0 = 0; d0 < 2; ++d0) { s16x4 lo[4], hi[4];
#pragma unroll
        for (int ks = 0; ks < 4; ++ks) {
            asm volatile("ds_read_b64_tr_b16 %0,%1 offset:%c2" : "=&v"(lo[ks]) : "v"(vb), "i"(d0 * 4096 + ks * 1024) : "memory");
            asm volatile("ds_read_b64_tr_b16 %0,%1 offset:%c2" : "=&v"(hi[ks]) : "v"(vb), "i"(d0 * 4096 + ks * 1024 + 512) : "memory"); }
        asm volatile("s_waitcnt lgkmcnt(0)" ::: "memory"); ATT_SBAR();
#define ATT_PK(k) (bf16x8){lo[k][0], lo[k][1], lo[k][2], lo[k][3], hi[k][0], hi[k][1], hi[k][2], hi[k][3]}
        o[d0] = __builtin_amdgcn_mfma_f32_32x32x16_bf16(pa0, ATT_PK(0), o[d0], 0, 0, 0);
        o[d0] = __builtin_amdgcn_mfma_f32_32x32x16_bf16(pa1, ATT_PK(1), o[d0], 0, 0, 0);
        o[d0] = __builtin_amdgcn_mfma_f32_32x32x16_bf16(pa2, ATT_PK(2), o[d0], 0, 0, 0);
        o[d0] = __builtin_amdgcn_mfma_f32_32x32x16_bf16(pa3, ATT_PK(3), o[d0], 0, 0, 0);
#undef ATT_PK
    }
}
#define ATT_WAIT_BAR0() asm volatile("s_waitcnt vmcnt(0) lgkmcnt(0)\n\ts_barrier" ::: "memory")
template <int THRL>
__device__ __forceinline__ void attn_unit(int b, int h, int qb, const bf16* Q, const bf16* K, const bf16* V, bf16* O, char* shm) {
    const int tid = threadIdx.x, lane = tid & 63, r32 = lane & 31, hi = lane >> 5; const int wid = __builtin_amdgcn_readfirstlane(tid >> 6);
    const long rowbase = (long)b * SEQ; const int q0 = qb * 256; const int NTL = 4 * qb + 4, tmax = 4 * qb + (wid >> 1);
    const bf16* Qw = Q + (rowbase + q0 + wid * 32) * QP + h * DQK;
    const long bh = (long)b * MH + h;
    const bf16* ksrc0 = K + (bh * 128 * 12 + wid) * 512 + lane * 8;
    const bf16* ksrc1 = K + (bh * 128 * 12 + 8 + (wid & 3)) * 512 + lane * 8;
    const bf16* vsrc = V + (bh * 128 * 2 + (wid >> 2)) * 2048 + (16 * (wid & 3) + (lane >> 2)) * 32 + (lane & 3) * 8;
    const unsigned lds0 = (unsigned)(uintptr_t)shm;
    const unsigned kdst0 = lds0 + LDS_K + wid * 1024, kdst1 = lds0 + LDS_K + (8 + (wid & 3)) * 1024, vdst = lds0 + LDS_V + wid * 1024;
    float* wsf = (float*)(shm + LDS_WS) + wid * 64;
#define ATT_DMA(t, s) do { glds16(ksrc0 + (long)(t) * 6144, (unsigned)__builtin_amdgcn_readfirstlane(kdst0 + (s) * KSLOT)); \
        if (wid < 4) glds16(ksrc1 + (long)(t) * 6144, (unsigned)__builtin_amdgcn_readfirstlane(kdst1 + (s) * KSLOT)); \
        glds16(vsrc + (long)(t) * 4096, (unsigned)__builtin_amdgcn_readfirstlane(vdst + (s) * VSLOT)); } while (0)
    ATT_DMA(0, 0);
    bf16x8 qr[6];
#pragma unroll
    for (int d0 = 0; d0 < 6; ++d0) qr[d0] = *reinterpret_cast<const bf16x8*>(&Qw[(long)r32 * QP + d0 * 16 + hi * 8]);
    float mhat = 0.f, l_reg = 0.f; f32x16 o[2]; o[0] = f32x16{}; o[1] = f32x16{}; f32x16 negm = f32x16{}; asm volatile("" : "+v"(negm));
    const lds_cptr shm3 = (lds_cptr)shm;
    const int vlane = ((lane >> 4) & 1) * 32 + (lane & 3) * 8 + (4 * hi + ((lane & 15) >> 2)) * 64;
    u32x4 pw0 = (u32x4){0u, 0u, 0u, 0u}, pw1 = pw0, pw2 = pw0, pw3 = pw0;
    s16x4 vlo[8], vhi[8];
#define ATT_KRD(slot, d0) do { ka[slot] = *(const __attribute__((address_space(3))) bf16x8*)(kp + (d0) * 2048); kb[slot] = *(const __attribute__((address_space(3))) bf16x8*)(kp + (d0) * 2048 + 512); } while (0)
#define ATT_VRD(i) do { vlo[i] = vtr(vp + (((i) >> 2) * 4096 + ((i) & 3) * 1024)); vhi[i] = vtr(vp + (((i) >> 2) * 4096 + ((i) & 3) * 1024 + 512)); } while (0)
#define ATT_QKSM(t, s) do { \
        const lds_cptr kp = shm3 + LDS_K + (s) * KSLOT + hi * 1024 + r32 * 16; const lds_cptr vp = shm3 + LDS_V + (s) * VSLOT + vlane; \
        f32x16 p0, p1; bf16x8 ka[3], kb[3]; \
        ATT_KRD(0, 0); ATT_KRD(1, 1); ATT_SBAR(); \
        ATT_KRD(2, 2); p0 = __builtin_amdgcn_mfma_f32_32x32x16_bf16(ka[0], qr[0], negm, 0, 0, 0); p1 = __builtin_amdgcn_mfma_f32_32x32x16_bf16(kb[0], qr[0], negm, 0, 0, 0); ATT_VRD(0); ATT_VRD(1); ATT_SBAR(); \
        ATT_KRD(0, 3); p0 = __builtin_amdgcn_mfma_f32_32x32x16_bf16(ka[1], qr[1], p0, 0, 0, 0); p1 = __builtin_amdgcn_mfma_f32_32x32x16_bf16(kb[1], qr[1], p1, 0, 0, 0); ATT_VRD(2); ATT_VRD(3); ATT_SBAR(); \
        ATT_KRD(1, 4); p0 = __builtin_amdgcn_mfma_f32_32x32x16_bf16(ka[2], qr[2], p0, 0, 0, 0); p1 = __builtin_amdgcn_mfma_f32_32x32x16_bf16(kb[2], qr[2], p1, 0, 0, 0); ATT_VRD(4); ATT_VRD(5); ATT_SBAR(); \
        ATT_KRD(2, 5); p0 = __builtin_amdgcn_mfma_f32_32x32x16_bf16(ka[0], qr[3], p0, 0, 0, 0); p1 = __builtin_amdgcn_mfma_f32_32x32x16_bf16(kb[0], qr[3], p1, 0, 0, 0); ATT_VRD(6); ATT_VRD(7); ATT_SBAR(); \
        p0 = __builtin_amdgcn_mfma_f32_32x32x16_bf16(ka[1], qr[4], p0, 0, 0, 0); p1 = __builtin_amdgcn_mfma_f32_32x32x16_bf16(kb[1], qr[4], p1, 0, 0, 0); ATT_SBAR(); \
        p0 = __builtin_amdgcn_mfma_f32_32x32x16_bf16(ka[2], qr[5], p0, 0, 0, 0); p1 = __builtin_amdgcn_mfma_f32_32x32x16_bf16(kb[2], qr[5], p1, 0, 0, 0); ATT_SBAR(); \
        const float rm = rowmax(p0, p1); \
        if ((t) == 0) { mhat = rm; \
            _Pragma("unroll") for (int r = 0; r < 16; ++r) { p0[r] -= rm; p1[r] -= rm; } \
            _Pragma("unroll") for (int r = 0; r < 16; ++r) negm[r] = -mhat; \
            asm volatile("" : "+v"(negm)); \
        } else if (__any(rm > (float)THRL)) { const float dl = __builtin_fmaxf(rm, 0.f); mhat += dl; \
            _Pragma("unroll") for (int r = 0; r < 16; ++r) { p0[r] -= dl; p1[r] -= dl; } \
            _Pragma("unroll") for (int r = 0; r < 16; ++r) negm[r] = -mhat; \
            asm volatile("" : "+v"(negm)); \
            const float f = __builtin_amdgcn_exp2f(-dl); l_reg *= f; if (hi == 0) wsf[r32] = f; \
            asm volatile("s_waitcnt lgkmcnt(0)" ::: "memory"); \
            _Pragma("unroll") for (int d_ = 0; d_ < 2; ++d_) _Pragma("unroll") for (int r = 0; r < 16; ++r) o[d_][r] *= wsf[crow(r, hi)]; } \
        float sacc = 0.f; \
        _Pragma("unroll") for (int r = 0; r < 16; ++r) { p0[r] = __builtin_amdgcn_exp2f(p0[r]); p1[r] = __builtin_amdgcn_exp2f(p1[r]); sacc += p0[r] + p1[r]; } \
        l_reg += sacc; \
        pw0 = (u32x4){cvtpk_s(p0[0], p0[1]), cvtpk_s(p0[2], p0[3]), cvtpk_s(p0[4], p0[5]), cvtpk_s(p0[6], p0[7])}; \
        pw1 = (u32x4){cvtpk_s(p0[8], p0[9]), cvtpk_s(p0[10], p0[11]), cvtpk_s(p0[12], p0[13]), cvtpk_s(p0[14], p0[15])}; \
        pw2 = (u32x4){cvtpk_s(p1[0], p1[1]), cvtpk_s(p1[2], p1[3]), cvtpk_s(p1[4], p1[5]), cvtpk_s(p1[6], p1[7])}; \
        pw3 = (u32x4){cvtpk_s(p1[8], p1[9]), cvtpk_s(p1[10], p1[11]), cvtpk_s(p1[12], p1[13]), cvtpk_s(p1[14], p1[15])}; \
    } while (0)
#define ATT_VFR(i) (bf16x8){vlo[i][0], vlo[i][1], vlo[i][2], vlo[i][3], vhi[i][0], vhi[i][1], vhi[i][2], vhi[i][3]}
#define ATT_PV(s) do { ATT_SBAR(); \
        o[0] = __builtin_amdgcn_mfma_f32_32x32x16_bf16(__builtin_bit_cast(bf16x8, pw0), ATT_VFR(0), o[0], 0, 0, 0); o[1] = __builtin_amdgcn_mfma_f32_32x32x16_bf16(__builtin_bit_cast(bf16x8, pw0), ATT_VFR(4), o[1], 0, 0, 0); \
        o[0] = __builtin_amdgcn_mfma_f32_32x32x16_bf16(__builtin_bit_cast(bf16x8, pw1), ATT_VFR(1), o[0], 0, 0, 0); o[1] = __builtin_amdgcn_mfma_f32_32x32x16_bf16(__builtin_bit_cast(bf16x8, pw1), ATT_VFR(5), o[1], 0, 0, 0); \
        o[0] = __builtin_amdgcn_mfma_f32_32x32x16_bf16(__builtin_bit_cast(bf16x8, pw2), ATT_VFR(2), o[0], 0, 0, 0); o[1] = __builtin_amdgcn_mfma_f32_32x32x16_bf16(__builtin_bit_cast(bf16x8, pw2), ATT_VFR(6), o[1], 0, 0, 0); \
        o[0] = __builtin_amdgcn_mfma_f32_32x32x16_bf16(__builtin_bit_cast(bf16x8, pw3), ATT_VFR(3), o[0], 0, 0, 0); o[1] = __builtin_amdgcn_mfma_f32_32x32x16_bf16(__builtin_bit_cast(bf16x8, pw3), ATT_VFR(7), o[1], 0, 0, 0); \
    } while (0)
    int s_cur = 0, s_prev = 2;
    if (wid < 4) {
        for (int t = 0; t < NTL; ++t) {
            ATT_WAIT_BAR0();
            const int s_next = (s_cur == 2) ? 0 : s_cur + 1;
            if (t + 1 < NTL) ATT_DMA(t + 1, s_next);
            if (t <= tmax) { ATT_QKSM(t, s_cur); ATT_PV(s_cur); }
            s_prev = s_cur; s_cur = s_next;
        }
    } else {
        for (int t = 0; t < NTL; ++t) {
            ATT_WAIT_BAR0();
            const int s_next = (s_cur == 2) ? 0 : s_cur + 1;
            if (t + 1 < NTL) ATT_DMA(t + 1, s_next);
            if (t >= 1 && t - 1 <= tmax) ATT_PV(s_prev);
            if (t <= tmax) ATT_QKSM(t, s_cur);
            s_prev = s_cur; s_cur = s_next;
        }
        if (NTL - 1 <= tmax) ATT_PV(s_prev);
    }
    { auto rr = __builtin_amdgcn_permlane32_swap(__float_as_uint(l_reg), __float_as_uint(l_reg), false, false); l_reg = __uint_as_float(rr[0]) + __uint_as_float(rr[1]); }
    if (hi == 0) wsf[32 + r32] = l_reg;
    asm volatile("s_waitcnt lgkmcnt(0)" ::: "memory");
    float rli[16];
#pragma unroll
    for (int r = 0; r < 16; ++r) rli[r] = __builtin_amdgcn_rcpf(wsf[32 + crow(r, hi)]);
    const long orow0 = rowbase + q0 + wid * 32; const int ocol0 = 512 + h * MV;
    { bf16* stg = (bf16*)(shm + LDS_OST) + wid * 2048;
#pragma unroll
        for (int r = 0; r < 16; ++r) { const int orow = crow(r, hi);
#pragma unroll
            for (int d0 = 0; d0 < 2; ++d0) stg[orow * 64 + d0 * 32 + r32] = (bf16)f2bf(o[d0][r] * rli[r]); }
        asm volatile("s_waitcnt lgkmcnt(0)" ::: "memory");
#pragma unroll
        for (int i = 0; i < 4; ++i) { const int row = i * 8 + (lane >> 3), ch = lane & 7; const u32x4 v = *(const u32x4*)(stg + row * 64 + ch * 8); const long r = orow0 + row; const int c = ocol0 + ch * 8;
            *(u32x4*)(O + ((r >> 4) * 32 + (c >> 5)) * 512 + (r & 15) * 32 + (c & 31)) = v; } }
    asm volatile("s_waitcnt lgkmcnt(0)\n\ts_barrier" ::: "memory");
#undef ATT_DMA
#undef ATT_QKSM
#undef ATT_KRD
#undef ATT_VRD
#undef ATT_VFR
#undef ATT_PV
}
__device__ __forceinline__ void attn_phase(const Ctx& C, char* lds) {
    const bf16* QF = (const bf16*)(C.ws + WS_QF); const bf16* KF = (const bf16*)(C.ws + WS_KF); const bf16* VF = (const bf16*)(C.ws + WS_VF); bf16* O = (bf16*)(C.ws + WS_B);
    const int G = (int)gridDim.x, bx = (int)blockIdx.x; const int vcu = (G % 8 == 0) ? (bx % 8) * (G / 8) + bx / 8 : bx;
    for (int i = vcu; i < BATCH * MH * 32; i += G) { const int bh = (i & 255) >> 4, s = i & 15, qb = (i < 256) ? 31 - s : s;
        attn_unit<8>(bh >> 3, bh & 7, qb, QF, KF, VF, O, lds); }
    __syncthreads();
}
}

namespace gla {
using att::bf16x8; using att::s16x4; using att::f32x16; using att::lds_cptr; using att::crow; using att::cvtpk_s;
constexpr int L_VIMG = 0, L_QIMG = 16384, L_KIMG = 24576, L_WT = 32768, L_OBUF = 36864, OLD = 132, L_WG = 73728, L_BG = L_WG + 16384;
#define GLA_BAR() asm volatile("s_waitcnt lgkmcnt(0)\n\ts_barrier" ::: "memory")
__device__ __forceinline__ void stage_gate(const Ctx& C, unsigned char* lds) {
    const int tid = threadIdx.x;
#pragma unroll
    for (int i = 0; i < 2; ++i) *(f32x4*)(lds + L_WG + (tid + NT * i) * 16) = *(const f32x4*)(C.w_gate_up + (tid + NT * i) * 4);
    if (tid < 64) *(f32x4*)(lds + L_BG + tid * 16) = *(const f32x4*)(C.b_gate + tid * 4);
}
__device__ __forceinline__ void cum_rows(const u32x4 g0, const u32x4 g1, int h, const unsigned char* lds, float (&cum)[8], float (&tot)[8]) {
    const int tid = threadIdx.x, lane = tid & 63; const int wv = __builtin_amdgcn_readfirstlane(tid >> 6);
    float zg[16];
    { float a[8], b[8]; unpack8(g0, a); unpack8(g1, b);
#pragma unroll
      for (int j = 0; j < 8; ++j) { zg[j] = a[j]; zg[8 + j] = b[j]; } }
    float x[8];
    { const f32x4 b0 = *(const f32x4*)(lds + L_BG + (h * 64 + 8 * wv) * 4), b1 = *(const f32x4*)(lds + L_BG + (h * 64 + 8 * wv + 4) * 4);
      x[0] = b0.x; x[1] = b0.y; x[2] = b0.z; x[3] = b0.w; x[4] = b1.x; x[5] = b1.y; x[6] = b1.z; x[7] = b1.w; }
#pragma unroll
    for (int gh = 0; gh < 2; ++gh) { f32x4 w0[8], w1[8];
#pragma unroll
        for (int g = 0; g < 8; ++g) { w0[g] = *(const f32x4*)(lds + L_WG + ((gh * 8 + g) * 256 + h * 64 + 8 * wv) * 4); w1[g] = *(const f32x4*)(lds + L_WG + ((gh * 8 + g) * 256 + h * 64 + 8 * wv + 4) * 4); }
#pragma unroll
        for (int g = 0; g < 8; ++g) { const float z = zg[gh * 8 + g];
            x[0] += z * w0[g].x; x[1] += z * w0[g].y; x[2] += z * w0[g].z; x[3] += z * w0[g].w; x[4] += z * w1[g].x; x[5] += z * w1[g].y; x[6] += z * w1[g].z; x[7] += z * w1[g].w; } }
#pragma unroll
    for (int j = 0; j < 8; ++j) x[j] = log_gate(x[j]);
#define GLA_DPP(v, ctrl, rmask) __builtin_bit_cast(float, __builtin_amdgcn_update_dpp(0, __builtin_bit_cast(int, (v)), (ctrl), (rmask), 0xF, true))
#pragma unroll
    for (int j = 0; j < 8; ++j) { float v = x[j];
        v += GLA_DPP(v, 0x111, 0xF); v += GLA_DPP(v, 0x112, 0xF); v += GLA_DPP(v, 0x114, 0xF); v += GLA_DPP(v, 0x118, 0xF);
        v += GLA_DPP(v, 0x142, 0xA); v += GLA_DPP(v, 0x143, 0xC);
        cum[j] = v; tot[j] = __builtin_bit_cast(float, __builtin_amdgcn_readlane(__builtin_bit_cast(int, v), 63)); }
#undef GLA_DPP
}
__device__ __forceinline__ void trfrag4(int base, bf16x8 (&f)[4]) {
    s16x4 lo[4], hi[4];
#pragma unroll
    for (int ks = 0; ks < 4; ++ks) {
        asm volatile("ds_read_b64_tr_b16 %0,%1 offset:%c2" : "=&v"(lo[ks]) : "v"(base), "i"(ks * 1024) : "memory");
        asm volatile("ds_read_b64_tr_b16 %0,%1 offset:%c2" : "=&v"(hi[ks]) : "v"(base), "i"(ks * 1024 + 512) : "memory"); }
    asm volatile("s_waitcnt lgkmcnt(0)" ::: "memory"); __builtin_amdgcn_sched_barrier(0);
#pragma unroll
    for (int ks = 0; ks < 4; ++ks) f[ks] = (bf16x8){lo[ks][0], lo[ks][1], lo[ks][2], lo[ks][3], hi[ks][0], hi[ks][1], hi[ks][2], hi[ks][3]};
}
struct Raw { u32x4 q, k, v0, v1, g0, g1, z0, z1; bf16x8 pf[4]; };
template <bool P2>
__device__ __forceinline__ void load_raw(const Ctx& C, int u, Raw& R) {
    const bf16* Z = (const bf16*)(C.ws + WS_Z); const bf16* PREV = (const bf16*)(C.ws + WS_A);
    const int tid = threadIdx.x, lane = tid & 63, r32 = lane & 31, hi = lane >> 5, c = tid >> 3, dc = tid & 7; const int wv = __builtin_amdgcn_readfirstlane(tid >> 6);
    const int n = u % NCH, h = (u / NCH) % GH, b = u / (NCH * GH); const int row0 = b * SEQ + n * 64;
    const size_t rl_ = (size_t)(row0 + lane);
    R.k = *(const u32x4*)(Z + ztile(rl_, ZC_K + h * 64 + 8 * wv)); R.g0 = *(const u32x4*)(Z + ztile(rl_, ZC_GATE)); R.g1 = *(const u32x4*)(Z + ztile(rl_, ZC_GATE + 8));
    { const int j = tid >> 4, cc = tid & 15; R.v0 = *(const u32x4*)(Z + ztile((size_t)(row0 + j), ZC_V + h * 128 + cc * 8)); R.v1 = *(const u32x4*)(Z + ztile((size_t)(row0 + 32 + j), ZC_V + h * 128 + cc * 8)); }
    if (P2) { R.q = *(const u32x4*)(Z + ztile(rl_, ZC_Q + h * 64 + 8 * wv)); const size_t rc_ = (size_t)(row0 + c); R.z0 = *(const u32x4*)(Z + ztile(rc_, ZC_G + h * 128 + 16 * dc)); R.z1 = *(const u32x4*)(Z + ztile(rc_, ZC_G + h * 128 + 16 * dc + 8));
        const int cb = wv & 3;
#pragma unroll
        for (int s = 0; s < 4; ++s) R.pf[s] = *(const bf16x8*)(PREV + ((size_t)u * 128 + 32 * cb + r32) * 64 + 16 * s + 8 * hi); }
}
__device__ __forceinline__ void store_vimg(const Raw& R, unsigned char* lds) {
    const int tid = threadIdx.x, j = tid >> 4, cc = tid & 15;
    *(u32x4*)(lds + L_VIMG + (cc >> 2) * 4096 + j * 64 + (cc & 3) * 16) = R.v0; *(u32x4*)(lds + L_VIMG + (cc >> 2) * 4096 + (32 + j) * 64 + (cc & 3) * 16) = R.v1;
}
__device__ __forceinline__ void pass1(const Ctx& C, unsigned char* lds) {
    float* CKV = (float*)(C.ws + WS_CKV); float* DEC = (float*)(C.ws + WS_DEC);
    const int tid = threadIdx.x, lane = tid & 63, r32 = lane & 31, hi = lane >> 5, c = tid >> 3, dc = tid & 7; const int wv = __builtin_amdgcn_readfirstlane(tid >> 6);
    const unsigned lds0 = (unsigned)(uintptr_t)lds; const int lpart = ((lane >> 4) & 1) * 32 + (lane & 3) * 8 + (4 * hi + ((lane & 15) >> 2)) * 64;
    const int NU = BATCH * GH * NCH, G = (int)gridDim.x;
    __syncthreads(); stage_gate(C, lds);
    Raw cur; if ((int)blockIdx.x < NU) load_raw<false>(C, (int)blockIdx.x, cur);
    for (int u = blockIdx.x; u < NU; u += G) {
        const int h = (u / NCH) % GH;
        Raw nxt = cur; if (u + G < NU) load_raw<false>(C, u + G, nxt);
        GLA_BAR();
        store_vimg(cur, lds);
        float kv[8]; unpack8(cur.k, kv);
        float cum[8], tot[8]; cum_rows(cur.g0, cur.g1, h, lds, cum, tot);
#pragma unroll
        for (int j = 0; j < 8; ++j) kv[j] *= fexp(tot[j] - cum[j]);
        *(u32x4*)(lds + L_QIMG + (wv >> 2) * 4096 + lane * 64 + (wv & 3) * 16) = pack8(kv);
        if (lane == 63) {
#pragma unroll
            for (int j = 0; j < 8; ++j) DEC[(size_t)u * 64 + 8 * wv + j] = fexp(tot[j]); }
        GLA_BAR();
        const int vb = wv >> 1, db = wv & 1;
        bf16x8 af[4], bfr[4]; trfrag4((int)(lds0 + L_VIMG + vb * 4096) + lpart, af); trfrag4((int)(lds0 + L_QIMG + db * 4096) + lpart, bfr);
        f32x16 o = f32x16{};
#pragma unroll
        for (int ks = 0; ks < 4; ++ks) o = __builtin_amdgcn_mfma_f32_32x32x16_bf16(af[ks], bfr[ks], o, 0, 0, 0);
#pragma unroll
        for (int r = 0; r < 16; ++r) CKV[((size_t)u * 128 + 32 * vb + crow(r, hi)) * 64 + 32 * db + r32] = o[r];
        cur = nxt;
    }
    __syncthreads();
}
__device__ __forceinline__ void pass2(const Ctx& C, unsigned char* lds) {
    bf16* MIX = (bf16*)(C.ws + WS_B);
    const int tid = threadIdx.x, lane = tid & 63, r32 = lane & 31, hi = lane >> 5, c = tid >> 3, dc = tid & 7; const int wv = __builtin_amdgcn_readfirstlane(tid >> 6);
    const unsigned lds0 = (unsigned)(uintptr_t)lds; const int lpart = ((lane >> 4) & 1) * 32 + (lane & 3) * 8 + (4 * hi + ((lane & 15) >> 2)) * 64;
    const lds_cptr L3 = (lds_cptr)lds; float* obuf = (float*)(lds + L_OBUF);
    const int rb = wv >> 2, cb = wv & 3;
    const int NU = BATCH * GH * NCH, G = (int)gridDim.x;
    f32x4 gn[4];
#pragma unroll
    for (int i = 0; i < 4; ++i) gn[i] = *(const f32x4*)(C.gla_out_norm + 16 * dc + 4 * i);
    __syncthreads(); stage_gate(C, lds);
    Raw cur; if ((int)blockIdx.x < NU) load_raw<true>(C, (int)blockIdx.x, cur);
    for (int u = blockIdx.x; u < NU; u += G) {
        const int n = u % NCH, h = (u / NCH) % GH, b = u / (NCH * GH); const int row0 = b * SEQ + n * 64;
        Raw nxt = cur; if (u + G < NU) load_raw<true>(C, u + G, nxt);
        GLA_BAR();
        store_vimg(cur, lds);
        float qv[8], kv[8]; unpack8(cur.q, qv); unpack8(cur.k, kv);
        float cum[8], tot[8]; cum_rows(cur.g0, cur.g1, h, lds, cum, tot);
#pragma unroll
        for (int j = 0; j < 8; ++j) { qv[j] *= 0.125f * fexp(cum[j]); kv[j] *= fexp(-cum[j]); }
        *(u32x4*)(lds + L_QIMG + wv * 1024 + lane * 16) = pack8(qv); *(u32x4*)(lds + L_KIMG + wv * 1024 + lane * 16) = pack8(kv);
        GLA_BAR();
        bf16x8 qr[4];
#pragma unroll
        for (int s = 0; s < 4; ++s) qr[s] = *(const __attribute__((address_space(3))) bf16x8*)(L3 + L_QIMG + (2 * s + hi) * 1024 + (32 * rb + r32) * 16);
        f32x16 p0 = f32x16{}, p1 = f32x16{};
#pragma unroll
        for (int s = 0; s < 4; ++s) { const lds_cptr kp = L3 + L_KIMG + (2 * s + hi) * 1024 + r32 * 16;
            const bf16x8 a0 = *(const __attribute__((address_space(3))) bf16x8*)(kp), a1 = *(const __attribute__((address_space(3))) bf16x8*)(kp + 512);
            p0 = __builtin_amdgcn_mfma_f32_32x32x16_bf16(a0, qr[s], p0, 0, 0, 0); p1 = __builtin_amdgcn_mfma_f32_32x32x16_bf16(a1, qr[s], p1, 0, 0, 0); }
        const int cq = 32 * rb + r32;
#pragma unroll
        for (int r = 0; r < 16; ++r) { const int j = crow(r, hi); p0[r] = (j <= cq) ? p0[r] : 0.f; p1[r] = (j + 32 <= cq) ? p1[r] : 0.f; }
        u32x4 pw0, pw1, pw2, pw3;
        pw0 = (u32x4){cvtpk_s(p0[0], p0[1]), cvtpk_s(p0[2], p0[3]), cvtpk_s(p0[4], p0[5]), cvtpk_s(p0[6], p0[7])};
        pw1 = (u32x4){cvtpk_s(p0[8], p0[9]), cvtpk_s(p0[10], p0[11]), cvtpk_s(p0[12], p0[13]), cvtpk_s(p0[14], p0[15])};
        pw2 = (u32x4){cvtpk_s(p1[0], p1[1]), cvtpk_s(p1[2], p1[3]), cvtpk_s(p1[4], p1[5]), cvtpk_s(p1[6], p1[7])};
        pw3 = (u32x4){cvtpk_s(p1[8], p1[9]), cvtpk_s(p1[10], p1[11]), cvtpk_s(p1[12], p1[13]), cvtpk_s(p1[14], p1[15])};
        __builtin_amdgcn_sched_barrier(0);
        bf16x8 vf[4]; trfrag4((int)(lds0 + L_VIMG + cb * 4096) + lpart, vf);
        f32x16 o = f32x16{};
        o = __builtin_amdgcn_mfma_f32_32x32x16_bf16(__builtin_bit_cast(bf16x8, pw0), vf[0], o, 0, 0, 0);
        o = __builtin_amdgcn_mfma_f32_32x32x16_bf16(__builtin_bit_cast(bf16x8, pw1), vf[1], o, 0, 0, 0);
        o = __builtin_amdgcn_mfma_f32_32x32x16_bf16(__builtin_bit_cast(bf16x8, pw2), vf[2], o, 0, 0, 0);
        o = __builtin_amdgcn_mfma_f32_32x32x16_bf16(__builtin_bit_cast(bf16x8, pw3), vf[3], o, 0, 0, 0);
#pragma unroll
        for (int s = 0; s < 4; ++s) o = __builtin_amdgcn_mfma_f32_32x32x16_bf16(qr[s], cur.pf[s], o, 0, 0, 0);
#pragma unroll
        for (int r = 0; r < 16; ++r) obuf[(32 * rb + crow(r, hi)) * OLD + 32 * cb + r32] = o[r];
        GLA_BAR();
        { float ov[16];
#pragma unroll
            for (int i = 0; i < 4; ++i) { const f32x4 t = *(const f32x4*)(obuf + c * OLD + 16 * dc + 4 * i); ov[4 * i] = t.x; ov[4 * i + 1] = t.y; ov[4 * i + 2] = t.z; ov[4 * i + 3] = t.w; }
            float ss = 0.f;
#pragma unroll
            for (int i = 0; i < 16; ++i) ss += ov[i] * ov[i];
            ss += __shfl_xor(ss, 1); ss += __shfl_xor(ss, 2); ss += __shfl_xor(ss, 4);
            const float rn = rsqrtf(ss * (1.f / GDV) + EPS); const size_t row = (size_t)(row0 + c);
            float g0[8], g1[8]; unpack8(cur.z0, g0); unpack8(cur.z1, g1);
            const float gv[16] = {gn[0].x, gn[0].y, gn[0].z, gn[0].w, gn[1].x, gn[1].y, gn[1].z, gn[1].w, gn[2].x, gn[2].y, gn[2].z, gn[2].w, gn[3].x, gn[3].y, gn[3].z, gn[3].w};
            float w0[8], w1[8];
#pragma unroll
            for (int i = 0; i < 8; ++i) { w0[i] = ov[i] * rn * gv[i] * silu_f(g0[i]); w1[i] = ov[8 + i] * rn * gv[8 + i] * silu_f(g1[i]); }
            { const int c0 = h * 128 + 16 * dc; bf16* mp = MIX + ((row >> 4) * 32 + (c0 >> 5)) * 512 + (row & 15) * 32 + (c0 & 31);
              *(u32x4*)mp = pack8(w0); *(u32x4*)(mp + 8) = pack8(w1); } }
        cur = nxt;
    }
    __syncthreads();
}
#undef GLA_BAR
}

namespace pg8 {
#define PG8_LAS __attribute__((address_space(3)))
typedef unsigned short bf16_t;
typedef short bf16x8 __attribute__((ext_vector_type(8)));
typedef float f32x4 __attribute__((ext_vector_type(4)));
typedef unsigned u32x4 __attribute__((ext_vector_type(4)));
constexpr int BM = 256, BK = 64, HALF = 128, HTB = HALF * BK * 2  , STAGE_BYTES = 8 * HTB, NXCD = 8, WGM = 8;

__host__ __device__ __forceinline__ int lds_byte(int r, int c) { const int st = (r >> 4) * 2 + (c >> 5), rr = r & 15, cc = c & 31, ob = rr * 64 + cc * 2; return st * 1024 + (ob ^ (((ob >> 9) & 1) << 5)); }
__host__ __device__ __forceinline__ void stage_rc(int b, int& R, int& C) { const int st = b / 1024, sb = b % 1024, swz = sb ^ (((sb >> 9) & 1) << 5); R = (st >> 1) * 16 + swz / 64; C = (st & 1) * 32 + (swz % 64) / 2; }
__host__ __device__ __forceinline__ int perm32(int rho) { const int n = rho >> 4, i = rho & 15; return 8 * (i >> 2) + 4 * n + (i & 3); }

struct Unit { int pm, pn; };
struct Gemm { const bf16_t* A; const bf16_t* Bt; int M, N, K, lda; bool ta, tb; };

struct StaticOrder {
    int nM, nN, nwg, G, c;
    __host__ __device__ void init(int M, int N, int G_, int c_) { nM = M / BM; nN = N / BM; nwg = nM * nN; G = G_; c = c_; }
    __host__ __device__ bool next(int i, Unit& u) const {
        const long L = (long)i * G + c; if (L >= nwg) return false;
        int wgid = (int)L; { const int q = nwg / NXCD, r = nwg % NXCD, xcd = wgid % NXCD, off = wgid / NXCD; wgid = (xcd < r ? xcd * (q + 1) : r * (q + 1) + (xcd - r) * q) + off; }
        const int nig = WGM * nN, gid = wgid / nig, fm = gid * WGM, gsz = (nM - fm) < WGM ? (nM - fm) : WGM;
        u.pm = fm + ((wgid % nig) % gsz); u.pn = (wgid % nig) / gsz; return true;
    }
    __device__ __forceinline__ void a_ready(const Unit&) const {}
    __device__ __forceinline__ void done(const Unit&) const {}
};

__device__ __forceinline__ unsigned cvt_pk_bf16(float lo, float hi) { unsigned r; asm volatile("v_cvt_pk_bf16_f32 %0, %1, %2" : "=v"(r) : "v"(lo), "v"(hi)); return r; }
typedef float f32x2 __attribute__((ext_vector_type(2)));
typedef unsigned u32x2v __attribute__((ext_vector_type(2)));
struct EpiBf16 {
    static constexpr bool PERM = true, AFTER_DRAIN = false; static constexpr int PROBE_BIT = 26;
    bf16_t* O; int ldc;
    __device__ __forceinline__ void operator()(const f32x4 (&acc)[2][2][4][2], const Unit& u, int wr, int wc, int fr, int fq) const {
        const int row0 = u.pm * BM + wr * 64 + fr, col0 = u.pn * BM + wc * 32 + 8 * fq;
#pragma unroll
        for (int ai = 0; ai < 2; ++ai)
#pragma unroll
            for (int m = 0; m < 4; ++m) { bf16_t* rowp = O + (size_t)(row0 + ai * HALF + m * 16) * ldc + col0;
#pragma unroll
                for (int bj = 0; bj < 2; ++bj) { const f32x4 v0 = acc[ai][bj][m][0], v1 = acc[ai][bj][m][1];
                    u32x4 w; w.x = cvt_pk_bf16(v0[0], v0[1]); w.y = cvt_pk_bf16(v0[2], v0[3]); w.z = cvt_pk_bf16(v1[0], v1[1]); w.w = cvt_pk_bf16(v1[2], v1[3]);
                    *(u32x4*)(rowp + bj * HALF) = w; } }
    }
};
struct EpiZ {
    static constexpr bool PERM = true, AFTER_DRAIN = false; static constexpr int PROBE_BIT = 27;
    bf16_t* O; int ldc; float* ssqq; float* ssqkv; float* ssqpe;
    __device__ __forceinline__ void operator()(const f32x4 (&acc)[2][2][4][2], const Unit& u, int wr, int wc, int fr, int fq) const {
        const int row0 = u.pm * BM + wr * 64 + fr, col0 = u.pn * BM + wc * 32 + 8 * fq;
#pragma unroll
        for (int ai = 0; ai < 2; ++ai)
#pragma unroll
            for (int m = 0; m < 4; ++m) { const int r = row0 + ai * HALF + m * 16; bf16_t* rowp = O + ((size_t)(r >> 4) * (ldc >> 5) + (col0 >> 5)) * 512 + (r & 15) * 32 + (col0 & 31); float sq[2];
#pragma unroll
                for (int bj = 0; bj < 2; ++bj) { const f32x4 v0 = acc[ai][bj][m][0], v1 = acc[ai][bj][m][1];
                    u32x4 w; w.x = cvt_pk_bf16(v0[0], v0[1]); w.y = cvt_pk_bf16(v0[2], v0[3]); w.z = cvt_pk_bf16(v1[0], v1[1]); w.w = cvt_pk_bf16(v1[2], v1[3]);
                    *(u32x4*)(rowp + bj * 4 * 512) = w;
                    sq[bj] = ((v0[0] * v0[0] + v0[1] * v0[1]) + (v0[2] * v0[2] + v0[3] * v0[3])) + ((v1[0] * v1[0] + v1[1] * v1[1]) + (v1[2] * v1[2] + v1[3] * v1[3])); }
                if (u.pn == 6) { float s = sq[0] + sq[1]; s += __shfl_xor(s, 16); s += __shfl_xor(s, 32); if (fq == 0) ssqq[(size_t)r * 4 + wc] = s; }
                else if (u.pn == 7) { float s = sq[0]; s += __shfl_xor(s, 16); s += __shfl_xor(s, 32); if (fq == 0) ssqkv[(size_t)r * 4 + wc] = s;
                    if (wc == 0) { float t = sq[1]; t += __shfl_xor(t, 16); t += __shfl_xor(t, 32); if (fq == 0) ssqpe[r] = t; } } }
    }
};
struct EpiQ {
    static constexpr bool PERM = false, AFTER_DRAIN = true; static constexpr int PROBE_BIT = 25;
    const float* ssqq; const float* gq; const float* cosT; const float* sinT; bf16_t* QF; float eps, qscale;
    __device__ __forceinline__ void fused(f32x4 (&acc)[2][2][4][2], const Unit& u, int wr, int wc, int fr, int fq, PG8_LAS unsigned char* lds, int wid, int lane) const {
        PG8_LAS float* P = (PG8_LAS float*)lds;
        f32x4 s4A[2][4];
#pragma unroll
        for (int ai = 0; ai < 2; ++ai)
#pragma unroll
            for (int m = 0; m < 4; ++m) s4A[ai][m] = *(const f32x4*)(ssqq + (size_t)(u.pm * BM + ai * HALF + wr * 64 + m * 16 + fr) * 4);
        __builtin_amdgcn_sched_barrier(0);
#pragma unroll
        for (int ai = 0; ai < 2; ++ai)
#pragma unroll
            for (int m = 0; m < 4; ++m) { const int rl = ai * HALF + wr * 64 + m * 16 + fr; const f32x4 s4 = s4A[ai][m];
                const float ra = __builtin_amdgcn_rsqf(((s4[0] + s4[1]) + (s4[2] + s4[3])) * (1.0f / 256.0f) + eps);
#pragma unroll
                for (int bj = 0; bj < 2; ++bj) { float s = 0.f;
#pragma unroll
                    for (int n = 0; n < 2; ++n) { const f32x4 v = acc[ai][bj][m][n] * ra; acc[ai][bj][m][n] = v; s += (v[0] * v[0] + v[1] * v[1]) + (v[2] * v[2] + v[3] * v[3]); }
                    s += __shfl_xor(s, 16); s += __shfl_xor(s, 32);
                    if (fq == 0) P[(rl * 2 + bj) * 4 + wc] = s; } }
        asm volatile("s_waitcnt lgkmcnt(0)" ::: "memory"); __builtin_amdgcn_s_barrier(); asm volatile("" ::: "memory");
        PG8_LAS unsigned char* ST = lds + 8192;
        if (wc < 3) {
            const int j0 = wc * 32 + 4 * fq; const f32x4 g0 = *(const f32x4*)(gq + j0), g1 = *(const f32x4*)(gq + j0 + 16);
            f32x4 csA[2][4], snA[2][4];
#pragma unroll
            for (int ai = 0; ai < 2; ++ai)
#pragma unroll
                for (int m = 0; m < 4; ++m) { const size_t r = (size_t)(u.pm * BM + ai * HALF + wr * 64 + m * 16 + fr); csA[ai][m] = (f32x4){1.f, 1.f, 1.f, 1.f}; snA[ai][m] = (f32x4){0.f, 0.f, 0.f, 0.f};
                    if (wc == 2) { csA[ai][m] = *(const f32x4*)(cosT + r * 16 + 4 * fq); snA[ai][m] = *(const f32x4*)(sinT + r * 16 + 4 * fq); } }
            __builtin_amdgcn_sched_barrier(0);
#pragma unroll
            for (int ai = 0; ai < 2; ++ai)
#pragma unroll
                for (int m = 0; m < 4; ++m) { const int rl = ai * HALF + wr * 64 + m * 16 + fr; const f32x4 cs = csA[ai][m], sn = snA[ai][m];
#pragma unroll
                    for (int bj = 0; bj < 2; ++bj) { const f32x4 p = *(const PG8_LAS f32x4*)(P + (rl * 2 + bj) * 4);
                        const float rh = qscale * __builtin_amdgcn_rsqf(((p[0] + p[1]) + (p[2] + p[3])) * (1.0f / 96.0f) + eps);
                        const f32x4 a = acc[ai][bj][m][0] * rh * g0, b = acc[ai][bj][m][1] * rh * g1;
                        f32x4 o0 = a, o1 = b; if (wc == 2) { o0 = a * cs - b * sn; o1 = a * sn + b * cs; }
                        PG8_LAS unsigned char* dst = ST + rl * 400 + (bj * 96 + j0) * 2;
                        u32x2v w0, w1; w0.x = cvt_pk_bf16(o0[0], o0[1]); w0.y = cvt_pk_bf16(o0[2], o0[3]); w1.x = cvt_pk_bf16(o1[0], o1[1]); w1.y = cvt_pk_bf16(o1[2], o1[3]);
                        *(PG8_LAS u32x2v*)dst = w0; *(PG8_LAS u32x2v*)(dst + 32) = w1; }
                    }
        }
        asm volatile("s_waitcnt lgkmcnt(0)" ::: "memory"); __builtin_amdgcn_s_barrier(); asm volatile("" ::: "memory");
        { const int tid = wid * 64 + lane;
#pragma unroll
            for (int i = 0; i < 12; ++i) { const int idx = tid + 512 * i, row = idx / 24, ch = idx - row * 24;
                *(u32x4*)(QF + (size_t)(u.pm * BM + row) * 768 + (2 * u.pn) * 96 + ch * 8) = *(const PG8_LAS u32x4*)(ST + row * 400 + ch * 16); } }
    }
};
struct EpiKV {
    static constexpr bool PERM = false, AFTER_DRAIN = true; static constexpr int PROBE_BIT = 24;
    const float* ssqkv; const float* ssqpe; const float* gk; const float* cosT; const float* sinT; const bf16_t* Z; bf16_t* KF; bf16_t* VF; float eps;
    __device__ __forceinline__ void fused(f32x4 (&acc)[2][2][4][2], const Unit& u, int wr, int wc, int fr, int fq, PG8_LAS unsigned char* lds, int wid, int lane) const {
        PG8_LAS float* P = (PG8_LAS float*)lds;
        f32x4 s4A[2][4];
#pragma unroll
        for (int ai = 0; ai < 2; ++ai)
#pragma unroll
            for (int m = 0; m < 4; ++m) s4A[ai][m] = *(const f32x4*)(ssqkv + (size_t)(u.pm * BM + ai * HALF + wr * 64 + m * 16 + fr) * 4);
        __builtin_amdgcn_sched_barrier(0);
#pragma unroll
        for (int ai = 0; ai < 2; ++ai)
#pragma unroll
            for (int m = 0; m < 4; ++m) { const int rl = ai * HALF + wr * 64 + m * 16 + fr; const f32x4 s4 = s4A[ai][m];
                const float ra = __builtin_amdgcn_rsqf(((s4[0] + s4[1]) + (s4[2] + s4[3])) * (1.0f / 128.0f) + eps);
#pragma unroll
                for (int bj = 0; bj < 2; ++bj) { float s = 0.f;
#pragma unroll
                    for (int n = 0; n < 2; ++n) { const f32x4 v = acc[ai][bj][m][n] * ra; acc[ai][bj][m][n] = v; s += (v[0] * v[0] + v[1] * v[1]) + (v[2] * v[2] + v[3] * v[3]); }
                    if (wc < 2) { s += __shfl_xor(s, 16); s += __shfl_xor(s, 32); if (fq == 0) P[(rl * 2 + bj) * 2 + wc] = s; } } }
        asm volatile("s_waitcnt lgkmcnt(0)" ::: "memory"); __builtin_amdgcn_s_barrier(); asm volatile("" ::: "memory");
        const int j0 = wc * 32 + 4 * fq;
        PG8_LAS unsigned char* ST = lds + 8192;
        if (wc < 2) {
            const f32x4 g0 = *(const f32x4*)(gk + j0), g1 = *(const f32x4*)(gk + j0 + 16);
            float pesA[2][4];
#pragma unroll
            for (int ai = 0; ai < 2; ++ai)
#pragma unroll
                for (int m = 0; m < 4; ++m) pesA[ai][m] = ssqpe[(size_t)(u.pm * BM + ai * HALF + wr * 64 + m * 16 + fr)];
            __builtin_amdgcn_sched_barrier(0);
#pragma unroll
            for (int ai = 0; ai < 2; ++ai)
#pragma unroll
                for (int m = 0; m < 4; ++m) { const int rl = ai * HALF + wr * 64 + m * 16 + fr; const float pes = pesA[ai][m];
#pragma unroll
                    for (int bj = 0; bj < 2; ++bj) { const float rk = __builtin_amdgcn_rsqf((P[(rl * 2 + bj) * 2] + P[(rl * 2 + bj) * 2 + 1] + pes) * (1.0f / 96.0f) + eps);
                        const f32x4 o0 = acc[ai][bj][m][0] * rk * g0, o1 = acc[ai][bj][m][1] * rk * g1; PG8_LAS unsigned char* dst = ST + rl * 400 + (bj * 96 + j0) * 2;
                        u32x2v w0, w1; w0.x = cvt_pk_bf16(o0[0], o0[1]); w0.y = cvt_pk_bf16(o0[2], o0[3]); w1.x = cvt_pk_bf16(o1[0], o1[1]); w1.y = cvt_pk_bf16(o1[2], o1[3]);
                        *(PG8_LAS u32x2v*)dst = w0; *(PG8_LAS u32x2v*)(dst + 32) = w1; }
                    asm volatile("" ::: "memory"); }
        } else {
#pragma unroll
            for (int ai = 0; ai < 2; ++ai)
#pragma unroll
                for (int m = 0; m < 4; ++m) { const int rl = ai * HALF + wr * 64 + m * 16 + fr; const size_t r = (size_t)(u.pm * BM + rl);
#pragma unroll
                    for (int bj = 0; bj < 2; ++bj) { const f32x4 o0 = acc[ai][bj][m][0], o1 = acc[ai][bj][m][1];
                        bf16_t* dst = VF + (((((size_t)(u.pm >> 5) * 8 + 2 * u.pn + bj) * 128 + (u.pm & 31) * 4 + (rl >> 6)) * 2 + (wc - 2)) * 64 + (rl & 63)) * 32 + 4 * fq;
                        u32x2v w0, w1; w0.x = cvt_pk_bf16(o0[0], o0[1]); w0.y = cvt_pk_bf16(o0[2], o0[3]); w1.x = cvt_pk_bf16(o1[0], o1[1]); w1.y = cvt_pk_bf16(o1[2], o1[3]);
                        *(u32x2v*)dst = w0; *(u32x2v*)(dst + 16) = w1; }
                    asm volatile("" ::: "memory"); }
            if (wc == 2) {
                const f32x4 g0 = *(const f32x4*)(gk + 64 + 4 * fq), g1 = *(const f32x4*)(gk + 80 + 4 * fq);
#pragma unroll
                for (int ai = 0; ai < 2; ++ai) {
                    float pesB[4]; u32x2v xaB[4], xbB[4]; f32x4 csB[4], snB[4];
#pragma unroll
                    for (int m = 0; m < 4; ++m) { const size_t r = (size_t)(u.pm * BM + ai * HALF + wr * 64 + m * 16 + fr); pesB[m] = ssqpe[r];
                        xaB[m] = *(const u32x2v*)(Z + ((r >> 4) * 64 + 60) * 512 + (r & 15) * 32 + 4 * fq); xbB[m] = *(const u32x2v*)(Z + ((r >> 4) * 64 + 60) * 512 + (r & 15) * 32 + 16 + 4 * fq);
                        csB[m] = *(const f32x4*)(cosT + r * 16 + 4 * fq); snB[m] = *(const f32x4*)(sinT + r * 16 + 4 * fq); }
                    __builtin_amdgcn_sched_barrier(0);
#pragma unroll
                    for (int m = 0; m < 4; ++m) { const int rl = ai * HALF + wr * 64 + m * 16 + fr; const float pes = pesB[m];
                        const u32x2v xa = xaB[m], xb = xbB[m];
                        const f32x4 x1 = (f32x4){__uint_as_float(xa.x << 16), __uint_as_float(xa.x & 0xffff0000u), __uint_as_float(xa.y << 16), __uint_as_float(xa.y & 0xffff0000u)};
                        const f32x4 x2 = (f32x4){__uint_as_float(xb.x << 16), __uint_as_float(xb.x & 0xffff0000u), __uint_as_float(xb.y << 16), __uint_as_float(xb.y & 0xffff0000u)};
                        const f32x4 cs = csB[m], sn = snB[m];
#pragma unroll
                        for (int bj = 0; bj < 2; ++bj) { const float rk = __builtin_amdgcn_rsqf((P[(rl * 2 + bj) * 2] + P[(rl * 2 + bj) * 2 + 1] + pes) * (1.0f / 96.0f) + eps);
                            const f32x4 a = x1 * rk * g0, b = x2 * rk * g1, o0 = a * cs - b * sn, o1 = a * sn + b * cs; PG8_LAS unsigned char* dst = ST + rl * 400 + (bj * 96 + 64 + 4 * fq) * 2;
                            u32x2v w0, w1; w0.x = cvt_pk_bf16(o0[0], o0[1]); w0.y = cvt_pk_bf16(o0[2], o0[3]); w1.x = cvt_pk_bf16(o1[0], o1[1]); w1.y = cvt_pk_bf16(o1[2], o1[3]);
                            *(PG8_LAS u32x2v*)dst = w0; *(PG8_LAS u32x2v*)(dst + 32) = w1; } }
                    asm volatile("" ::: "memory"); }
            }
        }
        asm volatile("s_waitcnt lgkmcnt(0)" ::: "memory"); __builtin_amdgcn_s_barrier(); asm volatile("" ::: "memory");
        { const int tid = wid * 64 + lane;
#pragma unroll
            for (int i = 0; i < 12; ++i) { const int idx = tid + 512 * i, ch = idx >> 8, row = idx & 255, hd = 2 * u.pn + (ch >= 12 ? 1 : 0), c = ch >= 12 ? ch - 12 : ch;
                *(u32x4*)(KF + (((((size_t)(u.pm >> 5) * 8 + hd) * 128 + (u.pm & 31) * 4 + (row >> 6)) * 12 + c) * 64 + (row & 63)) * 8) = *(const PG8_LAS u32x4*)(ST + row * 400 + ch * 16); } }
    }
};
struct EpiOutProjG {
    static constexpr bool PERM = false, AFTER_DRAIN = false; static constexpr int PROBE_BIT = 28;
    const float* x; float* x1; bf16_t* x1b; float* ssq;
    __device__ __forceinline__ void operator()(const f32x4 (&acc)[2][2][4][2], const Unit& u, int wr, int wc, int fr, int fq) const {
        const int col0 = u.pn * BM + wc * 32 + 4 * fq;
#pragma unroll
        for (int ai = 0; ai < 2; ++ai) {
            f32x4 xr[4][2][2];
#pragma unroll
            for (int m = 0; m < 4; ++m) { const size_t off = (size_t)(u.pm * BM + ai * HALF + wr * 64 + m * 16 + fr) * 1024 + col0;
#pragma unroll
                for (int bj = 0; bj < 2; ++bj)
#pragma unroll
                    for (int n = 0; n < 2; ++n) xr[m][bj][n] = *(const f32x4*)(x + off + bj * HALF + n * 16); }
            __builtin_amdgcn_sched_barrier(0);
#pragma unroll
            for (int m = 0; m < 4; ++m) { const int r = u.pm * BM + ai * HALF + wr * 64 + m * 16 + fr; const size_t off = (size_t)r * 1024 + col0; float s = 0.f;
#pragma unroll
                for (int bj = 0; bj < 2; ++bj)
#pragma unroll
                    for (int n = 0; n < 2; ++n) { const f32x4 t = xr[m][bj][n] + acc[ai][bj][m][n];
                        u32x2v w; w.x = cvt_pk_bf16(t[0], t[1]); w.y = cvt_pk_bf16(t[2], t[3]);
                        *(u32x2v*)(x1b + ((size_t)(r >> 4) * 32 + ((col0 >> 5) + 4 * bj)) * 512 + (r & 15) * 32 + (col0 & 31) + 16 * n) = w;
                        s += (t[0] * t[0] + t[1] * t[1]) + (t[2] * t[2] + t[3] * t[3]); }
                s += __shfl_xor(s, 16); s += __shfl_xor(s, 32);
                if (fq == 0) ssq[(size_t)r * 16 + u.pn * 4 + wc] = s; }
            asm volatile("" ::: "memory"); }
    }
};
struct EpiUpG {
    static constexpr bool PERM = true, AFTER_DRAIN = false; static constexpr int PROBE_BIT = 29;
    const PG8_LAS float* rtab; bf16_t* H;
    __device__ __forceinline__ void operator()(const f32x4 (&acc)[2][2][4][2], const Unit& u, int wr, int wc, int fr, int fq) const { (*this)(acc, u, wr, wc, fr, fq, 0); }
    __device__ __forceinline__ void operator()(const f32x4 (&acc)[2][2][4][2], const Unit& u, int wr, int wc, int fr, int fq, int ui) const {
        const int row0 = u.pm * BM + wr * 64 + fr, col0 = u.pn * BM + wc * 32 + 8 * fq;
#pragma unroll
        for (int ai = 0; ai < 2; ++ai)
#pragma unroll
            for (int m = 0; m < 4; ++m) { const int r = row0 + ai * HALF + m * 16;
                const float rstd = rtab[(ui & 3) * 256 + wr * 64 + fr + ai * HALF + m * 16];
                bf16_t* rowp = H + ((size_t)(r >> 4) * 128 + (col0 >> 5)) * 512 + (r & 15) * 32 + (col0 & 31);
#pragma unroll
                for (int bj = 0; bj < 2; ++bj) { f32x4 v0 = acc[ai][bj][m][0] * rstd, v1 = acc[ai][bj][m][1] * rstd;
#pragma unroll
                    for (int e = 0; e < 4; ++e) { v0[e] = __builtin_fmaxf(v0[e], 0.f); v1[e] = __builtin_fmaxf(v1[e], 0.f); }
                    v0 = v0 * v0; v1 = v1 * v1;
                    u32x4 w; w.x = cvt_pk_bf16(v0[0], v0[1]); w.y = cvt_pk_bf16(v0[2], v0[3]); w.z = cvt_pk_bf16(v1[0], v1[1]); w.w = cvt_pk_bf16(v1[2], v1[3]);
                    *(u32x4*)(rowp + bj * 4 * 512) = w; } }
    }
};
struct EpiDownG {
    static constexpr bool PERM = false, AFTER_DRAIN = false; static constexpr int PROBE_BIT = 30;
    const bf16_t* x1b; float* out;
    __device__ __forceinline__ void operator()(const f32x4 (&acc)[2][2][4][2], const Unit& u, int wr, int wc, int fr, int fq) const {
        const int col0 = u.pn * BM + wc * 32 + 4 * fq;
        u32x2v xw[2][4][2][2];
#pragma unroll
        for (int ai = 0; ai < 2; ++ai)
#pragma unroll
            for (int m = 0; m < 4; ++m) { const size_t off = (size_t)(u.pm * BM + ai * HALF + wr * 64 + m * 16 + fr) * 1024 + col0;
#pragma unroll
                for (int bj = 0; bj < 2; ++bj)
#pragma unroll
                    for (int n = 0; n < 2; ++n) { const int r_ = u.pm * BM + ai * HALF + wr * 64 + m * 16 + fr; xw[ai][m][bj][n] = *(const u32x2v*)(x1b + ((size_t)(r_ >> 4) * 32 + ((col0 >> 5) + 4 * bj)) * 512 + (r_ & 15) * 32 + (col0 & 31) + 16 * n); } }
        __builtin_amdgcn_sched_barrier(0);
#pragma unroll
        for (int ai = 0; ai < 2; ++ai)
#pragma unroll
            for (int m = 0; m < 4; ++m) { const size_t off = (size_t)(u.pm * BM + ai * HALF + wr * 64 + m * 16 + fr) * 1024 + col0;
#pragma unroll
                for (int bj = 0; bj < 2; ++bj)
#pragma unroll
                    for (int n = 0; n < 2; ++n) { const u32x2v w = xw[ai][m][bj][n];
                        const f32x4 xr = (f32x4){__uint_as_float(w.x << 16), __uint_as_float(w.x & 0xffff0000u), __uint_as_float(w.y << 16), __uint_as_float(w.y & 0xffff0000u)};
                        *(f32x4*)(out + off + bj * HALF + n * 16) = xr + acc[ai][bj][m][n]; } }
    }
};
template <class Epi, class Sched, bool ALIGN_EPI = false, bool SP2 = false>
__device__ __forceinline__ void gemm_phase(PG8_LAS unsigned char* lds, const Gemm g, const Sched& S, const Epi& E) {
    const int tid = threadIdx.x, wid = __builtin_amdgcn_readfirstlane(tid >> 6), lane = tid & 63, wr = wid >> 2, wc = wid & 3, fr = lane & 15, fq = lane >> 4;
    const int K = g.K, nt = K / BK;
    unsigned voffA[2], voffB[2];
#pragma unroll
    for (int i = 0; i < 2; ++i) { int R, C; stage_rc(tid * 16 + i * 8192, R, C); const int Rb = Epi::PERM ? ((R & ~31) + perm32(R & 31)) : R;
        voffA[i] = g.ta ? (unsigned)(((R >> 4) * (g.lda >> 5) + (C >> 5)) * 1024 + (R & 15) * 64 + (C & 31) * 2) : (unsigned)(R * g.lda + C) * 2u;
        voffB[i] = g.tb ? (unsigned)(((Rb >> 4) * (K >> 5) + (C >> 5)) * 1024 + (Rb & 15) * 64 + (C & 31) * 2) : (unsigned)(Rb * K + C) * 2u; }
    const size_t kstepA = g.ta ? (size_t)2048 : (size_t)(BK * 2), kstepB = g.tb ? (size_t)2048 : (size_t)(BK * 2);
    const size_t hstepB = (size_t)HALF * K * 2, hstepA = (size_t)HALF * g.lda * 2;
    const size_t tstepB = 2 * hstepB, tstepA = 2 * hstepA;
    const unsigned ldsw = (unsigned)wid * 1024u;
    const int aoff = lds_byte(wr * 64 + fr, fq * 8), boff = lds_byte(wc * 32 + fr, fq * 8);
#define PG8_SA(b, h) (((b) * 2 + (h)) * HTB)
#define PG8_SB(b, h) ((4 + (b) * 2 + (h)) * HTB)
#define PG8_STAGE(bufoff, gbase, voff) do { _Pragma("unroll") for (int _i = 0; _i < 2; ++_i) \
        __builtin_amdgcn_global_load_lds((const unsigned*)((const char*)(gbase) + (voff)[_i]), (PG8_LAS unsigned*)(lds + (bufoff) + ldsw + _i * 8192), 16, 0, 0); } while (0)
#define PG8_LDA(dst, b, h) do { _Pragma("unroll") for (int m = 0; m < 4; ++m) _Pragma("unroll") for (int k = 0; k < 2; ++k) dst[m][k] = *(const PG8_LAS bf16x8*)(lds + PG8_SA(b, h) + aoff + m * 2048 + k * 1024); } while (0)
#define PG8_LDB(dst, b, h) do { _Pragma("unroll") for (int n = 0; n < 2; ++n) _Pragma("unroll") for (int k = 0; k < 2; ++k) dst[n][k] = *(const PG8_LAS bf16x8*)(lds + PG8_SB(b, h) + boff + n * 2048 + k * 1024); } while (0)
#define PG8_MMA(ai, bj, At, Bt) do { __builtin_amdgcn_s_setprio(1); _Pragma("unroll") for (int m = 0; m < 4; ++m) _Pragma("unroll") for (int n = 0; n < 2; ++n) _Pragma("unroll") for (int k = 0; k < 2; ++k) \
        acc[ai][bj][m][n] = __builtin_amdgcn_mfma_f32_16x16x32_bf16(Bt[n][k], At[m][k], acc[ai][bj][m][n], 0, 0, 0); __builtin_amdgcn_s_setprio(0); } while (0)
#define PG8_WAIT_V(n) asm volatile("s_waitcnt vmcnt(" #n ")" ::: "memory")
#define PG8_WAIT_L(n) asm volatile("s_waitcnt lgkmcnt(" #n ")" ::: "memory")
#define PG8_BAR __builtin_amdgcn_s_barrier()
#define PG8_SCHED __builtin_amdgcn_sched_barrier(0)
    Unit cur, nxt; int ui = 0;
    if (!S.next(0, cur)) return;
    f32x4 acc[2][2][4][2];
#pragma unroll
    for (int a = 0; a < 2; ++a)
#pragma unroll
        for (int b = 0; b < 2; ++b)
#pragma unroll
            for (int m = 0; m < 4; ++m)
#pragma unroll
                for (int n = 0; n < 2; ++n) acc[a][b][m][n] = (f32x4){0.f, 0.f, 0.f, 0.f};
    bf16x8 At[4][2], B0[2][2], B1[2][2];
    const char* cA = (const char*)g.A + (size_t)cur.pm * tstepA; const char* cB = (const char*)g.Bt + (size_t)cur.pn * tstepB;
    S.a_ready(cur);
    if constexpr (SP2) {
        PG8_STAGE(PG8_SB(0, 0), cB, voffB); PG8_STAGE(PG8_SB(0, 1), cB + hstepB, voffB); PG8_STAGE(PG8_SA(0, 0), cA, voffA); PG8_STAGE(PG8_SA(0, 1), cA + hstepA, voffA);
        if (wr == 1) PG8_BAR;
        PG8_WAIT_V(2); PG8_BAR;
        PG8_STAGE(PG8_SB(1, 0), cB + kstepB, voffB); PG8_STAGE(PG8_SA(1, 0), cA + kstepA, voffA); PG8_STAGE(PG8_SB(1, 1), cB + hstepB + kstepB, voffB);
        PG8_WAIT_V(6); PG8_BAR;
    } else {
        PG8_STAGE(PG8_SB(0, 0), cB, voffB); PG8_STAGE(PG8_SA(0, 0), cA, voffA); PG8_STAGE(PG8_SB(0, 1), cB + hstepB, voffB); PG8_STAGE(PG8_SA(0, 1), cA + hstepA, voffA);
        if (wr == 1) PG8_BAR;
        PG8_WAIT_V(4); PG8_BAR;
        PG8_STAGE(PG8_SB(1, 0), cB + kstepB, voffB); PG8_STAGE(PG8_SA(1, 0), cA + kstepA, voffA); PG8_STAGE(PG8_SB(1, 1), cB + hstepB + kstepB, voffB);
        PG8_WAIT_V(6); PG8_BAR;
    }
    for (;;) {
        const bool has_next = S.next(ui + 1, nxt);
        const char* nA = has_next ? (const char*)g.A + (size_t)nxt.pm * tstepA : cA; const char* nB = has_next ? (const char*)g.Bt + (size_t)nxt.pn * tstepB : cB;
        for (int t = 0; t < nt; t += 2) {
            const bool last = (t == nt - 2);
            const char* a1 = cA + (size_t)(t + 1) * kstepA;
            const char* a2 = last ? nA : cA + (size_t)(t + 2) * kstepA; const char* b2 = last ? nB : cB + (size_t)(t + 2) * kstepB;
            const char* a3 = a2 + kstepA; const char* b3 = b2 + kstepB;
            if (last && has_next) S.a_ready(nxt);
            if constexpr (SP2) {
            PG8_LDB(B0, 0, 0); PG8_LDB(B1, 0, 1); PG8_SCHED; PG8_LDA(At, 0, 0); PG8_STAGE(PG8_SA(1, 1), a1 + hstepA, voffA);
            PG8_WAIT_V(8); PG8_WAIT_L(0); PG8_BAR; PG8_MMA(0, 0, At, B0); PG8_MMA(0, 1, At, B1); PG8_BAR; PG8_SCHED;
            PG8_LDA(At, 0, 1); PG8_STAGE(PG8_SB(0, 0), b2, voffB); PG8_STAGE(PG8_SB(0, 1), b2 + hstepB, voffB); PG8_STAGE(PG8_SA(0, 0), a2, voffA);
            PG8_WAIT_V(8); PG8_WAIT_L(0); PG8_BAR; PG8_MMA(1, 0, At, B0); PG8_MMA(1, 1, At, B1); PG8_BAR; PG8_SCHED;
            PG8_LDB(B0, 1, 0); PG8_LDB(B1, 1, 1); PG8_SCHED; PG8_LDA(At, 1, 0); PG8_STAGE(PG8_SA(0, 1), a2 + hstepA, voffA);
            PG8_WAIT_V(8); PG8_WAIT_L(0); PG8_BAR; PG8_MMA(0, 0, At, B0); PG8_MMA(0, 1, At, B1); PG8_BAR; PG8_SCHED;
            PG8_LDA(At, 1, 1); PG8_STAGE(PG8_SB(1, 0), b3, voffB); PG8_STAGE(PG8_SB(1, 1), b3 + hstepB, voffB); PG8_STAGE(PG8_SA(1, 0), a3, voffA);
            PG8_WAIT_V(8); PG8_WAIT_L(0); PG8_BAR; PG8_MMA(1, 0, At, B0); PG8_MMA(1, 1, At, B1); PG8_BAR; PG8_SCHED;
            } else {
            PG8_LDB(B0, 0, 0); PG8_SCHED; PG8_LDA(At, 0, 0); PG8_STAGE(PG8_SA(1, 1), a1 + hstepA, voffA);
            PG8_WAIT_L(8); PG8_BAR; PG8_WAIT_L(0); PG8_MMA(0, 0, At, B0); PG8_BAR; PG8_SCHED;
            PG8_LDB(B1, 0, 1); PG8_STAGE(PG8_SB(0, 0), b2, voffB);
            PG8_BAR; PG8_WAIT_L(0); PG8_MMA(0, 1, At, B1); PG8_BAR;
            PG8_LDA(At, 0, 1); PG8_STAGE(PG8_SA(0, 0), a2, voffA);
            PG8_BAR; PG8_WAIT_L(0); PG8_MMA(1, 0, At, B0); PG8_BAR; PG8_SCHED;
            PG8_STAGE(PG8_SB(0, 1), b2 + hstepB, voffB);
            PG8_WAIT_V(6); PG8_BAR; PG8_MMA(1, 1, At, B1); PG8_BAR;
            PG8_LDB(B0, 1, 0); PG8_SCHED; PG8_LDA(At, 1, 0); PG8_STAGE(PG8_SA(0, 1), a2 + hstepA, voffA);
            PG8_WAIT_L(8); PG8_BAR; PG8_WAIT_L(0); PG8_MMA(0, 0, At, B0); PG8_BAR; PG8_SCHED;
            PG8_LDB(B1, 1, 1); PG8_STAGE(PG8_SB(1, 0), b3, voffB);
            PG8_BAR; PG8_WAIT_L(0); PG8_MMA(0, 1, At, B1); PG8_BAR;
            PG8_LDA(At, 1, 1); PG8_STAGE(PG8_SA(1, 0), a3, voffA);
            PG8_BAR; PG8_WAIT_L(0); PG8_MMA(1, 0, At, B0); PG8_BAR; PG8_SCHED;
            PG8_STAGE(PG8_SB(1, 1), b3 + hstepB, voffB);
            PG8_WAIT_V(6); PG8_BAR; PG8_MMA(1, 1, At, B1); PG8_BAR;
            }
        }
        if constexpr (ALIGN_EPI) { if (wr == 0) PG8_BAR; }
        if constexpr (!Epi::AFTER_DRAIN) { if constexpr (Epi::PROBE_BIT == 29) E(acc, cur, wr, wc, fr, fq, ui); else E(acc, cur, wr, wc, fr, fq); if (DUPL(Epi::PROBE_BIT)) E(acc, cur, wr, wc, fr, fq); S.done(cur); }
        if (!has_next) break;
#pragma unroll
        for (int a = 0; a < 2; ++a)
#pragma unroll
            for (int b = 0; b < 2; ++b)
#pragma unroll
                for (int m = 0; m < 4; ++m)
#pragma unroll
                    for (int n = 0; n < 2; ++n) acc[a][b][m][n] = (f32x4){0.f, 0.f, 0.f, 0.f};
        cur = nxt; cA = nA; cB = nB; ++ui;
        if constexpr (ALIGN_EPI) { if (wr == 1) PG8_BAR; }
    }
    PG8_WAIT_V(0);
    if constexpr (!ALIGN_EPI) { if (wr == 0) PG8_BAR; }
    PG8_BAR;
    if constexpr (Epi::AFTER_DRAIN) { E.fused(acc, cur, wr, wc, fr, fq, lds, wid, lane); if (DUPL(Epi::PROBE_BIT)) { asm volatile("s_waitcnt lgkmcnt(0)" ::: "memory"); __builtin_amdgcn_s_barrier(); E.fused(acc, cur, wr, wc, fr, fq, lds, wid, lane); } S.done(cur); }
#undef PG8_SA
#undef PG8_SB
#undef PG8_STAGE
#undef PG8_LDA
#undef PG8_LDB
#undef PG8_MMA
#undef PG8_WAIT_V
#undef PG8_WAIT_L
#undef PG8_BAR
#undef PG8_SCHED
}
}

#define GAS __attribute__((address_space(1)))
#define LAS __attribute__((address_space(3)))
#define XB_TMO      128
#define XB_XCNT(j)  (256  + 64 * (j))
#define XB_XSUB(j)  (1280 + 64 * (j))
#define XB_XGEN(j)  (2304 + 64 * (j))
#define XB_TOP      3328
#define XB_TOPGEN   3392
#define XCD_BAR_WORDS 3456
#define XB_SPIN_CAP (1u << 18)
__device__ __forceinline__ unsigned xb_ld(unsigned* p)              { return __hip_atomic_load(p, __ATOMIC_RELAXED, __HIP_MEMORY_SCOPE_AGENT); }
__device__ __forceinline__ unsigned xb_add(unsigned* p, unsigned v) { return __hip_atomic_fetch_add(p, v, __ATOMIC_RELAXED, __HIP_MEMORY_SCOPE_AGENT); }
__device__ __forceinline__ unsigned xb_xcc_id() { return (unsigned)__builtin_amdgcn_s_getreg((3 << 11) | 20) & 0xFu; }
#define XB_SPIN(cond, bar) do { unsigned _sp = 0; while (cond) { __builtin_amdgcn_s_sleep(1); \
    if ((++_sp & 255u) == 0u) { if (xb_ld(&(bar)[XB_TMO])) break; if (_sp > XB_SPIN_CAP) { atomicAdd(&(bar)[XB_TMO], 1u); break; } } } } while (0)
struct XcdBarrier { unsigned* bar; unsigned x; volatile LAS unsigned* st; };
__device__ __forceinline__ XcdBarrier xcd_barrier_post(unsigned* bar, volatile LAS unsigned* st) {
    XcdBarrier b; b.bar = bar; b.x = xb_xcc_id(); b.st = st;
    if (threadIdx.x == 0) (void)xb_add(&bar[XB_XCNT(b.x)], 1u);
    return b;
}
__device__ __forceinline__ void xcd_barrier_complete(unsigned* bar, unsigned x, unsigned& nloc, unsigned& nx) {
    const unsigned G = gridDim.x * gridDim.y * gridDim.z;
    unsigned sum, cnt, mine, sp = 0u;
    for (;;) {
        sum = 0u; cnt = 0u; mine = 0u;
#pragma unroll
        for (unsigned j = 0; j < 16; ++j) { const unsigned c = xb_ld(&bar[XB_XCNT(j)]); sum += c; cnt += (c > 0u) ? 1u : 0u; mine = (j == x) ? c : mine; }
        if (sum == G) break;
        __builtin_amdgcn_s_sleep(1);
        if ((++sp & 255u) == 0u) { if (xb_ld(&bar[XB_TMO])) break; if (sp > XB_SPIN_CAP) { atomicAdd(&bar[XB_TMO], 1u); break; } }
    }
    nloc = mine > 0u ? mine : 1u; nx = cnt > 0u ? cnt : 1u;
}
__device__ __forceinline__ void xcd_barrier(const XcdBarrier& b) {
    asm volatile("s_waitcnt vmcnt(0)" ::: "memory");
    __syncthreads();
    if (threadIdx.x == 0) {
        unsigned* bar = b.bar;
        __builtin_amdgcn_s_waitcnt(0);
        unsigned nloc = b.st[0], nx = b.st[1];
        if (nloc == 0u) { xcd_barrier_complete(bar, b.x, nloc, nx); b.st[0] = nloc; b.st[1] = nx; }
        const unsigned old = xb_add(&bar[XB_XSUB(b.x)], 1u);
        const unsigned gen = old / nloc;
        if (old + 1u == (gen + 1u) * nloc) {
            __builtin_amdgcn_fence(__ATOMIC_RELEASE, "agent");
            asm volatile("s_waitcnt vmcnt(0)" ::: "memory");
            const unsigned og = xb_add(&bar[XB_TOP], 1u);
            const unsigned tg = og / nx;
            if (og + 1u == (tg + 1u) * nx) xb_add(&bar[XB_TOPGEN], 1u);
            else XB_SPIN(xb_ld(&bar[XB_TOPGEN]) == tg, bar);
            __builtin_amdgcn_fence(__ATOMIC_ACQUIRE, "agent");
            xb_add(&bar[XB_XGEN(b.x)], 1u);
            asm volatile("s_waitcnt vmcnt(0)" ::: "memory");
        } else {
            XB_SPIN(xb_ld(&bar[XB_XGEN(b.x)]) == gen, bar);
            __builtin_amdgcn_fence(__ATOMIC_ACQUIRE, "agent");
            asm volatile("s_waitcnt vmcnt(0)" ::: "memory");
        }
    }
    __syncthreads();
}

constexpr int LDS_BYTES = 147456;
constexpr int MISC_OFF = 131072 + 320;
constexpr int CW_BAR = 4096;
#ifndef MK_SINGLE
#define MK_SINGLE 1
#endif
constexpr int NPHASE = 11;
struct Args { Ctx C; int ph_lo, ph_hi; };
__global__ void __launch_bounds__(NT, 2) fwd_mega(Args args) {
    extern __shared__ __attribute__((aligned(16))) unsigned char lds_raw[];
    float* lds = (float*)lds_raw;
    PG8_LAS unsigned char* L3 = (PG8_LAS unsigned char*)lds_raw;
    const Ctx& C = args.C;
    unsigned char* ws = C.ws;
    volatile LAS unsigned* MISC = (volatile LAS unsigned*)((LAS unsigned char*)lds_raw + MISC_OFF);
    if (threadIdx.x < 32) MISC[threadIdx.x] = 0u;
    __syncthreads();
    XcdBarrier bar; bar.bar = (unsigned*)(ws + WS_CTL) + CW_BAR; bar.x = 0; bar.st = nullptr;
    if (MK_SINGLE) bar = xcd_barrier_post((unsigned*)(ws + WS_CTL) + CW_BAR, MISC + 8);
    const int lo = args.ph_lo, hi = args.ph_hi;
#define IN(k) (lo <= (k) && (k) < hi)
#define SEAM(k) do { if (IN(k) && IN((k) + 1)) { xcd_barrier(bar); if (DUPL(31)) xcd_barrier(bar); } } while (0)
#define PH(k, BODY) do { if (IN(k)) { BODY; if (DUPL(k)) { BODY; } } } while (0)
#define GEMM_PH(EPI, EINIT, AP, BP, NN, KK, LDA, AL) GEMM_PH2(EPI, EINIT, AP, BP, NN, KK, LDA, AL, false)
#define GEMM_PH2(EPI, EINIT, AP, BP, NN, KK, LDA, AL, TA) do { pg8::Gemm g{(const bf16*)(AP), (const bf16*)(BP), M, NN, KK, LDA, TA, true}; pg8::StaticOrder S; S.init(M, NN, (int)gridDim.x, (int)blockIdx.x); \
        pg8::EPI E EINIT; pg8::gemm_phase<pg8::EPI, pg8::StaticOrder, AL, true>(L3, g, S, E); } while (0)
    const float* COS = (const float*)(ws + WS_COS); const float* SIN = (const float*)(ws + WS_SIN);
    PH(0, p0_prologue(C, lds));
    SEAM(0);
    PH(1, GEMM_PH(EpiZ, ({(bf16*)(ws + WS_Z), NZ, (float*)(ws + WS_SSQQ), (float*)(ws + WS_SSQKV), (float*)(ws + WS_SSQPE)}), ws + WS_A, ws + WS_WIN, NZ, DM, DM, true));
    SEAM(1);
    const bool p1_first = ((blockIdx.x >> 3) & 1) != 0;
    if (p1_first) { PH(4, gla::pass1(C, lds_raw)); }
    PH(2, GEMM_PH2(EpiQ, ({(const float*)(ws + WS_SSQQ), C.q_head_norm, COS, SIN, (bf16*)(ws + WS_QF), EPS, QSCALE}), (const bf16*)(ws + WS_Z) + (ZC_CQ >> 5) * 512, ws + WS_WUQ, 1024, QRANK, NZ, false, true));
    __syncthreads();
    PH(3, GEMM_PH2(EpiKV, ({(const float*)(ws + WS_SSQKV), (const float*)(ws + WS_SSQPE), C.k_head_norm, COS, SIN, (const bf16*)(ws + WS_Z), (bf16*)(ws + WS_KF), (bf16*)(ws + WS_VF), EPS}), (const bf16*)(ws + WS_Z) + (ZC_CKV >> 5) * 512, ws + WS_WUKV, 1024, KVRANK, NZ, false, true));
    __syncthreads();
    if (!p1_first) { PH(4, gla::pass1(C, lds_raw)); }
    SEAM(4);
    PH(5, (gla_scan(C), p0_late_weights(C, lds)));
    SEAM(5);
    PH(6, att::attn_phase(C, (char*)lds_raw));
    PH(7, gla::pass2(C, lds_raw));
    SEAM(7);
    PH(8, GEMM_PH2(EpiOutProjG, ({C.x, C.out, (bf16*)(ws + WS_A), (float*)(ws + WS_SSQ)}), ws + WS_B, ws + WS_WO, DM, DM, DM, true, true));
    SEAM(8);
    if (IN(9)) {
        PG8_LAS float* rtab = (PG8_LAS float*)(L3 + 131072 + 1024);
        pg8::StaticOrder So; So.init(M, DFF, (int)gridDim.x, (int)blockIdx.x);
        for (int idx = threadIdx.x; idx < 4 * 256; idx += NT) { pg8::Unit uu; const int i = idx >> 8, row = idx & 255;
            if (So.next(i, uu)) { const f32x4* sp = (const f32x4*)(ws + WS_SSQ) + (size_t)(uu.pm * 256 + row) * 4; const f32x4 s4 = (sp[0] + sp[1]) + (sp[2] + sp[3]);
                rtab[idx] = __builtin_amdgcn_rsqf(((s4[0] + s4[1]) + (s4[2] + s4[3])) * (1.0f / DM) + EPS); } }
        __syncthreads();
    }
    PH(9, GEMM_PH2(EpiUpG, ({(const PG8_LAS float*)(L3 + 131072 + 1024), (bf16*)(ws + WS_H)}), ws + WS_A, ws + WS_WUP, DFF, DM, DM, true, true));
    SEAM(9);
    PH(10, GEMM_PH2(EpiDownG, ({(const bf16*)(ws + WS_A), C.out}), ws + WS_H, ws + WS_WDN, DM, DFF, DFF, true, true));

#undef IN
#undef SEAM
}

extern "C" void kernel_launch(void* const* d_in, const int* in_sizes, int n_in, void* d_out, int out_size, void* d_ws, size_t ws_size, hipStream_t stream) {
    static int grid = 0;
    if (grid == 0) {
        if (n_in != 17 || in_sizes[0] != M * DM || out_size != M * DM || ws_size < WS_END) { fprintf(stderr, "kernel_launch: unexpected shapes (n_in %d in0 %d out %d ws %zu)\n", n_in, n_in > 0 ? in_sizes[0] : -1, out_size, ws_size); grid = -1; return; }
        int dev = 0, cus = 0, per_cu = 0;
        if (hipGetDevice(&dev) != hipSuccess || hipDeviceGetAttribute(&cus, hipDeviceAttributeMultiprocessorCount, dev) != hipSuccess) { fprintf(stderr, "kernel_launch: device query failed\n"); grid = -1; return; }
        if (hipFuncSetAttribute((const void*)fwd_mega, hipFuncAttributeMaxDynamicSharedMemorySize, LDS_BYTES) != hipSuccess) { fprintf(stderr, "kernel_launch: hipFuncSetAttribute failed\n"); grid = -1; return; }
        if (hipOccupancyMaxActiveBlocksPerMultiprocessor(&per_cu, (const void*)fwd_mega, NT, LDS_BYTES) != hipSuccess || per_cu < 1) fprintf(stderr, "kernel_launch: note: occupancy query reports %d workgroups per CU\n", per_cu);
        (void)hipGetLastError();
        grid = cus;
    }
    if (grid < 0) return;
    Args a{};
    Ctx& C = a.C;
    C.x = (const float*)d_in[0]; C.pos = (const int*)d_in[1]; C.attn_norm = (const float*)d_in[2]; C.w_in = (const float*)d_in[3]; C.w_gate_up = (const float*)d_in[4];
    C.b_gate = (const float*)d_in[5]; C.gla_out_norm = (const float*)d_in[6]; C.q_a_norm = (const float*)d_in[7]; C.w_uq = (const float*)d_in[8]; C.kv_a_norm = (const float*)d_in[9];
    C.w_ukv = (const float*)d_in[10]; C.q_head_norm = (const float*)d_in[11]; C.k_head_norm = (const float*)d_in[12]; C.w_out = (const float*)d_in[13]; C.mlp_norm = (const float*)d_in[14];
    C.w_up = (const float*)d_in[15]; C.w_down = (const float*)d_in[16]; C.out = (float*)d_out; C.ws = (unsigned char*)d_ws;
    if (MK_SINGLE) {
        if (hipMemsetAsync((char*)d_ws + WS_CTL, 0, CTL_ZERO_BYTES, stream) != hipSuccess) { fprintf(stderr, "kernel_launch: memset failed\n"); return; }
        a.ph_lo = 0; a.ph_hi = NPHASE;
        hipLaunchKernelGGL(fwd_mega, dim3(grid), dim3(NT), LDS_BYTES, stream, a);
        if (DUPL(23)) { (void)hipMemsetAsync((char*)d_ws + WS_CTL, 0, CTL_ZERO_BYTES, stream); hipLaunchKernelGGL(fwd_mega, dim3(grid), dim3(NT), LDS_BYTES, stream, a); }
    } else {
        for (int s = 0; s < NPHASE; ++s) { a.ph_lo = s; a.ph_hi = s + 1; hipLaunchKernelGGL(fwd_mega, dim3(grid), dim3(NT), LDS_BYTES, stream, a); }
    }
}
```

```cpp
#include <hip/hip_runtime.h>
#include <cstdio>
#include <cstdint>
#ifndef DUP_MASK
#define DUP_MASK 0u
#endif
#define DUPL(k) (((DUP_MASK) >> (k)) & 1u)

constexpr int BATCH = 2, SEQ = 8192, DM = 1024, M = BATCH * SEQ;
constexpr int DPROJ = 1968, NZ = 2048, DFF = 4096;
constexpr int GH = 4, GDK = 64, GDV = 128, GRANK = 16, NCH = SEQ / 64;
constexpr int MH = 8, QRANK = 256, KVRANK = 128, NOPE = 64, ROPE = 32, MV = 64, DQK = 96;
constexpr float EPS = 1e-6f;
constexpr float QSCALE = 0.10206207261596577f * 1.4426950408889634f;
constexpr int ZC_Q = 0, ZC_K = 256, ZC_V = 512, ZC_G = 1024, ZC_CQ = 1536, ZC_CKV = 1792, ZC_KPE = 1920, ZC_GATE = 1952;
__host__ __device__ __forceinline__ size_t ztile(size_t r, int c) { return ((r >> 4) * 64 + (size_t)(c >> 5)) * 512 + (r & 15) * 32 + (c & 31); }

constexpr size_t MiB = 1u << 20;
constexpr size_t WS_CTL = 0;
constexpr size_t WS_WIN = 1 * MiB, WS_WUQ = 5 * MiB, WS_WUKV = 6 * MiB, WS_WO = 7 * MiB, WS_WUP = 9 * MiB, WS_WDN = 17 * MiB;
constexpr size_t WS_SSQ = 25 * MiB, WS_DEC = 512 * 1024, WS_COS = 26 * MiB, WS_SIN = 27 * MiB;
constexpr size_t CTL_ZERO_BYTES = 64 * 1024;
constexpr size_t WS_SSQQ = 5 * MiB + 512 * 1024, WS_SSQKV = 5 * MiB + 768 * 1024, WS_SSQPE = 6 * MiB + 512 * 1024;
constexpr size_t WS_A = 28 * MiB;
constexpr size_t WS_B = 60 * MiB;
constexpr size_t WS_Z = 92 * MiB;
constexpr size_t WS_QF = 156 * MiB, WS_AQ = 156 * MiB, WS_AKV = 164 * MiB, WS_KF = 180 * MiB, WS_VF = 204 * MiB;
constexpr size_t WS_CKV = 220 * MiB;
constexpr size_t WS_H = 92 * MiB;
constexpr size_t WS_END = 252 * MiB;

typedef unsigned short bf16;
typedef float f32x4 __attribute__((ext_vector_type(4)));
typedef unsigned u32x2 __attribute__((ext_vector_type(2)));
typedef unsigned u32x4 __attribute__((ext_vector_type(4)));

__device__ __forceinline__ float bf2f(unsigned b) { return __uint_as_float(b << 16); }
__device__ __forceinline__ unsigned f2bf(float f) { unsigned u = __float_as_uint(f); return (u + 0x7fffu + ((u >> 16) & 1u)) >> 16; }
typedef float f32x2c_t __attribute__((ext_vector_type(2))); typedef __bf16 bf16x2c_t __attribute__((ext_vector_type(2)));
__device__ __forceinline__ unsigned pk2(float lo, float hi) { f32x2c_t v = {lo, hi}; bf16x2c_t b = __builtin_convertvector(v, bf16x2c_t); return __builtin_bit_cast(unsigned, b); }
__device__ __forceinline__ float wave_sum(float v) {
#pragma unroll
    for (int o = 1; o < 64; o <<= 1) v += __shfl_xor(v, o);
    return v;
}

__device__ __forceinline__ unsigned otid() { unsigned t = threadIdx.x; asm volatile("" : "+v"(t)); return t; }

struct Ctx {
    const float* x; const int* pos; const float* attn_norm; const float* w_in; const float* w_gate_up; const float* b_gate; const float* gla_out_norm;
    const float* q_a_norm; const float* w_uq; const float* kv_a_norm; const float* w_ukv; const float* q_head_norm; const float* k_head_norm;
    const float* w_out; const float* mlp_norm; const float* w_up; const float* w_down;
    float* out; unsigned char* ws;
};
constexpr int NT = 512;

__device__ __forceinline__ int win_src_col(int n) {
    if (n < 1024) return n;
    if (n < 1536) return n - 1024 + 1040;
    if (n < 1792) return n - 1536 + 1552;
    if (n < 1920) return n - 1792 + 1808;
    if (n < 1952) return n - 1920 + 1936;
    if (n < 1968) return n - 1952 + 1024;
    return -1;
}
struct MapWin { __device__ __forceinline__ int operator()(int n) const { return win_src_col(n); } };
struct MapUq  { __device__ __forceinline__ int operator()(int n) const { const int h = n >> 7, j = n & 127; return j < DQK ? h * DQK + j : -1; } };
struct MapId  { __device__ __forceinline__ int operator()(int n) const { return n; } };
template <bool GAIN, class CMap>
__device__ __forceinline__ void p0_transpose_item(const float* W, int K, int Nsrc, int N, bf16* WT, const float* kgain, float* scr, int item, int lane, const CMap& cmap) {
    const int nblk = N / 32, kb = item / nblk, nb = item % nblk, k0 = 64 * kb, n0 = 32 * nb;
    const int sc = cmap(n0 + (lane & 31)); const float keep = sc >= 0 ? 1.f : 0.f; const int scc = sc >= 0 ? sc : 0;
    const float* wp = W + (size_t)(k0 + (lane >> 5)) * Nsrc + scc;
    float v[32];
#pragma unroll
    for (int i = 0; i < 32; ++i) v[i] = wp[(size_t)(2 * i) * Nsrc];
#pragma unroll
    for (int i = 0; i < 32; ++i) { const int kk = 2 * i + (lane >> 5); float t = v[i] * keep; if (GAIN) t *= kgain[k0 + kk]; scr[kk * 33 + (lane & 31)] = t; }
    asm volatile("s_waitcnt lgkmcnt(0)" ::: "memory");
    const int c = lane & 7;
#pragma unroll
    for (int j = 0; j < 4; ++j) { const int n = (lane >> 3) + 8 * j; const float* s = scr + (8 * c) * 33 + n;
        u32x4 o; o.x = pk2(s[0 * 33], s[1 * 33]); o.y = pk2(s[2 * 33], s[3 * 33]); o.z = pk2(s[4 * 33], s[5 * 33]); o.w = pk2(s[6 * 33], s[7 * 33]);
        *(u32x4*)(WT + ((size_t)((n0 + n) >> 4) * (K >> 5) + ((k0 + 8 * c) >> 5)) * 512 + ((n0 + n) & 15) * 32 + ((k0 + 8 * c) & 31)) = o; }
    asm volatile("s_waitcnt lgkmcnt(0)" ::: "memory");
}
__device__ __forceinline__ void p0_prologue(const Ctx& C, float* lds) {
    const size_t gt = (size_t)blockIdx.x * NT + otid(), GT = (size_t)gridDim.x * NT;
    bf16* win = (bf16*)(C.ws + WS_WIN); bf16* wuq = (bf16*)(C.ws + WS_WUQ); bf16* wukv = (bf16*)(C.ws + WS_WUKV);
    bf16* wo = (bf16*)(C.ws + WS_WO); bf16* wup = (bf16*)(C.ws + WS_WUP); bf16* wdn = (bf16*)(C.ws + WS_WDN);
    {   const int lane_ = otid() & 63, wv = otid() >> 6; float* scr = lds + wv * (64 * 33 + 32);
        const int gw_ = (int)(gt >> 6), NGW_ = (int)(GT >> 6);
        constexpr int I_IN = (DM / 64) * (NZ / 32), I_UQ = (QRANK / 64) * (1024 / 32), I_UKV = (KVRANK / 64) * (1024 / 32), I_O = (DM / 64) * (DM / 32), I_UP = (DM / 64) * (DFF / 32), I_DN = (DFF / 64) * (DM / 32);
        constexpr int NITEMS = I_IN + I_UQ + I_UKV;
        (void)wo; (void)wup; (void)wdn; (void)I_O; (void)I_UP; (void)I_DN;
        for (int it = gw_; it < NITEMS; it += NGW_) {
            int r = it;
            if (r < I_IN) { p0_transpose_item<false>(C.w_in, DM, DPROJ, NZ, win, nullptr, scr, r, lane_, MapWin{}); continue; } r -= I_IN;
            if (r < I_UQ) { p0_transpose_item<true>(C.w_uq, QRANK, MH * DQK, 1024, wuq, C.q_a_norm, scr, r, lane_, MapUq{}); continue; } r -= I_UQ;
            p0_transpose_item<true>(C.w_ukv, KVRANK, 1024, 1024, wukv, C.kv_a_norm, scr, r, lane_, MapId{});
        }
    }
    const int lane = otid() & 63; const int gw = (int)(gt >> 6), NGW = (int)(GT >> 6);
    bf16* XN = (bf16*)(C.ws + WS_A); float* COS = (float*)(C.ws + WS_COS); float* SIN = (float*)(C.ws + WS_SIN);
    f32x4 gn[4];
#pragma unroll
    for (int j = 0; j < 4; ++j) gn[j] = ((const f32x4*)C.attn_norm)[lane + 64 * j];
    for (int m = gw; m < M; m += 2 * NGW) {
        const int m2 = m + NGW;
        const f32x4* xa = (const f32x4*)(C.x + (size_t)m * DM) + lane; const f32x4* xb = (const f32x4*)(C.x + (size_t)(m2 < M ? m2 : m) * DM) + lane;
        f32x4 va[4], vb[4]; float sa = 0.f, sb = 0.f;
#pragma unroll
        for (int j = 0; j < 4; ++j) { va[j] = xa[64 * j]; vb[j] = xb[64 * j]; }
#pragma unroll
        for (int j = 0; j < 4; ++j) { sa += (va[j].x * va[j].x + va[j].y * va[j].y) + (va[j].z * va[j].z + va[j].w * va[j].w); sb += (vb[j].x * vb[j].x + vb[j].y * vb[j].y) + (vb[j].z * vb[j].z + vb[j].w * vb[j].w); }
        const float ra = rsqrtf(wave_sum(sa) * (1.f / DM) + EPS), rb = rsqrtf(wave_sum(sb) * (1.f / DM) + EPS);
        u32x2* oa = (u32x2*)(XN + (size_t)m * DM) + lane; u32x2* ob = (u32x2*)(XN + (size_t)m2 * DM) + lane;
#pragma unroll
        for (int j = 0; j < 4; ++j) { u32x2 w; w.x = pk2(va[j].x * ra * gn[j].x, va[j].y * ra * gn[j].y); w.y = pk2(va[j].z * ra * gn[j].z, va[j].w * ra * gn[j].w); oa[64 * j] = w; }
        if (m2 < M) {
#pragma unroll
            for (int j = 0; j < 4; ++j) { u32x2 w; w.x = pk2(vb[j].x * rb * gn[j].x, vb[j].y * rb * gn[j].y); w.y = pk2(vb[j].z * rb * gn[j].z, vb[j].w * rb * gn[j].w); ob[64 * j] = w; } }
    }
    for (size_t i = gt; i < (size_t)M * 16; i += GT) { const int m = (int)(i >> 4), f = (int)(i & 15);
        const float invf = exp2f(-(float)(2 * f) * (1.f / 32.f) * 13.287712379549449f);
        const float ang = (float)C.pos[m] * invf; float sn, cs; sincosf(ang, &sn, &cs); COS[i] = cs; SIN[i] = sn; }
}

__device__ __forceinline__ void p0_late_weights(const Ctx& C, float* lds) {
    const unsigned t = otid(); if (t < 256) return;
    bf16* wo = (bf16*)(C.ws + WS_WO); bf16* wup = (bf16*)(C.ws + WS_WUP); bf16* wdn = (bf16*)(C.ws + WS_WDN);
    const int lane_ = t & 63, wv = (t >> 6) - 4; float* scr = lds + wv * (64 * 33 + 32);
    const int gw_ = (int)blockIdx.x * 4 + wv, NGW_ = (int)gridDim.x * 4;
    constexpr int I_O = (DM / 64) * (DM / 32), I_UP = (DM / 64) * (DFF / 32), I_DN = (DFF / 64) * (DM / 32);
    for (int it = gw_; it < I_O + I_UP + I_DN; it += NGW_) {
        int r = it;
        if (r < I_UP) { p0_transpose_item<true>(C.w_up, DM, DFF, DFF, wup, C.mlp_norm, scr, r, lane_, MapId{}); continue; } r -= I_UP;
        if (r < I_DN) { p0_transpose_item<false>(C.w_down, DFF, DM, DM, wdn, nullptr, scr, r, lane_, MapId{}); continue; } r -= I_DN;
        p0_transpose_item<false>(C.w_out, DM, DM, DM, wo, nullptr, scr, r, lane_, MapId{});
    }
}

__device__ __forceinline__ void unpack8(const u32x4 w, float (&v)[8]) { v[0] = bf2f(w.x & 0xffffu); v[1] = bf2f(w.x >> 16); v[2] = bf2f(w.y & 0xffffu); v[3] = bf2f(w.y >> 16);
    v[4] = bf2f(w.z & 0xffffu); v[5] = bf2f(w.z >> 16); v[6] = bf2f(w.w & 0xffffu); v[7] = bf2f(w.w >> 16); }
__device__ __forceinline__ u32x4 pack8(const float (&v)[8]) { u32x4 w; w.x = pk2(v[0], v[1]); w.y = pk2(v[2], v[3]); w.z = pk2(v[4], v[5]); w.w = pk2(v[6], v[7]); return w; }
constexpr float LOG2E = 1.4426950408889634f, LN2 = 0.6931471805599453f;
__device__ __forceinline__ float fexp(float x) { return __builtin_amdgcn_exp2f(x * LOG2E); }
__device__ __forceinline__ float log_gate(float gl) { const float ls = fminf(gl, 0.f) - LN2 * __builtin_amdgcn_logf(1.f + fexp(-fabsf(gl))); return fmaxf(ls * (1.f / 16.f), -1.f); }
__device__ __forceinline__ float silu_f(float g) { return g * __builtin_amdgcn_rcpf(1.f + fexp(-g)); }
__device__ __forceinline__ void gla_scan(const Ctx& C) {
    const float* CKV = (const float*)(C.ws + WS_CKV); const float* DEC = (const float*)(C.ws + WS_DEC); bf16* PREV = (bf16*)(C.ws + WS_A);
    if (otid() >= 256) return;
    for (int e = blockIdx.x * 256 + otid(); e < BATCH * GH * 128 * 64; e += gridDim.x * 256) {
        const int d = e & 63, v = (e >> 6) & 127, bh = e >> 13; float st = 0.f;
        for (int n0 = 0; n0 < NCH; n0 += 16) {
            float cv[16], dv[16];
#pragma unroll
            for (int i = 0; i < 16; ++i) { const size_t u = (size_t)bh * NCH + n0 + i; cv[i] = CKV[(u * 128 + v) * 64 + d]; dv[i] = DEC[u * 64 + d]; }
#pragma unroll
            for (int i = 0; i < 16; ++i) { const size_t u = (size_t)bh * NCH + n0 + i; PREV[(u * 128 + v) * 64 + d] = (bf16)f2bf(st); st = dv[i] * st + cv[i]; }
        }
    }
}

namespace att {
typedef short bf16x8 __attribute__((ext_vector_type(8)));
typedef short s16x4 __attribute__((ext_vector_type(4)));
typedef float f32x16 __attribute__((ext_vector_type(16)));
typedef __attribute__((address_space(3))) const char* lds_cptr;
constexpr int KSLOT = 12288, VSLOT = 8192, LDS_K = 0, LDS_V = 3 * KSLOT, LDS_WS = LDS_V + 3 * VSLOT, LDS_OST = LDS_WS + 8 * 256, LDS_TOTAL = LDS_OST + 8 * 4096;
constexpr int QP = MH * DQK, VP = MH * MV;
#define ATT_SBAR() __builtin_amdgcn_sched_barrier(0)
__device__ __forceinline__ int crow(int r, int hi) { return (r & 3) + 8 * (r >> 2) + 4 * hi; }
__device__ __forceinline__ void glds16(const void* gsrc, unsigned lds_dst) { unsigned keep;
    asm volatile("s_mov_b32 %0, m0\n\ts_mov_b32 m0, %2\n\ts_nop 0\n\tglobal_load_lds_dwordx4 %1, off\n\ts_mov_b32 m0, %0" : "=&s"(keep) : "v"(gsrc), "s"(lds_dst) : "memory"); }
typedef float f32x2_t __attribute__((ext_vector_type(2))); typedef __bf16 bf16x2_t __attribute__((ext_vector_type(2)));
__device__ __forceinline__ unsigned cvtpk_s(float lo, float hi) { f32x2_t v = {lo, hi}; bf16x2_t b = __builtin_convertvector(v, bf16x2_t); return __builtin_bit_cast(unsigned, b); }
typedef short att_v4i16 __attribute__((ext_vector_type(4)));
__device__ __forceinline__ s16x4 vtr(lds_cptr p) { return __builtin_bit_cast(s16x4, __builtin_amdgcn_ds_read_tr16_b64_v4i16((__attribute__((address_space(3))) att_v4i16*)p)); }
#define ATT_MX3(a, b, c) __builtin_fmaxf(__builtin_fmaxf((a), (b)), (c))
__device__ __forceinline__ float rowmax(const f32x16& p0, const f32x16& p1) {
    float a = ATT_MX3(p0[0], p0[1], p1[0]), b = ATT_MX3(p0[2], p0[3], p1[1]); a = ATT_MX3(a, p1[2], p1[3]);
#pragma unroll
    for (int r = 4; r < 16; r += 4) { a = ATT_MX3(a, p0[r], p0[r + 1]); b = ATT_MX3(b, p0[r + 2], p0[r + 3]); a = ATT_MX3(a, p1[r], p1[r + 1]); b = ATT_MX3(b, p1[r + 2], p1[r + 3]); }
    float m = __builtin_fmaxf(a, b); auto rr = __builtin_amdgcn_permlane32_swap(__float_as_uint(m), __float_as_uint(m), false, false);
    return __builtin_fmaxf(__uint_as_float(rr[0]), __uint_as_float(rr[1])); }
__device__ __forceinline__ void pv(f32x16* o, int vb, bf16x8 pa0, bf16x8 pa1, bf16x8 pa2, bf16x8 pa3) {
#pragma unroll
    for (int d0 = 0; d0 < 2; ++d0) { s16x4 lo[4], hi[4];
#pragma unroll
        for (int ks = 0; ks < 4; ++ks) {
            asm volatile("ds_read_b64_tr_b16 %0,%1 offset:%c2" : "=&v"(lo[ks]) : "v"(vb), "i"(d0 * 4096 + ks * 1024) : "memory");
            asm volatile("ds_read_b64_tr_b16 %0,%1 offset:%c2" : "=&v"(hi[ks]) : "v"(vb), "i"(d0 * 4096 + ks * 1024 + 512) : "memory"); }
        asm volatile("s_waitcnt lgkmcnt(0)" ::: "memory"); ATT_SBAR();
#define ATT_PK(k) (bf16x8){lo[k][0], lo[k][1], lo[k][2], lo[k][3], hi[k][0], hi[k][1], hi[k][2], hi[k][3]}
        o[d0] = __builtin_amdgcn_mfma_f32_32x32x16_bf16(pa0, ATT_PK(0), o[d0], 0, 0, 0);
        o[d0] = __builtin_amdgcn_mfma_f32_32x32x16_bf16(pa1, ATT_PK(1), o[d0], 0, 0, 0);
        o[d0] = __builtin_amdgcn_mfma_f32_32x32x16_bf16(pa2, ATT_PK(2), o[d0], 0, 0, 0);
        o[d0] = __builtin_amdgcn_mfma_f32_32x32x16_bf16(pa3, ATT_PK(3), o[d0], 0, 0, 0);
#undef ATT_PK
    }
}
#define ATT_WAIT_BAR0() asm volatile("s_waitcnt vmcnt(0) lgkmcnt(0)\n\ts_barrier" ::: "memory")
template <int THRL>
__device__ __forceinline__ void attn_unit(int b, int h, int qb, const bf16* Q, const bf16* K, const bf16* V, bf16* O, char* shm) {
    const int tid = threadIdx.x, lane = tid & 63, r32 = lane & 31, hi = lane >> 5; const int wid = __builtin_amdgcn_readfirstlane(tid >> 6);
    const long rowbase = (long)b * SEQ; const int q0 = qb * 256; const int NTL = 4 * qb + 4, tmax = 4 * qb + (wid >> 1);
    const bf16* Qw = Q + (rowbase + q0 + wid * 32) * QP + h * DQK;
    const long bh = (long)b * MH + h;
    const bf16* ksrc0 = K + (bh * 128 * 12 + wid) * 512 + lane * 8;
    const bf16* ksrc1 = K + (bh * 128 * 12 + 8 + (wid & 3)) * 512 + lane * 8;
    const bf16* vsrc = V + (bh * 128 * 2 + (wid >> 2)) * 2048 + (16 * (wid & 3) + (lane >> 2)) * 32 + (lane & 3) * 8;
    const unsigned lds0 = (unsigned)(uintptr_t)shm;
    const unsigned kdst0 = lds0 + LDS_K + wid * 1024, kdst1 = lds0 + LDS_K + (8 + (wid & 3)) * 1024, vdst = lds0 + LDS_V + wid * 1024;
    float* wsf = (float*)(shm + LDS_WS) + wid * 64;
#define ATT_DMA(t, s) do { glds16(ksrc0 + (long)(t) * 6144, (unsigned)__builtin_amdgcn_readfirstlane(kdst0 + (s) * KSLOT)); \
        if (wid < 4) glds16(ksrc1 + (long)(t) * 6144, (unsigned)__builtin_amdgcn_readfirstlane(kdst1 + (s) * KSLOT)); \
        glds16(vsrc + (long)(t) * 4096, (unsigned)__builtin_amdgcn_readfirstlane(vdst + (s) * VSLOT)); } while (0)
    ATT_DMA(0, 0);
    bf16x8 qr[6];
#pragma unroll
    for (int d0 = 0; d0 < 6; ++d0) qr[d0] = *reinterpret_cast<const bf16x8*>(&Qw[(long)r32 * QP + d0 * 16 + hi * 8]);
    float mhat = 0.f, l_reg = 0.f; f32x16 o[2]; o[0] = f32x16{}; o[1] = f32x16{}; f32x16 negm = f32x16{}; asm volatile("" : "+v"(negm));
    const lds_cptr shm3 = (lds_cptr)shm;
    const int vlane = ((lane >> 4) & 1) * 32 + (lane & 3) * 8 + (4 * hi + ((lane & 15) >> 2)) * 64;
    u32x4 pw0 = (u32x4){0u, 0u, 0u, 0u}, pw1 = pw0, pw2 = pw0, pw3 = pw0;
    s16x4 vlo[8], vhi[8];
#define ATT_KRD(slot, d0) do { ka[slot] = *(const __attribute__((address_space(3))) bf16x8*)(kp + (d0) * 2048); kb[slot] = *(const __attribute__((address_space(3))) bf16x8*)(kp + (d0) * 2048 + 512); } while (0)
#define ATT_VRD(i) do { vlo[i] = vtr(vp + (((i) >> 2) * 4096 + ((i) & 3) * 1024)); vhi[i] = vtr(vp + (((i) >> 2) * 4096 + ((i) & 3) * 1024 + 512)); } while (0)
#define ATT_QKSM(t, s) do { \
        const lds_cptr kp = shm3 + LDS_K + (s) * KSLOT + hi * 1024 + r32 * 16; const lds_cptr vp = shm3 + LDS_V + (s) * VSLOT + vlane; \
        f32x16 p0, p1; bf16x8 ka[3], kb[3]; \
        ATT_KRD(0, 0); ATT_KRD(1, 1); ATT_SBAR(); \
        ATT_KRD(2, 2); p0 = __builtin_amdgcn_mfma_f32_32x32x16_bf16(ka[0], qr[0], negm, 0, 0, 0); p1 = __builtin_amdgcn_mfma_f32_32x32x16_bf16(kb[0], qr[0], negm, 0, 0, 0); ATT_VRD(0); ATT_VRD(1); ATT_SBAR(); \
        ATT_KRD(0, 3); p0 = __builtin_amdgcn_mfma_f32_32x32x16_bf16(ka[1], qr[1], p0, 0, 0, 0); p1 = __builtin_amdgcn_mfma_f32_32x32x16_bf16(kb[1], qr[1], p1, 0, 0, 0); ATT_VRD(2); ATT_VRD(3); ATT_SBAR(); \
        ATT_KRD(1, 4); p0 = __builtin_amdgcn_mfma_f32_32x32x16_bf16(ka[2], qr[2], p0, 0, 0, 0); p1 = __builtin_amdgcn_mfma_f32_32x32x16_bf16(kb[2], qr[2], p1, 0, 0, 0); ATT_VRD(4); ATT_VRD(5); ATT_SBAR(); \
        ATT_KRD(2, 5); p0 = __builtin_amdgcn_mfma_f32_32x32x16_bf16(ka[0], qr[3], p0, 0, 0, 0); p1 = __builtin_amdgcn_mfma_f32_32x32x16_bf16(kb[0], qr[3], p1, 0, 0, 0); ATT_VRD(6); ATT_VRD(7); ATT_SBAR(); \
        p0 = __builtin_amdgcn_mfma_f32_32x32x16_bf16(ka[1], qr[4], p0, 0, 0, 0); p1 = __builtin_amdgcn_mfma_f32_32x32x16_bf16(kb[1], qr[4], p1, 0, 0, 0); ATT_SBAR(); \
        p0 = __builtin_amdgcn_mfma_f32_32x32x16_bf16(ka[2], qr[5], p0, 0, 0, 0); p1 = __builtin_amdgcn_mfma_f32_32x32x16_bf16(kb[2], qr[5], p1, 0, 0, 0); ATT_SBAR(); \
        const float rm = rowmax(p0, p1); \
        if ((t) == 0) { mhat = rm; \
            _Pragma("unroll") for (int r = 0; r < 16; ++r) { p0[r] -= rm; p1[r] -= rm; } \
            _Pragma("unroll") for (int r = 0; r < 16; ++r) negm[r] = -mhat; \
            asm volatile("" : "+v"(negm)); \
        } else if (__any(rm > (float)THRL)) { const float dl = __builtin_fmaxf(rm, 0.f); mhat += dl; \
            _Pragma("unroll") for (int r = 0; r < 16; ++r) { p0[r] -= dl; p1[r] -= dl; } \
            _Pragma("unroll") for (int r = 0; r < 16; ++r) negm[r] = -mhat; \
            asm volatile("" : "+v"(negm)); \
            const float f = __builtin_amdgcn_exp2f(-dl); l_reg *= f; if (hi == 0) wsf[r32] = f; \
            asm volatile("s_waitcnt lgkmcnt(0)" ::: "memory"); \
            _Pragma("unroll") for (int d_ = 0; d_ < 2; ++d_) _Pragma("unroll") for (int r = 0; r < 16; ++r) o[d_][r] *= wsf[crow(r, hi)]; } \
        float sacc = 0.f; \
        _Pragma("unroll") for (int r = 0; r < 16; ++r) { p0[r] = __builtin_amdgcn_exp2f(p0[r]); p1[r] = __builtin_amdgcn_exp2f(p1[r]); sacc += p0[r] + p1[r]; } \
        l_reg += sacc; \
        pw0 = (u32x4){cvtpk_s(p0[0], p0[1]), cvtpk_s(p0[2], p0[3]), cvtpk_s(p0[4], p0[5]), cvtpk_s(p0[6], p0[7])}; \
        pw1 = (u32x4){cvtpk_s(p0[8], p0[9]), cvtpk_s(p0[10], p0[11]), cvtpk_s(p0[12], p0[13]), cvtpk_s(p0[14], p0[15])}; \
        pw2 = (u32x4){cvtpk_s(p1[0], p1[1]), cvtpk_s(p1[2], p1[3]), cvtpk_s(p1[4], p1[5]), cvtpk_s(p1[6], p1[7])}; \
        pw3 = (u32x4){cvtpk_s(p1[8], p1[9]), cvtpk_s(p1[10], p1[11]), cvtpk_s(p1[12], p1[13]), cvtpk_s(p1[14], p1[15])}; \
    } while (0)
#define ATT_VFR(i) (bf16x8){vlo[i][0], vlo[i][1], vlo[i][2], vlo[i][3], vhi[i][0], vhi[i][1], vhi[i][2], vhi[i][3]}
#define ATT_PV(s) do { ATT_SBAR(); \
        o[0] = __builtin_amdgcn_mfma_f32_32x32x16_bf16(__builtin_bit_cast(bf16x8, pw0), ATT_VFR(0), o[0], 0, 0, 0); o[1] = __builtin_amdgcn_mfma_f32_32x32x16_bf16(__builtin_bit_cast(bf16x8, pw0), ATT_VFR(4), o[1], 0, 0, 0); \
        o[0] = __builtin_amdgcn_mfma_f32_32x32x16_bf16(__builtin_bit_cast(bf16x8, pw1), ATT_VFR(1), o[0], 0, 0, 0); o[1] = __builtin_amdgcn_mfma_f32_32x32x16_bf16(__builtin_bit_cast(bf16x8, pw1), ATT_VFR(5), o[1], 0, 0, 0); \
        o[0] = __builtin_amdgcn_mfma_f32_32x32x16_bf16(__builtin_bit_cast(bf16x8, pw2), ATT_VFR(2), o[0], 0, 0, 0); o[1] = __builtin_amdgcn_mfma_f32_32x32x16_bf16(__builtin_bit_cast(bf16x8, pw2), ATT_VFR(6), o[1], 0, 0, 0); \
        o[0] = __builtin_amdgcn_mfma_f32_32x32x16_bf16(__builtin_bit_cast(bf16x8, pw3), ATT_VFR(3), o[0], 0, 0, 0); o[1] = __builtin_amdgcn_mfma_f32_32x32x16_bf16(__builtin_bit_cast(bf16x8, pw3), ATT_VFR(7), o[1], 0, 0, 0); \
    } while (0)
    int s_cur = 0, s_prev = 2;
    if (wid < 4) __builtin_amdgcn_s_setprio(1);
    if (wid < 4) {
        for (int t = 0; t < NTL; ++t) {
            ATT_WAIT_BAR0();
            const int s_next = (s_cur == 2) ? 0 : s_cur + 1;
            if (t + 1 < NTL) ATT_DMA(t + 1, s_next);
            if (t <= tmax) { ATT_QKSM(t, s_cur); ATT_PV(s_cur); }
            s_prev = s_cur; s_cur = s_next;
        }
    } else {
        for (int t = 0; t < NTL; ++t) {
            ATT_WAIT_BAR0();
            const int s_next = (s_cur == 2) ? 0 : s_cur + 1;
            if (t + 1 < NTL) ATT_DMA(t + 1, s_next);
            if (t >= 1 && t - 1 <= tmax) ATT_PV(s_prev);
            if (t <= tmax) ATT_QKSM(t, s_cur);
            s_prev = s_cur; s_cur = s_next;
        }
        if (NTL - 1 <= tmax) ATT_PV(s_prev);
    }
    __builtin_amdgcn_s_setprio(0);
    { auto rr = __builtin_amdgcn_permlane32_swap(__float_as_uint(l_reg), __float_as_uint(l_reg), false, false); l_reg = __uint_as_float(rr[0]) + __uint_as_float(rr[1]); }
    if (hi == 0) wsf[32 + r32] = l_reg;
    asm volatile("s_waitcnt lgkmcnt(0)" ::: "memory");
    float rli[16];
#pragma unroll
    for (int r = 0; r < 16; ++r) rli[r] = __builtin_amdgcn_rcpf(wsf[32 + crow(r, hi)]);
    const long orow0 = rowbase + q0 + wid * 32; const int ocol0 = 512 + h * MV;
    { bf16* stg = (bf16*)(shm + LDS_OST) + wid * 2048;
#pragma unroll
        for (int r = 0; r < 16; ++r) { const int orow = crow(r, hi);
#pragma unroll
            for (int d0 = 0; d0 < 2; ++d0) stg[orow * 64 + d0 * 32 + r32] = (bf16)f2bf(o[d0][r] * rli[r]); }
        asm volatile("s_waitcnt lgkmcnt(0)" ::: "memory");
#pragma unroll
        for (int i = 0; i < 4; ++i) { const int row = i * 8 + (lane >> 3), ch = lane & 7; const u32x4 v = *(const u32x4*)(stg + row * 64 + ch * 8); const long r = orow0 + row; const int c = ocol0 + ch * 8;
            *(u32x4*)(O + ((r >> 4) * 32 + (c >> 5)) * 512 + (r & 15) * 32 + (c & 31)) = v; } }
    asm volatile("s_waitcnt lgkmcnt(0)\n\ts_barrier" ::: "memory");
#undef ATT_DMA
#undef ATT_QKSM
#undef ATT_KRD
#undef ATT_VRD
#undef ATT_VFR
#undef ATT_PV
}
__device__ __forceinline__ void attn_phase(const Ctx& C, char* lds) {
    const bf16* QF = (const bf16*)(C.ws + WS_QF); const bf16* KF = (const bf16*)(C.ws + WS_KF); const bf16* VF = (const bf16*)(C.ws + WS_VF); bf16* O = (bf16*)(C.ws + WS_B);
    const int G = (int)gridDim.x, bx = (int)blockIdx.x; const int vcu = (G % 8 == 0) ? (bx % 8) * (G / 8) + bx / 8 : bx;
    for (int i = vcu; i < BATCH * MH * 32; i += G) { const int bh = (i & 255) >> 4, s = i & 15, qb = (i < 256) ? 31 - s : s;
        attn_unit<8>(bh >> 3, bh & 7, qb, QF, KF, VF, O, lds); }
    __syncthreads();
}
}

namespace gla {
using att::bf16x8; using att::s16x4; using att::f32x16; using att::lds_cptr; using att::crow; using att::cvtpk_s;
constexpr int L_VIMG = 0, L_QIMG = 16384, L_KIMG = 24576, L_WT = 32768, L_OBUF = 36864, OLD = 132, L_WG = 73728, L_BG = L_WG + 16384;
#define GLA_BAR() asm volatile("s_waitcnt lgkmcnt(0)\n\ts_barrier" ::: "memory")
__device__ __forceinline__ void stage_gate(const Ctx& C, unsigned char* lds) {
    const int tid = threadIdx.x;
#pragma unroll
    for (int i = 0; i < 2; ++i) *(f32x4*)(lds + L_WG + (tid + NT * i) * 16) = *(const f32x4*)(C.w_gate_up + (tid + NT * i) * 4);
    if (tid < 64) *(f32x4*)(lds + L_BG + tid * 16) = *(const f32x4*)(C.b_gate + tid * 4);
}
__device__ __forceinline__ void cum_rows(const u32x4 g0, const u32x4 g1, int h, const unsigned char* lds, float (&cum)[8], float (&tot)[8]) {
    const int tid = threadIdx.x, lane = tid & 63; const int wv = __builtin_amdgcn_readfirstlane(tid >> 6);
    float zg[16];
    { float a[8], b[8]; unpack8(g0, a); unpack8(g1, b);
#pragma unroll
      for (int j = 0; j < 8; ++j) { zg[j] = a[j]; zg[8 + j] = b[j]; } }
    float x[8];
    { const f32x4 b0 = *(const f32x4*)(lds + L_BG + (h * 64 + 8 * wv) * 4), b1 = *(const f32x4*)(lds + L_BG + (h * 64 + 8 * wv + 4) * 4);
      x[0] = b0.x; x[1] = b0.y; x[2] = b0.z; x[3] = b0.w; x[4] = b1.x; x[5] = b1.y; x[6] = b1.z; x[7] = b1.w; }
#pragma unroll
    for (int gh = 0; gh < 2; ++gh) { f32x4 w0[8], w1[8];
#pragma unroll
        for (int g = 0; g < 8; ++g) { w0[g] = *(const f32x4*)(lds + L_WG + ((gh * 8 + g) * 256 + h * 64 + 8 * wv) * 4); w1[g] = *(const f32x4*)(lds + L_WG + ((gh * 8 + g) * 256 + h * 64 + 8 * wv + 4) * 4); }
#pragma unroll
        for (int g = 0; g < 8; ++g) { const float z = zg[gh * 8 + g];
            x[0] += z * w0[g].x; x[1] += z * w0[g].y; x[2] += z * w0[g].z; x[3] += z * w0[g].w; x[4] += z * w1[g].x; x[5] += z * w1[g].y; x[6] += z * w1[g].z; x[7] += z * w1[g].w; } }
#pragma unroll
    for (int j = 0; j < 8; ++j) x[j] = log_gate(x[j]);
#define GLA_DPP(v, ctrl, rmask) __builtin_bit_cast(float, __builtin_amdgcn_update_dpp(0, __builtin_bit_cast(int, (v)), (ctrl), (rmask), 0xF, true))
#pragma unroll
    for (int j = 0; j < 8; ++j) { float v = x[j];
        v += GLA_DPP(v, 0x111, 0xF); v += GLA_DPP(v, 0x112, 0xF); v += GLA_DPP(v, 0x114, 0xF); v += GLA_DPP(v, 0x118, 0xF);
        v += GLA_DPP(v, 0x142, 0xA); v += GLA_DPP(v, 0x143, 0xC);
        cum[j] = v; tot[j] = __builtin_bit_cast(float, __builtin_amdgcn_readlane(__builtin_bit_cast(int, v), 63)); }
#undef GLA_DPP
}
__device__ __forceinline__ void trfrag4(int base, bf16x8 (&f)[4]) {
    s16x4 lo[4], hi[4];
#pragma unroll
    for (int ks = 0; ks < 4; ++ks) {
        asm volatile("ds_read_b64_tr_b16 %0,%1 offset:%c2" : "=&v"(lo[ks]) : "v"(base), "i"(ks * 1024) : "memory");
        asm volatile("ds_read_b64_tr_b16 %0,%1 offset:%c2" : "=&v"(hi[ks]) : "v"(base), "i"(ks * 1024 + 512) : "memory"); }
    asm volatile("s_waitcnt lgkmcnt(0)" ::: "memory"); __builtin_amdgcn_sched_barrier(0);
#pragma unroll
    for (int ks = 0; ks < 4; ++ks) f[ks] = (bf16x8){lo[ks][0], lo[ks][1], lo[ks][2], lo[ks][3], hi[ks][0], hi[ks][1], hi[ks][2], hi[ks][3]};
}
struct Raw { u32x4 q, k, v0, v1, g0, g1, z0, z1; bf16x8 pf[4]; };
template <bool P2>
__device__ __forceinline__ void load_raw(const Ctx& C, int u, Raw& R) {
    const bf16* Z = (const bf16*)(C.ws + WS_Z); const bf16* PREV = (const bf16*)(C.ws + WS_A);
    const int tid = threadIdx.x, lane = tid & 63, r32 = lane & 31, hi = lane >> 5, c = tid >> 3, dc = tid & 7; const int wv = __builtin_amdgcn_readfirstlane(tid >> 6);
    const int n = u % NCH, h = (u / NCH) % GH, b = u / (NCH * GH); const int row0 = b * SEQ + n * 64;
    const size_t rl_ = (size_t)(row0 + lane);
    R.k = *(const u32x4*)(Z + ztile(rl_, ZC_K + h * 64 + 8 * wv)); R.g0 = *(const u32x4*)(Z + ztile(rl_, ZC_GATE)); R.g1 = *(const u32x4*)(Z + ztile(rl_, ZC_GATE + 8));
    { const int j = tid >> 4, cc = tid & 15; R.v0 = *(const u32x4*)(Z + ztile((size_t)(row0 + j), ZC_V + h * 128 + cc * 8)); R.v1 = *(const u32x4*)(Z + ztile((size_t)(row0 + 32 + j), ZC_V + h * 128 + cc * 8)); }
    if (P2) { R.q = *(const u32x4*)(Z + ztile(rl_, ZC_Q + h * 64 + 8 * wv)); const size_t rc_ = (size_t)(row0 + c); R.z0 = *(const u32x4*)(Z + ztile(rc_, ZC_G + h * 128 + 16 * dc)); R.z1 = *(const u32x4*)(Z + ztile(rc_, ZC_G + h * 128 + 16 * dc + 8));
        const int cb = wv & 3;
#pragma unroll
        for (int s = 0; s < 4; ++s) R.pf[s] = *(const bf16x8*)(PREV + ((size_t)u * 128 + 32 * cb + r32) * 64 + 16 * s + 8 * hi); }
}
__device__ __forceinline__ void store_vimg(const Raw& R, unsigned char* lds) {
    const int tid = threadIdx.x, j = tid >> 4, cc = tid & 15;
    *(u32x4*)(lds + L_VIMG + (cc >> 2) * 4096 + j * 64 + (cc & 3) * 16) = R.v0; *(u32x4*)(lds + L_VIMG + (cc >> 2) * 4096 + (32 + j) * 64 + (cc & 3) * 16) = R.v1;
}
__device__ __forceinline__ void pass1(const Ctx& C, unsigned char* lds) {
    float* CKV = (float*)(C.ws + WS_CKV); float* DEC = (float*)(C.ws + WS_DEC);
    const int tid = threadIdx.x, lane = tid & 63, r32 = lane & 31, hi = lane >> 5, c = tid >> 3, dc = tid & 7; const int wv = __builtin_amdgcn_readfirstlane(tid >> 6);
    const unsigned lds0 = (unsigned)(uintptr_t)lds; const int lpart = ((lane >> 4) & 1) * 32 + (lane & 3) * 8 + (4 * hi + ((lane & 15) >> 2)) * 64;
    const int NU = BATCH * GH * NCH, G = (int)gridDim.x;
    __syncthreads(); stage_gate(C, lds);
    Raw cur; if ((int)blockIdx.x < NU) load_raw<false>(C, (int)blockIdx.x, cur);
    for (int u = blockIdx.x; u < NU; u += G) {
        const int h = (u / NCH) % GH;
        Raw nxt = cur; if (u + G < NU) load_raw<false>(C, u + G, nxt);
        GLA_BAR();
        store_vimg(cur, lds);
        float kv[8]; unpack8(cur.k, kv);
        float cum[8], tot[8]; cum_rows(cur.g0, cur.g1, h, lds, cum, tot);
#pragma unroll
        for (int j = 0; j < 8; ++j) kv[j] *= fexp(tot[j] - cum[j]);
        *(u32x4*)(lds + L_QIMG + (wv >> 2) * 4096 + lane * 64 + (wv & 3) * 16) = pack8(kv);
        if (lane == 63) {
#pragma unroll
            for (int j = 0; j < 8; ++j) DEC[(size_t)u * 64 + 8 * wv + j] = fexp(tot[j]); }
        GLA_BAR();
        const int vb = wv >> 1, db = wv & 1;
        bf16x8 af[4], bfr[4]; trfrag4((int)(lds0 + L_VIMG + vb * 4096) + lpart, af); trfrag4((int)(lds0 + L_QIMG + db * 4096) + lpart, bfr);
        f32x16 o = f32x16{};
#pragma unroll
        for (int ks = 0; ks < 4; ++ks) o = __builtin_amdgcn_mfma_f32_32x32x16_bf16(af[ks], bfr[ks], o, 0, 0, 0);
#pragma unroll
        for (int r = 0; r < 16; ++r) CKV[((size_t)u * 128 + 32 * vb + crow(r, hi)) * 64 + 32 * db + r32] = o[r];
        cur = nxt;
    }
    __syncthreads();
}
__device__ __forceinline__ void pass2(const Ctx& C, unsigned char* lds) {
    bf16* MIX = (bf16*)(C.ws + WS_B);
    const int tid = threadIdx.x, lane = tid & 63, r32 = lane & 31, hi = lane >> 5, c = tid >> 3, dc = tid & 7; const int wv = __builtin_amdgcn_readfirstlane(tid >> 6);
    const unsigned lds0 = (unsigned)(uintptr_t)lds; const int lpart = ((lane >> 4) & 1) * 32 + (lane & 3) * 8 + (4 * hi + ((lane & 15) >> 2)) * 64;
    const lds_cptr L3 = (lds_cptr)lds; float* obuf = (float*)(lds + L_OBUF);
    const int rb = wv >> 2, cb = wv & 3;
    const int NU = BATCH * GH * NCH, G = (int)gridDim.x;
    f32x4 gn[4];
#pragma unroll
    for (int i = 0; i < 4; ++i) gn[i] = *(const f32x4*)(C.gla_out_norm + 16 * dc + 4 * i);
    __syncthreads(); stage_gate(C, lds);
    Raw cur; if ((int)blockIdx.x < NU) load_raw<true>(C, (int)blockIdx.x, cur);
    for (int u = blockIdx.x; u < NU; u += G) {
        const int n = u % NCH, h = (u / NCH) % GH, b = u / (NCH * GH); const int row0 = b * SEQ + n * 64;
        Raw nxt = cur; if (u + G < NU) load_raw<true>(C, u + G, nxt);
        GLA_BAR();
        store_vimg(cur, lds);
        float qv[8], kv[8]; unpack8(cur.q, qv); unpack8(cur.k, kv);
        float cum[8], tot[8]; cum_rows(cur.g0, cur.g1, h, lds, cum, tot);
#pragma unroll
        for (int j = 0; j < 8; ++j) { qv[j] *= 0.125f * fexp(cum[j]); kv[j] *= fexp(-cum[j]); }
        *(u32x4*)(lds + L_QIMG + wv * 1024 + lane * 16) = pack8(qv); *(u32x4*)(lds + L_KIMG + wv * 1024 + lane * 16) = pack8(kv);
        GLA_BAR();
        bf16x8 qr[4];
#pragma unroll
        for (int s = 0; s < 4; ++s) qr[s] = *(const __attribute__((address_space(3))) bf16x8*)(L3 + L_QIMG + (2 * s + hi) * 1024 + (32 * rb + r32) * 16);
        f32x16 p0 = f32x16{}, p1 = f32x16{};
#pragma unroll
        for (int s = 0; s < 4; ++s) { const lds_cptr kp = L3 + L_KIMG + (2 * s + hi) * 1024 + r32 * 16;
            const bf16x8 a0 = *(const __attribute__((address_space(3))) bf16x8*)(kp), a1 = *(const __attribute__((address_space(3))) bf16x8*)(kp + 512);
            p0 = __builtin_amdgcn_mfma_f32_32x32x16_bf16(a0, qr[s], p0, 0, 0, 0); p1 = __builtin_amdgcn_mfma_f32_32x32x16_bf16(a1, qr[s], p1, 0, 0, 0); }
        const int cq = 32 * rb + r32;
#pragma unroll
        for (int r = 0; r < 16; ++r) { const int j = crow(r, hi); p0[r] = (j <= cq) ? p0[r] : 0.f; p1[r] = (j + 32 <= cq) ? p1[r] : 0.f; }
        u32x4 pw0, pw1, pw2, pw3;
        pw0 = (u32x4){cvtpk_s(p0[0], p0[1]), cvtpk_s(p0[2], p0[3]), cvtpk_s(p0[4], p0[5]), cvtpk_s(p0[6], p0[7])};
        pw1 = (u32x4){cvtpk_s(p0[8], p0[9]), cvtpk_s(p0[10], p0[11]), cvtpk_s(p0[12], p0[13]), cvtpk_s(p0[14], p0[15])};
        pw2 = (u32x4){cvtpk_s(p1[0], p1[1]), cvtpk_s(p1[2], p1[3]), cvtpk_s(p1[4], p1[5]), cvtpk_s(p1[6], p1[7])};
        pw3 = (u32x4){cvtpk_s(p1[8], p1[9]), cvtpk_s(p1[10], p1[11]), cvtpk_s(p1[12], p1[13]), cvtpk_s(p1[14], p1[15])};
        __builtin_amdgcn_sched_barrier(0);
        bf16x8 vf[4]; trfrag4((int)(lds0 + L_VIMG + cb * 4096) + lpart, vf);
        f32x16 o = f32x16{};
        o = __builtin_amdgcn_mfma_f32_32x32x16_bf16(__builtin_bit_cast(bf16x8, pw0), vf[0], o, 0, 0, 0);
        o = __builtin_amdgcn_mfma_f32_32x32x16_bf16(__builtin_bit_cast(bf16x8, pw1), vf[1], o, 0, 0, 0);
        o = __builtin_amdgcn_mfma_f32_32x32x16_bf16(__builtin_bit_cast(bf16x8, pw2), vf[2], o, 0, 0, 0);
        o = __builtin_amdgcn_mfma_f32_32x32x16_bf16(__builtin_bit_cast(bf16x8, pw3), vf[3], o, 0, 0, 0);
#pragma unroll
        for (int s = 0; s < 4; ++s) o = __builtin_amdgcn_mfma_f32_32x32x16_bf16(qr[s], cur.pf[s], o, 0, 0, 0);
#pragma unroll
        for (int r = 0; r < 16; ++r) obuf[(32 * rb + crow(r, hi)) * OLD + 32 * cb + r32] = o[r];
        GLA_BAR();
        { float ov[16];
#pragma unroll
            for (int i = 0; i < 4; ++i) { const f32x4 t = *(const f32x4*)(obuf + c * OLD + 16 * dc + 4 * i); ov[4 * i] = t.x; ov[4 * i + 1] = t.y; ov[4 * i + 2] = t.z; ov[4 * i + 3] = t.w; }
            float ss = 0.f;
#pragma unroll
            for (int i = 0; i < 16; ++i) ss += ov[i] * ov[i];
            ss += __shfl_xor(ss, 1); ss += __shfl_xor(ss, 2); ss += __shfl_xor(ss, 4);
            const float rn = rsqrtf(ss * (1.f / GDV) + EPS); const size_t row = (size_t)(row0 + c);
            float g0[8], g1[8]; unpack8(cur.z0, g0); unpack8(cur.z1, g1);
            const float gv[16] = {gn[0].x, gn[0].y, gn[0].z, gn[0].w, gn[1].x, gn[1].y, gn[1].z, gn[1].w, gn[2].x, gn[2].y, gn[2].z, gn[2].w, gn[3].x, gn[3].y, gn[3].z, gn[3].w};
            float w0[8], w1[8];
#pragma unroll
            for (int i = 0; i < 8; ++i) { w0[i] = ov[i] * rn * gv[i] * silu_f(g0[i]); w1[i] = ov[8 + i] * rn * gv[8 + i] * silu_f(g1[i]); }
            { const int c0 = h * 128 + 16 * dc; bf16* mp = MIX + ((row >> 4) * 32 + (c0 >> 5)) * 512 + (row & 15) * 32 + (c0 & 31);
              *(u32x4*)mp = pack8(w0); *(u32x4*)(mp + 8) = pack8(w1); } }
        cur = nxt;
    }
    __syncthreads();
}
#undef GLA_BAR
}

namespace pg8 {
#define PG8_LAS __attribute__((address_space(3)))
typedef unsigned short bf16_t;
typedef short bf16x8 __attribute__((ext_vector_type(8)));
typedef float f32x4 __attribute__((ext_vector_type(4)));
typedef unsigned u32x4 __attribute__((ext_vector_type(4)));
constexpr int BM = 256, BK = 64, HALF = 128, HTB = HALF * BK * 2  , STAGE_BYTES = 8 * HTB, NXCD = 8, WGM = 8;

__host__ __device__ __forceinline__ int lds_byte(int r, int c) { const int st = (r >> 4) * 2 + (c >> 5), rr = r & 15, cc = c & 31, ob = rr * 64 + cc * 2; return st * 1024 + (ob ^ (((ob >> 9) & 1) << 5)); }
__host__ __device__ __forceinline__ void stage_rc(int b, int& R, int& C) { const int st = b / 1024, sb = b % 1024, swz = sb ^ (((sb >> 9) & 1) << 5); R = (st >> 1) * 16 + swz / 64; C = (st & 1) * 32 + (swz % 64) / 2; }
__host__ __device__ __forceinline__ int perm32(int rho) { const int n = rho >> 4, i = rho & 15; return 8 * (i >> 2) + 4 * n + (i & 3); }

struct Unit { int pm, pn; };
struct Gemm { const bf16_t* A; const bf16_t* Bt; int M, N, K, lda; bool ta, tb; };

struct StaticOrder {
    int nM, nN, nwg, G, c;
    __host__ __device__ void init(int M, int N, int G_, int c_) { nM = M / BM; nN = N / BM; nwg = nM * nN; G = G_; c = c_; }
    __host__ __device__ bool next(int i, Unit& u) const {
        const long L = (long)i * G + c; if (L >= nwg) return false;
        int wgid = (int)L; { const int q = nwg / NXCD, r = nwg % NXCD, xcd = wgid % NXCD, off = wgid / NXCD; wgid = (xcd < r ? xcd * (q + 1) : r * (q + 1) + (xcd - r) * q) + off; }
        const int nig = WGM * nN, gid = wgid / nig, fm = gid * WGM, gsz = (nM - fm) < WGM ? (nM - fm) : WGM;
        u.pm = fm + ((wgid % nig) % gsz); u.pn = (wgid % nig) / gsz; return true;
    }
    __device__ __forceinline__ void a_ready(const Unit&) const {}
    __device__ __forceinline__ void done(const Unit&) const {}
};

__device__ __forceinline__ unsigned cvt_pk_bf16(float lo, float hi) { unsigned r; asm volatile("v_cvt_pk_bf16_f32 %0, %1, %2" : "=v"(r) : "v"(lo), "v"(hi)); return r; }
typedef float f32x2 __attribute__((ext_vector_type(2)));
typedef unsigned u32x2v __attribute__((ext_vector_type(2)));
struct EpiBf16 {
    static constexpr bool PERM = true, AFTER_DRAIN = false; static constexpr int PROBE_BIT = 26;
    bf16_t* O; int ldc;
    __device__ __forceinline__ void operator()(const f32x4 (&acc)[2][2][4][2], const Unit& u, int wr, int wc, int fr, int fq) const {
        const int row0 = u.pm * BM + wr * 64 + fr, col0 = u.pn * BM + wc * 32 + 8 * fq;
#pragma unroll
        for (int ai = 0; ai < 2; ++ai)
#pragma unroll
            for (int m = 0; m < 4; ++m) { bf16_t* rowp = O + (size_t)(row0 + ai * HALF + m * 16) * ldc + col0;
#pragma unroll
                for (int bj = 0; bj < 2; ++bj) { const f32x4 v0 = acc[ai][bj][m][0], v1 = acc[ai][bj][m][1];
                    u32x4 w; w.x = cvt_pk_bf16(v0[0], v0[1]); w.y = cvt_pk_bf16(v0[2], v0[3]); w.z = cvt_pk_bf16(v1[0], v1[1]); w.w = cvt_pk_bf16(v1[2], v1[3]);
                    *(u32x4*)(rowp + bj * HALF) = w; } }
    }
};
struct EpiZ {
    static constexpr bool PERM = true, AFTER_DRAIN = false; static constexpr int PROBE_BIT = 27;
    bf16_t* O; int ldc; float* ssqq; float* ssqkv; float* ssqpe;
    __device__ __forceinline__ void operator()(const f32x4 (&acc)[2][2][4][2], const Unit& u, int wr, int wc, int fr, int fq) const {
        const int row0 = u.pm * BM + wr * 64 + fr, col0 = u.pn * BM + wc * 32 + 8 * fq;
#pragma unroll
        for (int ai = 0; ai < 2; ++ai)
#pragma unroll
            for (int m = 0; m < 4; ++m) { const int r = row0 + ai * HALF + m * 16; bf16_t* rowp = O + ((size_t)(r >> 4) * (ldc >> 5) + (col0 >> 5)) * 512 + (r & 15) * 32 + (col0 & 31); float sq[2];
#pragma unroll
                for (int bj = 0; bj < 2; ++bj) { const f32x4 v0 = acc[ai][bj][m][0], v1 = acc[ai][bj][m][1];
                    u32x4 w; w.x = cvt_pk_bf16(v0[0], v0[1]); w.y = cvt_pk_bf16(v0[2], v0[3]); w.z = cvt_pk_bf16(v1[0], v1[1]); w.w = cvt_pk_bf16(v1[2], v1[3]);
                    *(u32x4*)(rowp + bj * 4 * 512) = w;
                    sq[bj] = ((v0[0] * v0[0] + v0[1] * v0[1]) + (v0[2] * v0[2] + v0[3] * v0[3])) + ((v1[0] * v1[0] + v1[1] * v1[1]) + (v1[2] * v1[2] + v1[3] * v1[3])); }
                if (u.pn == 6) { float s = sq[0] + sq[1]; s += __shfl_xor(s, 16); s += __shfl_xor(s, 32); if (fq == 0) ssqq[(size_t)r * 4 + wc] = s; }
                else if (u.pn == 7) { float s = sq[0]; s += __shfl_xor(s, 16); s += __shfl_xor(s, 32); if (fq == 0) ssqkv[(size_t)r * 4 + wc] = s;
                    if (wc == 0) { float t = sq[1]; t += __shfl_xor(t, 16); t += __shfl_xor(t, 32); if (fq == 0) ssqpe[r] = t; } } }
    }
};
struct EpiQ {
    static constexpr bool PERM = false, AFTER_DRAIN = true; static constexpr int PROBE_BIT = 25;
    const float* ssqq; const float* gq; const float* cosT; const float* sinT; bf16_t* QF; float eps, qscale;
    __device__ __forceinline__ void fused(f32x4 (&acc)[2][2][4][2], const Unit& u, int wr, int wc, int fr, int fq, PG8_LAS unsigned char* lds, int wid, int lane) const {
        PG8_LAS float* P = (PG8_LAS float*)lds;
        f32x4 s4A[2][4];
#pragma unroll
        for (int ai = 0; ai < 2; ++ai)
#pragma unroll
            for (int m = 0; m < 4; ++m) s4A[ai][m] = *(const f32x4*)(ssqq + (size_t)(u.pm * BM + ai * HALF + wr * 64 + m * 16 + fr) * 4);
        __builtin_amdgcn_sched_barrier(0);
#pragma unroll
        for (int ai = 0; ai < 2; ++ai)
#pragma unroll
            for (int m = 0; m < 4; ++m) { const int rl = ai * HALF + wr * 64 + m * 16 + fr; const f32x4 s4 = s4A[ai][m];
                const float ra = __builtin_amdgcn_rsqf(((s4[0] + s4[1]) + (s4[2] + s4[3])) * (1.0f / 256.0f) + eps);
#pragma unroll
                for (int bj = 0; bj < 2; ++bj) { float s = 0.f;
#pragma unroll
                    for (int n = 0; n < 2; ++n) { const f32x4 v = acc[ai][bj][m][n] * ra; acc[ai][bj][m][n] = v; s += (v[0] * v[0] + v[1] * v[1]) + (v[2] * v[2] + v[3] * v[3]); }
                    s += __shfl_xor(s, 16); s += __shfl_xor(s, 32);
                    if (fq == 0) P[(rl * 2 + bj) * 4 + wc] = s; } }
        asm volatile("s_waitcnt lgkmcnt(0)" ::: "memory"); __builtin_amdgcn_s_barrier(); asm volatile("" ::: "memory");
        PG8_LAS unsigned char* ST = lds + 8192;
        if (wc < 3) {
            const int j0 = wc * 32 + 4 * fq; const f32x4 g0 = *(const f32x4*)(gq + j0), g1 = *(const f32x4*)(gq + j0 + 16);
            f32x4 csA[2][4], snA[2][4];
#pragma unroll
            for (int ai = 0; ai < 2; ++ai)
#pragma unroll
                for (int m = 0; m < 4; ++m) { const size_t r = (size_t)(u.pm * BM + ai * HALF + wr * 64 + m * 16 + fr); csA[ai][m] = (f32x4){1.f, 1.f, 1.f, 1.f}; snA[ai][m] = (f32x4){0.f, 0.f, 0.f, 0.f};
                    if (wc == 2) { csA[ai][m] = *(const f32x4*)(cosT + r * 16 + 4 * fq); snA[ai][m] = *(const f32x4*)(sinT + r * 16 + 4 * fq); } }
            __builtin_amdgcn_sched_barrier(0);
#pragma unroll
            for (int ai = 0; ai < 2; ++ai)
#pragma unroll
                for (int m = 0; m < 4; ++m) { const int rl = ai * HALF + wr * 64 + m * 16 + fr; const f32x4 cs = csA[ai][m], sn = snA[ai][m];
#pragma unroll
                    for (int bj = 0; bj < 2; ++bj) { const f32x4 p = *(const PG8_LAS f32x4*)(P + (rl * 2 + bj) * 4);
                        const float rh = qscale * __builtin_amdgcn_rsqf(((p[0] + p[1]) + (p[2] + p[3])) * (1.0f / 96.0f) + eps);
                        const f32x4 a = acc[ai][bj][m][0] * rh * g0, b = acc[ai][bj][m][1] * rh * g1;
                        f32x4 o0 = a, o1 = b; if (wc == 2) { o0 = a * cs - b * sn; o1 = a * sn + b * cs; }
                        PG8_LAS unsigned char* dst = ST + rl * 400 + (bj * 96 + j0) * 2;
                        u32x2v w0, w1; w0.x = cvt_pk_bf16(o0[0], o0[1]); w0.y = cvt_pk_bf16(o0[2], o0[3]); w1.x = cvt_pk_bf16(o1[0], o1[1]); w1.y = cvt_pk_bf16(o1[2], o1[3]);
                        *(PG8_LAS u32x2v*)dst = w0; *(PG8_LAS u32x2v*)(dst + 32) = w1; }
                    }
        }
        asm volatile("s_waitcnt lgkmcnt(0)" ::: "memory"); __builtin_amdgcn_s_barrier(); asm volatile("" ::: "memory");
        { const int tid = wid * 64 + lane;
#pragma unroll
            for (int i = 0; i < 12; ++i) { const int idx = tid + 512 * i, row = idx / 24, ch = idx - row * 24;
                *(u32x4*)(QF + (size_t)(u.pm * BM + row) * 768 + (2 * u.pn) * 96 + ch * 8) = *(const PG8_LAS u32x4*)(ST + row * 400 + ch * 16); } }
    }
};
struct EpiKV {
    static constexpr bool PERM = false, AFTER_DRAIN = true; static constexpr int PROBE_BIT = 24;
    const float* ssqkv; const float* ssqpe; const float* gk; const float* cosT; const float* sinT; const bf16_t* Z; bf16_t* KF; bf16_t* VF; float eps;
    __device__ __forceinline__ void fused(f32x4 (&acc)[2][2][4][2], const Unit& u, int wr, int wc, int fr, int fq, PG8_LAS unsigned char* lds, int wid, int lane) const {
        PG8_LAS float* P = (PG8_LAS float*)lds;
        f32x4 s4A[2][4];
#pragma unroll
        for (int ai = 0; ai < 2; ++ai)
#pragma unroll
            for (int m = 0; m < 4; ++m) s4A[ai][m] = *(const f32x4*)(ssqkv + (size_t)(u.pm * BM + ai * HALF + wr * 64 + m * 16 + fr) * 4);
        __builtin_amdgcn_sched_barrier(0);
#pragma unroll
        for (int ai = 0; ai < 2; ++ai)
#pragma unroll
            for (int m = 0; m < 4; ++m) { const int rl = ai * HALF + wr * 64 + m * 16 + fr; const f32x4 s4 = s4A[ai][m];
                const float ra = __builtin_amdgcn_rsqf(((s4[0] + s4[1]) + (s4[2] + s4[3])) * (1.0f / 128.0f) + eps);
#pragma unroll
                for (int bj = 0; bj < 2; ++bj) { float s = 0.f;
#pragma unroll
                    for (int n = 0; n < 2; ++n) { const f32x4 v = acc[ai][bj][m][n] * ra; acc[ai][bj][m][n] = v; s += (v[0] * v[0] + v[1] * v[1]) + (v[2] * v[2] + v[3] * v[3]); }
                    if (wc < 2) { s += __shfl_xor(s, 16); s += __shfl_xor(s, 32); if (fq == 0) P[(rl * 2 + bj) * 2 + wc] = s; } } }
        asm volatile("s_waitcnt lgkmcnt(0)" ::: "memory"); __builtin_amdgcn_s_barrier(); asm volatile("" ::: "memory");
        const int j0 = wc * 32 + 4 * fq;
        PG8_LAS unsigned char* ST = lds + 8192;
        if (wc < 2) {
            const f32x4 g0 = *(const f32x4*)(gk + j0), g1 = *(const f32x4*)(gk + j0 + 16);
            float pesA[2][4];
#pragma unroll
            for (int ai = 0; ai < 2; ++ai)
#pragma unroll
                for (int m = 0; m < 4; ++m) pesA[ai][m] = ssqpe[(size_t)(u.pm * BM + ai * HALF + wr * 64 + m * 16 + fr)];
            __builtin_amdgcn_sched_barrier(0);
#pragma unroll
            for (int ai = 0; ai < 2; ++ai)
#pragma unroll
                for (int m = 0; m < 4; ++m) { const int rl = ai * HALF + wr * 64 + m * 16 + fr; const float pes = pesA[ai][m];
#pragma unroll
                    for (int bj = 0; bj < 2; ++bj) { const float rk = __builtin_amdgcn_rsqf((P[(rl * 2 + bj) * 2] + P[(rl * 2 + bj) * 2 + 1] + pes) * (1.0f / 96.0f) + eps);
                        const f32x4 o0 = acc[ai][bj][m][0] * rk * g0, o1 = acc[ai][bj][m][1] * rk * g1; PG8_LAS unsigned char* dst = ST + rl * 400 + (bj * 96 + j0) * 2;
                        u32x2v w0, w1; w0.x = cvt_pk_bf16(o0[0], o0[1]); w0.y = cvt_pk_bf16(o0[2], o0[3]); w1.x = cvt_pk_bf16(o1[0], o1[1]); w1.y = cvt_pk_bf16(o1[2], o1[3]);
                        *(PG8_LAS u32x2v*)dst = w0; *(PG8_LAS u32x2v*)(dst + 32) = w1; }
                    asm volatile("" ::: "memory"); }
        } else {
#pragma unroll
            for (int ai = 0; ai < 2; ++ai)
#pragma unroll
                for (int m = 0; m < 4; ++m) { const int rl = ai * HALF + wr * 64 + m * 16 + fr; const size_t r = (size_t)(u.pm * BM + rl);
#pragma unroll
                    for (int bj = 0; bj < 2; ++bj) { const f32x4 o0 = acc[ai][bj][m][0], o1 = acc[ai][bj][m][1];
                        bf16_t* dst = VF + (((((size_t)(u.pm >> 5) * 8 + 2 * u.pn + bj) * 128 + (u.pm & 31) * 4 + (rl >> 6)) * 2 + (wc - 2)) * 64 + (rl & 63)) * 32 + 4 * fq;
                        u32x2v w0, w1; w0.x = cvt_pk_bf16(o0[0], o0[1]); w0.y = cvt_pk_bf16(o0[2], o0[3]); w1.x = cvt_pk_bf16(o1[0], o1[1]); w1.y = cvt_pk_bf16(o1[2], o1[3]);
                        *(u32x2v*)dst = w0; *(u32x2v*)(dst + 16) = w1; }
                    asm volatile("" ::: "memory"); }
            if (wc == 2) {
                const f32x4 g0 = *(const f32x4*)(gk + 64 + 4 * fq), g1 = *(const f32x4*)(gk + 80 + 4 * fq);
#pragma unroll
                for (int ai = 0; ai < 2; ++ai) {
                    float pesB[4]; u32x2v xaB[4], xbB[4]; f32x4 csB[4], snB[4];
#pragma unroll
                    for (int m = 0; m < 4; ++m) { const size_t r = (size_t)(u.pm * BM + ai * HALF + wr * 64 + m * 16 + fr); pesB[m] = ssqpe[r];
                        xaB[m] = *(const u32x2v*)(Z + ((r >> 4) * 64 + 60) * 512 + (r & 15) * 32 + 4 * fq); xbB[m] = *(const u32x2v*)(Z + ((r >> 4) * 64 + 60) * 512 + (r & 15) * 32 + 16 + 4 * fq);
                        csB[m] = *(const f32x4*)(cosT + r * 16 + 4 * fq); snB[m] = *(const f32x4*)(sinT + r * 16 + 4 * fq); }
                    __builtin_amdgcn_sched_barrier(0);
#pragma unroll
                    for (int m = 0; m < 4; ++m) { const int rl = ai * HALF + wr * 64 + m * 16 + fr; const float pes = pesB[m];
                        const u32x2v xa = xaB[m], xb = xbB[m];
                        const f32x4 x1 = (f32x4){__uint_as_float(xa.x << 16), __uint_as_float(xa.x & 0xffff0000u), __uint_as_float(xa.y << 16), __uint_as_float(xa.y & 0xffff0000u)};
                        const f32x4 x2 = (f32x4){__uint_as_float(xb.x << 16), __uint_as_float(xb.x & 0xffff0000u), __uint_as_float(xb.y << 16), __uint_as_float(xb.y & 0xffff0000u)};
                        const f32x4 cs = csB[m], sn = snB[m];
#pragma unroll
                        for (int bj = 0; bj < 2; ++bj) { const float rk = __builtin_amdgcn_rsqf((P[(rl * 2 + bj) * 2] + P[(rl * 2 + bj) * 2 + 1] + pes) * (1.0f / 96.0f) + eps);
                            const f32x4 a = x1 * rk * g0, b = x2 * rk * g1, o0 = a * cs - b * sn, o1 = a * sn + b * cs; PG8_LAS unsigned char* dst = ST + rl * 400 + (bj * 96 + 64 + 4 * fq) * 2;
                            u32x2v w0, w1; w0.x = cvt_pk_bf16(o0[0], o0[1]); w0.y = cvt_pk_bf16(o0[2], o0[3]); w1.x = cvt_pk_bf16(o1[0], o1[1]); w1.y = cvt_pk_bf16(o1[2], o1[3]);
                            *(PG8_LAS u32x2v*)dst = w0; *(PG8_LAS u32x2v*)(dst + 32) = w1; } }
                    asm volatile("" ::: "memory"); }
            }
        }
        asm volatile("s_waitcnt lgkmcnt(0)" ::: "memory"); __builtin_amdgcn_s_barrier(); asm volatile("" ::: "memory");
        { const int tid = wid * 64 + lane;
#pragma unroll
            for (int i = 0; i < 12; ++i) { const int idx = tid + 512 * i, ch = idx >> 8, row = idx & 255, hd = 2 * u.pn + (ch >= 12 ? 1 : 0), c = ch >= 12 ? ch - 12 : ch;
                *(u32x4*)(KF + (((((size_t)(u.pm >> 5) * 8 + hd) * 128 + (u.pm & 31) * 4 + (row >> 6)) * 12 + c) * 64 + (row & 63)) * 8) = *(const PG8_LAS u32x4*)(ST + row * 400 + ch * 16); } }
    }
};
struct EpiOutProjG {
    static constexpr bool PERM = false, AFTER_DRAIN = false; static constexpr int PROBE_BIT = 28;
    const float* x; float* x1; bf16_t* x1b; float* ssq;
    __device__ __forceinline__ void operator()(const f32x4 (&acc)[2][2][4][2], const Unit& u, int wr, int wc, int fr, int fq) const {
        const int col0 = u.pn * BM + wc * 32 + 4 * fq;
#pragma unroll
        for (int ai = 0; ai < 2; ++ai) {
            f32x4 xr[4][2][2];
#pragma unroll
            for (int m = 0; m < 4; ++m) { const size_t off = (size_t)(u.pm * BM + ai * HALF + wr * 64 + m * 16 + fr) * 1024 + col0;
#pragma unroll
                for (int bj = 0; bj < 2; ++bj)
#pragma unroll
                    for (int n = 0; n < 2; ++n) xr[m][bj][n] = *(const f32x4*)(x + off + bj * HALF + n * 16); }
            __builtin_amdgcn_sched_barrier(0);
#pragma unroll
            for (int m = 0; m < 4; ++m) { const int r = u.pm * BM + ai * HALF + wr * 64 + m * 16 + fr; const size_t off = (size_t)r * 1024 + col0; float s = 0.f;
#pragma unroll
                for (int bj = 0; bj < 2; ++bj)
#pragma unroll
                    for (int n = 0; n < 2; ++n) { const f32x4 t = xr[m][bj][n] + acc[ai][bj][m][n];
                        u32x2v w; w.x = cvt_pk_bf16(t[0], t[1]); w.y = cvt_pk_bf16(t[2], t[3]);
                        *(u32x2v*)(x1b + ((size_t)(r >> 4) * 32 + ((col0 >> 5) + 4 * bj)) * 512 + (r & 15) * 32 + (col0 & 31) + 16 * n) = w;
                        s += (t[0] * t[0] + t[1] * t[1]) + (t[2] * t[2] + t[3] * t[3]); }
                s += __shfl_xor(s, 16); s += __shfl_xor(s, 32);
                if (fq == 0) ssq[(size_t)r * 16 + u.pn * 4 + wc] = s; }
            asm volatile("" ::: "memory"); }
    }
};
struct EpiUpG {
    static constexpr bool PERM = true, AFTER_DRAIN = false; static constexpr int PROBE_BIT = 29;
    const PG8_LAS float* rtab; bf16_t* H;
    __device__ __forceinline__ void operator()(const f32x4 (&acc)[2][2][4][2], const Unit& u, int wr, int wc, int fr, int fq) const { (*this)(acc, u, wr, wc, fr, fq, 0); }
    __device__ __forceinline__ void operator()(const f32x4 (&acc)[2][2][4][2], const Unit& u, int wr, int wc, int fr, int fq, int ui) const {
        const int row0 = u.pm * BM + wr * 64 + fr, col0 = u.pn * BM + wc * 32 + 8 * fq;
#pragma unroll
        for (int ai = 0; ai < 2; ++ai)
#pragma unroll
            for (int m = 0; m < 4; ++m) { const int r = row0 + ai * HALF + m * 16;
                const float rstd = rtab[(ui & 3) * 256 + wr * 64 + fr + ai * HALF + m * 16];
                bf16_t* rowp = H + ((size_t)(r >> 4) * 128 + (col0 >> 5)) * 512 + (r & 15) * 32 + (col0 & 31);
#pragma unroll
                for (int bj = 0; bj < 2; ++bj) { f32x4 v0 = acc[ai][bj][m][0] * rstd, v1 = acc[ai][bj][m][1] * rstd;
#pragma unroll
                    for (int e = 0; e < 4; ++e) { v0[e] = __builtin_fmaxf(v0[e], 0.f); v1[e] = __builtin_fmaxf(v1[e], 0.f); }
                    v0 = v0 * v0; v1 = v1 * v1;
                    u32x4 w; w.x = cvt_pk_bf16(v0[0], v0[1]); w.y = cvt_pk_bf16(v0[2], v0[3]); w.z = cvt_pk_bf16(v1[0], v1[1]); w.w = cvt_pk_bf16(v1[2], v1[3]);
                    *(u32x4*)(rowp + bj * 4 * 512) = w; } }
    }
};
struct EpiDownG {
    static constexpr bool PERM = false, AFTER_DRAIN = false; static constexpr int PROBE_BIT = 30;
    const bf16_t* x1b; float* out;
    __device__ __forceinline__ void operator()(const f32x4 (&acc)[2][2][4][2], const Unit& u, int wr, int wc, int fr, int fq) const {
        const int col0 = u.pn * BM + wc * 32 + 4 * fq;
        u32x2v xw[2][4][2][2];
#pragma unroll
        for (int ai = 0; ai < 2; ++ai)
#pragma unroll
            for (int m = 0; m < 4; ++m) { const size_t off = (size_t)(u.pm * BM + ai * HALF + wr * 64 + m * 16 + fr) * 1024 + col0;
#pragma unroll
                for (int bj = 0; bj < 2; ++bj)
#pragma unroll
                    for (int n = 0; n < 2; ++n) { const int r_ = u.pm * BM + ai * HALF + wr * 64 + m * 16 + fr; xw[ai][m][bj][n] = *(const u32x2v*)(x1b + ((size_t)(r_ >> 4) * 32 + ((col0 >> 5) + 4 * bj)) * 512 + (r_ & 15) * 32 + (col0 & 31) + 16 * n); } }
        __builtin_amdgcn_sched_barrier(0);
#pragma unroll
        for (int ai = 0; ai < 2; ++ai)
#pragma unroll
            for (int m = 0; m < 4; ++m) { const size_t off = (size_t)(u.pm * BM + ai * HALF + wr * 64 + m * 16 + fr) * 1024 + col0;
#pragma unroll
                for (int bj = 0; bj < 2; ++bj)
#pragma unroll
                    for (int n = 0; n < 2; ++n) { const u32x2v w = xw[ai][m][bj][n];
                        const f32x4 xr = (f32x4){__uint_as_float(w.x << 16), __uint_as_float(w.x & 0xffff0000u), __uint_as_float(w.y << 16), __uint_as_float(w.y & 0xffff0000u)};
                        *(f32x4*)(out + off + bj * HALF + n * 16) = xr + acc[ai][bj][m][n]; } }
    }
};
template <class Epi, class Sched, bool ALIGN_EPI = false, bool SP2 = false>
__device__ __forceinline__ void gemm_phase(PG8_LAS unsigned char* lds, const Gemm g, const Sched& S, const Epi& E) {
    const int tid = threadIdx.x, wid = __builtin_amdgcn_readfirstlane(tid >> 6), lane = tid & 63, wr = wid >> 2, wc = wid & 3, fr = lane & 15, fq = lane >> 4;
    const int K = g.K, nt = K / BK;
    unsigned voffA[2], voffB[2];
#pragma unroll
    for (int i = 0; i < 2; ++i) { int R, C; stage_rc(tid * 16 + i * 8192, R, C); const int Rb = Epi::PERM ? ((R & ~31) + perm32(R & 31)) : R;
        voffA[i] = g.ta ? (unsigned)(((R >> 4) * (g.lda >> 5) + (C >> 5)) * 1024 + (R & 15) * 64 + (C & 31) * 2) : (unsigned)(R * g.lda + C) * 2u;
        voffB[i] = g.tb ? (unsigned)(((Rb >> 4) * (K >> 5) + (C >> 5)) * 1024 + (Rb & 15) * 64 + (C & 31) * 2) : (unsigned)(Rb * K + C) * 2u; }
    const size_t kstepA = g.ta ? (size_t)2048 : (size_t)(BK * 2), kstepB = g.tb ? (size_t)2048 : (size_t)(BK * 2);
    const size_t hstepB = (size_t)HALF * K * 2, hstepA = (size_t)HALF * g.lda * 2;
    const size_t tstepB = 2 * hstepB, tstepA = 2 * hstepA;
    const unsigned ldsw = (unsigned)wid * 1024u;
    const int aoff = lds_byte(wr * 64 + fr, fq * 8), boff = lds_byte(wc * 32 + fr, fq * 8);
#define PG8_SA(b, h) (((b) * 2 + (h)) * HTB)
#define PG8_SB(b, h) ((4 + (b) * 2 + (h)) * HTB)
#define PG8_STAGE(bufoff, gbase, voff) do { _Pragma("unroll") for (int _i = 0; _i < 2; ++_i) \
        __builtin_amdgcn_global_load_lds((const unsigned*)((const char*)(gbase) + (voff)[_i]), (PG8_LAS unsigned*)(lds + (bufoff) + ldsw + _i * 8192), 16, 0, 0); } while (0)
#define PG8_LDA(dst, b, h) do { _Pragma("unroll") for (int m = 0; m < 4; ++m) _Pragma("unroll") for (int k = 0; k < 2; ++k) dst[m][k] = *(const PG8_LAS bf16x8*)(lds + PG8_SA(b, h) + aoff + m * 2048 + k * 1024); } while (0)
#define PG8_LDB(dst, b, h) do { _Pragma("unroll") for (int n = 0; n < 2; ++n) _Pragma("unroll") for (int k = 0; k < 2; ++k) dst[n][k] = *(const PG8_LAS bf16x8*)(lds + PG8_SB(b, h) + boff + n * 2048 + k * 1024); } while (0)
#define PG8_MMA(ai, bj, At, Bt) do { __builtin_amdgcn_s_setprio(1); _Pragma("unroll") for (int m = 0; m < 4; ++m) _Pragma("unroll") for (int n = 0; n < 2; ++n) _Pragma("unroll") for (int k = 0; k < 2; ++k) \
        acc[ai][bj][m][n] = __builtin_amdgcn_mfma_f32_16x16x32_bf16(Bt[n][k], At[m][k], acc[ai][bj][m][n], 0, 0, 0); __builtin_amdgcn_s_setprio(0); } while (0)
#define PG8_WAIT_V(n) asm volatile("s_waitcnt vmcnt(" #n ")" ::: "memory")
#define PG8_WAIT_L(n) asm volatile("s_waitcnt lgkmcnt(" #n ")" ::: "memory")
#define PG8_BAR __builtin_amdgcn_s_barrier()
#define PG8_SCHED __builtin_amdgcn_sched_barrier(0)
    Unit cur, nxt; int ui = 0;
    if (!S.next(0, cur)) return;
    f32x4 acc[2][2][4][2];
#pragma unroll
    for (int a = 0; a < 2; ++a)
#pragma unroll
        for (int b = 0; b < 2; ++b)
#pragma unroll
            for (int m = 0; m < 4; ++m)
#pragma unroll
                for (int n = 0; n < 2; ++n) acc[a][b][m][n] = (f32x4){0.f, 0.f, 0.f, 0.f};
    bf16x8 At[4][2], B0[2][2], B1[2][2];
    const char* cA = (const char*)g.A + (size_t)cur.pm * tstepA; const char* cB = (const char*)g.Bt + (size_t)cur.pn * tstepB;
    S.a_ready(cur);
    if constexpr (SP2) {
        PG8_STAGE(PG8_SB(0, 0), cB, voffB); PG8_STAGE(PG8_SB(0, 1), cB + hstepB, voffB); PG8_STAGE(PG8_SA(0, 0), cA, voffA); PG8_STAGE(PG8_SA(0, 1), cA + hstepA, voffA);
        if (wr == 1) PG8_BAR;
        PG8_WAIT_V(2); PG8_BAR;
        PG8_STAGE(PG8_SB(1, 0), cB + kstepB, voffB); PG8_STAGE(PG8_SA(1, 0), cA + kstepA, voffA); PG8_STAGE(PG8_SB(1, 1), cB + hstepB + kstepB, voffB);
        PG8_WAIT_V(6); PG8_BAR;
    } else {
        PG8_STAGE(PG8_SB(0, 0), cB, voffB); PG8_STAGE(PG8_SA(0, 0), cA, voffA); PG8_STAGE(PG8_SB(0, 1), cB + hstepB, voffB); PG8_STAGE(PG8_SA(0, 1), cA + hstepA, voffA);
        if (wr == 1) PG8_BAR;
        PG8_WAIT_V(4); PG8_BAR;
        PG8_STAGE(PG8_SB(1, 0), cB + kstepB, voffB); PG8_STAGE(PG8_SA(1, 0), cA + kstepA, voffA); PG8_STAGE(PG8_SB(1, 1), cB + hstepB + kstepB, voffB);
        PG8_WAIT_V(6); PG8_BAR;
    }
    for (;;) {
        const bool has_next = S.next(ui + 1, nxt);
        const char* nA = has_next ? (const char*)g.A + (size_t)nxt.pm * tstepA : cA; const char* nB = has_next ? (const char*)g.Bt + (size_t)nxt.pn * tstepB : cB;
        for (int t = 0; t < nt; t += 2) {
            const bool last = (t == nt - 2);
            const char* a1 = cA + (size_t)(t + 1) * kstepA;
            const char* a2 = last ? nA : cA + (size_t)(t + 2) * kstepA; const char* b2 = last ? nB : cB + (size_t)(t + 2) * kstepB;
            const char* a3 = a2 + kstepA; const char* b3 = b2 + kstepB;
            if (last && has_next) S.a_ready(nxt);
            if constexpr (SP2) {
            PG8_LDB(B0, 0, 0); PG8_LDB(B1, 0, 1); PG8_SCHED; PG8_LDA(At, 0, 0); PG8_STAGE(PG8_SA(1, 1), a1 + hstepA, voffA);
            PG8_WAIT_V(8); PG8_WAIT_L(0); PG8_BAR; PG8_MMA(0, 0, At, B0); PG8_MMA(0, 1, At, B1); PG8_BAR; PG8_SCHED;
            PG8_LDA(At, 0, 1); PG8_STAGE(PG8_SB(0, 0), b2, voffB); PG8_STAGE(PG8_SB(0, 1), b2 + hstepB, voffB); PG8_STAGE(PG8_SA(0, 0), a2, voffA);
            PG8_WAIT_V(8); PG8_WAIT_L(0); PG8_BAR; PG8_MMA(1, 0, At, B0); PG8_MMA(1, 1, At, B1); PG8_BAR; PG8_SCHED;
            PG8_LDB(B0, 1, 0); PG8_LDB(B1, 1, 1); PG8_SCHED; PG8_LDA(At, 1, 0); PG8_STAGE(PG8_SA(0, 1), a2 + hstepA, voffA);
            PG8_WAIT_V(8); PG8_WAIT_L(0); PG8_BAR; PG8_MMA(0, 0, At, B0); PG8_MMA(0, 1, At, B1); PG8_BAR; PG8_SCHED;
            PG8_LDA(At, 1, 1); PG8_STAGE(PG8_SB(1, 0), b3, voffB); PG8_STAGE(PG8_SB(1, 1), b3 + hstepB, voffB); PG8_STAGE(PG8_SA(1, 0), a3, voffA);
            PG8_WAIT_V(8); PG8_WAIT_L(0); PG8_BAR; PG8_MMA(1, 0, At, B0); PG8_MMA(1, 1, At, B1); PG8_BAR; PG8_SCHED;
            } else {
            PG8_LDB(B0, 0, 0); PG8_SCHED; PG8_LDA(At, 0, 0); PG8_STAGE(PG8_SA(1, 1), a1 + hstepA, voffA);
            PG8_WAIT_L(8); PG8_BAR; PG8_WAIT_L(0); PG8_MMA(0, 0, At, B0); PG8_BAR; PG8_SCHED;
            PG8_LDB(B1, 0, 1); PG8_STAGE(PG8_SB(0, 0), b2, voffB);
            PG8_BAR; PG8_WAIT_L(0); PG8_MMA(0, 1, At, B1); PG8_BAR;
            PG8_LDA(At, 0, 1); PG8_STAGE(PG8_SA(0, 0), a2, voffA);
            PG8_BAR; PG8_WAIT_L(0); PG8_MMA(1, 0, At, B0); PG8_BAR; PG8_SCHED;
            PG8_STAGE(PG8_SB(0, 1), b2 + hstepB, voffB);
            PG8_WAIT_V(6); PG8_BAR; PG8_MMA(1, 1, At, B1); PG8_BAR;
            PG8_LDB(B0, 1, 0); PG8_SCHED; PG8_LDA(At, 1, 0); PG8_STAGE(PG8_SA(0, 1), a2 + hstepA, voffA);
            PG8_WAIT_L(8); PG8_BAR; PG8_WAIT_L(0); PG8_MMA(0, 0, At, B0); PG8_BAR; PG8_SCHED;
            PG8_LDB(B1, 1, 1); PG8_STAGE(PG8_SB(1, 0), b3, voffB);
            PG8_BAR; PG8_WAIT_L(0); PG8_MMA(0, 1, At, B1); PG8_BAR;
            PG8_LDA(At, 1, 1); PG8_STAGE(PG8_SA(1, 0), a3, voffA);
            PG8_BAR; PG8_WAIT_L(0); PG8_MMA(1, 0, At, B0); PG8_BAR; PG8_SCHED;
            PG8_STAGE(PG8_SB(1, 1), b3 + hstepB, voffB);
            PG8_WAIT_V(6); PG8_BAR; PG8_MMA(1, 1, At, B1); PG8_BAR;
            }
        }
        if constexpr (ALIGN_EPI) { if (wr == 0) PG8_BAR; }
        if constexpr (!Epi::AFTER_DRAIN) { if constexpr (Epi::PROBE_BIT == 29) E(acc, cur, wr, wc, fr, fq, ui); else E(acc, cur, wr, wc, fr, fq); if (DUPL(Epi::PROBE_BIT)) E(acc, cur, wr, wc, fr, fq); S.done(cur); }
        if (!has_next) break;
#pragma unroll
        for (int a = 0; a < 2; ++a)
#pragma unroll
            for (int b = 0; b < 2; ++b)
#pragma unroll
                for (int m = 0; m < 4; ++m)
#pragma unroll
                    for (int n = 0; n < 2; ++n) acc[a][b][m][n] = (f32x4){0.f, 0.f, 0.f, 0.f};
        cur = nxt; cA = nA; cB = nB; ++ui;
        if constexpr (ALIGN_EPI) { if (wr == 1) PG8_BAR; }
    }
    PG8_WAIT_V(0);
    if constexpr (!ALIGN_EPI) { if (wr == 0) PG8_BAR; }
    PG8_BAR;
    if constexpr (Epi::AFTER_DRAIN) { E.fused(acc, cur, wr, wc, fr, fq, lds, wid, lane); if (DUPL(Epi::PROBE_BIT)) { asm volatile("s_waitcnt lgkmcnt(0)" ::: "memory"); __builtin_amdgcn_s_barrier(); E.fused(acc, cur, wr, wc, fr, fq, lds, wid, lane); } S.done(cur); }
#undef PG8_SA
#undef PG8_SB
#undef PG8_STAGE
#undef PG8_LDA
#undef PG8_LDB
#undef PG8_MMA
#undef PG8_WAIT_V
#undef PG8_WAIT_L
#undef PG8_BAR
#undef PG8_SCHED
}
}

#define GAS __attribute__((address_space(1)))
#define LAS __attribute__((address_space(3)))
#define XB_TMO      128
#define XB_XCNT(j)  (256  + 64 * (j))
#define XB_XSUB(j)  (1280 + 64 * (j))
#define XB_XGEN(j)  (2304 + 64 * (j))
#define XB_TOP      3328
#define XB_TOPGEN   3392
#define XCD_BAR_WORDS 3456
#define XB_SPIN_CAP (1u << 18)
__device__ __forceinline__ unsigned xb_ld(unsigned* p)              { return __hip_atomic_load(p, __ATOMIC_RELAXED, __HIP_MEMORY_SCOPE_AGENT); }
__device__ __forceinline__ unsigned xb_add(unsigned* p, unsigned v) { return __hip_atomic_fetch_add(p, v, __ATOMIC_RELAXED, __HIP_MEMORY_SCOPE_AGENT); }
__device__ __forceinline__ unsigned xb_xcc_id() { return (unsigned)__builtin_amdgcn_s_getreg((3 << 11) | 20) & 0xFu; }
#define XB_SPIN(cond, bar) do { unsigned _sp = 0; while (cond) { __builtin_amdgcn_s_sleep(1); \
    if ((++_sp & 255u) == 0u) { if (xb_ld(&(bar)[XB_TMO])) break; if (_sp > XB_SPIN_CAP) { atomicAdd(&(bar)[XB_TMO], 1u); break; } } } } while (0)
struct XcdBarrier { unsigned* bar; unsigned x; volatile LAS unsigned* st; };
__device__ __forceinline__ XcdBarrier xcd_barrier_post(unsigned* bar, volatile LAS unsigned* st) {
    XcdBarrier b; b.bar = bar; b.x = xb_xcc_id(); b.st = st;
    if (threadIdx.x == 0) (void)xb_add(&bar[XB_XCNT(b.x)], 1u);
    return b;
}
__device__ __forceinline__ void xcd_barrier_complete(unsigned* bar, unsigned x, unsigned& nloc, unsigned& nx) {
    const unsigned G = gridDim.x * gridDim.y * gridDim.z;
    unsigned sum, cnt, mine, sp = 0u;
    for (;;) {
        sum = 0u; cnt = 0u; mine = 0u;
#pragma unroll
        for (unsigned j = 0; j < 16; ++j) { const unsigned c = xb_ld(&bar[XB_XCNT(j)]); sum += c; cnt += (c > 0u) ? 1u : 0u; mine = (j == x) ? c : mine; }
        if (sum == G) break;
        __builtin_amdgcn_s_sleep(1);
        if ((++sp & 255u) == 0u) { if (xb_ld(&bar[XB_TMO])) break; if (sp > XB_SPIN_CAP) { atomicAdd(&bar[XB_TMO], 1u); break; } }
    }
    nloc = mine > 0u ? mine : 1u; nx = cnt > 0u ? cnt : 1u;
}
__device__ __forceinline__ void xcd_barrier(const XcdBarrier& b) {
    asm volatile("s_waitcnt vmcnt(0)" ::: "memory");
    __syncthreads();
    if (threadIdx.x == 0) {
        unsigned* bar = b.bar;
        __builtin_amdgcn_s_waitcnt(0);
        unsigned nloc = b.st[0], nx = b.st[1];
        if (nloc == 0u) { xcd_barrier_complete(bar, b.x, nloc, nx); b.st[0] = nloc; b.st[1] = nx; }
        const unsigned old = xb_add(&bar[XB_XSUB(b.x)], 1u);
        const unsigned gen = old / nloc;
        if (old + 1u == (gen + 1u) * nloc) {
            __builtin_amdgcn_fence(__ATOMIC_RELEASE, "agent");
            asm volatile("s_waitcnt vmcnt(0)" ::: "memory");
            const unsigned og = xb_add(&bar[XB_TOP], 1u);
            const unsigned tg = og / nx;
            if (og + 1u == (tg + 1u) * nx) xb_add(&bar[XB_TOPGEN], 1u);
            else XB_SPIN(xb_ld(&bar[XB_TOPGEN]) == tg, bar);
            __builtin_amdgcn_fence(__ATOMIC_ACQUIRE, "agent");
            xb_add(&bar[XB_XGEN(b.x)], 1u);
            asm volatile("s_waitcnt vmcnt(0)" ::: "memory");
        } else {
            XB_SPIN(xb_ld(&bar[XB_XGEN(b.x)]) == gen, bar);
            __builtin_amdgcn_fence(__ATOMIC_ACQUIRE, "agent");
            asm volatile("s_waitcnt vmcnt(0)" ::: "memory");
        }
    }
    __syncthreads();
}

constexpr int LDS_BYTES = 147456;
constexpr int MISC_OFF = 131072 + 320;
constexpr int CW_BAR = 4096;
#ifndef MK_SINGLE
#define MK_SINGLE 1
#endif
constexpr int NPHASE = 11;
struct Args { Ctx C; int ph_lo, ph_hi; };
__global__ void __launch_bounds__(NT, 2) fwd_mega(Args args) {
    extern __shared__ __attribute__((aligned(16))) unsigned char lds_raw[];
    float* lds = (float*)lds_raw;
    PG8_LAS unsigned char* L3 = (PG8_LAS unsigned char*)lds_raw;
    const Ctx& C = args.C;
    unsigned char* ws = C.ws;
    volatile LAS unsigned* MISC = (volatile LAS unsigned*)((LAS unsigned char*)lds_raw + MISC_OFF);
    if (threadIdx.x < 32) MISC[threadIdx.x] = 0u;
    __syncthreads();
    XcdBarrier bar; bar.bar = (unsigned*)(ws + WS_CTL) + CW_BAR; bar.x = 0; bar.st = nullptr;
    if (MK_SINGLE) bar = xcd_barrier_post((unsigned*)(ws + WS_CTL) + CW_BAR, MISC + 8);
    const int lo = args.ph_lo, hi = args.ph_hi;
#define IN(k) (lo <= (k) && (k) < hi)
#define SEAM(k) do { if (IN(k) && IN((k) + 1)) { xcd_barrier(bar); if (DUPL(31)) xcd_barrier(bar); } } while (0)
#define PH(k, BODY) do { if (IN(k)) { BODY; if (DUPL(k)) { BODY; } } } while (0)
#define GEMM_PH(EPI, EINIT, AP, BP, NN, KK, LDA, AL) GEMM_PH2(EPI, EINIT, AP, BP, NN, KK, LDA, AL, false)
#define GEMM_PH2(EPI, EINIT, AP, BP, NN, KK, LDA, AL, TA) do { pg8::Gemm g{(const bf16*)(AP), (const bf16*)(BP), M, NN, KK, LDA, TA, true}; pg8::StaticOrder S; S.init(M, NN, (int)gridDim.x, (int)blockIdx.x); \
        pg8::EPI E EINIT; pg8::gemm_phase<pg8::EPI, pg8::StaticOrder, AL, true>(L3, g, S, E); } while (0)
    const float* COS = (const float*)(ws + WS_COS); const float* SIN = (const float*)(ws + WS_SIN);
    PH(0, p0_prologue(C, lds));
    SEAM(0);
    PH(1, GEMM_PH(EpiZ, ({(bf16*)(ws + WS_Z), NZ, (float*)(ws + WS_SSQQ), (float*)(ws + WS_SSQKV), (float*)(ws + WS_SSQPE)}), ws + WS_A, ws + WS_WIN, NZ, DM, DM, true));
    SEAM(1);
    const bool p1_first = ((blockIdx.x >> 3) & 1) != 0;
    if (p1_first) { PH(4, gla::pass1(C, lds_raw)); }
    PH(2, GEMM_PH2(EpiQ, ({(const float*)(ws + WS_SSQQ), C.q_head_norm, COS, SIN, (bf16*)(ws + WS_QF), EPS, QSCALE}), (const bf16*)(ws + WS_Z) + (ZC_CQ >> 5) * 512, ws + WS_WUQ, 1024, QRANK, NZ, false, true));
    __syncthreads();
    PH(3, GEMM_PH2(EpiKV, ({(const float*)(ws + WS_SSQKV), (const float*)(ws + WS_SSQPE), C.k_head_norm, COS, SIN, (const bf16*)(ws + WS_Z), (bf16*)(ws + WS_KF), (bf16*)(ws + WS_VF), EPS}), (const bf16*)(ws + WS_Z) + (ZC_CKV >> 5) * 512, ws + WS_WUKV, 1024, KVRANK, NZ, false, true));
    __syncthreads();
    if (!p1_first) { PH(4, gla::pass1(C, lds_raw)); }
    SEAM(4);
    PH(5, (gla_scan(C), p0_late_weights(C, lds)));
    SEAM(5);
    PH(6, att::attn_phase(C, (char*)lds_raw));
    PH(7, gla::pass2(C, lds_raw));
    SEAM(7);
    PH(8, GEMM_PH2(EpiOutProjG, ({C.x, C.out, (bf16*)(ws + WS_A), (float*)(ws + WS_SSQ)}), ws + WS_B, ws + WS_WO, DM, DM, DM, true, true));
    SEAM(8);
    if (IN(9)) {
        PG8_LAS float* rtab = (PG8_LAS float*)(L3 + 131072 + 1024);
        pg8::StaticOrder So; So.init(M, DFF, (int)gridDim.x, (int)blockIdx.x);
        for (int idx = threadIdx.x; idx < 4 * 256; idx += NT) { pg8::Unit uu; const int i = idx >> 8, row = idx & 255;
            if (So.next(i, uu)) { const f32x4* sp = (const f32x4*)(ws + WS_SSQ) + (size_t)(uu.pm * 256 + row) * 4; const f32x4 s4 = (sp[0] + sp[1]) + (sp[2] + sp[3]);
                rtab[idx] = __builtin_amdgcn_rsqf(((s4[0] + s4[1]) + (s4[2] + s4[3])) * (1.0f / DM) + EPS); } }
        __syncthreads();
    }
    PH(9, GEMM_PH2(EpiUpG, ({(const PG8_LAS float*)(L3 + 131072 + 1024), (bf16*)(ws + WS_H)}), ws + WS_A, ws + WS_WUP, DFF, DM, DM, true, true));
    SEAM(9);
    PH(10, GEMM_PH2(EpiDownG, ({(const bf16*)(ws + WS_A), C.out}), ws + WS_H, ws + WS_WDN, DM, DFF, DFF, true, true));

#undef IN
#undef SEAM
}

extern "C" void kernel_launch(void* const* d_in, const int* in_sizes, int n_in, void* d_out, int out_size, void* d_ws, size_t ws_size, hipStream_t stream) {
    static int grid = 0;
    if (grid == 0) {
        if (n_in != 17 || in_sizes[0] != M * DM || out_size != M * DM || ws_size < WS_END) { fprintf(stderr, "kernel_launch: unexpected shapes (n_in %d in0 %d out %d ws %zu)\n", n_in, n_in > 0 ? in_sizes[0] : -1, out_size, ws_size); grid = -1; return; }
        int dev = 0, cus = 0, per_cu = 0;
        if (hipGetDevice(&dev) != hipSuccess || hipDeviceGetAttribute(&cus, hipDeviceAttributeMultiprocessorCount, dev) != hipSuccess) { fprintf(stderr, "kernel_launch: device query failed\n"); grid = -1; return; }
        if (hipFuncSetAttribute((const void*)fwd_mega, hipFuncAttributeMaxDynamicSharedMemorySize, LDS_BYTES) != hipSuccess) { fprintf(stderr, "kernel_launch: hipFuncSetAttribute failed\n"); grid = -1; return; }
        if (hipOccupancyMaxActiveBlocksPerMultiprocessor(&per_cu, (const void*)fwd_mega, NT, LDS_BYTES) != hipSuccess || per_cu < 1) fprintf(stderr, "kernel_launch: note: occupancy query reports %d workgroups per CU\n", per_cu);
        (void)hipGetLastError();
        grid = cus;
    }
    if (grid < 0) return;
    Args a{};
    Ctx& C = a.C;
    C.x = (const float*)d_in[0]; C.pos = (const int*)d_in[1]; C.attn_norm = (const float*)d_in[2]; C.w_in = (const float*)d_in[3]; C.w_gate_up = (const float*)d_in[4];
    C.b_gate = (const float*)d_in[5]; C.gla_out_norm = (const float*)d_in[6]; C.q_a_norm = (const float*)d_in[7]; C.w_uq = (const float*)d_in[8]; C.kv_a_norm = (const float*)d_in[9];
    C.w_ukv = (const float*)d_in[10]; C.q_head_norm = (const float*)d_in[11]; C.k_head_norm = (const float*)d_in[12]; C.w_out = (const float*)d_in[13]; C.mlp_norm = (const float*)d_in[14];
    C.w_up = (const float*)d_in[15]; C.w_down = (const float*)d_in[16]; C.out = (float*)d_out; C.ws = (unsigned char*)d_ws;
    if (MK_SINGLE) {
        if (hipMemsetAsync((char*)d_ws + WS_CTL, 0, CTL_ZERO_BYTES, stream) != hipSuccess) { fprintf(stderr, "kernel_launch: memset failed\n"); return; }
        a.ph_lo = 0; a.ph_hi = NPHASE;
        hipLaunchKernelGGL(fwd_mega, dim3(grid), dim3(NT), LDS_BYTES, stream, a);
        if (DUPL(23)) { (void)hipMemsetAsync((char*)d_ws + WS_CTL, 0, CTL_ZERO_BYTES, stream); hipLaunchKernelGGL(fwd_mega, dim3(grid), dim3(NT), LDS_BYTES, stream, a); }
    } else {
        for (int s = 0; s < NPHASE; ++s) { a.ph_lo = s; a.ph_hi = s + 1; hipLaunchKernelGGL(fwd_mega, dim3(grid), dim3(NT), LDS_BYTES, stream, a); }
    }
}
```

```cpp
#include <hip/hip_runtime.h>
#include <cstdio>
#include <cstdint>
#ifndef DUP_MASK
#define DUP_MASK 0u
#endif
#define DUPL(k) (((DUP_MASK) >> (k)) & 1u)

constexpr int BATCH = 2, SEQ = 8192, DM = 1024, M = BATCH * SEQ;
constexpr int DPROJ = 1968, NZ = 2048, DFF = 4096;
constexpr int GH = 4, GDK = 64, GDV = 128, GRANK = 16, NCH = SEQ / 64;
constexpr int MH = 8, QRANK = 256, KVRANK = 128, NOPE = 64, ROPE = 32, MV = 64, DQK = 96;
constexpr float EPS = 1e-6f;
constexpr float QSCALE = 0.10206207261596577f * 1.4426950408889634f;
constexpr int ZC_Q = 0, ZC_K = 256, ZC_V = 512, ZC_G = 1024, ZC_CQ = 1536, ZC_CKV = 1792, ZC_KPE = 1920, ZC_GATE = 1952;
__host__ __device__ __forceinline__ size_t ztile(size_t r, int c) { return ((r >> 4) * 64 + (size_t)(c >> 5)) * 512 + (r & 15) * 32 + (c & 31); }

constexpr size_t MiB = 1u << 20;
constexpr size_t WS_CTL = 0;
constexpr size_t WS_WIN = 1 * MiB, WS_WUQ = 5 * MiB, WS_WUKV = 6 * MiB, WS_WO = 7 * MiB, WS_WUP = 9 * MiB, WS_WDN = 17 * MiB;
constexpr size_t WS_SSQ = 25 * MiB, WS_DEC = 512 * 1024, WS_COS = 26 * MiB, WS_SIN = 27 * MiB;
constexpr size_t CTL_ZERO_BYTES = 64 * 1024;
constexpr size_t WS_SSQQ = 5 * MiB + 512 * 1024, WS_SSQKV = 5 * MiB + 768 * 1024, WS_SSQPE = 6 * MiB + 512 * 1024;
constexpr size_t WS_A = 28 * MiB;
constexpr size_t WS_B = 60 * MiB;
constexpr size_t WS_Z = 92 * MiB;
constexpr size_t WS_QF = 156 * MiB, WS_AQ = 156 * MiB, WS_AKV = 164 * MiB, WS_KF = 180 * MiB, WS_VF = 204 * MiB;
constexpr size_t WS_CKV = 220 * MiB;
constexpr size_t WS_H = 92 * MiB;
constexpr size_t WS_END = 252 * MiB;

typedef unsigned short bf16;
typedef float f32x4 __attribute__((ext_vector_type(4)));
typedef unsigned u32x2 __attribute__((ext_vector_type(2)));
typedef unsigned u32x4 __attribute__((ext_vector_type(4)));

__device__ __forceinline__ float bf2f(unsigned b) { return __uint_as_float(b << 16); }
__device__ __forceinline__ unsigned f2bf(float f) { unsigned u = __float_as_uint(f); return (u + 0x7fffu + ((u >> 16) & 1u)) >> 16; }
typedef float f32x2c_t __attribute__((ext_vector_type(2))); typedef __bf16 bf16x2c_t __attribute__((ext_vector_type(2)));
__device__ __forceinline__ unsigned pk2(float lo, float hi) { f32x2c_t v = {lo, hi}; bf16x2c_t b = __builtin_convertvector(v, bf16x2c_t); return __builtin_bit_cast(unsigned, b); }
__device__ __forceinline__ float wave_sum(float v) {
#pragma unroll
    for (int o = 1; o < 64; o <<= 1) v += __shfl_xor(v, o);
    return v;
}

__device__ __forceinline__ unsigned otid() { unsigned t = threadIdx.x; asm volatile("" : "+v"(t)); return t; }

struct Ctx {
    const float* x; const int* pos; const float* attn_norm; const float* w_in; const float* w_gate_up; const float* b_gate; const float* gla_out_norm;
    const float* q_a_norm; const float* w_uq; const float* kv_a_norm; const float* w_ukv; const float* q_head_norm; const float* k_head_norm;
    const float* w_out; const float* mlp_norm; const float* w_up; const float* w_down;
    float* out; unsigned char* ws;
};
constexpr int NT = 512;

__device__ __forceinline__ int win_src_col(int n) {
    if (n < 1024) return n;
    if (n < 1536) return n - 1024 + 1040;
    if (n < 1792) return n - 1536 + 1552;
    if (n < 1920) return n - 1792 + 1808;
    if (n < 1952) return n - 1920 + 1936;
    if (n < 1968) return n - 1952 + 1024;
    return -1;
}
struct MapWin { __device__ __forceinline__ int operator()(int n) const { return win_src_col(n); } };
struct MapUq  { __device__ __forceinline__ int operator()(int n) const { const int h = n >> 7, j = n & 127; return j < DQK ? h * DQK + j : -1; } };
struct MapId  { __device__ __forceinline__ int operator()(int n) const { return n; } };
template <bool GAIN, class CMap>
__device__ __forceinline__ void p0_transpose_item(const float* W, int K, int Nsrc, int N, bf16* WT, const float* kgain, float* scr, int item, int lane, const CMap& cmap) {
    const int nblk = N / 32, kb = item / nblk, nb = item % nblk, k0 = 64 * kb, n0 = 32 * nb;
    const int sc = cmap(n0 + (lane & 31)); const float keep = sc >= 0 ? 1.f : 0.f; const int scc = sc >= 0 ? sc : 0;
    const float* wp = W + (size_t)(k0 + (lane >> 5)) * Nsrc + scc;
    float v[32];
#pragma unroll
    for (int i = 0; i < 32; ++i) v[i] = wp[(size_t)(2 * i) * Nsrc];
#pragma unroll
    for (int i = 0; i < 32; ++i) { const int kk = 2 * i + (lane >> 5); float t = v[i] * keep; if (GAIN) t *= kgain[k0 + kk]; scr[kk * 33 + (lane & 31)] = t; }
    asm volatile("s_waitcnt lgkmcnt(0)" ::: "memory");
    const int c = lane & 7;
#pragma unroll
    for (int j = 0; j < 4; ++j) { const int n = (lane >> 3) + 8 * j; const float* s = scr + (8 * c) * 33 + n;
        u32x4 o; o.x = pk2(s[0 * 33], s[1 * 33]); o.y = pk2(s[2 * 33], s[3 * 33]); o.z = pk2(s[4 * 33], s[5 * 33]); o.w = pk2(s[6 * 33], s[7 * 33]);
        *(u32x4*)(WT + ((size_t)((n0 + n) >> 4) * (K >> 5) + ((k0 + 8 * c) >> 5)) * 512 + ((n0 + n) & 15) * 32 + ((k0 + 8 * c) & 31)) = o; }
    asm volatile("s_waitcnt lgkmcnt(0)" ::: "memory");
}
__device__ __forceinline__ void p0_prologue(const Ctx& C, float* lds) {
    const size_t gt = (size_t)blockIdx.x * NT + otid(), GT = (size_t)gridDim.x * NT;
    bf16* win = (bf16*)(C.ws + WS_WIN); bf16* wuq = (bf16*)(C.ws + WS_WUQ); bf16* wukv = (bf16*)(C.ws + WS_WUKV);
    bf16* wo = (bf16*)(C.ws + WS_WO); bf16* wup = (bf16*)(C.ws + WS_WUP); bf16* wdn = (bf16*)(C.ws + WS_WDN);
    {   const int lane_ = otid() & 63, wv = otid() >> 6; float* scr = lds + wv * (64 * 33 + 32);
        const int gw_ = (int)(gt >> 6), NGW_ = (int)(GT >> 6);
        constexpr int I_IN = (DM / 64) * (NZ / 32), I_UQ = (QRANK / 64) * (1024 / 32), I_UKV = (KVRANK / 64) * (1024 / 32), I_O = (DM / 64) * (DM / 32), I_UP = (DM / 64) * (DFF / 32), I_DN = (DFF / 64) * (DM / 32);
        constexpr int NITEMS = I_IN + I_UQ + I_UKV;
        (void)wo; (void)wup; (void)wdn; (void)I_O; (void)I_UP; (void)I_DN;
        for (int it = gw_; it < NITEMS; it += NGW_) {
            int r = it;
            if (r < I_IN) { p0_transpose_item<false>(C.w_in, DM, DPROJ, NZ, win, nullptr, scr, r, lane_, MapWin{}); continue; } r -= I_IN;
            if (r < I_UQ) { p0_transpose_item<true>(C.w_uq, QRANK, MH * DQK, 1024, wuq, C.q_a_norm, scr, r, lane_, MapUq{}); continue; } r -= I_UQ;
            p0_transpose_item<true>(C.w_ukv, KVRANK, 1024, 1024, wukv, C.kv_a_norm, scr, r, lane_, MapId{});
        }
    }
    const int lane = otid() & 63; const int gw = (int)(gt >> 6), NGW = (int)(GT >> 6);
    bf16* XN = (bf16*)(C.ws + WS_A); float* COS = (float*)(C.ws + WS_COS); float* SIN = (float*)(C.ws + WS_SIN);
    f32x4 gn[4];
#pragma unroll
    for (int j = 0; j < 4; ++j) gn[j] = ((const f32x4*)C.attn_norm)[lane + 64 * j];
    for (int m = gw; m < M; m += 2 * NGW) {
        const int m2 = m + NGW;
        const f32x4* xa = (const f32x4*)(C.x + (size_t)m * DM) + lane; const f32x4* xb = (const f32x4*)(C.x + (size_t)(m2 < M ? m2 : m) * DM) + lane;
        f32x4 va[4], vb[4]; float sa = 0.f, sb = 0.f;
#pragma unroll
        for (int j = 0; j < 4; ++j) { va[j] = xa[64 * j]; vb[j] = xb[64 * j]; }
#pragma unroll
        for (int j = 0; j < 4; ++j) { sa += (va[j].x * va[j].x + va[j].y * va[j].y) + (va[j].z * va[j].z + va[j].w * va[j].w); sb += (vb[j].x * vb[j].x + vb[j].y * vb[j].y) + (vb[j].z * vb[j].z + vb[j].w * vb[j].w); }
        const float ra = rsqrtf(wave_sum(sa) * (1.f / DM) + EPS), rb = rsqrtf(wave_sum(sb) * (1.f / DM) + EPS);
        u32x2* oa = (u32x2*)(XN + (size_t)m * DM) + lane; u32x2* ob = (u32x2*)(XN + (size_t)m2 * DM) + lane;
#pragma unroll
        for (int j = 0; j < 4; ++j) { u32x2 w; w.x = pk2(va[j].x * ra * gn[j].x, va[j].y * ra * gn[j].y); w.y = pk2(va[j].z * ra * gn[j].z, va[j].w * ra * gn[j].w); oa[64 * j] = w; }
        if (m2 < M) {
#pragma unroll
            for (int j = 0; j < 4; ++j) { u32x2 w; w.x = pk2(vb[j].x * rb * gn[j].x, vb[j].y * rb * gn[j].y); w.y = pk2(vb[j].z * rb * gn[j].z, vb[j].w * rb * gn[j].w); ob[64 * j] = w; } }
    }
    for (size_t i = gt; i < (size_t)M * 16; i += GT) { const int m = (int)(i >> 4), f = (int)(i & 15);
        const float invf = exp2f(-(float)(2 * f) * (1.f / 32.f) * 13.287712379549449f);
        const float ang = (float)C.pos[m] * invf; float sn, cs; sincosf(ang, &sn, &cs); COS[i] = cs; SIN[i] = sn; }
}

__device__ __forceinline__ void p0_late_weights(const Ctx& C, float* lds) {
    const unsigned t = otid(); if (t < 256) return;
    bf16* wo = (bf16*)(C.ws + WS_WO); bf16* wup = (bf16*)(C.ws + WS_WUP); bf16* wdn = (bf16*)(C.ws + WS_WDN);
    const int lane_ = t & 63, wv = (t >> 6) - 4; float* scr = lds + wv * (64 * 33 + 32);
    const int gw_ = (int)blockIdx.x * 4 + wv, NGW_ = (int)gridDim.x * 4;
    constexpr int I_O = (DM / 64) * (DM / 32), I_UP = (DM / 64) * (DFF / 32), I_DN = (DFF / 64) * (DM / 32);
    for (int it = gw_; it < I_O + I_UP + I_DN; it += NGW_) {
        int r = it;
        if (r < I_UP) { p0_transpose_item<true>(C.w_up, DM, DFF, DFF, wup, C.mlp_norm, scr, r, lane_, MapId{}); continue; } r -= I_UP;
        if (r < I_DN) { p0_transpose_item<false>(C.w_down, DFF, DM, DM, wdn, nullptr, scr, r, lane_, MapId{}); continue; } r -= I_DN;
        p0_transpose_item<false>(C.w_out, DM, DM, DM, wo, nullptr, scr, r, lane_, MapId{});
    }
}

__device__ __forceinline__ void unpack8(const u32x4 w, float (&v)[8]) { v[0] = bf2f(w.x & 0xffffu); v[1] = bf2f(w.x >> 16); v[2] = bf2f(w.y & 0xffffu); v[3] = bf2f(w.y >> 16);
    v[4] = bf2f(w.z & 0xffffu); v[5] = bf2f(w.z >> 16); v[6] = bf2f(w.w & 0xffffu); v[7] = bf2f(w.w >> 16); }
__device__ __forceinline__ u32x4 pack8(const float (&v)[8]) { u32x4 w; w.x = pk2(v[0], v[1]); w.y = pk2(v[2], v[3]); w.z = pk2(v[4], v[5]); w.w = pk2(v[6], v[7]); return w; }
constexpr float LOG2E = 1.4426950408889634f, LN2 = 0.6931471805599453f;
__device__ __forceinline__ float fexp(float x) { return __builtin_amdgcn_exp2f(x * LOG2E); }
__device__ __forceinline__ float log_gate(float gl) { const float ls = fminf(gl, 0.f) - LN2 * __builtin_amdgcn_logf(1.f + fexp(-fabsf(gl))); return fmaxf(ls * (1.f / 16.f), -1.f); }
__device__ __forceinline__ float silu_f(float g) { return g * __builtin_amdgcn_rcpf(1.f + fexp(-g)); }
__device__ __forceinline__ void gla_scan(const Ctx& C) {
    const float* CKV = (const float*)(C.ws + WS_CKV); const float* DEC = (const float*)(C.ws + WS_DEC); bf16* PREV = (bf16*)(C.ws + WS_A);
    if (otid() >= 256) return;
    for (int e = blockIdx.x * 256 + otid(); e < BATCH * GH * 128 * 64; e += gridDim.x * 256) {
        const int d = e & 63, v = (e >> 6) & 127, bh = e >> 13; float st = 0.f;
        for (int n0 = 0; n0 < NCH; n0 += 16) {
            float cv[16], dv[16];
#pragma unroll
            for (int i = 0; i < 16; ++i) { const size_t u = (size_t)bh * NCH + n0 + i; cv[i] = CKV[(u * 128 + v) * 64 + d]; dv[i] = DEC[u * 64 + d]; }
#pragma unroll
            for (int i = 0; i < 16; ++i) { const size_t u = (size_t)bh * NCH + n0 + i; PREV[(u * 128 + v) * 64 + d] = (bf16)f2bf(st); st = dv[i] * st + cv[i]; }
        }
    }
}

namespace att {
typedef short bf16x8 __attribute__((ext_vector_type(8)));
typedef short s16x4 __attribute__((ext_vector_type(4)));
typedef float f32x16 __attribute__((ext_vector_type(16)));
typedef __attribute__((address_space(3))) const char* lds_cptr;
constexpr int KSLOT = 12288, VSLOT = 8192, LDS_K = 0, LDS_V = 3 * KSLOT, LDS_WS = LDS_V + 3 * VSLOT, LDS_OST = LDS_WS + 8 * 256, LDS_TOTAL = LDS_OST + 8 * 4096;
constexpr int QP = MH * DQK, VP = MH * MV;
#define ATT_SBAR() __builtin_amdgcn_sched_barrier(0)
__device__ __forceinline__ int crow(int r, int hi) { return (r & 3) + 8 * (r >> 2) + 4 * hi; }
__device__ __forceinline__ void glds16(const void* gsrc, unsigned lds_dst) { unsigned keep;
    asm volatile("s_mov_b32 %0, m0\n\ts_mov_b32 m0, %2\n\ts_nop 0\n\tglobal_load_lds_dwordx4 %1, off\n\ts_mov_b32 m0, %0" : "=&s"(keep) : "v"(gsrc), "s"(lds_dst) : "memory"); }
typedef float f32x2_t __attribute__((ext_vector_type(2))); typedef __bf16 bf16x2_t __attribute__((ext_vector_type(2)));
__device__ __forceinline__ unsigned cvtpk_s(float lo, float hi) { f32x2_t v = {lo, hi}; bf16x2_t b = __builtin_convertvector(v, bf16x2_t); return __builtin_bit_cast(unsigned, b); }
typedef short att_v4i16 __attribute__((ext_vector_type(4)));
__device__ __forceinline__ s16x4 vtr(lds_cptr p) { return __builtin_bit_cast(s16x4, __builtin_amdgcn_ds_read_tr16_b64_v4i16((__attribute__((address_space(3))) att_v4i16*)p)); }
#define ATT_MX3(a, b, c) __builtin_fmaxf(__builtin_fmaxf((a), (b)), (c))
__device__ __forceinline__ float rowmax(const f32x16& p0, const f32x16& p1) {
    float a = ATT_MX3(p0[0], p0[1], p1[0]), b = ATT_MX3(p0[2], p0[3], p1[1]); a = ATT_MX3(a, p1[2], p1[3]);
#pragma unroll
    for (int r = 4; r < 16; r += 4) { a = ATT_MX3(a, p0[r], p0[r + 1]); b = ATT_MX3(b, p0[r + 2], p0[r + 3]); a = ATT_MX3(a, p1[r], p1[r + 1]); b = ATT_MX3(b, p1[r + 2], p1[r + 3]); }
    float m = __builtin_fmaxf(a, b); auto rr = __builtin_amdgcn_permlane32_swap(__float_as_uint(m), __float_as_uint(m), false, false);
    return __builtin_fmaxf(__uint_as_float(rr[0]), __uint_as_float(rr[1])); }
__device__ __forceinline__ void pv(f32x16* o, int vb, bf16x8 pa0, bf16x8 pa1, bf16x8 pa2, bf16x8 pa3) {
#pragma unroll
    for (int d0 = 0; d0 < 2; ++d0) { s16x4 lo[4], hi[4];
#pragma unroll
        for (int ks = 0; ks < 4; ++ks) {
            asm volatile("ds_read_b64_tr_b16 %0,%1 offset:%c2" : "=&v"(lo[ks]) : "v"(vb), "i"(d0 * 4096 + ks * 1024) : "memory");
            asm volatile("ds_read_b64_tr_b16 %0,%1 offset:%c2" : "=&v"(hi[ks]) : "v"(vb), "i"(d0 * 4096 + ks * 1024 + 512) : "memory"); }
        asm volatile("s_waitcnt lgkmcnt(0)" ::: "memory"); ATT_SBAR();
#define ATT_PK(k) (bf16x8){lo[k][0], lo[k][1], lo[k][2], lo[k][3], hi[k][0], hi[k][1], hi[k][2], hi[k][3]}
        o[d0] = __builtin_amdgcn_mfma_f32_32x32x16_bf16(pa0, ATT_PK(0), o[d0], 0, 0, 0);
        o[d0] = __builtin_amdgcn_mfma_f32_32x32x16_bf16(pa1, ATT_PK(1), o[d0], 0, 0, 0);
        o[d0] = __builtin_amdgcn_mfma_f32_32x32x16_bf16(pa2, ATT_PK(2), o[d0], 0, 0, 0);
        o[d0] = __builtin_amdgcn_mfma_f32_32x32x16_bf16(pa3, ATT_PK(3), o[d0], 0, 0, 0);
#undef ATT_PK
    }
}
#define ATT_WAIT_BAR0() asm volatile("s_waitcnt vmcnt(0) lgkmcnt(0)\n\ts_barrier" ::: "memory")
template <int THRL>
__device__ __forceinline__ void attn_unit(int b, int h, int qb, const bf16* Q, const bf16* K, const bf16* V, bf16* O, char* shm) {
    const int tid = threadIdx.x, lane = tid & 63, r32 = lane & 31, hi = lane >> 5; const int wid = __builtin_amdgcn_readfirstlane(tid >> 6);
    const long rowbase = (long)b * SEQ; const int q0 = qb * 256; const int NTL = 4 * qb + 4, tmax = 4 * qb + (wid >> 1);
    const bf16* Qw = Q + (rowbase + q0 + wid * 32) * QP + h * DQK;
    const long bh = (long)b * MH + h;
    const bf16* ksrc0 = K + (bh * 128 * 12 + wid) * 512 + lane * 8;
    const bf16* ksrc1 = K + (bh * 128 * 12 + 8 + (wid & 3)) * 512 + lane * 8;
    const bf16* vsrc = V + (bh * 128 * 2 + (wid >> 2)) * 2048 + (16 * (wid & 3) + (lane >> 2)) * 32 + (lane & 3) * 8;
    const unsigned lds0 = (unsigned)(uintptr_t)shm;
    const unsigned kdst0 = lds0 + LDS_K + wid * 1024, kdst1 = lds0 + LDS_K + (8 + (wid & 3)) * 1024, vdst = lds0 + LDS_V + wid * 1024;
    float* wsf = (float*)(shm + LDS_WS) + wid * 64;
#define ATT_DMA(t, s) do { glds16(ksrc0 + (long)(t) * 6144, (unsigned)__builtin_amdgcn_readfirstlane(kdst0 + (s) * KSLOT)); \
        if (wid < 4) glds16(ksrc1 + (long)(t) * 6144, (unsigned)__builtin_amdgcn_readfirstlane(kdst1 + (s) * KSLOT)); \
        glds16(vsrc + (long)(t) * 4096, (unsigned)__builtin_amdgcn_readfirstlane(vdst + (s) * VSLOT)); } while (0)
    ATT_DMA(0, 0);
    bf16x8 qr[6];
#pragma unroll
    for (int d0 = 0; d0 < 6; ++d0) qr[d0] = *reinterpret_cast<const bf16x8*>(&Qw[(long)r32 * QP + d0 * 16 + hi * 8]);
    float mhat = 0.f, l_reg = 0.f; f32x16 o[2]; o[0] = f32x16{}; o[1] = f32x16{}; f32x16 negm = f32x16{}; asm volatile("" : "+v"(negm));
    const lds_cptr shm3 = (lds_cptr)shm;
    const int vlane = ((lane >> 4) & 1) * 32 + (lane & 3) * 8 + (4 * hi + ((lane & 15) >> 2)) * 64;
    u32x4 pw0 = (u32x4){0u, 0u, 0u, 0u}, pw1 = pw0, pw2 = pw0, pw3 = pw0;
    s16x4 vlo[8], vhi[8];
#define ATT_KRD(slot, d0) do { ka[slot] = *(const __attribute__((address_space(3))) bf16x8*)(kp + (d0) * 2048); kb[slot] = *(const __attribute__((address_space(3))) bf16x8*)(kp + (d0) * 2048 + 512); } while (0)
#define ATT_VRD(i) do { vlo[i] = vtr(vp + (((i) >> 2) * 4096 + ((i) & 3) * 1024)); vhi[i] = vtr(vp + (((i) >> 2) * 4096 + ((i) & 3) * 1024 + 512)); } while (0)
#define ATT_QKSM(t, s) do { \
        const lds_cptr kp = shm3 + LDS_K + (s) * KSLOT + hi * 1024 + r32 * 16; const lds_cptr vp = shm3 + LDS_V + (s) * VSLOT + vlane; \
        f32x16 p0, p1; bf16x8 ka[3], kb[3]; \
        ATT_KRD(0, 0); ATT_KRD(1, 1); ATT_SBAR(); \
        ATT_KRD(2, 2); p0 = __builtin_amdgcn_mfma_f32_32x32x16_bf16(ka[0], qr[0], negm, 0, 0, 0); p1 = __builtin_amdgcn_mfma_f32_32x32x16_bf16(kb[0], qr[0], negm, 0, 0, 0); ATT_VRD(0); ATT_VRD(1); ATT_SBAR(); \
        ATT_KRD(0, 3); p0 = __builtin_amdgcn_mfma_f32_32x32x16_bf16(ka[1], qr[1], p0, 0, 0, 0); p1 = __builtin_amdgcn_mfma_f32_32x32x16_bf16(kb[1], qr[1], p1, 0, 0, 0); ATT_VRD(2); ATT_VRD(3); ATT_SBAR(); \
        ATT_KRD(1, 4); p0 = __builtin_amdgcn_mfma_f32_32x32x16_bf16(ka[2], qr[2], p0, 0, 0, 0); p1 = __builtin_amdgcn_mfma_f32_32x32x16_bf16(kb[2], qr[2], p1, 0, 0, 0); ATT_VRD(4); ATT_VRD(5); ATT_SBAR(); \
        ATT_KRD(2, 5); p0 = __builtin_amdgcn_mfma_f32_32x32x16_bf16(ka[0], qr[3], p0, 0, 0, 0); p1 = __builtin_amdgcn_mfma_f32_32x32x16_bf16(kb[0], qr[3], p1, 0, 0, 0); ATT_VRD(6); ATT_VRD(7); ATT_SBAR(); \
        p0 = __builtin_amdgcn_mfma_f32_32x32x16_bf16(ka[1], qr[4], p0, 0, 0, 0); p1 = __builtin_amdgcn_mfma_f32_32x32x16_bf16(kb[1], qr[4], p1, 0, 0, 0); ATT_SBAR(); \
        p0 = __builtin_amdgcn_mfma_f32_32x32x16_bf16(ka[2], qr[5], p0, 0, 0, 0); p1 = __builtin_amdgcn_mfma_f32_32x32x16_bf16(kb[2], qr[5], p1, 0, 0, 0); ATT_SBAR(); \
        const float rm = rowmax(p0, p1); \
        if ((t) == 0) { mhat = rm; \
            _Pragma("unroll") for (int r = 0; r < 16; ++r) { p0[r] -= rm; p1[r] -= rm; } \
            _Pragma("unroll") for (int r = 0; r < 16; ++r) negm[r] = -mhat; \
            asm volatile("" : "+v"(negm)); \
        } else if (__any(rm > (float)THRL)) { const float dl = __builtin_fmaxf(rm, 0.f); mhat += dl; \
            _Pragma("unroll") for (int r = 0; r < 16; ++r) { p0[r] -= dl; p1[r] -= dl; } \
            _Pragma("unroll") for (int r = 0; r < 16; ++r) negm[r] = -mhat; \
            asm volatile("" : "+v"(negm)); \
            const float f = __builtin_amdgcn_exp2f(-dl); l_reg *= f; if (hi == 0) wsf[r32] = f; \
            asm volatile("s_waitcnt lgkmcnt(0)" ::: "memory"); \
            _Pragma("unroll") for (int d_ = 0; d_ < 2; ++d_) _Pragma("unroll") for (int r = 0; r < 16; ++r) o[d_][r] *= wsf[crow(r, hi)]; } \
        float sacc = 0.f; \
        _Pragma("unroll") for (int r = 0; r < 16; ++r) { p0[r] = __builtin_amdgcn_exp2f(p0[r]); p1[r] = __builtin_amdgcn_exp2f(p1[r]); sacc += p0[r] + p1[r]; } \
        l_reg += sacc; \
        pw0 = (u32x4){cvtpk_s(p0[0], p0[1]), cvtpk_s(p0[2], p0[3]), cvtpk_s(p0[4], p0[5]), cvtpk_s(p0[6], p0[7])}; \
        pw1 = (u32x4){cvtpk_s(p0[8], p0[9]), cvtpk_s(p0[10], p0[11]), cvtpk_s(p0[12], p0[13]), cvtpk_s(p0[14], p0[15])}; \
        pw2 = (u32x4){cvtpk_s(p1[0], p1[1]), cvtpk_s(p1[2], p1[3]), cvtpk_s(p1[4], p1[5]), cvtpk_s(p1[6], p1[7])}; \
        pw3 = (u32x4){cvtpk_s(p1[8], p1[9]), cvtpk_s(p1[10], p1[11]), cvtpk_s(p1[12], p1[13]), cvtpk_s(p1[14], p1[15])}; \
    } while (0)
#define ATT_VFR(i) (bf16x8){vlo[i][0], vlo[i][1], vlo[i][2], vlo[i][3], vhi[i][0], vhi[i][1], vhi[i][2], vhi[i][3]}
#define ATT_PV(s) do { ATT_SBAR(); \
        o[0] = __builtin_amdgcn_mfma_f32_32x32x16_bf16(__builtin_bit_cast(bf16x8, pw0), ATT_VFR(0), o[0], 0, 0, 0); o[1] = __builtin_amdgcn_mfma_f32_32x32x16_bf16(__builtin_bit_cast(bf16x8, pw0), ATT_VFR(4), o[1], 0, 0, 0); \
        o[0] = __builtin_amdgcn_mfma_f32_32x32x16_bf16(__builtin_bit_cast(bf16x8, pw1), ATT_VFR(1), o[0], 0, 0, 0); o[1] = __builtin_amdgcn_mfma_f32_32x32x16_bf16(__builtin_bit_cast(bf16x8, pw1), ATT_VFR(5), o[1], 0, 0, 0); \
        o[0] = __builtin_amdgcn_mfma_f32_32x32x16_bf16(__builtin_bit_cast(bf16x8, pw2), ATT_VFR(2), o[0], 0, 0, 0); o[1] = __builtin_amdgcn_mfma_f32_32x32x16_bf16(__builtin_bit_cast(bf16x8, pw2), ATT_VFR(6), o[1], 0, 0, 0); \
        o[0] = __builtin_amdgcn_mfma_f32_32x32x16_bf16(__builtin_bit_cast(bf16x8, pw3), ATT_VFR(3), o[0], 0, 0, 0); o[1] = __builtin_amdgcn_mfma_f32_32x32x16_bf16(__builtin_bit_cast(bf16x8, pw3), ATT_VFR(7), o[1], 0, 0, 0); \
    } while (0)
    int s_cur = 0, s_prev = 2;
    if (wid < 4) __builtin_amdgcn_s_setprio(1);
    if (wid < 4) {
        for (int t = 0; t < NTL; ++t) {
            ATT_WAIT_BAR0();
            const int s_next = (s_cur == 2) ? 0 : s_cur + 1;
            if (t + 1 < NTL) ATT_DMA(t + 1, s_next);
            if (t <= tmax) { ATT_QKSM(t, s_cur); ATT_PV(s_cur); }
            s_prev = s_cur; s_cur = s_next;
        }
    } else {
        for (int t = 0; t < NTL; ++t) {
            ATT_WAIT_BAR0();
            const int s_next = (s_cur == 2) ? 0 : s_cur + 1;
            if (t + 1 < NTL) ATT_DMA(t + 1, s_next);
            if (t >= 1 && t - 1 <= tmax) ATT_PV(s_prev);
            if (t <= tmax) ATT_QKSM(t, s_cur);
            s_prev = s_cur; s_cur = s_next;
        }
        if (NTL - 1 <= tmax) ATT_PV(s_prev);
    }
    __builtin_amdgcn_s_setprio(0);
    { auto rr = __builtin_amdgcn_permlane32_swap(__float_as_uint(l_reg), __float_as_uint(l_reg), false, false); l_reg = __uint_as_float(rr[0]) + __uint_as_float(rr[1]); }
    if (hi == 0) wsf[32 + r32] = l_reg;
    asm volatile("s_waitcnt lgkmcnt(0)" ::: "memory");
    float rli[16];
#pragma unroll
    for (int r = 0; r < 16; ++r) rli[r] = __builtin_amdgcn_rcpf(wsf[32 + crow(r, hi)]);
    const long orow0 = rowbase + q0 + wid * 32; const int ocol0 = 512 + h * MV;
    { bf16* stg = (bf16*)(shm + LDS_OST) + wid * 2048;
#pragma unroll
        for (int r = 0; r < 16; ++r) { const int orow = crow(r, hi);
#pragma unroll
            for (int d0 = 0; d0 < 2; ++d0) stg[orow * 64 + d0 * 32 + r32] = (bf16)f2bf(o[d0][r] * rli[r]); }
        asm volatile("s_waitcnt lgkmcnt(0)" ::: "memory");
#pragma unroll
        for (int i = 0; i < 4; ++i) { const int row = i * 8 + (lane >> 3), ch = lane & 7; const u32x4 v = *(const u32x4*)(stg + row * 64 + ch * 8); const long r = orow0 + row; const int c = ocol0 + ch * 8;
            *(u32x4*)(O + ((r >> 4) * 32 + (c >> 5)) * 512 + (r & 15) * 32 + (c & 31)) = v; } }
    asm volatile("s_waitcnt lgkmcnt(0)\n\ts_barrier" ::: "memory");
#undef ATT_DMA
#undef ATT_QKSM
#undef ATT_KRD
#undef ATT_VRD
#undef ATT_VFR
#undef ATT_PV
}
__device__ __forceinline__ void attn_phase(const Ctx& C, char* lds) {
    const bf16* QF = (const bf16*)(C.ws + WS_QF); const bf16* KF = (const bf16*)(C.ws + WS_KF); const bf16* VF = (const bf16*)(C.ws + WS_VF); bf16* O = (bf16*)(C.ws + WS_B);
    const int G = (int)gridDim.x, bx = (int)blockIdx.x; const int vcu = (G % 8 == 0) ? (bx % 8) * (G / 8) + bx / 8 : bx;
    for (int i = vcu; i < BATCH * MH * 32; i += G) { const int bh = (i & 255) >> 4, s = i & 15, qb = (i < 256) ? 31 - s : s;
        attn_unit<8>(bh >> 3, bh & 7, qb, QF, KF, VF, O, lds); }
    __syncthreads();
}
}

namespace gla {
using att::bf16x8; using att::s16x4; using att::f32x16; using att::lds_cptr; using att::crow; using att::cvtpk_s;
constexpr int L_VIMG = 0, L_QIMG = 16384, L_KIMG = 24576, L_WT = 32768, L_OBUF = 36864, OLD = 132, L_WG = 73728, L_BG = L_WG + 16384;
#define GLA_BAR() asm volatile("s_waitcnt lgkmcnt(0)\n\ts_barrier" ::: "memory")
__device__ __forceinline__ void stage_gate(const Ctx& C, unsigned char* lds) {
    const int tid = threadIdx.x;
#pragma unroll
    for (int i = 0; i < 2; ++i) *(f32x4*)(lds + L_WG + (tid + NT * i) * 16) = *(const f32x4*)(C.w_gate_up + (tid + NT * i) * 4);
    if (tid < 64) *(f32x4*)(lds + L_BG + tid * 16) = *(const f32x4*)(C.b_gate + tid * 4);
}
__device__ __forceinline__ void cum_rows(const u32x4 g0, const u32x4 g1, int h, const unsigned char* lds, float (&cum)[8], float (&tot)[8]) {
    const int tid = threadIdx.x, lane = tid & 63; const int wv = __builtin_amdgcn_readfirstlane(tid >> 6);
    float zg[16];
    { float a[8], b[8]; unpack8(g0, a); unpack8(g1, b);
#pragma unroll
      for (int j = 0; j < 8; ++j) { zg[j] = a[j]; zg[8 + j] = b[j]; } }
    float x[8];
    { const f32x4 b0 = *(const f32x4*)(lds + L_BG + (h * 64 + 8 * wv) * 4), b1 = *(const f32x4*)(lds + L_BG + (h * 64 + 8 * wv + 4) * 4);
      x[0] = b0.x; x[1] = b0.y; x[2] = b0.z; x[3] = b0.w; x[4] = b1.x; x[5] = b1.y; x[6] = b1.z; x[7] = b1.w; }
#pragma unroll
    for (int gh = 0; gh < 2; ++gh) { f32x4 w0[8], w1[8];
#pragma unroll
        for (int g = 0; g < 8; ++g) { w0[g] = *(const f32x4*)(lds + L_WG + ((gh * 8 + g) * 256 + h * 64 + 8 * wv) * 4); w1[g] = *(const f32x4*)(lds + L_WG + ((gh * 8 + g) * 256 + h * 64 + 8 * wv + 4) * 4); }
#pragma unroll
        for (int g = 0; g < 8; ++g) { const float z = zg[gh * 8 + g];
            x[0] += z * w0[g].x; x[1] += z * w0[g].y; x[2] += z * w0[g].z; x[3] += z * w0[g].w; x[4] += z * w1[g].x; x[5] += z * w1[g].y; x[6] += z * w1[g].z; x[7] += z * w1[g].w; } }
#pragma unroll
    for (int j = 0; j < 8; ++j) x[j] = log_gate(x[j]);
#define GLA_DPP(v, ctrl, rmask) __builtin_bit_cast(float, __builtin_amdgcn_update_dpp(0, __builtin_bit_cast(int, (v)), (ctrl), (rmask), 0xF, true))
#pragma unroll
    for (int j = 0; j < 8; ++j) { float v = x[j];
        v += GLA_DPP(v, 0x111, 0xF); v += GLA_DPP(v, 0x112, 0xF); v += GLA_DPP(v, 0x114, 0xF); v += GLA_DPP(v, 0x118, 0xF);
        v += GLA_DPP(v, 0x142, 0xA); v += GLA_DPP(v, 0x143, 0xC);
        cum[j] = v; tot[j] = __builtin_bit_cast(float, __builtin_amdgcn_readlane(__builtin_bit_cast(int, v), 63)); }
#undef GLA_DPP
}
__device__ __forceinline__ void trfrag4(int base, bf16x8 (&f)[4]) {
    s16x4 lo[4], hi[4];
#pragma unroll
    for (int ks = 0; ks < 4; ++ks) {
        asm volatile("ds_read_b64_tr_b16 %0,%1 offset:%c2" : "=&v"(lo[ks]) : "v"(base), "i"(ks * 1024) : "memory");
        asm volatile("ds_read_b64_tr_b16 %0,%1 offset:%c2" : "=&v"(hi[ks]) : "v"(base), "i"(ks * 1024 + 512) : "memory"); }
    asm volatile("s_waitcnt lgkmcnt(0)" ::: "memory"); __builtin_amdgcn_sched_barrier(0);
#pragma unroll
    for (int ks = 0; ks < 4; ++ks) f[ks] = (bf16x8){lo[ks][0], lo[ks][1], lo[ks][2], lo[ks][3], hi[ks][0], hi[ks][1], hi[ks][2], hi[ks][3]};
}
struct Raw { u32x4 q, k, v0, v1, g0, g1, z0, z1; bf16x8 pf[4]; };
template <bool P2>
__device__ __forceinline__ void load_raw(const Ctx& C, int u, Raw& R) {
    const bf16* Z = (const bf16*)(C.ws + WS_Z); const bf16* PREV = (const bf16*)(C.ws + WS_A);
    const int tid = threadIdx.x, lane = tid & 63, r32 = lane & 31, hi = lane >> 5, c = tid >> 3, dc = tid & 7; const int wv = __builtin_amdgcn_readfirstlane(tid >> 6);
    const int n = u % NCH, h = (u / NCH) % GH, b = u / (NCH * GH); const int row0 = b * SEQ + n * 64;
    const size_t rl_ = (size_t)(row0 + lane);
    R.k = *(const u32x4*)(Z + ztile(rl_, ZC_K + h * 64 + 8 * wv)); R.g0 = *(const u32x4*)(Z + ztile(rl_, ZC_GATE)); R.g1 = *(const u32x4*)(Z + ztile(rl_, ZC_GATE + 8));
    { const int j = tid >> 4, cc = tid & 15; R.v0 = *(const u32x4*)(Z + ztile((size_t)(row0 + j), ZC_V + h * 128 + cc * 8)); R.v1 = *(const u32x4*)(Z + ztile((size_t)(row0 + 32 + j), ZC_V + h * 128 + cc * 8)); }
    if (P2) { R.q = *(const u32x4*)(Z + ztile(rl_, ZC_Q + h * 64 + 8 * wv)); const size_t rc_ = (size_t)(row0 + c); R.z0 = *(const u32x4*)(Z + ztile(rc_, ZC_G + h * 128 + 16 * dc)); R.z1 = *(const u32x4*)(Z + ztile(rc_, ZC_G + h * 128 + 16 * dc + 8));
        const int cb = wv & 3;
#pragma unroll
        for (int s = 0; s < 4; ++s) R.pf[s] = *(const bf16x8*)(PREV + ((size_t)u * 128 + 32 * cb + r32) * 64 + 16 * s + 8 * hi); }
}
__device__ __forceinline__ void store_vimg(const Raw& R, unsigned char* lds) {
    const int tid = threadIdx.x, j = tid >> 4, cc = tid & 15;
    *(u32x4*)(lds + L_VIMG + (cc >> 2) * 4096 + j * 64 + (cc & 3) * 16) = R.v0; *(u32x4*)(lds + L_VIMG + (cc >> 2) * 4096 + (32 + j) * 64 + (cc & 3) * 16) = R.v1;
}
__device__ __forceinline__ void pass1(const Ctx& C, unsigned char* lds) {
    float* CKV = (float*)(C.ws + WS_CKV); float* DEC = (float*)(C.ws + WS_DEC);
    const int tid = threadIdx.x, lane = tid & 63, r32 = lane & 31, hi = lane >> 5, c = tid >> 3, dc = tid & 7; const int wv = __builtin_amdgcn_readfirstlane(tid >> 6);
    const unsigned lds0 = (unsigned)(uintptr_t)lds; const int lpart = ((lane >> 4) & 1) * 32 + (lane & 3) * 8 + (4 * hi + ((lane & 15) >> 2)) * 64;
    const int NU = BATCH * GH * NCH, G = (int)gridDim.x;
    __syncthreads(); stage_gate(C, lds);
    Raw cur; if ((int)blockIdx.x < NU) load_raw<false>(C, (int)blockIdx.x, cur);
    for (int u = blockIdx.x; u < NU; u += G) {
        const int h = (u / NCH) % GH;
        Raw nxt = cur; if (u + G < NU) load_raw<false>(C, u + G, nxt);
        GLA_BAR();
        store_vimg(cur, lds);
        float kv[8]; unpack8(cur.k, kv);
        float cum[8], tot[8]; cum_rows(cur.g0, cur.g1, h, lds, cum, tot);
#pragma unroll
        for (int j = 0; j < 8; ++j) kv[j] *= fexp(tot[j] - cum[j]);
        *(u32x4*)(lds + L_QIMG + (wv >> 2) * 4096 + lane * 64 + (wv & 3) * 16) = pack8(kv);
        if (lane == 63) {
#pragma unroll
            for (int j = 0; j < 8; ++j) DEC[(size_t)u * 64 + 8 * wv + j] = fexp(tot[j]); }
        GLA_BAR();
        const int vb = wv >> 1, db = wv & 1;
        bf16x8 af[4], bfr[4]; trfrag4((int)(lds0 + L_VIMG + vb * 4096) + lpart, af); trfrag4((int)(lds0 + L_QIMG + db * 4096) + lpart, bfr);
        f32x16 o = f32x16{};
#pragma unroll
        for (int ks = 0; ks < 4; ++ks) o = __builtin_amdgcn_mfma_f32_32x32x16_bf16(af[ks], bfr[ks], o, 0, 0, 0);
#pragma unroll
        for (int r = 0; r < 16; ++r) CKV[((size_t)u * 128 + 32 * vb + crow(r, hi)) * 64 + 32 * db + r32] = o[r];
        cur = nxt;
    }
    __syncthreads();
}
__device__ __forceinline__ void pass2(const Ctx& C, unsigned char* lds) {
    bf16* MIX = (bf16*)(C.ws + WS_B);
    const int tid = threadIdx.x, lane = tid & 63, r32 = lane & 31, hi = lane >> 5, c = tid >> 3, dc = tid & 7; const int wv = __builtin_amdgcn_readfirstlane(tid >> 6);
    const unsigned lds0 = (unsigned)(uintptr_t)lds; const int lpart = ((lane >> 4) & 1) * 32 + (lane & 3) * 8 + (4 * hi + ((lane & 15) >> 2)) * 64;
    const lds_cptr L3 = (lds_cptr)lds; float* obuf = (float*)(lds + L_OBUF);
    const int rb = wv >> 2, cb = wv & 3;
    const int NU = BATCH * GH * NCH, G = (int)gridDim.x;
    f32x4 gn[4];
#pragma unroll
    for (int i = 0; i < 4; ++i) gn[i] = *(const f32x4*)(C.gla_out_norm + 16 * dc + 4 * i);
    __syncthreads(); stage_gate(C, lds);
    Raw cur; if ((int)blockIdx.x < NU) load_raw<true>(C, (int)blockIdx.x, cur);
    for (int u = blockIdx.x; u < NU; u += G) {
        const int n = u % NCH, h = (u / NCH) % GH, b = u / (NCH * GH); const int row0 = b * SEQ + n * 64;
        Raw nxt = cur; if (u + G < NU) load_raw<true>(C, u + G, nxt);
        GLA_BAR();
        store_vimg(cur, lds);
        float qv[8], kv[8]; unpack8(cur.q, qv); unpack8(cur.k, kv);
        float cum[8], tot[8]; cum_rows(cur.g0, cur.g1, h, lds, cum, tot);
#pragma unroll
        for (int j = 0; j < 8; ++j) { qv[j] *= 0.125f * fexp(cum[j]); kv[j] *= fexp(-cum[j]); }
        *(u32x4*)(lds + L_QIMG + wv * 1024 + lane * 16) = pack8(qv); *(u32x4*)(lds + L_KIMG + wv * 1024 + lane * 16) = pack8(kv);
        GLA_BAR();
        bf16x8 qr[4];
#pragma unroll
        for (int s = 0; s < 4; ++s) qr[s] = *(const __attribute__((address_space(3))) bf16x8*)(L3 + L_QIMG + (2 * s + hi) * 1024 + (32 * rb + r32) * 16);
        f32x16 p0 = f32x16{}, p1 = f32x16{};
#pragma unroll
        for (int s = 0; s < 4; ++s) { const lds_cptr kp = L3 + L_KIMG + (2 * s + hi) * 1024 + r32 * 16;
            const bf16x8 a0 = *(const __attribute__((address_space(3))) bf16x8*)(kp), a1 = *(const __attribute__((address_space(3))) bf16x8*)(kp + 512);
            p0 = __builtin_amdgcn_mfma_f32_32x32x16_bf16(a0, qr[s], p0, 0, 0, 0); p1 = __builtin_amdgcn_mfma_f32_32x32x16_bf16(a1, qr[s], p1, 0, 0, 0); }
        const int cq = 32 * rb + r32;
#pragma unroll
        for (int r = 0; r < 16; ++r) { const int j = crow(r, hi); p0[r] = (j <= cq) ? p0[r] : 0.f; p1[r] = (j + 32 <= cq) ? p1[r] : 0.f; }
        u32x4 pw0, pw1, pw2, pw3;
        pw0 = (u32x4){cvtpk_s(p0[0], p0[1]), cvtpk_s(p0[2], p0[3]), cvtpk_s(p0[4], p0[5]), cvtpk_s(p0[6], p0[7])};
        pw1 = (u32x4){cvtpk_s(p0[8], p0[9]), cvtpk_s(p0[10], p0[11]), cvtpk_s(p0[12], p0[13]), cvtpk_s(p0[14], p0[15])};
        pw2 = (u32x4){cvtpk_s(p1[0], p1[1]), cvtpk_s(p1[2], p1[3]), cvtpk_s(p1[4], p1[5]), cvtpk_s(p1[6], p1[7])};
        pw3 = (u32x4){cvtpk_s(p1[8], p1[9]), cvtpk_s(p1[10], p1[11]), cvtpk_s(p1[12], p1[13]), cvtpk_s(p1[14], p1[15])};
        __builtin_amdgcn_sched_barrier(0);
        bf16x8 vf[4]; trfrag4((int)(lds0 + L_VIMG + cb * 4096) + lpart, vf);
        f32x16 o = f32x16{};
        o = __builtin_amdgcn_mfma_f32_32x32x16_bf16(__builtin_bit_cast(bf16x8, pw0), vf[0], o, 0, 0, 0);
        o = __builtin_amdgcn_mfma_f32_32x32x16_bf16(__builtin_bit_cast(bf16x8, pw1), vf[1], o, 0, 0, 0);
        o = __builtin_amdgcn_mfma_f32_32x32x16_bf16(__builtin_bit_cast(bf16x8, pw2), vf[2], o, 0, 0, 0);
        o = __builtin_amdgcn_mfma_f32_32x32x16_bf16(__builtin_bit_cast(bf16x8, pw3), vf[3], o, 0, 0, 0);
#pragma unroll
        for (int s = 0; s < 4; ++s) o = __builtin_amdgcn_mfma_f32_32x32x16_bf16(qr[s], cur.pf[s], o, 0, 0, 0);
#pragma unroll
        for (int r = 0; r < 16; ++r) obuf[(32 * rb + crow(r, hi)) * OLD + 32 * cb + r32] = o[r];
        GLA_BAR();
        { float ov[16];
#pragma unroll
            for (int i = 0; i < 4; ++i) { const f32x4 t = *(const f32x4*)(obuf + c * OLD + 16 * dc + 4 * i); ov[4 * i] = t.x; ov[4 * i + 1] = t.y; ov[4 * i + 2] = t.z; ov[4 * i + 3] = t.w; }
            float ss = 0.f;
#pragma unroll
            for (int i = 0; i < 16; ++i) ss += ov[i] * ov[i];
            ss += __shfl_xor(ss, 1); ss += __shfl_xor(ss, 2); ss += __shfl_xor(ss, 4);
            const float rn = rsqrtf(ss * (1.f / GDV) + EPS); const size_t row = (size_t)(row0 + c);
            float g0[8], g1[8]; unpack8(cur.z0, g0); unpack8(cur.z1, g1);
            const float gv[16] = {gn[0].x, gn[0].y, gn[0].z, gn[0].w, gn[1].x, gn[1].y, gn[1].z, gn[1].w, gn[2].x, gn[2].y, gn[2].z, gn[2].w, gn[3].x, gn[3].y, gn[3].z, gn[3].w};
            float w0[8], w1[8];
#pragma unroll
            for (int i = 0; i < 8; ++i) { w0[i] = ov[i] * rn * gv[i] * silu_f(g0[i]); w1[i] = ov[8 + i] * rn * gv[8 + i] * silu_f(g1[i]); }
            { const int c0 = h * 128 + 16 * dc; bf16* mp = MIX + ((row >> 4) * 32 + (c0 >> 5)) * 512 + (row & 15) * 32 + (c0 & 31);
              *(u32x4*)mp = pack8(w0); *(u32x4*)(mp + 8) = pack8(w1); } }
        cur = nxt;
    }
    __syncthreads();
}
#undef GLA_BAR
}

namespace pg8 {
#define PG8_LAS __attribute__((address_space(3)))
typedef unsigned short bf16_t;
typedef short bf16x8 __attribute__((ext_vector_type(8)));
typedef float f32x4 __attribute__((ext_vector_type(4)));
typedef unsigned u32x4 __attribute__((ext_vector_type(4)));
constexpr int BM = 256, BK = 64, HALF = 128, HTB = HALF * BK * 2  , STAGE_BYTES = 8 * HTB, NXCD = 8, WGM = 8;

__host__ __device__ __forceinline__ int lds_byte(int r, int c) { const int st = (r >> 4) * 2 + (c >> 5), rr = r & 15, cc = c & 31, ob = rr * 64 + cc * 2; return st * 1024 + (ob ^ (((ob >> 9) & 1) << 5)); }
__host__ __device__ __forceinline__ void stage_rc(int b, int& R, int& C) { const int st = b / 1024, sb = b % 1024, swz = sb ^ (((sb >> 9) & 1) << 5); R = (st >> 1) * 16 + swz / 64; C = (st & 1) * 32 + (swz % 64) / 2; }
__host__ __device__ __forceinline__ int perm32(int rho) { const int n = rho >> 4, i = rho & 15; return 8 * (i >> 2) + 4 * n + (i & 3); }

struct Unit { int pm, pn; };
struct Gemm { const bf16_t* A; const bf16_t* Bt; int M, N, K, lda; bool ta, tb; };

struct StaticOrder {
    int nM, nN, nwg, G, c;
    __host__ __device__ void init(int M, int N, int G_, int c_) { nM = M / BM; nN = N / BM; nwg = nM * nN; G = G_; c = c_; }
    __host__ __device__ bool next(int i, Unit& u) const {
        const long L = (long)i * G + c; if (L >= nwg) return false;
        int wgid = (int)L; { const int q = nwg / NXCD, r = nwg % NXCD, xcd = wgid % NXCD, off = wgid / NXCD; wgid = (xcd < r ? xcd * (q + 1) : r * (q + 1) + (xcd - r) * q) + off; }
        const int nig = WGM * nN, gid = wgid / nig, fm = gid * WGM, gsz = (nM - fm) < WGM ? (nM - fm) : WGM;
        u.pm = fm + ((wgid % nig) % gsz); u.pn = (wgid % nig) / gsz; return true;
    }
    __device__ __forceinline__ void a_ready(const Unit&) const {}
    __device__ __forceinline__ void done(const Unit&) const {}
};

__device__ __forceinline__ unsigned cvt_pk_bf16(float lo, float hi) { unsigned r; asm volatile("v_cvt_pk_bf16_f32 %0, %1, %2" : "=v"(r) : "v"(lo), "v"(hi)); return r; }
typedef float f32x2 __attribute__((ext_vector_type(2)));
typedef unsigned u32x2v __attribute__((ext_vector_type(2)));
struct EpiBf16 {
    static constexpr bool PERM = true, AFTER_DRAIN = false; static constexpr int PROBE_BIT = 26;
    bf16_t* O; int ldc;
    __device__ __forceinline__ void operator()(const f32x4 (&acc)[2][2][4][2], const Unit& u, int wr, int wc, int fr, int fq) const {
        const int row0 = u.pm * BM + wr * 64 + fr, col0 = u.pn * BM + wc * 32 + 8 * fq;
#pragma unroll
        for (int ai = 0; ai < 2; ++ai)
#pragma unroll
            for (int m = 0; m < 4; ++m) { bf16_t* rowp = O + (size_t)(row0 + ai * HALF + m * 16) * ldc + col0;
#pragma unroll
                for (int bj = 0; bj < 2; ++bj) { const f32x4 v0 = acc[ai][bj][m][0], v1 = acc[ai][bj][m][1];
                    u32x4 w; w.x = cvt_pk_bf16(v0[0], v0[1]); w.y = cvt_pk_bf16(v0[2], v0[3]); w.z = cvt_pk_bf16(v1[0], v1[1]); w.w = cvt_pk_bf16(v1[2], v1[3]);
                    *(u32x4*)(rowp + bj * HALF) = w; } }
    }
};
struct EpiZ {
    static constexpr bool PERM = true, AFTER_DRAIN = false; static constexpr int PROBE_BIT = 27;
    bf16_t* O; int ldc; float* ssqq; float* ssqkv; float* ssqpe;
    __device__ __forceinline__ void operator()(const f32x4 (&acc)[2][2][4][2], const Unit& u, int wr, int wc, int fr, int fq) const {
        const int row0 = u.pm * BM + wr * 64 + fr, col0 = u.pn * BM + wc * 32 + 8 * fq;
#pragma unroll
        for (int ai = 0; ai < 2; ++ai)
#pragma unroll
            for (int m = 0; m < 4; ++m) { const int r = row0 + ai * HALF + m * 16; bf16_t* rowp = O + ((size_t)(r >> 4) * (ldc >> 5) + (col0 >> 5)) * 512 + (r & 15) * 32 + (col0 & 31); float sq[2];
#pragma unroll
                for (int bj = 0; bj < 2; ++bj) { const f32x4 v0 = acc[ai][bj][m][0], v1 = acc[ai][bj][m][1];
                    u32x4 w; w.x = cvt_pk_bf16(v0[0], v0[1]); w.y = cvt_pk_bf16(v0[2], v0[3]); w.z = cvt_pk_bf16(v1[0], v1[1]); w.w = cvt_pk_bf16(v1[2], v1[3]);
                    *(u32x4*)(rowp + bj * 4 * 512) = w;
                    sq[bj] = ((v0[0] * v0[0] + v0[1] * v0[1]) + (v0[2] * v0[2] + v0[3] * v0[3])) + ((v1[0] * v1[0] + v1[1] * v1[1]) + (v1[2] * v1[2] + v1[3] * v1[3])); }
                if (u.pn == 6) { float s = sq[0] + sq[1]; s += __shfl_xor(s, 16); s += __shfl_xor(s, 32); if (fq == 0) ssqq[(size_t)r * 4 + wc] = s; }
                else if (u.pn == 7) { float s = sq[0]; s += __shfl_xor(s, 16); s += __shfl_xor(s, 32); if (fq == 0) ssqkv[(size_t)r * 4 + wc] = s;
                    if (wc == 0) { float t = sq[1]; t += __shfl_xor(t, 16); t += __shfl_xor(t, 32); if (fq == 0) ssqpe[r] = t; } } }
    }
};
struct EpiQ {
    static constexpr bool PERM = false, AFTER_DRAIN = true; static constexpr int PROBE_BIT = 25;
    const float* ssqq; const float* gq; const float* cosT; const float* sinT; bf16_t* QF; float eps, qscale;
    __device__ __forceinline__ void fused(f32x4 (&acc)[2][2][4][2], const Unit& u, int wr, int wc, int fr, int fq, PG8_LAS unsigned char* lds, int wid, int lane) const {
        PG8_LAS float* P = (PG8_LAS float*)lds;
        f32x4 s4A[2][4];
#pragma unroll
        for (int ai = 0; ai < 2; ++ai)
#pragma unroll
            for (int m = 0; m < 4; ++m) s4A[ai][m] = *(const f32x4*)(ssqq + (size_t)(u.pm * BM + ai * HALF + wr * 64 + m * 16 + fr) * 4);
        __builtin_amdgcn_sched_barrier(0);
#pragma unroll
        for (int ai = 0; ai < 2; ++ai)
#pragma unroll
            for (int m = 0; m < 4; ++m) { const int rl = ai * HALF + wr * 64 + m * 16 + fr; const f32x4 s4 = s4A[ai][m];
                const float ra = __builtin_amdgcn_rsqf(((s4[0] + s4[1]) + (s4[2] + s4[3])) * (1.0f / 256.0f) + eps);
#pragma unroll
                for (int bj = 0; bj < 2; ++bj) { float s = 0.f;
#pragma unroll
                    for (int n = 0; n < 2; ++n) { const f32x4 v = acc[ai][bj][m][n] * ra; acc[ai][bj][m][n] = v; s += (v[0] * v[0] + v[1] * v[1]) + (v[2] * v[2] + v[3] * v[3]); }
                    s += __shfl_xor(s, 16); s += __shfl_xor(s, 32);
                    if (fq == 0) P[(rl * 2 + bj) * 4 + wc] = s; } }
        asm volatile("s_waitcnt lgkmcnt(0)" ::: "memory"); __builtin_amdgcn_s_barrier(); asm volatile("" ::: "memory");
        PG8_LAS unsigned char* ST = lds + 8192;
        if (wc < 3) {
            const int j0 = wc * 32 + 4 * fq; const f32x4 g0 = *(const f32x4*)(gq + j0), g1 = *(const f32x4*)(gq + j0 + 16);
            f32x4 csA[2][4], snA[2][4];
#pragma unroll
            for (int ai = 0; ai < 2; ++ai)
#pragma unroll
                for (int m = 0; m < 4; ++m) { const size_t r = (size_t)(u.pm * BM + ai * HALF + wr * 64 + m * 16 + fr); csA[ai][m] = (f32x4){1.f, 1.f, 1.f, 1.f}; snA[ai][m] = (f32x4){0.f, 0.f, 0.f, 0.f};
                    if (wc == 2) { csA[ai][m] = *(const f32x4*)(cosT + r * 16 + 4 * fq); snA[ai][m] = *(const f32x4*)(sinT + r * 16 + 4 * fq); } }
            __builtin_amdgcn_sched_barrier(0);
#pragma unroll
            for (int ai = 0; ai < 2; ++ai)
#pragma unroll
                for (int m = 0; m < 4; ++m) { const int rl = ai * HALF + wr * 64 + m * 16 + fr; const f32x4 cs = csA[ai][m], sn = snA[ai][m];
#pragma unroll
                    for (int bj = 0; bj < 2; ++bj) { const f32x4 p = *(const PG8_LAS f32x4*)(P + (rl * 2 + bj) * 4);
                        const float rh = qscale * __builtin_amdgcn_rsqf(((p[0] + p[1]) + (p[2] + p[3])) * (1.0f / 96.0f) + eps);
                        const f32x4 a = acc[ai][bj][m][0] * rh * g0, b = acc[ai][bj][m][1] * rh * g1;
                        f32x4 o0 = a, o1 = b; if (wc == 2) { o0 = a * cs - b * sn; o1 = a * sn + b * cs; }
                        PG8_LAS unsigned char* dst = ST + rl * 400 + (bj * 96 + j0) * 2;
                        u32x2v w0, w1; w0.x = cvt_pk_bf16(o0[0], o0[1]); w0.y = cvt_pk_bf16(o0[2], o0[3]); w1.x = cvt_pk_bf16(o1[0], o1[1]); w1.y = cvt_pk_bf16(o1[2], o1[3]);
                        *(PG8_LAS u32x2v*)dst = w0; *(PG8_LAS u32x2v*)(dst + 32) = w1; }
                    }
        }
        asm volatile("s_waitcnt lgkmcnt(0)" ::: "memory"); __builtin_amdgcn_s_barrier(); asm volatile("" ::: "memory");
        { const int tid = wid * 64 + lane;
#pragma unroll
            for (int i = 0; i < 12; ++i) { const int idx = tid + 512 * i, row = idx / 24, ch = idx - row * 24;
                *(u32x4*)(QF + (size_t)(u.pm * BM + row) * 768 + (2 * u.pn) * 96 + ch * 8) = *(const PG8_LAS u32x4*)(ST + row * 400 + ch * 16); } }
    }
};
struct EpiKV {
    static constexpr bool PERM = false, AFTER_DRAIN = true; static constexpr int PROBE_BIT = 24;
    const float* ssqkv; const float* ssqpe; const float* gk; const float* cosT; const float* sinT; const bf16_t* Z; bf16_t* KF; bf16_t* VF; float eps;
    __device__ __forceinline__ void fused(f32x4 (&acc)[2][2][4][2], const Unit& u, int wr, int wc, int fr, int fq, PG8_LAS unsigned char* lds, int wid, int lane) const {
        PG8_LAS float* P = (PG8_LAS float*)lds;
        f32x4 s4A[2][4];
#pragma unroll
        for (int ai = 0; ai < 2; ++ai)
#pragma unroll
            for (int m = 0; m < 4; ++m) s4A[ai][m] = *(const f32x4*)(ssqkv + (size_t)(u.pm * BM + ai * HALF + wr * 64 + m * 16 + fr) * 4);
        __builtin_amdgcn_sched_barrier(0);
#pragma unroll
        for (int ai = 0; ai < 2; ++ai)
#pragma unroll
            for (int m = 0; m < 4; ++m) { const int rl = ai * HALF + wr * 64 + m * 16 + fr; const f32x4 s4 = s4A[ai][m];
                const float ra = __builtin_amdgcn_rsqf(((s4[0] + s4[1]) + (s4[2] + s4[3])) * (1.0f / 128.0f) + eps);
#pragma unroll
                for (int bj = 0; bj < 2; ++bj) { float s = 0.f;
#pragma unroll
                    for (int n = 0; n < 2; ++n) { const f32x4 v = acc[ai][bj][m][n] * ra; acc[ai][bj][m][n] = v; s += (v[0] * v[0] + v[1] * v[1]) + (v[2] * v[2] + v[3] * v[3]); }
                    if (wc < 2) { s += __shfl_xor(s, 16); s += __shfl_xor(s, 32); if (fq == 0) P[(rl * 2 + bj) * 2 + wc] = s; } } }
        asm volatile("s_waitcnt lgkmcnt(0)" ::: "memory"); __builtin_amdgcn_s_barrier(); asm volatile("" ::: "memory");
        const int j0 = wc * 32 + 4 * fq;
        PG8_LAS unsigned char* ST = lds + 8192;
        if (wc < 2) {
            const f32x4 g0 = *(const f32x4*)(gk + j0), g1 = *(const f32x4*)(gk + j0 + 16);
            float pesA[2][4];
#pragma unroll
            for (int ai = 0; ai < 2; ++ai)
#pragma unroll
                for (int m = 0; m < 4; ++m) pesA[ai][m] = ssqpe[(size_t)(u.pm * BM + ai * HALF + wr * 64 + m * 16 + fr)];
            __builtin_amdgcn_sched_barrier(0);
#pragma unroll
            for (int ai = 0; ai < 2; ++ai)
#pragma unroll
                for (int m = 0; m < 4; ++m) { const int rl = ai * HALF + wr * 64 + m * 16 + fr; const float pes = pesA[ai][m];
#pragma unroll
                    for (int bj = 0; bj < 2; ++bj) { const float rk = __builtin_amdgcn_rsqf((P[(rl * 2 + bj) * 2] + P[(rl * 2 + bj) * 2 + 1] + pes) * (1.0f / 96.0f) + eps);
                        const f32x4 o0 = acc[ai][bj][m][0] * rk * g0, o1 = acc[ai][bj][m][1] * rk * g1; PG8_LAS unsigned char* dst = ST + rl * 400 + (bj * 96 + j0) * 2;
                        u32x2v w0, w1; w0.x = cvt_pk_bf16(o0[0], o0[1]); w0.y = cvt_pk_bf16(o0[2], o0[3]); w1.x = cvt_pk_bf16(o1[0], o1[1]); w1.y = cvt_pk_bf16(o1[2], o1[3]);
                        *(PG8_LAS u32x2v*)dst = w0; *(PG8_LAS u32x2v*)(dst + 32) = w1; }
                    asm volatile("" ::: "memory"); }
        } else {
#pragma unroll
            for (int ai = 0; ai < 2; ++ai)
#pragma unroll
                for (int m = 0; m < 4; ++m) { const int rl = ai * HALF + wr * 64 + m * 16 + fr; const size_t r = (size_t)(u.pm * BM + rl);
#pragma unroll
                    for (int bj = 0; bj < 2; ++bj) { const f32x4 o0 = acc[ai][bj][m][0], o1 = acc[ai][bj][m][1];
                        bf16_t* dst = VF + (((((size_t)(u.pm >> 5) * 8 + 2 * u.pn + bj) * 128 + (u.pm & 31) * 4 + (rl >> 6)) * 2 + (wc - 2)) * 64 + (rl & 63)) * 32 + 4 * fq;
                        u32x2v w0, w1; w0.x = cvt_pk_bf16(o0[0], o0[1]); w0.y = cvt_pk_bf16(o0[2], o0[3]); w1.x = cvt_pk_bf16(o1[0], o1[1]); w1.y = cvt_pk_bf16(o1[2], o1[3]);
                        *(u32x2v*)dst = w0; *(u32x2v*)(dst + 16) = w1; }
                    asm volatile("" ::: "memory"); }
            if (wc == 2) {
                const f32x4 g0 = *(const f32x4*)(gk + 64 + 4 * fq), g1 = *(const f32x4*)(gk + 80 + 4 * fq);
#pragma unroll
                for (int ai = 0; ai < 2; ++ai) {
                    float pesB[4]; u32x2v xaB[4], xbB[4]; f32x4 csB[4], snB[4];
#pragma unroll
                    for (int m = 0; m < 4; ++m) { const size_t r = (size_t)(u.pm * BM + ai * HALF + wr * 64 + m * 16 + fr); pesB[m] = ssqpe[r];
                        xaB[m] = *(const u32x2v*)(Z + ((r >> 4) * 64 + 60) * 512 + (r & 15) * 32 + 4 * fq); xbB[m] = *(const u32x2v*)(Z + ((r >> 4) * 64 + 60) * 512 + (r & 15) * 32 + 16 + 4 * fq);
                        csB[m] = *(const f32x4*)(cosT + r * 16 + 4 * fq); snB[m] = *(const f32x4*)(sinT + r * 16 + 4 * fq); }
                    __builtin_amdgcn_sched_barrier(0);
#pragma unroll
                    for (int m = 0; m < 4; ++m) { const int rl = ai * HALF + wr * 64 + m * 16 + fr; const float pes = pesB[m];
                        const u32x2v xa = xaB[m], xb = xbB[m];
                        const f32x4 x1 = (f32x4){__uint_as_float(xa.x << 16), __uint_as_float(xa.x & 0xffff0000u), __uint_as_float(xa.y << 16), __uint_as_float(xa.y & 0xffff0000u)};
                        const f32x4 x2 = (f32x4){__uint_as_float(xb.x << 16), __uint_as_float(xb.x & 0xffff0000u), __uint_as_float(xb.y << 16), __uint_as_float(xb.y & 0xffff0000u)};
                        const f32x4 cs = csB[m], sn = snB[m];
#pragma unroll
                        for (int bj = 0; bj < 2; ++bj) { const float rk = __builtin_amdgcn_rsqf((P[(rl * 2 + bj) * 2] + P[(rl * 2 + bj) * 2 + 1] + pes) * (1.0f / 96.0f) + eps);
                            const f32x4 a = x1 * rk * g0, b = x2 * rk * g1, o0 = a * cs - b * sn, o1 = a * sn + b * cs; PG8_LAS unsigned char* dst = ST + rl * 400 + (bj * 96 + 64 + 4 * fq) * 2;
                            u32x2v w0, w1; w0.x = cvt_pk_bf16(o0[0], o0[1]); w0.y = cvt_pk_bf16(o0[2], o0[3]); w1.x = cvt_pk_bf16(o1[0], o1[1]); w1.y = cvt_pk_bf16(o1[2], o1[3]);
                            *(PG8_LAS u32x2v*)dst = w0; *(PG8_LAS u32x2v*)(dst + 32) = w1; } }
                    asm volatile("" ::: "memory"); }
            }
        }
        asm volatile("s_waitcnt lgkmcnt(0)" ::: "memory"); __builtin_amdgcn_s_barrier(); asm volatile("" ::: "memory");
        { const int tid = wid * 64 + lane;
#pragma unroll
            for (int i = 0; i < 12; ++i) { const int idx = tid + 512 * i, ch = idx >> 8, row = idx & 255, hd = 2 * u.pn + (ch >= 12 ? 1 : 0), c = ch >= 12 ? ch - 12 : ch;
                *(u32x4*)(KF + (((((size_t)(u.pm >> 5) * 8 + hd) * 128 + (u.pm & 31) * 4 + (row >> 6)) * 12 + c) * 64 + (row & 63)) * 8) = *(const PG8_LAS u32x4*)(ST + row * 400 + ch * 16); } }
    }
};
struct EpiOutProjG {
    static constexpr bool PERM = false, AFTER_DRAIN = false; static constexpr int PROBE_BIT = 28;
    const float* x; float* x1; bf16_t* x1b; float* ssq;
    __device__ __forceinline__ void operator()(const f32x4 (&acc)[2][2][4][2], const Unit& u, int wr, int wc, int fr, int fq) const {
        const int col0 = u.pn * BM + wc * 32 + 4 * fq;
#pragma unroll
        for (int ai = 0; ai < 2; ++ai) {
            f32x4 xr[4][2][2];
#pragma unroll
            for (int m = 0; m < 4; ++m) { const size_t off = (size_t)(u.pm * BM + ai * HALF + wr * 64 + m * 16 + fr) * 1024 + col0;
#pragma unroll
                for (int bj = 0; bj < 2; ++bj)
#pragma unroll
                    for (int n = 0; n < 2; ++n) xr[m][bj][n] = *(const f32x4*)(x + off + bj * HALF + n * 16); }
            __builtin_amdgcn_sched_barrier(0);
#pragma unroll
            for (int m = 0; m < 4; ++m) { const int r = u.pm * BM + ai * HALF + wr * 64 + m * 16 + fr; const size_t off = (size_t)r * 1024 + col0; float s = 0.f;
#pragma unroll
                for (int bj = 0; bj < 2; ++bj)
#pragma unroll
                    for (int n = 0; n < 2; ++n) { const f32x4 t = xr[m][bj][n] + acc[ai][bj][m][n];
                        u32x2v w; w.x = cvt_pk_bf16(t[0], t[1]); w.y = cvt_pk_bf16(t[2], t[3]);
                        *(u32x2v*)(x1b + ((size_t)(r >> 4) * 32 + ((col0 >> 5) + 4 * bj)) * 512 + (r & 15) * 32 + (col0 & 31) + 16 * n) = w;
                        s += (t[0] * t[0] + t[1] * t[1]) + (t[2] * t[2] + t[3] * t[3]); }
                s += __shfl_xor(s, 16); s += __shfl_xor(s, 32);
                if (fq == 0) ssq[(size_t)r * 16 + u.pn * 4 + wc] = s; }
            asm volatile("" ::: "memory"); }
    }
};
struct EpiUpG {
    static constexpr bool PERM = true, AFTER_DRAIN = false; static constexpr int PROBE_BIT = 29;
    const PG8_LAS float* rtab; bf16_t* H;
    __device__ __forceinline__ void operator()(const f32x4 (&acc)[2][2][4][2], const Unit& u, int wr, int wc, int fr, int fq) const { (*this)(acc, u, wr, wc, fr, fq, 0); }
    __device__ __forceinline__ void operator()(const f32x4 (&acc)[2][2][4][2], const Unit& u, int wr, int wc, int fr, int fq, int ui) const {
        const int row0 = u.pm * BM + wr * 64 + fr, col0 = u.pn * BM + wc * 32 + 8 * fq;
#pragma unroll
        for (int ai = 0; ai < 2; ++ai)
#pragma unroll
            for (int m = 0; m < 4; ++m) { const int r = row0 + ai * HALF + m * 16;
                const float rstd = rtab[(ui & 3) * 256 + wr * 64 + fr + ai * HALF + m * 16];
                bf16_t* rowp = H + ((size_t)(r >> 4) * 128 + (col0 >> 5)) * 512 + (r & 15) * 32 + (col0 & 31);
#pragma unroll
                for (int bj = 0; bj < 2; ++bj) { f32x4 v0 = acc[ai][bj][m][0] * rstd, v1 = acc[ai][bj][m][1] * rstd;
#pragma unroll
                    for (int e = 0; e < 4; ++e) { v0[e] = __builtin_fmaxf(v0[e], 0.f); v1[e] = __builtin_fmaxf(v1[e], 0.f); }
                    v0 = v0 * v0; v1 = v1 * v1;
                    u32x4 w; w.x = cvt_pk_bf16(v0[0], v0[1]); w.y = cvt_pk_bf16(v0[2], v0[3]); w.z = cvt_pk_bf16(v1[0], v1[1]); w.w = cvt_pk_bf16(v1[2], v1[3]);
                    *(u32x4*)(rowp + bj * 4 * 512) = w; } }
    }
};
struct EpiDownG {
    static constexpr bool PERM = false, AFTER_DRAIN = false; static constexpr int PROBE_BIT = 30;
    const bf16_t* x1b; float* out;
    __device__ __forceinline__ void operator()(const f32x4 (&acc)[2][2][4][2], const Unit& u, int wr, int wc, int fr, int fq) const {
        const int col0 = u.pn * BM + wc * 32 + 4 * fq;
        u32x2v xw[2][4][2][2];
#pragma unroll
        for (int ai = 0; ai < 2; ++ai)
#pragma unroll
            for (int m = 0; m < 4; ++m) { const size_t off = (size_t)(u.pm * BM + ai * HALF + wr * 64 + m * 16 + fr) * 1024 + col0;
#pragma unroll
                for (int bj = 0; bj < 2; ++bj)
#pragma unroll
                    for (int n = 0; n < 2; ++n) { const int r_ = u.pm * BM + ai * HALF + wr * 64 + m * 16 + fr; xw[ai][m][bj][n] = *(const u32x2v*)(x1b + ((size_t)(r_ >> 4) * 32 + ((col0 >> 5) + 4 * bj)) * 512 + (r_ & 15) * 32 + (col0 & 31) + 16 * n); } }
        __builtin_amdgcn_sched_barrier(0);
#pragma unroll
        for (int ai = 0; ai < 2; ++ai)
#pragma unroll
            for (int m = 0; m < 4; ++m) { const size_t off = (size_t)(u.pm * BM + ai * HALF + wr * 64 + m * 16 + fr) * 1024 + col0;
#pragma unroll
                for (int bj = 0; bj < 2; ++bj)
#pragma unroll
                    for (int n = 0; n < 2; ++n) { const u32x2v w = xw[ai][m][bj][n];
                        const f32x4 xr = (f32x4){__uint_as_float(w.x << 16), __uint_as_float(w.x & 0xffff0000u), __uint_as_float(w.y << 16), __uint_as_float(w.y & 0xffff0000u)};
                        *(f32x4*)(out + off + bj * HALF + n * 16) = xr + acc[ai][bj][m][n]; } }
    }
};
template <class Epi, class Sched, bool ALIGN_EPI = false, bool SP2 = false>
__device__ __forceinline__ void gemm_phase(PG8_LAS unsigned char* lds, const Gemm g, const Sched& S, const Epi& E) {
    const int tid = threadIdx.x, wid = __builtin_amdgcn_readfirstlane(tid >> 6), lane = tid & 63, wr = wid >> 2, wc = wid & 3, fr = lane & 15, fq = lane >> 4;
    const int K = g.K, nt = K / BK;
    unsigned voffA[2], voffB[2];
#pragma unroll
    for (int i = 0; i < 2; ++i) { int R, C; stage_rc(tid * 16 + i * 8192, R, C); const int Rb = Epi::PERM ? ((R & ~31) + perm32(R & 31)) : R;
        voffA[i] = g.ta ? (unsigned)(((R >> 4) * (g.lda >> 5) + (C >> 5)) * 1024 + (R & 15) * 64 + (C & 31) * 2) : (unsigned)(R * g.lda + C) * 2u;
        voffB[i] = g.tb ? (unsigned)(((Rb >> 4) * (K >> 5) + (C >> 5)) * 1024 + (Rb & 15) * 64 + (C & 31) * 2) : (unsigned)(Rb * K + C) * 2u; }
    const size_t kstepA = g.ta ? (size_t)2048 : (size_t)(BK * 2), kstepB = g.tb ? (size_t)2048 : (size_t)(BK * 2);
    const size_t hstepB = (size_t)HALF * K * 2, hstepA = (size_t)HALF * g.lda * 2;
    const size_t tstepB = 2 * hstepB, tstepA = 2 * hstepA;
    const unsigned ldsw = (unsigned)wid * 1024u;
    const int aoff = lds_byte(wr * 64 + fr, fq * 8), boff = lds_byte(wc * 32 + fr, fq * 8);
#define PG8_SA(b, h) (((b) * 2 + (h)) * HTB)
#define PG8_SB(b, h) ((4 + (b) * 2 + (h)) * HTB)
#define PG8_STAGE(bufoff, gbase, voff) do { _Pragma("unroll") for (int _i = 0; _i < 2; ++_i) \
        __builtin_amdgcn_global_load_lds((const unsigned*)((const char*)(gbase) + (voff)[_i]), (PG8_LAS unsigned*)(lds + (bufoff) + ldsw + _i * 8192), 16, 0, 0); } while (0)
#define PG8_LDA(dst, b, h) do { _Pragma("unroll") for (int m = 0; m < 4; ++m) _Pragma("unroll") for (int k = 0; k < 2; ++k) dst[m][k] = *(const PG8_LAS bf16x8*)(lds + PG8_SA(b, h) + aoff + m * 2048 + k * 1024); } while (0)
#define PG8_LDB(dst, b, h) do { _Pragma("unroll") for (int n = 0; n < 2; ++n) _Pragma("unroll") for (int k = 0; k < 2; ++k) dst[n][k] = *(const PG8_LAS bf16x8*)(lds + PG8_SB(b, h) + boff + n * 2048 + k * 1024); } while (0)
#define PG8_MMA(ai, bj, At, Bt) do { __builtin_amdgcn_s_setprio(1); _Pragma("unroll") for (int m = 0; m < 4; ++m) _Pragma("unroll") for (int n = 0; n < 2; ++n) _Pragma("unroll") for (int k = 0; k < 2; ++k) \
        acc[ai][bj][m][n] = __builtin_amdgcn_mfma_f32_16x16x32_bf16(Bt[n][k], At[m][k], acc[ai][bj][m][n], 0, 0, 0); __builtin_amdgcn_s_setprio(0); } while (0)
#define PG8_WAIT_V(n) asm volatile("s_waitcnt vmcnt(" #n ")" ::: "memory")
#define PG8_WAIT_L(n) asm volatile("s_waitcnt lgkmcnt(" #n ")" ::: "memory")
#define PG8_BAR __builtin_amdgcn_s_barrier()
#define PG8_SCHED __builtin_amdgcn_sched_barrier(0)
    Unit cur, nxt; int ui = 0;
    if (!S.next(0, cur)) return;
    f32x4 acc[2][2][4][2];
#pragma unroll
    for (int a = 0; a < 2; ++a)
#pragma unroll
        for (int b = 0; b < 2; ++b)
#pragma unroll
            for (int m = 0; m < 4; ++m)
#pragma unroll
                for (int n = 0; n < 2; ++n) acc[a][b][m][n] = (f32x4){0.f, 0.f, 0.f, 0.f};
    bf16x8 At[4][2], B0[2][2], B1[2][2];
    const char* cA = (const char*)g.A + (size_t)cur.pm * tstepA; const char* cB = (const char*)g.Bt + (size_t)cur.pn * tstepB;
    S.a_ready(cur);
    if constexpr (SP2) {
        PG8_STAGE(PG8_SB(0, 0), cB, voffB); PG8_STAGE(PG8_SB(0, 1), cB + hstepB, voffB); PG8_STAGE(PG8_SA(0, 0), cA, voffA); PG8_STAGE(PG8_SA(0, 1), cA + hstepA, voffA);
        if (wr == 1) PG8_BAR;
        PG8_WAIT_V(2); PG8_BAR;
        PG8_STAGE(PG8_SB(1, 0), cB + kstepB, voffB); PG8_STAGE(PG8_SA(1, 0), cA + kstepA, voffA); PG8_STAGE(PG8_SB(1, 1), cB + hstepB + kstepB, voffB);
        PG8_WAIT_V(6); PG8_BAR;
    } else {
        PG8_STAGE(PG8_SB(0, 0), cB, voffB); PG8_STAGE(PG8_SA(0, 0), cA, voffA); PG8_STAGE(PG8_SB(0, 1), cB + hstepB, voffB); PG8_STAGE(PG8_SA(0, 1), cA + hstepA, voffA);
        if (wr == 1) PG8_BAR;
        PG8_WAIT_V(4); PG8_BAR;
        PG8_STAGE(PG8_SB(1, 0), cB + kstepB, voffB); PG8_STAGE(PG8_SA(1, 0), cA + kstepA, voffA); PG8_STAGE(PG8_SB(1, 1), cB + hstepB + kstepB, voffB);
        PG8_WAIT_V(6); PG8_BAR;
    }
    for (;;) {
        const bool has_next = S.next(ui + 1, nxt);
        const char* nA = has_next ? (const char*)g.A + (size_t)nxt.pm * tstepA : cA; const char* nB = has_next ? (const char*)g.Bt + (size_t)nxt.pn * tstepB : cB;
        for (int t = 0; t < nt; t += 2) {
            const bool last = (t == nt - 2);
            const char* a1 = cA + (size_t)(t + 1) * kstepA;
            const char* a2 = last ? nA : cA + (size_t)(t + 2) * kstepA; const char* b2 = last ? nB : cB + (size_t)(t + 2) * kstepB;
            const char* a3 = a2 + kstepA; const char* b3 = b2 + kstepB;
            if (last && has_next) S.a_ready(nxt);
            if constexpr (SP2) {
            PG8_LDB(B0, 0, 0); PG8_LDB(B1, 0, 1); PG8_SCHED; PG8_LDA(At, 0, 0); PG8_STAGE(PG8_SA(1, 1), a1 + hstepA, voffA);
            PG8_WAIT_V(8); PG8_WAIT_L(0); PG8_BAR; PG8_MMA(0, 0, At, B0); PG8_MMA(0, 1, At, B1); PG8_BAR; PG8_SCHED;
            PG8_LDA(At, 0, 1); PG8_STAGE(PG8_SB(0, 0), b2, voffB); PG8_STAGE(PG8_SB(0, 1), b2 + hstepB, voffB); PG8_STAGE(PG8_SA(0, 0), a2, voffA);
            PG8_WAIT_V(8); PG8_WAIT_L(0); PG8_BAR; PG8_MMA(1, 0, At, B0); PG8_MMA(1, 1, At, B1); PG8_BAR; PG8_SCHED;
            PG8_LDB(B0, 1, 0); PG8_LDB(B1, 1, 1); PG8_SCHED; PG8_LDA(At, 1, 0); PG8_STAGE(PG8_SA(0, 1), a2 + hstepA, voffA);
            PG8_WAIT_V(8); PG8_WAIT_L(0); PG8_BAR; PG8_MMA(0, 0, At, B0); PG8_MMA(0, 1, At, B1); PG8_BAR; PG8_SCHED;
            PG8_LDA(At, 1, 1); PG8_STAGE(PG8_SB(1, 0), b3, voffB); PG8_STAGE(PG8_SB(1, 1), b3 + hstepB, voffB); PG8_STAGE(PG8_SA(1, 0), a3, voffA);
            PG8_WAIT_V(8); PG8_WAIT_L(0); PG8_BAR; PG8_MMA(1, 0, At, B0); PG8_MMA(1, 1, At, B1); PG8_BAR; PG8_SCHED;
            } else {
            PG8_LDB(B0, 0, 0); PG8_SCHED; PG8_LDA(At, 0, 0); PG8_STAGE(PG8_SA(1, 1), a1 + hstepA, voffA);
            PG8_WAIT_L(8); PG8_BAR; PG8_WAIT_L(0); PG8_MMA(0, 0, At, B0); PG8_BAR; PG8_SCHED;
            PG8_LDB(B1, 0, 1); PG8_STAGE(PG8_SB(0, 0), b2, voffB);
            PG8_BAR; PG8_WAIT_L(0); PG8_MMA(0, 1, At, B1); PG8_BAR;
            PG8_LDA(At, 0, 1); PG8_STAGE(PG8_SA(0, 0), a2, voffA);
            PG8_BAR; PG8_WAIT_L(0); PG8_MMA(1, 0, At, B0); PG8_BAR; PG8_SCHED;
            PG8_STAGE(PG8_SB(0, 1), b2 + hstepB, voffB);
            PG8_WAIT_V(6); PG8_BAR; PG8_MMA(1, 1, At, B1); PG8_BAR;
            PG8_LDB(B0, 1, 0); PG8_SCHED; PG8_LDA(At, 1, 0); PG8_STAGE(PG8_SA(0, 1), a2 + hstepA, voffA);
            PG8_WAIT_L(8); PG8_BAR; PG8_WAIT_L(0); PG8_MMA(0, 0, At, B0); PG8_BAR; PG8_SCHED;
            PG8_LDB(B1, 1, 1); PG8_STAGE(PG8_SB(1, 0), b3, voffB);
            PG8_BAR; PG8_WAIT_L(0); PG8_MMA(0, 1, At, B1); PG8_BAR;
            PG8_LDA(At, 1, 1); PG8_STAGE(PG8_SA(1, 0), a3, voffA);
            PG8_BAR; PG8_WAIT_L(0); PG8_MMA(1, 0, At, B0); PG8_BAR; PG8_SCHED;
            PG8_STAGE(PG8_SB(1, 1), b3 + hstepB, voffB);
            PG8_WAIT_V(6); PG8_BAR; PG8_MMA(1, 1, At, B1); PG8_BAR;
            }
        }
        if constexpr (ALIGN_EPI) { if (wr == 0) PG8_BAR; }
        if constexpr (!Epi::AFTER_DRAIN) { if constexpr (Epi::PROBE_BIT == 29) E(acc, cur, wr, wc, fr, fq, ui); else E(acc, cur, wr, wc, fr, fq); if (DUPL(Epi::PROBE_BIT)) E(acc, cur, wr, wc, fr, fq); S.done(cur); }
        if (!has_next) break;
#pragma unroll
        for (int a = 0; a < 2; ++a)
#pragma unroll
            for (int b = 0; b < 2; ++b)
#pragma unroll
                for (int m = 0; m < 4; ++m)
#pragma unroll
                    for (int n = 0; n < 2; ++n) acc[a][b][m][n] = (f32x4){0.f, 0.f, 0.f, 0.f};
        cur = nxt; cA = nA; cB = nB; ++ui;
        if constexpr (ALIGN_EPI) { if (wr == 1) PG8_BAR; }
    }
    PG8_WAIT_V(0);
    if constexpr (!ALIGN_EPI) { if (wr == 0) PG8_BAR; }
    PG8_BAR;
    if constexpr (Epi::AFTER_DRAIN) { E.fused(acc, cur, wr, wc, fr, fq, lds, wid, lane); if (DUPL(Epi::PROBE_BIT)) { asm volatile("s_waitcnt lgkmcnt(0)" ::: "memory"); __builtin_amdgcn_s_barrier(); E.fused(acc, cur, wr, wc, fr, fq, lds, wid, lane); } S.done(cur); }
#undef PG8_SA
#undef PG8_SB
#undef PG8_STAGE
#undef PG8_LDA
#undef PG8_LDB
#undef PG8_MMA
#undef PG8_WAIT_V
#undef PG8_WAIT_L
#undef PG8_BAR
#undef PG8_SCHED
}
}

#define GAS __attribute__((address_space(1)))
#define LAS __attribute__((address_space(3)))
#define XB_TMO      128
#define XB_XCNT(j)  (256  + 64 * (j))
#define XB_XSUB(j)  (1280 + 64 * (j))
#define XB_XGEN(j)  (2304 + 64 * (j))
#define XB_TOP      3328
#define XB_TOPGEN   3392
#define XCD_BAR_WORDS 3456
#define XB_SPIN_CAP (1u << 18)
__device__ __forceinline__ unsigned xb_ld(unsigned* p)              { return __hip_atomic_load(p, __ATOMIC_RELAXED, __HIP_MEMORY_SCOPE_AGENT); }
__device__ __forceinline__ unsigned xb_add(unsigned* p, unsigned v) { return __hip_atomic_fetch_add(p, v, __ATOMIC_RELAXED, __HIP_MEMORY_SCOPE_AGENT); }
__device__ __forceinline__ unsigned xb_xcc_id() { return (unsigned)__builtin_amdgcn_s_getreg((3 << 11) | 20) & 0xFu; }
#define XB_SPIN(cond, bar) do { unsigned _sp = 0; while (cond) { __builtin_amdgcn_s_sleep(1); \
    if ((++_sp & 255u) == 0u) { if (xb_ld(&(bar)[XB_TMO])) break; if (_sp > XB_SPIN_CAP) { atomicAdd(&(bar)[XB_TMO], 1u); break; } } } } while (0)
struct XcdBarrier { unsigned* bar; unsigned x; volatile LAS unsigned* st; };
__device__ __forceinline__ XcdBarrier xcd_barrier_post(unsigned* bar, volatile LAS unsigned* st) {
    XcdBarrier b; b.bar = bar; b.x = xb_xcc_id(); b.st = st;
    if (threadIdx.x == 0) (void)xb_add(&bar[XB_XCNT(b.x)], 1u);
    return b;
}
__device__ __forceinline__ void xcd_barrier_complete(unsigned* bar, unsigned x, unsigned& nloc, unsigned& nx) {
    const unsigned G = gridDim.x * gridDim.y * gridDim.z;
    unsigned sum, cnt, mine, sp = 0u;
    for (;;) {
        sum = 0u; cnt = 0u; mine = 0u;
#pragma unroll
        for (unsigned j = 0; j < 16; ++j) { const unsigned c = xb_ld(&bar[XB_XCNT(j)]); sum += c; cnt += (c > 0u) ? 1u : 0u; mine = (j == x) ? c : mine; }
        if (sum == G) break;
        __builtin_amdgcn_s_sleep(1);
        if ((++sp & 255u) == 0u) { if (xb_ld(&bar[XB_TMO])) break; if (sp > XB_SPIN_CAP) { atomicAdd(&bar[XB_TMO], 1u); break; } }
    }
    nloc = mine > 0u ? mine : 1u; nx = cnt > 0u ? cnt : 1u;
}
__device__ __forceinline__ void xcd_barrier(const XcdBarrier& b) {
    asm volatile("s_waitcnt vmcnt(0)" ::: "memory");
    __syncthreads();
    if (threadIdx.x == 0) {
        unsigned* bar = b.bar;
        __builtin_amdgcn_s_waitcnt(0);
        unsigned nloc = b.st[0], nx = b.st[1];
        if (nloc == 0u) { xcd_barrier_complete(bar, b.x, nloc, nx); b.st[0] = nloc; b.st[1] = nx; }
        const unsigned old = xb_add(&bar[XB_XSUB(b.x)], 1u);
        const unsigned gen = old / nloc;
        if (old + 1u == (gen + 1u) * nloc) {
            __builtin_amdgcn_fence(__ATOMIC_RELEASE, "agent");
            asm volatile("s_waitcnt vmcnt(0)" ::: "memory");
            const unsigned og = xb_add(&bar[XB_TOP], 1u);
            const unsigned tg = og / nx;
            asm volatile("buffer_inv sc1" ::: "memory");
            if (og + 1u == (tg + 1u) * nx) xb_add(&bar[XB_TOPGEN], 1u);
            else XB_SPIN(xb_ld(&bar[XB_TOPGEN]) == tg, bar);
            xb_add(&bar[XB_XGEN(b.x)], 1u);
            asm volatile("s_waitcnt vmcnt(0)" ::: "memory");
        } else {
            asm volatile("buffer_inv sc1" ::: "memory");
            XB_SPIN(xb_ld(&bar[XB_XGEN(b.x)]) == gen, bar);
            asm volatile("s_waitcnt vmcnt(0)" ::: "memory");
        }
    }
    __syncthreads();
}

constexpr int LDS_BYTES = 147456;
constexpr int MISC_OFF = 131072 + 320;
constexpr int CW_BAR = 4096;
#ifndef MK_SINGLE
#define MK_SINGLE 1
#endif
constexpr int NPHASE = 11;
struct Args { Ctx C; int ph_lo, ph_hi; };
__global__ void __launch_bounds__(NT, 2) fwd_mega(Args args) {
    extern __shared__ __attribute__((aligned(16))) unsigned char lds_raw[];
    float* lds = (float*)lds_raw;
    PG8_LAS unsigned char* L3 = (PG8_LAS unsigned char*)lds_raw;
    const Ctx& C = args.C;
    unsigned char* ws = C.ws;
    volatile LAS unsigned* MISC = (volatile LAS unsigned*)((LAS unsigned char*)lds_raw + MISC_OFF);
    if (threadIdx.x < 32) MISC[threadIdx.x] = 0u;
    __syncthreads();
    XcdBarrier bar; bar.bar = (unsigned*)(ws + WS_CTL) + CW_BAR; bar.x = 0; bar.st = nullptr;
    if (MK_SINGLE) bar = xcd_barrier_post((unsigned*)(ws + WS_CTL) + CW_BAR, MISC + 8);
    const int lo = args.ph_lo, hi = args.ph_hi;
#define IN(k) (lo <= (k) && (k) < hi)
#define SEAM(k) do { if (IN(k) && IN((k) + 1)) { xcd_barrier(bar); if (DUPL(31)) xcd_barrier(bar); } } while (0)
#define PH(k, BODY) do { if (IN(k)) { BODY; if (DUPL(k)) { BODY; } } } while (0)
#define GEMM_PH(EPI, EINIT, AP, BP, NN, KK, LDA, AL) GEMM_PH2(EPI, EINIT, AP, BP, NN, KK, LDA, AL, false)
#define GEMM_PH2(EPI, EINIT, AP, BP, NN, KK, LDA, AL, TA) do { pg8::Gemm g{(const bf16*)(AP), (const bf16*)(BP), M, NN, KK, LDA, TA, true}; pg8::StaticOrder S; S.init(M, NN, (int)gridDim.x, (int)blockIdx.x); \
        pg8::EPI E EINIT; pg8::gemm_phase<pg8::EPI, pg8::StaticOrder, AL, true>(L3, g, S, E); } while (0)
    const float* COS = (const float*)(ws + WS_COS); const float* SIN = (const float*)(ws + WS_SIN);
    PH(0, p0_prologue(C, lds));
    SEAM(0);
    PH(1, GEMM_PH(EpiZ, ({(bf16*)(ws + WS_Z), NZ, (float*)(ws + WS_SSQQ), (float*)(ws + WS_SSQKV), (float*)(ws + WS_SSQPE)}), ws + WS_A, ws + WS_WIN, NZ, DM, DM, true));
    SEAM(1);
    const bool p1_first = ((blockIdx.x >> 3) & 1) != 0;
    if (p1_first) { PH(4, gla::pass1(C, lds_raw)); }
    PH(2, GEMM_PH2(EpiQ, ({(const float*)(ws + WS_SSQQ), C.q_head_norm, COS, SIN, (bf16*)(ws + WS_QF), EPS, QSCALE}), (const bf16*)(ws + WS_Z) + (ZC_CQ >> 5) * 512, ws + WS_WUQ, 1024, QRANK, NZ, false, true));
    __syncthreads();
    PH(3, GEMM_PH2(EpiKV, ({(const float*)(ws + WS_SSQKV), (const float*)(ws + WS_SSQPE), C.k_head_norm, COS, SIN, (const bf16*)(ws + WS_Z), (bf16*)(ws + WS_KF), (bf16*)(ws + WS_VF), EPS}), (const bf16*)(ws + WS_Z) + (ZC_CKV >> 5) * 512, ws + WS_WUKV, 1024, KVRANK, NZ, false, true));
    __syncthreads();
    if (!p1_first) { PH(4, gla::pass1(C, lds_raw)); }
    SEAM(4);
    PH(5, (gla_scan(C), p0_late_weights(C, lds)));
    SEAM(5);
    PH(6, att::attn_phase(C, (char*)lds_raw));
    PH(7, gla::pass2(C, lds_raw));
    SEAM(7);
    PH(8, GEMM_PH2(EpiOutProjG, ({C.x, C.out, (bf16*)(ws + WS_A), (float*)(ws + WS_SSQ)}), ws + WS_B, ws + WS_WO, DM, DM, DM, true, true));
    SEAM(8);
    if (IN(9)) {
        PG8_LAS float* rtab = (PG8_LAS float*)(L3 + 131072 + 1024);
        pg8::StaticOrder So; So.init(M, DFF, (int)gridDim.x, (int)blockIdx.x);
        for (int idx = threadIdx.x; idx < 4 * 256; idx += NT) { pg8::Unit uu; const int i = idx >> 8, row = idx & 255;
            if (So.next(i, uu)) { const f32x4* sp = (const f32x4*)(ws + WS_SSQ) + (size_t)(uu.pm * 256 + row) * 4; const f32x4 s4 = (sp[0] + sp[1]) + (sp[2] + sp[3]);
                rtab[idx] = __builtin_amdgcn_rsqf(((s4[0] + s4[1]) + (s4[2] + s4[3])) * (1.0f / DM) + EPS); } }
        __syncthreads();
    }
    PH(9, GEMM_PH2(EpiUpG, ({(const PG8_LAS float*)(L3 + 131072 + 1024), (bf16*)(ws + WS_H)}), ws + WS_A, ws + WS_WUP, DFF, DM, DM, true, true));
    SEAM(9);
    PH(10, GEMM_PH2(EpiDownG, ({(const bf16*)(ws + WS_A), C.out}), ws + WS_H, ws + WS_WDN, DM, DFF, DFF, true, true));

#undef IN
#undef SEAM
}

extern "C" void kernel_launch(void* const* d_in, const int* in_sizes, int n_in, void* d_out, int out_size, void* d_ws, size_t ws_size, hipStream_t stream) {
    static int grid = 0;
    if (grid == 0) {
        if (n_in != 17 || in_sizes[0] != M * DM || out_size != M * DM || ws_size < WS_END) { fprintf(stderr, "kernel_launch: unexpected shapes (n_in %d in0 %d out %d ws %zu)\n", n_in, n_in > 0 ? in_sizes[0] : -1, out_size, ws_size); grid = -1; return; }
        int dev = 0, cus = 0, per_cu = 0;
        if (hipGetDevice(&dev) != hipSuccess || hipDeviceGetAttribute(&cus, hipDeviceAttributeMultiprocessorCount, dev) != hipSuccess) { fprintf(stderr, "kernel_launch: device query failed\n"); grid = -1; return; }
        if (hipFuncSetAttribute((const void*)fwd_mega, hipFuncAttributeMaxDynamicSharedMemorySize, LDS_BYTES) != hipSuccess) { fprintf(stderr, "kernel_launch: hipFuncSetAttribute failed\n"); grid = -1; return; }
        if (hipOccupancyMaxActiveBlocksPerMultiprocessor(&per_cu, (const void*)fwd_mega, NT, LDS_BYTES) != hipSuccess || per_cu < 1) fprintf(stderr, "kernel_launch: note: occupancy query reports %d workgroups per CU\n", per_cu);
        (void)hipGetLastError();
        grid = cus;
    }
    if (grid < 0) return;
    Args a{};
    Ctx& C = a.C;
    C.x = (const float*)d_in[0]; C.pos = (const int*)d_in[1]; C.attn_norm = (const float*)d_in[2]; C.w_in = (const float*)d_in[3]; C.w_gate_up = (const float*)d_in[4];
    C.b_gate = (const float*)d_in[5]; C.gla_out_norm = (const float*)d_in[6]; C.q_a_norm = (const float*)d_in[7]; C.w_uq = (const float*)d_in[8]; C.kv_a_norm = (const float*)d_in[9];
    C.w_ukv = (const float*)d_in[10]; C.q_head_norm = (const float*)d_in[11]; C.k_head_norm = (const float*)d_in[12]; C.w_out = (const float*)d_in[13]; C.mlp_norm = (const float*)d_in[14];
    C.w_up = (const float*)d_in[15]; C.w_down = (const float*)d_in[16]; C.out = (float*)d_out; C.ws = (unsigned char*)d_ws;
    if (MK_SINGLE) {
        if (hipMemsetAsync((char*)d_ws + WS_CTL, 0, CTL_ZERO_BYTES, stream) != hipSuccess) { fprintf(stderr, "kernel_launch: memset failed\n"); return; }
        a.ph_lo = 0; a.ph_hi = NPHASE;
        hipLaunchKernelGGL(fwd_mega, dim3(grid), dim3(NT), LDS_BYTES, stream, a);
        if (DUPL(23)) { (void)hipMemsetAsync((char*)d_ws + WS_CTL, 0, CTL_ZERO_BYTES, stream); hipLaunchKernelGGL(fwd_mega, dim3(grid), dim3(NT), LDS_BYTES, stream, a); }
    } else {
        for (int s = 0; s < NPHASE; ++s) { a.ph_lo = s; a.ph_hi = s + 1; hipLaunchKernelGGL(fwd_mega, dim3(grid), dim3(NT), LDS_BYTES, stream, a); }
    }
}
```

```cpp
#include <hip/hip_runtime.h>
#include <cstdio>
#include <cstdint>
#ifndef DUP_MASK
#define DUP_MASK 0u
#endif
#define DUPL(k) (((DUP_MASK) >> (k)) & 1u)

constexpr int BATCH = 2, SEQ = 8192, DM = 1024, M = BATCH * SEQ;
constexpr int DPROJ = 1968, NZ = 2048, DFF = 4096;
constexpr int GH = 4, GDK = 64, GDV = 128, GRANK = 16, NCH = SEQ / 64;
constexpr int MH = 8, QRANK = 256, KVRANK = 128, NOPE = 64, ROPE = 32, MV = 64, DQK = 96;
constexpr float EPS = 1e-6f;
constexpr float QSCALE = 0.10206207261596577f * 1.4426950408889634f;
constexpr int ZC_Q = 0, ZC_K = 256, ZC_V = 512, ZC_G = 1024, ZC_CQ = 1536, ZC_CKV = 1792, ZC_KPE = 1920, ZC_GATE = 1952;
__host__ __device__ __forceinline__ size_t ztile(size_t r, int c) { return ((r >> 4) * 64 + (size_t)(c >> 5)) * 512 + (r & 15) * 32 + (c & 31); }

constexpr size_t MiB = 1u << 20;
constexpr size_t WS_CTL = 0;
constexpr size_t WS_WIN = 1 * MiB, WS_WUQ = 5 * MiB, WS_WUKV = 6 * MiB, WS_WO = 7 * MiB, WS_WUP = 9 * MiB, WS_WDN = 17 * MiB;
constexpr size_t WS_SSQ = 25 * MiB, WS_DEC = 512 * 1024, WS_COS = 26 * MiB, WS_SIN = 27 * MiB;
constexpr size_t CTL_ZERO_BYTES = 64 * 1024;
constexpr size_t WS_SSQQ = 5 * MiB + 512 * 1024, WS_SSQKV = 5 * MiB + 768 * 1024, WS_SSQPE = 6 * MiB + 512 * 1024;
constexpr size_t WS_A = 28 * MiB;
constexpr size_t WS_B = 60 * MiB;
constexpr size_t WS_Z = 92 * MiB;
constexpr size_t WS_QF = 156 * MiB, WS_AQ = 156 * MiB, WS_AKV = 164 * MiB, WS_KF = 180 * MiB, WS_VF = 204 * MiB;
constexpr size_t WS_CKV = 220 * MiB;
constexpr size_t WS_H = 92 * MiB;
constexpr size_t WS_END = 252 * MiB;

typedef unsigned short bf16;
typedef float f32x4 __attribute__((ext_vector_type(4)));
typedef unsigned u32x2 __attribute__((ext_vector_type(2)));
typedef unsigned u32x4 __attribute__((ext_vector_type(4)));

__device__ __forceinline__ float bf2f(unsigned b) { return __uint_as_float(b << 16); }
__device__ __forceinline__ unsigned f2bf(float f) { unsigned u = __float_as_uint(f); return (u + 0x7fffu + ((u >> 16) & 1u)) >> 16; }
typedef float f32x2c_t __attribute__((ext_vector_type(2))); typedef __bf16 bf16x2c_t __attribute__((ext_vector_type(2)));
__device__ __forceinline__ unsigned pk2(float lo, float hi) { f32x2c_t v = {lo, hi}; bf16x2c_t b = __builtin_convertvector(v, bf16x2c_t); return __builtin_bit_cast(unsigned, b); }
__device__ __forceinline__ float wave_sum(float v) {
#pragma unroll
    for (int o = 1; o < 64; o <<= 1) v += __shfl_xor(v, o);
    return v;
}

__device__ __forceinline__ unsigned otid() { unsigned t = threadIdx.x; asm volatile("" : "+v"(t)); return t; }

struct Ctx {
    const float* x; const int* pos; const float* attn_norm; const float* w_in; const float* w_gate_up; const float* b_gate; const float* gla_out_norm;
    const float* q_a_norm; const float* w_uq; const float* kv_a_norm; const float* w_ukv; const float* q_head_norm; const float* k_head_norm;
    const float* w_out; const float* mlp_norm; const float* w_up; const float* w_down;
    float* out; unsigned char* ws;
};
constexpr int NT = 512;

__device__ __forceinline__ int win_src_col(int n) {
    if (n < 1024) return n;
    if (n < 1536) return n - 1024 + 1040;
    if (n < 1792) return n - 1536 + 1552;
    if (n < 1920) return n - 1792 + 1808;
    if (n < 1952) return n - 1920 + 1936;
    if (n < 1968) return n - 1952 + 1024;
    return -1;
}
struct MapWin { __device__ __forceinline__ int operator()(int n) const { return win_src_col(n); } };
struct MapUq  { __device__ __forceinline__ int operator()(int n) const { const int h = n >> 7, j = n & 127; return j < DQK ? h * DQK + j : -1; } };
struct MapId  { __device__ __forceinline__ int operator()(int n) const { return n; } };
template <bool GAIN, class CMap>
__device__ __forceinline__ void p0_transpose_item(const float* W, int K, int Nsrc, int N, bf16* WT, const float* kgain, float* scr, int item, int lane, const CMap& cmap) {
    const int nblk = N / 32, kb = item / nblk, nb = item % nblk, k0 = 64 * kb, n0 = 32 * nb;
    const int sc = cmap(n0 + (lane & 31)); const float keep = sc >= 0 ? 1.f : 0.f; const int scc = sc >= 0 ? sc : 0;
    const float* wp = W + (size_t)(k0 + (lane >> 5)) * Nsrc + scc;
    float v[32];
#pragma unroll
    for (int i = 0; i < 32; ++i) v[i] = wp[(size_t)(2 * i) * Nsrc];
#pragma unroll
    for (int i = 0; i < 32; ++i) { const int kk = 2 * i + (lane >> 5); float t = v[i] * keep; if (GAIN) t *= kgain[k0 + kk]; scr[kk * 33 + (lane & 31)] = t; }
    asm volatile("s_waitcnt lgkmcnt(0)" ::: "memory");
    const int c = lane & 7;
#pragma unroll
    for (int j = 0; j < 4; ++j) { const int n = (lane >> 3) + 8 * j; const float* s = scr + (8 * c) * 33 + n;
        u32x4 o; o.x = pk2(s[0 * 33], s[1 * 33]); o.y = pk2(s[2 * 33], s[3 * 33]); o.z = pk2(s[4 * 33], s[5 * 33]); o.w = pk2(s[6 * 33], s[7 * 33]);
        *(u32x4*)(WT + ((size_t)((n0 + n) >> 4) * (K >> 5) + ((k0 + 8 * c) >> 5)) * 512 + ((n0 + n) & 15) * 32 + ((k0 + 8 * c) & 31)) = o; }
    asm volatile("s_waitcnt lgkmcnt(0)" ::: "memory");
}
__device__ __forceinline__ void p0_prologue(const Ctx& C, float* lds) {
    const size_t gt = (size_t)blockIdx.x * NT + otid(), GT = (size_t)gridDim.x * NT;
    bf16* win = (bf16*)(C.ws + WS_WIN); bf16* wuq = (bf16*)(C.ws + WS_WUQ); bf16* wukv = (bf16*)(C.ws + WS_WUKV);
    bf16* wo = (bf16*)(C.ws + WS_WO); bf16* wup = (bf16*)(C.ws + WS_WUP); bf16* wdn = (bf16*)(C.ws + WS_WDN);
    {   const int lane_ = otid() & 63, wv = otid() >> 6; float* scr = lds + wv * (64 * 33 + 32);
        const int gw_ = (int)(gt >> 6), NGW_ = (int)(GT >> 6);
        constexpr int I_IN = (DM / 64) * (NZ / 32), I_UQ = (QRANK / 64) * (1024 / 32), I_UKV = (KVRANK / 64) * (1024 / 32), I_O = (DM / 64) * (DM / 32), I_UP = (DM / 64) * (DFF / 32), I_DN = (DFF / 64) * (DM / 32);
        constexpr int NITEMS = I_IN + I_UQ + I_UKV;
        (void)wo; (void)wup; (void)wdn; (void)I_O; (void)I_UP; (void)I_DN;
        for (int it = gw_; it < NITEMS; it += NGW_) {
            int r = it;
            if (r < I_IN) { p0_transpose_item<false>(C.w_in, DM, DPROJ, NZ, win, nullptr, scr, r, lane_, MapWin{}); continue; } r -= I_IN;
            if (r < I_UQ) { p0_transpose_item<true>(C.w_uq, QRANK, MH * DQK, 1024, wuq, C.q_a_norm, scr, r, lane_, MapUq{}); continue; } r -= I_UQ;
            p0_transpose_item<true>(C.w_ukv, KVRANK, 1024, 1024, wukv, C.kv_a_norm, scr, r, lane_, MapId{});
        }
    }
    const int lane = otid() & 63; const int gw = (int)(gt >> 6), NGW = (int)(GT >> 6);
    bf16* XN = (bf16*)(C.ws + WS_A); float* COS = (float*)(C.ws + WS_COS); float* SIN = (float*)(C.ws + WS_SIN);
    f32x4 gn[4];
#pragma unroll
    for (int j = 0; j < 4; ++j) gn[j] = ((const f32x4*)C.attn_norm)[lane + 64 * j];
    for (int m = gw; m < M; m += 2 * NGW) {
        const int m2 = m + NGW;
        const f32x4* xa = (const f32x4*)(C.x + (size_t)m * DM) + lane; const f32x4* xb = (const f32x4*)(C.x + (size_t)(m2 < M ? m2 : m) * DM) + lane;
        f32x4 va[4], vb[4]; float sa = 0.f, sb = 0.f;
#pragma unroll
        for (int j = 0; j < 4; ++j) { va[j] = xa[64 * j]; vb[j] = xb[64 * j]; }
#pragma unroll
        for (int j = 0; j < 4; ++j) { sa += (va[j].x * va[j].x + va[j].y * va[j].y) + (va[j].z * va[j].z + va[j].w * va[j].w); sb += (vb[j].x * vb[j].x + vb[j].y * vb[j].y) + (vb[j].z * vb[j].z + vb[j].w * vb[j].w); }
        const float ra = rsqrtf(wave_sum(sa) * (1.f / DM) + EPS), rb = rsqrtf(wave_sum(sb) * (1.f / DM) + EPS);
        u32x2* oa = (u32x2*)(XN + (size_t)m * DM) + lane; u32x2* ob = (u32x2*)(XN + (size_t)m2 * DM) + lane;
#pragma unroll
        for (int j = 0; j < 4; ++j) { u32x2 w; w.x = pk2(va[j].x * ra * gn[j].x, va[j].y * ra * gn[j].y); w.y = pk2(va[j].z * ra * gn[j].z, va[j].w * ra * gn[j].w); oa[64 * j] = w; }
        if (m2 < M) {
#pragma unroll
            for (int j = 0; j < 4; ++j) { u32x2 w; w.x = pk2(vb[j].x * rb * gn[j].x, vb[j].y * rb * gn[j].y); w.y = pk2(vb[j].z * rb * gn[j].z, vb[j].w * rb * gn[j].w); ob[64 * j] = w; } }
    }
    for (size_t i = gt; i < (size_t)M * 16; i += GT) { const int m = (int)(i >> 4), f = (int)(i & 15);
        const float invf = exp2f(-(float)(2 * f) * (1.f / 32.f) * 13.287712379549449f);
        const float ang = (float)C.pos[m] * invf; float sn, cs; sincosf(ang, &sn, &cs); COS[i] = cs; SIN[i] = sn; }
}

__device__ __forceinline__ void p0_late_weights(const Ctx& C, float* lds) {
    const unsigned t = otid(); if (t < 256) return;
    bf16* wo = (bf16*)(C.ws + WS_WO); bf16* wup = (bf16*)(C.ws + WS_WUP); bf16* wdn = (bf16*)(C.ws + WS_WDN);
    const int lane_ = t & 63, wv = (t >> 6) - 4; float* scr = lds + wv * (64 * 33 + 32);
    const int gw_ = (int)blockIdx.x * 4 + wv, NGW_ = (int)gridDim.x * 4;
    constexpr int I_O = (DM / 64) * (DM / 32), I_UP = (DM / 64) * (DFF / 32), I_DN = (DFF / 64) * (DM / 32);
    for (int it = gw_; it < I_O + I_UP + I_DN; it += NGW_) {
        int r = it;
        if (r < I_UP) { p0_transpose_item<true>(C.w_up, DM, DFF, DFF, wup, C.mlp_norm, scr, r, lane_, MapId{}); continue; } r -= I_UP;
        if (r < I_DN) { p0_transpose_item<false>(C.w_down, DFF, DM, DM, wdn, nullptr, scr, r, lane_, MapId{}); continue; } r -= I_DN;
        p0_transpose_item<false>(C.w_out, DM, DM, DM, wo, nullptr, scr, r, lane_, MapId{});
    }
}

__device__ __forceinline__ void unpack8(const u32x4 w, float (&v)[8]) { v[0] = bf2f(w.x & 0xffffu); v[1] = bf2f(w.x >> 16); v[2] = bf2f(w.y & 0xffffu); v[3] = bf2f(w.y >> 16);
    v[4] = bf2f(w.z & 0xffffu); v[5] = bf2f(w.z >> 16); v[6] = bf2f(w.w & 0xffffu); v[7] = bf2f(w.w >> 16); }
__device__ __forceinline__ u32x4 pack8(const float (&v)[8]) { u32x4 w; w.x = pk2(v[0], v[1]); w.y = pk2(v[2], v[3]); w.z = pk2(v[4], v[5]); w.w = pk2(v[6], v[7]); return w; }
constexpr float LOG2E = 1.4426950408889634f, LN2 = 0.6931471805599453f;
__device__ __forceinline__ float fexp(float x) { return __builtin_amdgcn_exp2f(x * LOG2E); }
__device__ __forceinline__ float log_gate(float gl) { const float ls = fminf(gl, 0.f) - LN2 * __builtin_amdgcn_logf(1.f + fexp(-fabsf(gl))); return fmaxf(ls * (1.f / 16.f), -1.f); }
__device__ __forceinline__ float silu_f(float g) { return g * __builtin_amdgcn_rcpf(1.f + fexp(-g)); }
__device__ __forceinline__ void gla_scan(const Ctx& C) {
    const float* CKV = (const float*)(C.ws + WS_CKV); const float* DEC = (const float*)(C.ws + WS_DEC); bf16* PREV = (bf16*)(C.ws + WS_A);
    if (otid() >= 256) return;
    for (int e = blockIdx.x * 256 + otid(); e < BATCH * GH * 128 * 64; e += gridDim.x * 256) {
        const int d = e & 63, v = (e >> 6) & 127, bh = e >> 13; float st = 0.f;
        for (int n0 = 0; n0 < NCH; n0 += 16) {
            float cv[16], dv[16];
#pragma unroll
            for (int i = 0; i < 16; ++i) { const size_t u = (size_t)bh * NCH + n0 + i; cv[i] = CKV[(u * 128 + v) * 64 + d]; dv[i] = DEC[u * 64 + d]; }
#pragma unroll
            for (int i = 0; i < 16; ++i) { const size_t u = (size_t)bh * NCH + n0 + i; PREV[(u * 128 + v) * 64 + d] = (bf16)f2bf(st); st = dv[i] * st + cv[i]; }
        }
    }
}

namespace att {
typedef short bf16x8 __attribute__((ext_vector_type(8)));
typedef short s16x4 __attribute__((ext_vector_type(4)));
typedef float f32x16 __attribute__((ext_vector_type(16)));
typedef __attribute__((address_space(3))) const char* lds_cptr;
constexpr int KSLOT = 12288, VSLOT = 8192, LDS_K = 0, LDS_V = 3 * KSLOT, LDS_WS = LDS_V + 3 * VSLOT, LDS_OST = LDS_WS + 8 * 256, LDS_TOTAL = LDS_OST + 8 * 4096;
constexpr int QP = MH * DQK, VP = MH * MV;
#define ATT_SBAR() __builtin_amdgcn_sched_barrier(0)
__device__ __forceinline__ int crow(int r, int hi) { return (r & 3) + 8 * (r >> 2) + 4 * hi; }
__device__ __forceinline__ void glds16(const void* gsrc, unsigned lds_dst) { unsigned keep;
    asm volatile("s_mov_b32 %0, m0\n\ts_mov_b32 m0, %2\n\ts_nop 0\n\tglobal_load_lds_dwordx4 %1, off\n\ts_mov_b32 m0, %0" : "=&s"(keep) : "v"(gsrc), "s"(lds_dst) : "memory"); }
typedef float f32x2_t __attribute__((ext_vector_type(2))); typedef __bf16 bf16x2_t __attribute__((ext_vector_type(2)));
__device__ __forceinline__ unsigned cvtpk_s(float lo, float hi) { f32x2_t v = {lo, hi}; bf16x2_t b = __builtin_convertvector(v, bf16x2_t); return __builtin_bit_cast(unsigned, b); }
typedef short att_v4i16 __attribute__((ext_vector_type(4)));
__device__ __forceinline__ s16x4 vtr(lds_cptr p) { return __builtin_bit_cast(s16x4, __builtin_amdgcn_ds_read_tr16_b64_v4i16((__attribute__((address_space(3))) att_v4i16*)p)); }
#define ATT_MX3(a, b, c) __builtin_fmaxf(__builtin_fmaxf((a), (b)), (c))
__device__ __forceinline__ float rowmax(const f32x16& p0, const f32x16& p1) {
    float a = ATT_MX3(p0[0], p0[1], p1[0]), b = ATT_MX3(p0[2], p0[3], p1[1]); a = ATT_MX3(a, p1[2], p1[3]);
#pragma unroll
    for (int r = 4; r < 16; r += 4) { a = ATT_MX3(a, p0[r], p0[r + 1]); b = ATT_MX3(b, p0[r + 2], p0[r + 3]); a = ATT_MX3(a, p1[r], p1[r + 1]); b = ATT_MX3(b, p1[r + 2], p1[r + 3]); }
    float m = __builtin_fmaxf(a, b); auto rr = __builtin_amdgcn_permlane32_swap(__float_as_uint(m), __float_as_uint(m), false, false);
    return __builtin_fmaxf(__uint_as_float(rr[0]), __uint_as_float(rr[1])); }
__device__ __forceinline__ void pv(f32x16* o, int vb, bf16x8 pa0, bf16x8 pa1, bf16x8 pa2, bf16x8 pa3) {
#pragma unroll
    for (int d0 = 0; d0 < 2; ++d0) { s16x4 lo[4], hi[4];
#pragma unroll
        for (int ks = 0; ks < 4; ++ks) {
            asm volatile("ds_read_b64_tr_b16 %0,%1 offset:%c2" : "=&v"(lo[ks]) : "v"(vb), "i"(d0 * 4096 + ks * 1024) : "memory");
            asm volatile("ds_read_b64_tr_b16 %0,%1 offset:%c2" : "=&v"(hi[ks]) : "v"(vb), "i"(d0 * 4096 + ks * 1024 + 512) : "memory"); }
        asm volatile("s_waitcnt lgkmcnt(0)" ::: "memory"); ATT_SBAR();
#define ATT_PK(k) (bf16x8){lo[k][0], lo[k][1], lo[k][2], lo[k][3], hi[k][0], hi[k][1], hi[k][2], hi[k][3]}
        o[d0] = __builtin_amdgcn_mfma_f32_32x32x16_bf16(pa0, ATT_PK(0), o[d0], 0, 0, 0);
        o[d0] = __builtin_amdgcn_mfma_f32_32x32x16_bf16(pa1, ATT_PK(1), o[d0], 0, 0, 0);
        o[d0] = __builtin_amdgcn_mfma_f32_32x32x16_bf16(pa2, ATT_PK(2), o[d0], 0, 0, 0);
        o[d0] = __builtin_amdgcn_mfma_f32_32x32x16_bf16(pa3, ATT_PK(3), o[d0], 0, 0, 0);
#undef ATT_PK
    }
}
#define ATT_WAIT_BAR0() asm volatile("s_waitcnt vmcnt(0) lgkmcnt(0)\n\ts_barrier" ::: "memory")
template <int THRL>
__device__ __forceinline__ void attn_unit(int b, int h, int qb, const bf16* Q, const bf16* K, const bf16* V, bf16* O, char* shm) {
    const int tid = threadIdx.x, lane = tid & 63, r32 = lane & 31, hi = lane >> 5; const int wid = __builtin_amdgcn_readfirstlane(tid >> 6);
    const long rowbase = (long)b * SEQ; const int q0 = qb * 256; const int NTL = 4 * qb + 4, tmax = 4 * qb + (wid >> 1);
    const bf16* Qw = Q + (rowbase + q0 + wid * 32) * QP + h * DQK;
    const long bh = (long)b * MH + h;
    const bf16* ksrc0 = K + (bh * 128 * 12 + wid) * 512 + lane * 8;
    const bf16* ksrc1 = K + (bh * 128 * 12 + 8 + (wid & 3)) * 512 + lane * 8;
    const bf16* vsrc = V + (bh * 128 * 2 + (wid >> 2)) * 2048 + (16 * (wid & 3) + (lane >> 2)) * 32 + (lane & 3) * 8;
    const unsigned lds0 = (unsigned)(uintptr_t)shm;
    const unsigned kdst0 = lds0 + LDS_K + wid * 1024, kdst1 = lds0 + LDS_K + (8 + (wid & 3)) * 1024, vdst = lds0 + LDS_V + wid * 1024;
    float* wsf = (float*)(shm + LDS_WS) + wid * 64;
#define ATT_DMA(t, s) do { glds16(ksrc0 + (long)(t) * 6144, (unsigned)__builtin_amdgcn_readfirstlane(kdst0 + (s) * KSLOT)); \
        if (wid < 4) glds16(ksrc1 + (long)(t) * 6144, (unsigned)__builtin_amdgcn_readfirstlane(kdst1 + (s) * KSLOT)); \
        glds16(vsrc + (long)(t) * 4096, (unsigned)__builtin_amdgcn_readfirstlane(vdst + (s) * VSLOT)); } while (0)
    ATT_DMA(0, 0);
    bf16x8 qr[6];
#pragma unroll
    for (int d0 = 0; d0 < 6; ++d0) qr[d0] = *reinterpret_cast<const bf16x8*>(&Qw[(long)r32 * QP + d0 * 16 + hi * 8]);
    float mhat = 0.f, l_reg = 0.f; f32x16 o[2]; o[0] = f32x16{}; o[1] = f32x16{}; f32x16 negm = f32x16{}; asm volatile("" : "+v"(negm));
    const lds_cptr shm3 = (lds_cptr)shm;
    const int vlane = ((lane >> 4) & 1) * 32 + (lane & 3) * 8 + (4 * hi + ((lane & 15) >> 2)) * 64;
    u32x4 pw0 = (u32x4){0u, 0u, 0u, 0u}, pw1 = pw0, pw2 = pw0, pw3 = pw0;
    s16x4 vlo[8], vhi[8];
#define ATT_KRD(slot, d0) do { ka[slot] = *(const __attribute__((address_space(3))) bf16x8*)(kp + (d0) * 2048); kb[slot] = *(const __attribute__((address_space(3))) bf16x8*)(kp + (d0) * 2048 + 512); } while (0)
#define ATT_VRD(i) do { vlo[i] = vtr(vp + (((i) >> 2) * 4096 + ((i) & 3) * 1024)); vhi[i] = vtr(vp + (((i) >> 2) * 4096 + ((i) & 3) * 1024 + 512)); } while (0)
#define ATT_QKSM(t, s) do { \
        const lds_cptr kp = shm3 + LDS_K + (s) * KSLOT + hi * 1024 + r32 * 16; const lds_cptr vp = shm3 + LDS_V + (s) * VSLOT + vlane; \
        f32x16 p0, p1; bf16x8 ka[3], kb[3]; \
        ATT_KRD(0, 0); ATT_KRD(1, 1); ATT_SBAR(); \
        ATT_KRD(2, 2); p0 = __builtin_amdgcn_mfma_f32_32x32x16_bf16(ka[0], qr[0], negm, 0, 0, 0); p1 = __builtin_amdgcn_mfma_f32_32x32x16_bf16(kb[0], qr[0], negm, 0, 0, 0); ATT_VRD(0); ATT_VRD(1); ATT_SBAR(); \
        ATT_KRD(0, 3); p0 = __builtin_amdgcn_mfma_f32_32x32x16_bf16(ka[1], qr[1], p0, 0, 0, 0); p1 = __builtin_amdgcn_mfma_f32_32x32x16_bf16(kb[1], qr[1], p1, 0, 0, 0); ATT_VRD(2); ATT_VRD(3); ATT_SBAR(); \
        ATT_KRD(1, 4); p0 = __builtin_amdgcn_mfma_f32_32x32x16_bf16(ka[2], qr[2], p0, 0, 0, 0); p1 = __builtin_amdgcn_mfma_f32_32x32x16_bf16(kb[2], qr[2], p1, 0, 0, 0); ATT_VRD(4); ATT_VRD(5); ATT_SBAR(); \
        ATT_KRD(2, 5); p0 = __builtin_amdgcn_mfma_f32_32x32x16_bf16(ka[0], qr[3], p0, 0, 0, 0); p1 = __builtin_amdgcn_mfma_f32_32x32x16_bf16(kb[0], qr[3], p1, 0, 0, 0); ATT_VRD(6); ATT_VRD(7); ATT_SBAR(); \
        p0 = __builtin_amdgcn_mfma_f32_32x32x16_bf16(ka[1], qr[4], p0, 0, 0, 0); p1 = __builtin_amdgcn_mfma_f32_32x32x16_bf16(kb[1], qr[4], p1, 0, 0, 0); ATT_SBAR(); \
        p0 = __builtin_amdgcn_mfma_f32_32x32x16_bf16(ka[2], qr[5], p0, 0, 0, 0); p1 = __builtin_amdgcn_mfma_f32_32x32x16_bf16(kb[2], qr[5], p1, 0, 0, 0); ATT_SBAR(); \
        const float rm = rowmax(p0, p1); \
        if ((t) == 0) { mhat = rm; \
            _Pragma("unroll") for (int r = 0; r < 16; ++r) { p0[r] -= rm; p1[r] -= rm; } \
            _Pragma("unroll") for (int r = 0; r < 16; ++r) negm[r] = -mhat; \
            asm volatile("" : "+v"(negm)); \
        } else if (__any(rm > (float)THRL)) { const float dl = __builtin_fmaxf(rm, 0.f); mhat += dl; \
            _Pragma("unroll") for (int r = 0; r < 16; ++r) { p0[r] -= dl; p1[r] -= dl; } \
            _Pragma("unroll") for (int r = 0; r < 16; ++r) negm[r] = -mhat; \
            asm volatile("" : "+v"(negm)); \
            const float f = __builtin_amdgcn_exp2f(-dl); l_reg *= f; if (hi == 0) wsf[r32] = f; \
            asm volatile("s_waitcnt lgkmcnt(0)" ::: "memory"); \
            _Pragma("unroll") for (int d_ = 0; d_ < 2; ++d_) _Pragma("unroll") for (int r = 0; r < 16; ++r) o[d_][r] *= wsf[crow(r, hi)]; } \
        float sacc = 0.f; \
        _Pragma("unroll") for (int r = 0; r < 16; ++r) { p0[r] = __builtin_amdgcn_exp2f(p0[r]); p1[r] = __builtin_amdgcn_exp2f(p1[r]); sacc += p0[r] + p1[r]; } \
        l_reg += sacc; \
        pw0 = (u32x4){cvtpk_s(p0[0], p0[1]), cvtpk_s(p0[2], p0[3]), cvtpk_s(p0[4], p0[5]), cvtpk_s(p0[6], p0[7])}; \
        pw1 = (u32x4){cvtpk_s(p0[8], p0[9]), cvtpk_s(p0[10], p0[11]), cvtpk_s(p0[12], p0[13]), cvtpk_s(p0[14], p0[15])}; \
        pw2 = (u32x4){cvtpk_s(p1[0], p1[1]), cvtpk_s(p1[2], p1[3]), cvtpk_s(p1[4], p1[5]), cvtpk_s(p1[6], p1[7])}; \
        pw3 = (u32x4){cvtpk_s(p1[8], p1[9]), cvtpk_s(p1[10], p1[11]), cvtpk_s(p1[12], p1[13]), cvtpk_s(p1[14], p1[15])}; \
    } while (0)
#define ATT_VFR(i) (bf16x8){vlo[i][0], vlo[i][1], vlo[i][2], vlo[i][3], vhi[i][0], vhi[i][1], vhi[i][2], vhi[i][3]}
#define ATT_PV(s) do { ATT_SBAR(); \
        o[0] = __builtin_amdgcn_mfma_f32_32x32x16_bf16(__builtin_bit_cast(bf16x8, pw0), ATT_VFR(0), o[0], 0, 0, 0); o[1] = __builtin_amdgcn_mfma_f32_32x32x16_bf16(__builtin_bit_cast(bf16x8, pw0), ATT_VFR(4), o[1], 0, 0, 0); \
        o[0] = __builtin_amdgcn_mfma_f32_32x32x16_bf16(__builtin_bit_cast(bf16x8, pw1), ATT_VFR(1), o[0], 0, 0, 0); o[1] = __builtin_amdgcn_mfma_f32_32x32x16_bf16(__builtin_bit_cast(bf16x8, pw1), ATT_VFR(5), o[1], 0, 0, 0); \
        o[0] = __builtin_amdgcn_mfma_f32_32x32x16_bf16(__builtin_bit_cast(bf16x8, pw2), ATT_VFR(2), o[0], 0, 0, 0); o[1] = __builtin_amdgcn_mfma_f32_32x32x16_bf16(__builtin_bit_cast(bf16x8, pw2), ATT_VFR(6), o[1], 0, 0, 0); \
        o[0] = __builtin_amdgcn_mfma_f32_32x32x16_bf16(__builtin_bit_cast(bf16x8, pw3), ATT_VFR(3), o[0], 0, 0, 0); o[1] = __builtin_amdgcn_mfma_f32_32x32x16_bf16(__builtin_bit_cast(bf16x8, pw3), ATT_VFR(7), o[1], 0, 0, 0); \
    } while (0)
    int s_cur = 0, s_prev = 2;
    if (wid < 4) __builtin_amdgcn_s_setprio(1);
    if (wid < 4) {
        for (int t = 0; t < NTL; ++t) {
            ATT_WAIT_BAR0();
            const int s_next = (s_cur == 2) ? 0 : s_cur + 1;
            if (t + 1 < NTL) ATT_DMA(t + 1, s_next);
            if (t <= tmax) { ATT_QKSM(t, s_cur); ATT_PV(s_cur); }
            s_prev = s_cur; s_cur = s_next;
        }
    } else {
        for (int t = 0; t < NTL; ++t) {
            ATT_WAIT_BAR0();
            const int s_next = (s_cur == 2) ? 0 : s_cur + 1;
            if (t + 1 < NTL) ATT_DMA(t + 1, s_next);
            if (t >= 1 && t - 1 <= tmax) ATT_PV(s_prev);
            if (t <= tmax) ATT_QKSM(t, s_cur);
            s_prev = s_cur; s_cur = s_next;
        }
        if (NTL - 1 <= tmax) ATT_PV(s_prev);
    }
    __builtin_amdgcn_s_setprio(0);
    { auto rr = __builtin_amdgcn_permlane32_swap(__float_as_uint(l_reg), __float_as_uint(l_reg), false, false); l_reg = __uint_as_float(rr[0]) + __uint_as_float(rr[1]); }
    if (hi == 0) wsf[32 + r32] = l_reg;
    asm volatile("s_waitcnt lgkmcnt(0)" ::: "memory");
    float rli[16];
#pragma unroll
    for (int r = 0; r < 16; ++r) rli[r] = __builtin_amdgcn_rcpf(wsf[32 + crow(r, hi)]);
    const long orow0 = rowbase + q0 + wid * 32; const int ocol0 = 512 + h * MV;
    { bf16* stg = (bf16*)(shm + LDS_OST) + wid * 2048;
#pragma unroll
        for (int r = 0; r < 16; ++r) { const int orow = crow(r, hi);
#pragma unroll
            for (int d0 = 0; d0 < 2; ++d0) stg[orow * 64 + d0 * 32 + r32] = (bf16)f2bf(o[d0][r] * rli[r]); }
        asm volatile("s_waitcnt lgkmcnt(0)" ::: "memory");
#pragma unroll
        for (int i = 0; i < 4; ++i) { const int row = i * 8 + (lane >> 3), ch = lane & 7; const u32x4 v = *(const u32x4*)(stg + row * 64 + ch * 8); const long r = orow0 + row; const int c = ocol0 + ch * 8;
            *(u32x4*)(O + ((r >> 4) * 32 + (c >> 5)) * 512 + (r & 15) * 32 + (c & 31)) = v; } }
    asm volatile("s_waitcnt lgkmcnt(0)\n\ts_barrier" ::: "memory");
#undef ATT_DMA
#undef ATT_QKSM
#undef ATT_KRD
#undef ATT_VRD
#undef ATT_VFR
#undef ATT_PV
}
__device__ __forceinline__ void attn_phase(const Ctx& C, char* lds) {
    const bf16* QF = (const bf16*)(C.ws + WS_QF); const bf16* KF = (const bf16*)(C.ws + WS_KF); const bf16* VF = (const bf16*)(C.ws + WS_VF); bf16* O = (bf16*)(C.ws + WS_B);
    const int G = (int)gridDim.x, bx = (int)blockIdx.x; const int vcu = (G % 8 == 0) ? (bx % 8) * (G / 8) + bx / 8 : bx;
    for (int i = vcu; i < BATCH * MH * 32; i += G) { const int bh = (i & 255) >> 4, s = i & 15, qb = (i < 256) ? 31 - s : s;
        attn_unit<8>(bh >> 3, bh & 7, qb, QF, KF, VF, O, lds); }
    __syncthreads();
}
}

namespace gla {
using att::bf16x8; using att::s16x4; using att::f32x16; using att::lds_cptr; using att::crow; using att::cvtpk_s;
constexpr int L_VIMG = 0, L_QIMG = 16384, L_KIMG = 24576, L_WT = 32768, L_OBUF = 36864, OLD = 132, L_WG = 73728, L_BG = L_WG + 16384;
#define GLA_BAR() asm volatile("s_waitcnt lgkmcnt(0)\n\ts_barrier" ::: "memory")
__device__ __forceinline__ void stage_gate(const Ctx& C, unsigned char* lds) {
    const int tid = threadIdx.x;
#pragma unroll
    for (int i = 0; i < 2; ++i) *(f32x4*)(lds + L_WG + (tid + NT * i) * 16) = *(const f32x4*)(C.w_gate_up + (tid + NT * i) * 4);
    if (tid < 64) *(f32x4*)(lds + L_BG + tid * 16) = *(const f32x4*)(C.b_gate + tid * 4);
}
__device__ __forceinline__ void cum_rows(const u32x4 g0, const u32x4 g1, int h, const unsigned char* lds, float (&cum)[8], float (&tot)[8]) {
    const int tid = threadIdx.x, lane = tid & 63; const int wv = __builtin_amdgcn_readfirstlane(tid >> 6);
    float zg[16];
    { float a[8], b[8]; unpack8(g0, a); unpack8(g1, b);
#pragma unroll
      for (int j = 0; j < 8; ++j) { zg[j] = a[j]; zg[8 + j] = b[j]; } }
    float x[8];
    { const f32x4 b0 = *(const f32x4*)(lds + L_BG + (h * 64 + 8 * wv) * 4), b1 = *(const f32x4*)(lds + L_BG + (h * 64 + 8 * wv + 4) * 4);
      x[0] = b0.x; x[1] = b0.y; x[2] = b0.z; x[3] = b0.w; x[4] = b1.x; x[5] = b1.y; x[6] = b1.z; x[7] = b1.w; }
#pragma unroll
    for (int gh = 0; gh < 2; ++gh) { f32x4 w0[8], w1[8];
#pragma unroll
        for (int g = 0; g < 8; ++g) { w0[g] = *(const f32x4*)(lds + L_WG + ((gh * 8 + g) * 256 + h * 64 + 8 * wv) * 4); w1[g] = *(const f32x4*)(lds + L_WG + ((gh * 8 + g) * 256 + h * 64 + 8 * wv + 4) * 4); }
#pragma unroll
        for (int g = 0; g < 8; ++g) { const float z = zg[gh * 8 + g];
            x[0] += z * w0[g].x; x[1] += z * w0[g].y; x[2] += z * w0[g].z; x[3] += z * w0[g].w; x[4] += z * w1[g].x; x[5] += z * w1[g].y; x[6] += z * w1[g].z; x[7] += z * w1[g].w; } }
#pragma unroll
    for (int j = 0; j < 8; ++j) x[j] = log_gate(x[j]);
#define GLA_DPP(v, ctrl, rmask) __builtin_bit_cast(float, __builtin_amdgcn_update_dpp(0, __builtin_bit_cast(int, (v)), (ctrl), (rmask), 0xF, true))
#pragma unroll
    for (int j = 0; j < 8; ++j) { float v = x[j];
        v += GLA_DPP(v, 0x111, 0xF); v += GLA_DPP(v, 0x112, 0xF); v += GLA_DPP(v, 0x114, 0xF); v += GLA_DPP(v, 0x118, 0xF);
        v += GLA_DPP(v, 0x142, 0xA); v += GLA_DPP(v, 0x143, 0xC);
        cum[j] = v; tot[j] = __builtin_bit_cast(float, __builtin_amdgcn_readlane(__builtin_bit_cast(int, v), 63)); }
#undef GLA_DPP
}
__device__ __forceinline__ void trfrag4(int base, bf16x8 (&f)[4]) {
    s16x4 lo[4], hi[4];
#pragma unroll
    for (int ks = 0; ks < 4; ++ks) {
        asm volatile("ds_read_b64_tr_b16 %0,%1 offset:%c2" : "=&v"(lo[ks]) : "v"(base), "i"(ks * 1024) : "memory");
        asm volatile("ds_read_b64_tr_b16 %0,%1 offset:%c2" : "=&v"(hi[ks]) : "v"(base), "i"(ks * 1024 + 512) : "memory"); }
    asm volatile("s_waitcnt lgkmcnt(0)" ::: "memory"); __builtin_amdgcn_sched_barrier(0);
#pragma unroll
    for (int ks = 0; ks < 4; ++ks) f[ks] = (bf16x8){lo[ks][0], lo[ks][1], lo[ks][2], lo[ks][3], hi[ks][0], hi[ks][1], hi[ks][2], hi[ks][3]};
}
struct Raw { u32x4 q, k, v0, v1, g0, g1, z0, z1; bf16x8 pf[4]; };
template <bool P2>
__device__ __forceinline__ void load_raw(const Ctx& C, int u, Raw& R) {
    const bf16* Z = (const bf16*)(C.ws + WS_Z); const bf16* PREV = (const bf16*)(C.ws + WS_A);
    const int tid = threadIdx.x, lane = tid & 63, r32 = lane & 31, hi = lane >> 5, c = tid >> 3, dc = tid & 7; const int wv = __builtin_amdgcn_readfirstlane(tid >> 6);
    const int n = u % NCH, h = (u / NCH) % GH, b = u / (NCH * GH); const int row0 = b * SEQ + n * 64;
    const size_t rl_ = (size_t)(row0 + lane);
    R.k = *(const u32x4*)(Z + ztile(rl_, ZC_K + h * 64 + 8 * wv)); R.g0 = *(const u32x4*)(Z + ztile(rl_, ZC_GATE)); R.g1 = *(const u32x4*)(Z + ztile(rl_, ZC_GATE + 8));
    { const int j = tid >> 4, cc = tid & 15; R.v0 = *(const u32x4*)(Z + ztile((size_t)(row0 + j), ZC_V + h * 128 + cc * 8)); R.v1 = *(const u32x4*)(Z + ztile((size_t)(row0 + 32 + j), ZC_V + h * 128 + cc * 8)); }
    if (P2) { R.q = *(const u32x4*)(Z + ztile(rl_, ZC_Q + h * 64 + 8 * wv)); const size_t rc_ = (size_t)(row0 + c); R.z0 = *(const u32x4*)(Z + ztile(rc_, ZC_G + h * 128 + 16 * dc)); R.z1 = *(const u32x4*)(Z + ztile(rc_, ZC_G + h * 128 + 16 * dc + 8));
        const int cb = wv & 3;
#pragma unroll
        for (int s = 0; s < 4; ++s) R.pf[s] = *(const bf16x8*)(PREV + ((size_t)u * 128 + 32 * cb + r32) * 64 + 16 * s + 8 * hi); }
}
__device__ __forceinline__ void store_vimg(const Raw& R, unsigned char* lds) {
    const int tid = threadIdx.x, j = tid >> 4, cc = tid & 15;
    *(u32x4*)(lds + L_VIMG + (cc >> 2) * 4096 + j * 64 + (cc & 3) * 16) = R.v0; *(u32x4*)(lds + L_VIMG + (cc >> 2) * 4096 + (32 + j) * 64 + (cc & 3) * 16) = R.v1;
}
__device__ __forceinline__ void pass1(const Ctx& C, unsigned char* lds) {
    float* CKV = (float*)(C.ws + WS_CKV); float* DEC = (float*)(C.ws + WS_DEC);
    const int tid = threadIdx.x, lane = tid & 63, r32 = lane & 31, hi = lane >> 5, c = tid >> 3, dc = tid & 7; const int wv = __builtin_amdgcn_readfirstlane(tid >> 6);
    const unsigned lds0 = (unsigned)(uintptr_t)lds; const int lpart = ((lane >> 4) & 1) * 32 + (lane & 3) * 8 + (4 * hi + ((lane & 15) >> 2)) * 64;
    const int NU = BATCH * GH * NCH, G = (int)gridDim.x;
    __syncthreads(); stage_gate(C, lds);
    Raw cur; if ((int)blockIdx.x < NU) load_raw<false>(C, (int)blockIdx.x, cur);
    for (int u = blockIdx.x; u < NU; u += G) {
        const int h = (u / NCH) % GH;
        Raw nxt = cur; if (u + G < NU) load_raw<false>(C, u + G, nxt);
        GLA_BAR();
        store_vimg(cur, lds);
        float kv[8]; unpack8(cur.k, kv);
        float cum[8], tot[8]; cum_rows(cur.g0, cur.g1, h, lds, cum, tot);
#pragma unroll
        for (int j = 0; j < 8; ++j) kv[j] *= fexp(tot[j] - cum[j]);
        *(u32x4*)(lds + L_QIMG + (wv >> 2) * 4096 + lane * 64 + (wv & 3) * 16) = pack8(kv);
        if (lane == 63) {
#pragma unroll
            for (int j = 0; j < 8; ++j) DEC[(size_t)u * 64 + 8 * wv + j] = fexp(tot[j]); }
        GLA_BAR();
        const int vb = wv >> 1, db = wv & 1;
        bf16x8 af[4], bfr[4]; trfrag4((int)(lds0 + L_VIMG + vb * 4096) + lpart, af); trfrag4((int)(lds0 + L_QIMG + db * 4096) + lpart, bfr);
        f32x16 o = f32x16{};
#pragma unroll
        for (int ks = 0; ks < 4; ++ks) o = __builtin_amdgcn_mfma_f32_32x32x16_bf16(af[ks], bfr[ks], o, 0, 0, 0);
#pragma unroll
        for (int r = 0; r < 16; ++r) CKV[((size_t)u * 128 + 32 * vb + crow(r, hi)) * 64 + 32 * db + r32] = o[r];
        cur = nxt;
    }
    __syncthreads();
}
__device__ __forceinline__ void pass2(const Ctx& C, unsigned char* lds) {
    bf16* MIX = (bf16*)(C.ws + WS_B);
    const int tid = threadIdx.x, lane = tid & 63, r32 = lane & 31, hi = lane >> 5, c = tid >> 3, dc = tid & 7; const int wv = __builtin_amdgcn_readfirstlane(tid >> 6);
    const unsigned lds0 = (unsigned)(uintptr_t)lds; const int lpart = ((lane >> 4) & 1) * 32 + (lane & 3) * 8 + (4 * hi + ((lane & 15) >> 2)) * 64;
    const lds_cptr L3 = (lds_cptr)lds; float* obuf = (float*)(lds + L_OBUF);
    const int rb = wv >> 2, cb = wv & 3;
    const int NU = BATCH * GH * NCH, G = (int)gridDim.x;
    f32x4 gn[4];
#pragma unroll
    for (int i = 0; i < 4; ++i) gn[i] = *(const f32x4*)(C.gla_out_norm + 16 * dc + 4 * i);
    __syncthreads(); stage_gate(C, lds);
    Raw cur; if ((int)blockIdx.x < NU) load_raw<true>(C, (int)blockIdx.x, cur);
    for (int u = blockIdx.x; u < NU; u += G) {
        const int n = u % NCH, h = (u / NCH) % GH, b = u / (NCH * GH); const int row0 = b * SEQ + n * 64;
        Raw nxt = cur; if (u + G < NU) load_raw<true>(C, u + G, nxt);
        GLA_BAR();
        store_vimg(cur, lds);
        float qv[8], kv[8]; unpack8(cur.q, qv); unpack8(cur.k, kv);
        float cum[8], tot[8]; cum_rows(cur.g0, cur.g1, h, lds, cum, tot);
#pragma unroll
        for (int j = 0; j < 8; ++j) { qv[j] *= 0.125f * fexp(cum[j]); kv[j] *= fexp(-cum[j]); }
        *(u32x4*)(lds + L_QIMG + wv * 1024 + lane * 16) = pack8(qv); *(u32x4*)(lds + L_KIMG + wv * 1024 + lane * 16) = pack8(kv);
        GLA_BAR();
        bf16x8 qr[4];
#pragma unroll
        for (int s = 0; s < 4; ++s) qr[s] = *(const __attribute__((address_space(3))) bf16x8*)(L3 + L_QIMG + (2 * s + hi) * 1024 + (32 * rb + r32) * 16);
        f32x16 p0 = f32x16{}, p1 = f32x16{};
#pragma unroll
        for (int s = 0; s < 4; ++s) { const lds_cptr kp = L3 + L_KIMG + (2 * s + hi) * 1024 + r32 * 16;
            const bf16x8 a0 = *(const __attribute__((address_space(3))) bf16x8*)(kp), a1 = *(const __attribute__((address_space(3))) bf16x8*)(kp + 512);
            p0 = __builtin_amdgcn_mfma_f32_32x32x16_bf16(a0, qr[s], p0, 0, 0, 0); p1 = __builtin_amdgcn_mfma_f32_32x32x16_bf16(a1, qr[s], p1, 0, 0, 0); }
        const int cq = 32 * rb + r32;
#pragma unroll
        for (int r = 0; r < 16; ++r) { const int j = crow(r, hi); p0[r] = (j <= cq) ? p0[r] : 0.f; p1[r] = (j + 32 <= cq) ? p1[r] : 0.f; }
        u32x4 pw0, pw1, pw2, pw3;
        pw0 = (u32x4){cvtpk_s(p0[0], p0[1]), cvtpk_s(p0[2], p0[3]), cvtpk_s(p0[4], p0[5]), cvtpk_s(p0[6], p0[7])};
        pw1 = (u32x4){cvtpk_s(p0[8], p0[9]), cvtpk_s(p0[10], p0[11]), cvtpk_s(p0[12], p0[13]), cvtpk_s(p0[14], p0[15])};
        pw2 = (u32x4){cvtpk_s(p1[0], p1[1]), cvtpk_s(p1[2], p1[3]), cvtpk_s(p1[4], p1[5]), cvtpk_s(p1[6], p1[7])};
        pw3 = (u32x4){cvtpk_s(p1[8], p1[9]), cvtpk_s(p1[10], p1[11]), cvtpk_s(p1[12], p1[13]), cvtpk_s(p1[14], p1[15])};
        __builtin_amdgcn_sched_barrier(0);
        bf16x8 vf[4]; trfrag4((int)(lds0 + L_VIMG + cb * 4096) + lpart, vf);
        f32x16 o = f32x16{};
        o = __builtin_amdgcn_mfma_f32_32x32x16_bf16(__builtin_bit_cast(bf16x8, pw0), vf[0], o, 0, 0, 0);
        o = __builtin_amdgcn_mfma_f32_32x32x16_bf16(__builtin_bit_cast(bf16x8, pw1), vf[1], o, 0, 0, 0);
        o = __builtin_amdgcn_mfma_f32_32x32x16_bf16(__builtin_bit_cast(bf16x8, pw2), vf[2], o, 0, 0, 0);
        o = __builtin_amdgcn_mfma_f32_32x32x16_bf16(__builtin_bit_cast(bf16x8, pw3), vf[3], o, 0, 0, 0);
#pragma unroll
        for (int s = 0; s < 4; ++s) o = __builtin_amdgcn_mfma_f32_32x32x16_bf16(qr[s], cur.pf[s], o, 0, 0, 0);
#pragma unroll
        for (int r = 0; r < 16; ++r) obuf[(32 * rb + crow(r, hi)) * OLD + 32 * cb + r32] = o[r];
        GLA_BAR();
        { float ov[16];
#pragma unroll
            for (int i = 0; i < 4; ++i) { const f32x4 t = *(const f32x4*)(obuf + c * OLD + 16 * dc + 4 * i); ov[4 * i] = t.x; ov[4 * i + 1] = t.y; ov[4 * i + 2] = t.z; ov[4 * i + 3] = t.w; }
            float ss = 0.f;
#pragma unroll
            for (int i = 0; i < 16; ++i) ss += ov[i] * ov[i];
            ss += __shfl_xor(ss, 1); ss += __shfl_xor(ss, 2); ss += __shfl_xor(ss, 4);
            const float rn = rsqrtf(ss * (1.f / GDV) + EPS); const size_t row = (size_t)(row0 + c);
            float g0[8], g1[8]; unpack8(cur.z0, g0); unpack8(cur.z1, g1);
            const float gv[16] = {gn[0].x, gn[0].y, gn[0].z, gn[0].w, gn[1].x, gn[1].y, gn[1].z, gn[1].w, gn[2].x, gn[2].y, gn[2].z, gn[2].w, gn[3].x, gn[3].y, gn[3].z, gn[3].w};
            float w0[8], w1[8];
#pragma unroll
            for (int i = 0; i < 8; ++i) { w0[i] = ov[i] * rn * gv[i] * silu_f(g0[i]); w1[i] = ov[8 + i] * rn * gv[8 + i] * silu_f(g1[i]); }
            { const int c0 = h * 128 + 16 * dc; bf16* mp = MIX + ((row >> 4) * 32 + (c0 >> 5)) * 512 + (row & 15) * 32 + (c0 & 31);
              *(u32x4*)mp = pack8(w0); *(u32x4*)(mp + 8) = pack8(w1); } }
        cur = nxt;
    }
    __syncthreads();
}
#undef GLA_BAR
}

namespace pg8 {
#define PG8_LAS __attribute__((address_space(3)))
typedef unsigned short bf16_t;
typedef short bf16x8 __attribute__((ext_vector_type(8)));
typedef float f32x4 __attribute__((ext_vector_type(4)));
typedef unsigned u32x4 __attribute__((ext_vector_type(4)));
constexpr int BM = 256, BK = 64, HALF = 128, HTB = HALF * BK * 2  , STAGE_BYTES = 8 * HTB, NXCD = 8, WGM = 8;

__host__ __device__ __forceinline__ int lds_byte(int r, int c) { const int st = (r >> 4) * 2 + (c >> 5), rr = r & 15, cc = c & 31, ob = rr * 64 + cc * 2; return st * 1024 + (ob ^ (((ob >> 9) & 1) << 5)); }
__host__ __device__ __forceinline__ void stage_rc(int b, int& R, int& C) { const int st = b / 1024, sb = b % 1024, swz = sb ^ (((sb >> 9) & 1) << 5); R = (st >> 1) * 16 + swz / 64; C = (st & 1) * 32 + (swz % 64) / 2; }
__host__ __device__ __forceinline__ int perm32(int rho) { const int n = rho >> 4, i = rho & 15; return 8 * (i >> 2) + 4 * n + (i & 3); }

struct Unit { int pm, pn; };
struct Gemm { const bf16_t* A; const bf16_t* Bt; int M, N, K, lda; bool ta, tb; };

struct StaticOrder {
    int nM, nN, nwg, G, c;
    __host__ __device__ void init(int M, int N, int G_, int c_) { nM = M / BM; nN = N / BM; nwg = nM * nN; G = G_; c = c_; }
    __host__ __device__ bool next(int i, Unit& u) const {
        const long L = (long)i * G + c; if (L >= nwg) return false;
        int wgid = (int)L; { const int q = nwg / NXCD, r = nwg % NXCD, xcd = wgid % NXCD, off = wgid / NXCD; wgid = (xcd < r ? xcd * (q + 1) : r * (q + 1) + (xcd - r) * q) + off; }
        const int nig = WGM * nN, gid = wgid / nig, fm = gid * WGM, gsz = (nM - fm) < WGM ? (nM - fm) : WGM;
        u.pm = fm + ((wgid % nig) % gsz); u.pn = (wgid % nig) / gsz; return true;
    }
    __device__ __forceinline__ void a_ready(const Unit&) const {}
    __device__ __forceinline__ void done(const Unit&) const {}
};

__device__ __forceinline__ unsigned cvt_pk_bf16(float lo, float hi) { unsigned r; asm volatile("v_cvt_pk_bf16_f32 %0, %1, %2" : "=v"(r) : "v"(lo), "v"(hi)); return r; }
typedef float f32x2 __attribute__((ext_vector_type(2)));
__device__ __forceinline__ void st16_wt(void* p, u32x4 v) { asm volatile("global_store_dwordx4 %0, %1, off sc1\n\ts_nop 1" :: "v"(p), "v"(v) : "memory"); }
typedef unsigned u32x2v __attribute__((ext_vector_type(2)));
struct EpiBf16 {
    static constexpr bool PERM = true, AFTER_DRAIN = false; static constexpr int PROBE_BIT = 26;
    bf16_t* O; int ldc;
    __device__ __forceinline__ void operator()(const f32x4 (&acc)[2][2][4][2], const Unit& u, int wr, int wc, int fr, int fq) const {
        const int row0 = u.pm * BM + wr * 64 + fr, col0 = u.pn * BM + wc * 32 + 8 * fq;
#pragma unroll
        for (int ai = 0; ai < 2; ++ai)
#pragma unroll
            for (int m = 0; m < 4; ++m) { bf16_t* rowp = O + (size_t)(row0 + ai * HALF + m * 16) * ldc + col0;
#pragma unroll
                for (int bj = 0; bj < 2; ++bj) { const f32x4 v0 = acc[ai][bj][m][0], v1 = acc[ai][bj][m][1];
                    u32x4 w; w.x = cvt_pk_bf16(v0[0], v0[1]); w.y = cvt_pk_bf16(v0[2], v0[3]); w.z = cvt_pk_bf16(v1[0], v1[1]); w.w = cvt_pk_bf16(v1[2], v1[3]);
                    *(u32x4*)(rowp + bj * HALF) = w; } }
    }
};
struct EpiZ {
    static constexpr bool PERM = true, AFTER_DRAIN = false; static constexpr int PROBE_BIT = 27;
    bf16_t* O; int ldc; float* ssqq; float* ssqkv; float* ssqpe;
    __device__ __forceinline__ void operator()(const f32x4 (&acc)[2][2][4][2], const Unit& u, int wr, int wc, int fr, int fq) const {
        const int row0 = u.pm * BM + wr * 64 + fr, col0 = u.pn * BM + wc * 32 + 8 * fq;
#pragma unroll
        for (int ai = 0; ai < 2; ++ai)
#pragma unroll
            for (int m = 0; m < 4; ++m) { const int r = row0 + ai * HALF + m * 16; bf16_t* rowp = O + ((size_t)(r >> 4) * (ldc >> 5) + (col0 >> 5)) * 512 + (r & 15) * 32 + (col0 & 31); float sq[2];
#pragma unroll
                for (int bj = 0; bj < 2; ++bj) { const f32x4 v0 = acc[ai][bj][m][0], v1 = acc[ai][bj][m][1];
                    u32x4 w; w.x = cvt_pk_bf16(v0[0], v0[1]); w.y = cvt_pk_bf16(v0[2], v0[3]); w.z = cvt_pk_bf16(v1[0], v1[1]); w.w = cvt_pk_bf16(v1[2], v1[3]);
                    st16_wt(rowp + bj * 4 * 512, w);
                    sq[bj] = ((v0[0] * v0[0] + v0[1] * v0[1]) + (v0[2] * v0[2] + v0[3] * v0[3])) + ((v1[0] * v1[0] + v1[1] * v1[1]) + (v1[2] * v1[2] + v1[3] * v1[3])); }
                if (u.pn == 6) { float s = sq[0] + sq[1]; s += __shfl_xor(s, 16); s += __shfl_xor(s, 32); if (fq == 0) ssqq[(size_t)r * 4 + wc] = s; }
                else if (u.pn == 7) { float s = sq[0]; s += __shfl_xor(s, 16); s += __shfl_xor(s, 32); if (fq == 0) ssqkv[(size_t)r * 4 + wc] = s;
                    if (wc == 0) { float t = sq[1]; t += __shfl_xor(t, 16); t += __shfl_xor(t, 32); if (fq == 0) ssqpe[r] = t; } } }
    }
};
struct EpiQ {
    static constexpr bool PERM = false, AFTER_DRAIN = true; static constexpr int PROBE_BIT = 25;
    const float* ssqq; const float* gq; const float* cosT; const float* sinT; bf16_t* QF; float eps, qscale;
    __device__ __forceinline__ void fused(f32x4 (&acc)[2][2][4][2], const Unit& u, int wr, int wc, int fr, int fq, PG8_LAS unsigned char* lds, int wid, int lane) const {
        PG8_LAS float* P = (PG8_LAS float*)lds;
        f32x4 s4A[2][4];
#pragma unroll
        for (int ai = 0; ai < 2; ++ai)
#pragma unroll
            for (int m = 0; m < 4; ++m) s4A[ai][m] = *(const f32x4*)(ssqq + (size_t)(u.pm * BM + ai * HALF + wr * 64 + m * 16 + fr) * 4);
        __builtin_amdgcn_sched_barrier(0);
#pragma unroll
        for (int ai = 0; ai < 2; ++ai)
#pragma unroll
            for (int m = 0; m < 4; ++m) { const int rl = ai * HALF + wr * 64 + m * 16 + fr; const f32x4 s4 = s4A[ai][m];
                const float ra = __builtin_amdgcn_rsqf(((s4[0] + s4[1]) + (s4[2] + s4[3])) * (1.0f / 256.0f) + eps);
#pragma unroll
                for (int bj = 0; bj < 2; ++bj) { float s = 0.f;
#pragma unroll
                    for (int n = 0; n < 2; ++n) { const f32x4 v = acc[ai][bj][m][n] * ra; acc[ai][bj][m][n] = v; s += (v[0] * v[0] + v[1] * v[1]) + (v[2] * v[2] + v[3] * v[3]); }
                    s += __shfl_xor(s, 16); s += __shfl_xor(s, 32);
                    if (fq == 0) P[(rl * 2 + bj) * 4 + wc] = s; } }
        asm volatile("s_waitcnt lgkmcnt(0)" ::: "memory"); __builtin_amdgcn_s_barrier(); asm volatile("" ::: "memory");
        PG8_LAS unsigned char* ST = lds + 8192;
        if (wc < 3) {
            const int j0 = wc * 32 + 4 * fq; const f32x4 g0 = *(const f32x4*)(gq + j0), g1 = *(const f32x4*)(gq + j0 + 16);
            f32x4 csA[2][4], snA[2][4];
#pragma unroll
            for (int ai = 0; ai < 2; ++ai)
#pragma unroll
                for (int m = 0; m < 4; ++m) { const size_t r = (size_t)(u.pm * BM + ai * HALF + wr * 64 + m * 16 + fr); csA[ai][m] = (f32x4){1.f, 1.f, 1.f, 1.f}; snA[ai][m] = (f32x4){0.f, 0.f, 0.f, 0.f};
                    if (wc == 2) { csA[ai][m] = *(const f32x4*)(cosT + r * 16 + 4 * fq); snA[ai][m] = *(const f32x4*)(sinT + r * 16 + 4 * fq); } }
            __builtin_amdgcn_sched_barrier(0);
#pragma unroll
            for (int ai = 0; ai < 2; ++ai)
#pragma unroll
                for (int m = 0; m < 4; ++m) { const int rl = ai * HALF + wr * 64 + m * 16 + fr; const f32x4 cs = csA[ai][m], sn = snA[ai][m];
#pragma unroll
                    for (int bj = 0; bj < 2; ++bj) { const f32x4 p = *(const PG8_LAS f32x4*)(P + (rl * 2 + bj) * 4);
                        const float rh = qscale * __builtin_amdgcn_rsqf(((p[0] + p[1]) + (p[2] + p[3])) * (1.0f / 96.0f) + eps);
                        const f32x4 a = acc[ai][bj][m][0] * rh * g0, b = acc[ai][bj][m][1] * rh * g1;
                        f32x4 o0 = a, o1 = b; if (wc == 2) { o0 = a * cs - b * sn; o1 = a * sn + b * cs; }
                        PG8_LAS unsigned char* dst = ST + rl * 400 + (bj * 96 + j0) * 2;
                        u32x2v w0, w1; w0.x = cvt_pk_bf16(o0[0], o0[1]); w0.y = cvt_pk_bf16(o0[2], o0[3]); w1.x = cvt_pk_bf16(o1[0], o1[1]); w1.y = cvt_pk_bf16(o1[2], o1[3]);
                        *(PG8_LAS u32x2v*)dst = w0; *(PG8_LAS u32x2v*)(dst + 32) = w1; }
                    }
        }
        asm volatile("s_waitcnt lgkmcnt(0)" ::: "memory"); __builtin_amdgcn_s_barrier(); asm volatile("" ::: "memory");
        { const int tid = wid * 64 + lane;
#pragma unroll
            for (int i = 0; i < 12; ++i) { const int idx = tid + 512 * i, row = idx / 24, ch = idx - row * 24;
                st16_wt(QF + (size_t)(u.pm * BM + row) * 768 + (2 * u.pn) * 96 + ch * 8, *(const PG8_LAS u32x4*)(ST + row * 400 + ch * 16)); } }
    }
};
struct EpiKV {
    static constexpr bool PERM = false, AFTER_DRAIN = true; static constexpr int PROBE_BIT = 24;
    const float* ssqkv; const float* ssqpe; const float* gk; const float* cosT; const float* sinT; const bf16_t* Z; bf16_t* KF; bf16_t* VF; float eps;
    __device__ __forceinline__ void fused(f32x4 (&acc)[2][2][4][2], const Unit& u, int wr, int wc, int fr, int fq, PG8_LAS unsigned char* lds, int wid, int lane) const {
        PG8_LAS float* P = (PG8_LAS float*)lds;
        f32x4 s4A[2][4];
#pragma unroll
        for (int ai = 0; ai < 2; ++ai)
#pragma unroll
            for (int m = 0; m < 4; ++m) s4A[ai][m] = *(const f32x4*)(ssqkv + (size_t)(u.pm * BM + ai * HALF + wr * 64 + m * 16 + fr) * 4);
        __builtin_amdgcn_sched_barrier(0);
#pragma unroll
        for (int ai = 0; ai < 2; ++ai)
#pragma unroll
            for (int m = 0; m < 4; ++m) { const int rl = ai * HALF + wr * 64 + m * 16 + fr; const f32x4 s4 = s4A[ai][m];
                const float ra = __builtin_amdgcn_rsqf(((s4[0] + s4[1]) + (s4[2] + s4[3])) * (1.0f / 128.0f) + eps);
#pragma unroll
                for (int bj = 0; bj < 2; ++bj) { float s = 0.f;
#pragma unroll
                    for (int n = 0; n < 2; ++n) { const f32x4 v = acc[ai][bj][m][n] * ra; acc[ai][bj][m][n] = v; s += (v[0] * v[0] + v[1] * v[1]) + (v[2] * v[2] + v[3] * v[3]); }
                    if (wc < 2) { s += __shfl_xor(s, 16); s += __shfl_xor(s, 32); if (fq == 0) P[(rl * 2 + bj) * 2 + wc] = s; } } }
        asm volatile("s_waitcnt lgkmcnt(0)" ::: "memory"); __builtin_amdgcn_s_barrier(); asm volatile("" ::: "memory");
        const int j0 = wc * 32 + 4 * fq;
        PG8_LAS unsigned char* ST = lds + 8192;
        if (wc < 2) {
            const f32x4 g0 = *(const f32x4*)(gk + j0), g1 = *(const f32x4*)(gk + j0 + 16);
            float pesA[2][4];
#pragma unroll
            for (int ai = 0; ai < 2; ++ai)
#pragma unroll
                for (int m = 0; m < 4; ++m) pesA[ai][m] = ssqpe[(size_t)(u.pm * BM + ai * HALF + wr * 64 + m * 16 + fr)];
            __builtin_amdgcn_sched_barrier(0);
#pragma unroll
            for (int ai = 0; ai < 2; ++ai)
#pragma unroll
                for (int m = 0; m < 4; ++m) { const int rl = ai * HALF + wr * 64 + m * 16 + fr; const float pes = pesA[ai][m];
#pragma unroll
                    for (int bj = 0; bj < 2; ++bj) { const float rk = __builtin_amdgcn_rsqf((P[(rl * 2 + bj) * 2] + P[(rl * 2 + bj) * 2 + 1] + pes) * (1.0f / 96.0f) + eps);
                        const f32x4 o0 = acc[ai][bj][m][0] * rk * g0, o1 = acc[ai][bj][m][1] * rk * g1; PG8_LAS unsigned char* dst = ST + rl * 400 + (bj * 96 + j0) * 2;
                        u32x2v w0, w1; w0.x = cvt_pk_bf16(o0[0], o0[1]); w0.y = cvt_pk_bf16(o0[2], o0[3]); w1.x = cvt_pk_bf16(o1[0], o1[1]); w1.y = cvt_pk_bf16(o1[2], o1[3]);
                        *(PG8_LAS u32x2v*)dst = w0; *(PG8_LAS u32x2v*)(dst + 32) = w1; }
                    asm volatile("" ::: "memory"); }
        } else {
#pragma unroll
            for (int ai = 0; ai < 2; ++ai)
#pragma unroll
                for (int m = 0; m < 4; ++m) { const int rl = ai * HALF + wr * 64 + m * 16 + fr; const size_t r = (size_t)(u.pm * BM + rl);
#pragma unroll
                    for (int bj = 0; bj < 2; ++bj) { const f32x4 o0 = acc[ai][bj][m][0], o1 = acc[ai][bj][m][1];
                        bf16_t* dst = VF + (((((size_t)(u.pm >> 5) * 8 + 2 * u.pn + bj) * 128 + (u.pm & 31) * 4 + (rl >> 6)) * 2 + (wc - 2)) * 64 + (rl & 63)) * 32 + 4 * fq;
                        u32x2v w0, w1; w0.x = cvt_pk_bf16(o0[0], o0[1]); w0.y = cvt_pk_bf16(o0[2], o0[3]); w1.x = cvt_pk_bf16(o1[0], o1[1]); w1.y = cvt_pk_bf16(o1[2], o1[3]);
                        *(u32x2v*)dst = w0; *(u32x2v*)(dst + 16) = w1; }
                    asm volatile("" ::: "memory"); }
            if (wc == 2) {
                const f32x4 g0 = *(const f32x4*)(gk + 64 + 4 * fq), g1 = *(const f32x4*)(gk + 80 + 4 * fq);
#pragma unroll
                for (int ai = 0; ai < 2; ++ai) {
                    float pesB[4]; u32x2v xaB[4], xbB[4]; f32x4 csB[4], snB[4];
#pragma unroll
                    for (int m = 0; m < 4; ++m) { const size_t r = (size_t)(u.pm * BM + ai * HALF + wr * 64 + m * 16 + fr); pesB[m] = ssqpe[r];
                        xaB[m] = *(const u32x2v*)(Z + ((r >> 4) * 64 + 60) * 512 + (r & 15) * 32 + 4 * fq); xbB[m] = *(const u32x2v*)(Z + ((r >> 4) * 64 + 60) * 512 + (r & 15) * 32 + 16 + 4 * fq);
                        csB[m] = *(const f32x4*)(cosT + r * 16 + 4 * fq); snB[m] = *(const f32x4*)(sinT + r * 16 + 4 * fq); }
                    __builtin_amdgcn_sched_barrier(0);
#pragma unroll
                    for (int m = 0; m < 4; ++m) { const int rl = ai * HALF + wr * 64 + m * 16 + fr; const float pes = pesB[m];
                        const u32x2v xa = xaB[m], xb = xbB[m];
                        const f32x4 x1 = (f32x4){__uint_as_float(xa.x << 16), __uint_as_float(xa.x & 0xffff0000u), __uint_as_float(xa.y << 16), __uint_as_float(xa.y & 0xffff0000u)};
                        const f32x4 x2 = (f32x4){__uint_as_float(xb.x << 16), __uint_as_float(xb.x & 0xffff0000u), __uint_as_float(xb.y << 16), __uint_as_float(xb.y & 0xffff0000u)};
                        const f32x4 cs = csB[m], sn = snB[m];
#pragma unroll
                        for (int bj = 0; bj < 2; ++bj) { const float rk = __builtin_amdgcn_rsqf((P[(rl * 2 + bj) * 2] + P[(rl * 2 + bj) * 2 + 1] + pes) * (1.0f / 96.0f) + eps);
                            const f32x4 a = x1 * rk * g0, b = x2 * rk * g1, o0 = a * cs - b * sn, o1 = a * sn + b * cs; PG8_LAS unsigned char* dst = ST + rl * 400 + (bj * 96 + 64 + 4 * fq) * 2;
                            u32x2v w0, w1; w0.x = cvt_pk_bf16(o0[0], o0[1]); w0.y = cvt_pk_bf16(o0[2], o0[3]); w1.x = cvt_pk_bf16(o1[0], o1[1]); w1.y = cvt_pk_bf16(o1[2], o1[3]);
                            *(PG8_LAS u32x2v*)dst = w0; *(PG8_LAS u32x2v*)(dst + 32) = w1; } }
                    asm volatile("" ::: "memory"); }
            }
        }
        asm volatile("s_waitcnt lgkmcnt(0)" ::: "memory"); __builtin_amdgcn_s_barrier(); asm volatile("" ::: "memory");
        { const int tid = wid * 64 + lane;
#pragma unroll
            for (int i = 0; i < 12; ++i) { const int idx = tid + 512 * i, ch = idx >> 8, row = idx & 255, hd = 2 * u.pn + (ch >= 12 ? 1 : 0), c = ch >= 12 ? ch - 12 : ch;
                st16_wt(KF + (((((size_t)(u.pm >> 5) * 8 + hd) * 128 + (u.pm & 31) * 4 + (row >> 6)) * 12 + c) * 64 + (row & 63)) * 8, *(const PG8_LAS u32x4*)(ST + row * 400 + ch * 16)); } }
    }
};
struct EpiOutProjG {
    static constexpr bool PERM = false, AFTER_DRAIN = false; static constexpr int PROBE_BIT = 28;
    const float* x; float* x1; bf16_t* x1b; float* ssq;
    __device__ __forceinline__ void operator()(const f32x4 (&acc)[2][2][4][2], const Unit& u, int wr, int wc, int fr, int fq) const {
        const int col0 = u.pn * BM + wc * 32 + 4 * fq;
#pragma unroll
        for (int ai = 0; ai < 2; ++ai) {
            f32x4 xr[4][2][2];
#pragma unroll
            for (int m = 0; m < 4; ++m) { const size_t off = (size_t)(u.pm * BM + ai * HALF + wr * 64 + m * 16 + fr) * 1024 + col0;
#pragma unroll
                for (int bj = 0; bj < 2; ++bj)
#pragma unroll
                    for (int n = 0; n < 2; ++n) xr[m][bj][n] = *(const f32x4*)(x + off + bj * HALF + n * 16); }
            __builtin_amdgcn_sched_barrier(0);
#pragma unroll
            for (int m = 0; m < 4; ++m) { const int r = u.pm * BM + ai * HALF + wr * 64 + m * 16 + fr; const size_t off = (size_t)r * 1024 + col0; float s = 0.f;
#pragma unroll
                for (int bj = 0; bj < 2; ++bj)
#pragma unroll
                    for (int n = 0; n < 2; ++n) { const f32x4 t = xr[m][bj][n] + acc[ai][bj][m][n];
                        u32x2v w; w.x = cvt_pk_bf16(t[0], t[1]); w.y = cvt_pk_bf16(t[2], t[3]);
                        *(u32x2v*)(x1b + ((size_t)(r >> 4) * 32 + ((col0 >> 5) + 4 * bj)) * 512 + (r & 15) * 32 + (col0 & 31) + 16 * n) = w;
                        s += (t[0] * t[0] + t[1] * t[1]) + (t[2] * t[2] + t[3] * t[3]); }
                s += __shfl_xor(s, 16); s += __shfl_xor(s, 32);
                if (fq == 0) ssq[(size_t)r * 16 + u.pn * 4 + wc] = s; }
            asm volatile("" ::: "memory"); }
    }
};
struct EpiUpG {
    static constexpr bool PERM = true, AFTER_DRAIN = false; static constexpr int PROBE_BIT = 29;
    const PG8_LAS float* rtab; bf16_t* H;
    __device__ __forceinline__ void operator()(const f32x4 (&acc)[2][2][4][2], const Unit& u, int wr, int wc, int fr, int fq) const { (*this)(acc, u, wr, wc, fr, fq, 0); }
    __device__ __forceinline__ void operator()(const f32x4 (&acc)[2][2][4][2], const Unit& u, int wr, int wc, int fr, int fq, int ui) const {
        const int row0 = u.pm * BM + wr * 64 + fr, col0 = u.pn * BM + wc * 32 + 8 * fq;
#pragma unroll
        for (int ai = 0; ai < 2; ++ai)
#pragma unroll
            for (int m = 0; m < 4; ++m) { const int r = row0 + ai * HALF + m * 16;
                const float rstd = rtab[(ui & 3) * 256 + wr * 64 + fr + ai * HALF + m * 16];
                bf16_t* rowp = H + ((size_t)(r >> 4) * 128 + (col0 >> 5)) * 512 + (r & 15) * 32 + (col0 & 31);
#pragma unroll
                for (int bj = 0; bj < 2; ++bj) { f32x4 v0 = acc[ai][bj][m][0] * rstd, v1 = acc[ai][bj][m][1] * rstd;
#pragma unroll
                    for (int e = 0; e < 4; ++e) { v0[e] = __builtin_fmaxf(v0[e], 0.f); v1[e] = __builtin_fmaxf(v1[e], 0.f); }
                    v0 = v0 * v0; v1 = v1 * v1;
                    u32x4 w; w.x = cvt_pk_bf16(v0[0], v0[1]); w.y = cvt_pk_bf16(v0[2], v0[3]); w.z = cvt_pk_bf16(v1[0], v1[1]); w.w = cvt_pk_bf16(v1[2], v1[3]);
                    st16_wt(rowp + bj * 4 * 512, w); } }
    }
};
struct EpiDownG {
    static constexpr bool PERM = false, AFTER_DRAIN = false; static constexpr int PROBE_BIT = 30;
    const bf16_t* x1b; float* out;
    __device__ __forceinline__ void operator()(const f32x4 (&acc)[2][2][4][2], const Unit& u, int wr, int wc, int fr, int fq) const {
        const int col0 = u.pn * BM + wc * 32 + 4 * fq;
        u32x2v xw[2][4][2][2];
#pragma unroll
        for (int ai = 0; ai < 2; ++ai)
#pragma unroll
            for (int m = 0; m < 4; ++m) { const size_t off = (size_t)(u.pm * BM + ai * HALF + wr * 64 + m * 16 + fr) * 1024 + col0;
#pragma unroll
                for (int bj = 0; bj < 2; ++bj)
#pragma unroll
                    for (int n = 0; n < 2; ++n) { const int r_ = u.pm * BM + ai * HALF + wr * 64 + m * 16 + fr; xw[ai][m][bj][n] = *(const u32x2v*)(x1b + ((size_t)(r_ >> 4) * 32 + ((col0 >> 5) + 4 * bj)) * 512 + (r_ & 15) * 32 + (col0 & 31) + 16 * n); } }
        __builtin_amdgcn_sched_barrier(0);
#pragma unroll
        for (int ai = 0; ai < 2; ++ai)
#pragma unroll
            for (int m = 0; m < 4; ++m) { const size_t off = (size_t)(u.pm * BM + ai * HALF + wr * 64 + m * 16 + fr) * 1024 + col0;
#pragma unroll
                for (int bj = 0; bj < 2; ++bj)
#pragma unroll
                    for (int n = 0; n < 2; ++n) { const u32x2v w = xw[ai][m][bj][n];
                        const f32x4 xr = (f32x4){__uint_as_float(w.x << 16), __uint_as_float(w.x & 0xffff0000u), __uint_as_float(w.y << 16), __uint_as_float(w.y & 0xffff0000u)};
                        *(f32x4*)(out + off + bj * HALF + n * 16) = xr + acc[ai][bj][m][n]; } }
    }
};
template <class Epi, class Sched, bool ALIGN_EPI = false, bool SP2 = false>
__device__ __forceinline__ void gemm_phase(PG8_LAS unsigned char* lds, const Gemm g, const Sched& S, const Epi& E) {
    const int tid = threadIdx.x, wid = __builtin_amdgcn_readfirstlane(tid >> 6), lane = tid & 63, wr = wid >> 2, wc = wid & 3, fr = lane & 15, fq = lane >> 4;
    const int K = g.K, nt = K / BK;
    unsigned voffA[2], voffB[2];
#pragma unroll
    for (int i = 0; i < 2; ++i) { int R, C; stage_rc(tid * 16 + i * 8192, R, C); const int Rb = Epi::PERM ? ((R & ~31) + perm32(R & 31)) : R;
        voffA[i] = g.ta ? (unsigned)(((R >> 4) * (g.lda >> 5) + (C >> 5)) * 1024 + (R & 15) * 64 + (C & 31) * 2) : (unsigned)(R * g.lda + C) * 2u;
        voffB[i] = g.tb ? (unsigned)(((Rb >> 4) * (K >> 5) + (C >> 5)) * 1024 + (Rb & 15) * 64 + (C & 31) * 2) : (unsigned)(Rb * K + C) * 2u; }
    const size_t kstepA = g.ta ? (size_t)2048 : (size_t)(BK * 2), kstepB = g.tb ? (size_t)2048 : (size_t)(BK * 2);
    const size_t hstepB = (size_t)HALF * K * 2, hstepA = (size_t)HALF * g.lda * 2;
    const size_t tstepB = 2 * hstepB, tstepA = 2 * hstepA;
    const unsigned ldsw = (unsigned)wid * 1024u;
    const int aoff = lds_byte(wr * 64 + fr, fq * 8), boff = lds_byte(wc * 32 + fr, fq * 8);
#define PG8_SA(b, h) (((b) * 2 + (h)) * HTB)
#define PG8_SB(b, h) ((4 + (b) * 2 + (h)) * HTB)
#define PG8_STAGE(bufoff, gbase, voff) do { _Pragma("unroll") for (int _i = 0; _i < 2; ++_i) \
        __builtin_amdgcn_global_load_lds((const unsigned*)((const char*)(gbase) + (voff)[_i]), (PG8_LAS unsigned*)(lds + (bufoff) + ldsw + _i * 8192), 16, 0, 0); } while (0)
#define PG8_LDA(dst, b, h) do { _Pragma("unroll") for (int m = 0; m < 4; ++m) _Pragma("unroll") for (int k = 0; k < 2; ++k) dst[m][k] = *(const PG8_LAS bf16x8*)(lds + PG8_SA(b, h) + aoff + m * 2048 + k * 1024); } while (0)
#define PG8_LDB(dst, b, h) do { _Pragma("unroll") for (int n = 0; n < 2; ++n) _Pragma("unroll") for (int k = 0; k < 2; ++k) dst[n][k] = *(const PG8_LAS bf16x8*)(lds + PG8_SB(b, h) + boff + n * 2048 + k * 1024); } while (0)
#define PG8_MMA(ai, bj, At, Bt) do { __builtin_amdgcn_s_setprio(1); _Pragma("unroll") for (int m = 0; m < 4; ++m) _Pragma("unroll") for (int n = 0; n < 2; ++n) _Pragma("unroll") for (int k = 0; k < 2; ++k) \
        acc[ai][bj][m][n] = __builtin_amdgcn_mfma_f32_16x16x32_bf16(Bt[n][k], At[m][k], acc[ai][bj][m][n], 0, 0, 0); __builtin_amdgcn_s_setprio(0); } while (0)
#define PG8_WAIT_V(n) asm volatile("s_waitcnt vmcnt(" #n ")" ::: "memory")
#define PG8_WAIT_L(n) asm volatile("s_waitcnt lgkmcnt(" #n ")" ::: "memory")
#define PG8_BAR __builtin_amdgcn_s_barrier()
#define PG8_SCHED __builtin_amdgcn_sched_barrier(0)
    Unit cur, nxt; int ui = 0;
    if (!S.next(0, cur)) return;
    f32x4 acc[2][2][4][2];
#pragma unroll
    for (int a = 0; a < 2; ++a)
#pragma unroll
        for (int b = 0; b < 2; ++b)
#pragma unroll
            for (int m = 0; m < 4; ++m)
#pragma unroll
                for (int n = 0; n < 2; ++n) acc[a][b][m][n] = (f32x4){0.f, 0.f, 0.f, 0.f};
    bf16x8 At[4][2], B0[2][2], B1[2][2];
    const char* cA = (const char*)g.A + (size_t)cur.pm * tstepA; const char* cB = (const char*)g.Bt + (size_t)cur.pn * tstepB;
    S.a_ready(cur);
    if constexpr (SP2) {
        PG8_STAGE(PG8_SB(0, 0), cB, voffB); PG8_STAGE(PG8_SB(0, 1), cB + hstepB, voffB); PG8_STAGE(PG8_SA(0, 0), cA, voffA); PG8_STAGE(PG8_SA(0, 1), cA + hstepA, voffA);
        if (wr == 1) PG8_BAR;
        PG8_WAIT_V(2); PG8_BAR;
        PG8_STAGE(PG8_SB(1, 0), cB + kstepB, voffB); PG8_STAGE(PG8_SA(1, 0), cA + kstepA, voffA); PG8_STAGE(PG8_SB(1, 1), cB + hstepB + kstepB, voffB);
        PG8_WAIT_V(6); PG8_BAR;
    } else {
        PG8_STAGE(PG8_SB(0, 0), cB, voffB); PG8_STAGE(PG8_SA(0, 0), cA, voffA); PG8_STAGE(PG8_SB(0, 1), cB + hstepB, voffB); PG8_STAGE(PG8_SA(0, 1), cA + hstepA, voffA);
        if (wr == 1) PG8_BAR;
        PG8_WAIT_V(4); PG8_BAR;
        PG8_STAGE(PG8_SB(1, 0), cB + kstepB, voffB); PG8_STAGE(PG8_SA(1, 0), cA + kstepA, voffA); PG8_STAGE(PG8_SB(1, 1), cB + hstepB + kstepB, voffB);
        PG8_WAIT_V(6); PG8_BAR;
    }
    for (;;) {
        const bool has_next = S.next(ui + 1, nxt);
        const char* nA = has_next ? (const char*)g.A + (size_t)nxt.pm * tstepA : cA; const char* nB = has_next ? (const char*)g.Bt + (size_t)nxt.pn * tstepB : cB;
        for (int t = 0; t < nt; t += 2) {
            const bool last = (t == nt - 2);
            const char* a1 = cA + (size_t)(t + 1) * kstepA;
            const char* a2 = last ? nA : cA + (size_t)(t + 2) * kstepA; const char* b2 = last ? nB : cB + (size_t)(t + 2) * kstepB;
            const char* a3 = a2 + kstepA; const char* b3 = b2 + kstepB;
            if (last && has_next) S.a_ready(nxt);
            if constexpr (SP2) {
            PG8_LDB(B0, 0, 0); PG8_LDB(B1, 0, 1); PG8_SCHED; PG8_LDA(At, 0, 0); PG8_STAGE(PG8_SA(1, 1), a1 + hstepA, voffA);
            PG8_WAIT_V(8); PG8_WAIT_L(0); PG8_BAR; PG8_MMA(0, 0, At, B0); PG8_MMA(0, 1, At, B1); PG8_BAR; PG8_SCHED;
            PG8_LDA(At, 0, 1); PG8_STAGE(PG8_SB(0, 0), b2, voffB); PG8_STAGE(PG8_SB(0, 1), b2 + hstepB, voffB); PG8_STAGE(PG8_SA(0, 0), a2, voffA);
            PG8_WAIT_V(8); PG8_WAIT_L(0); PG8_BAR; PG8_MMA(1, 0, At, B0); PG8_MMA(1, 1, At, B1); PG8_BAR; PG8_SCHED;
            PG8_LDB(B0, 1, 0); PG8_LDB(B1, 1, 1); PG8_SCHED; PG8_LDA(At, 1, 0); PG8_STAGE(PG8_SA(0, 1), a2 + hstepA, voffA);
            PG8_WAIT_V(8); PG8_WAIT_L(0); PG8_BAR; PG8_MMA(0, 0, At, B0); PG8_MMA(0, 1, At, B1); PG8_BAR; PG8_SCHED;
            PG8_LDA(At, 1, 1); PG8_STAGE(PG8_SB(1, 0), b3, voffB); PG8_STAGE(PG8_SB(1, 1), b3 + hstepB, voffB); PG8_STAGE(PG8_SA(1, 0), a3, voffA);
            PG8_WAIT_V(8); PG8_WAIT_L(0); PG8_BAR; PG8_MMA(1, 0, At, B0); PG8_MMA(1, 1, At, B1); PG8_BAR; PG8_SCHED;
            } else {
            PG8_LDB(B0, 0, 0); PG8_SCHED; PG8_LDA(At, 0, 0); PG8_STAGE(PG8_SA(1, 1), a1 + hstepA, voffA);
            PG8_WAIT_L(8); PG8_BAR; PG8_WAIT_L(0); PG8_MMA(0, 0, At, B0); PG8_BAR; PG8_SCHED;
            PG8_LDB(B1, 0, 1); PG8_STAGE(PG8_SB(0, 0), b2, voffB);
            PG8_BAR; PG8_WAIT_L(0); PG8_MMA(0, 1, At, B1); PG8_BAR;
            PG8_LDA(At, 0, 1); PG8_STAGE(PG8_SA(0, 0), a2, voffA);
            PG8_BAR; PG8_WAIT_L(0); PG8_MMA(1, 0, At, B0); PG8_BAR; PG8_SCHED;
            PG8_STAGE(PG8_SB(0, 1), b2 + hstepB, voffB);
            PG8_WAIT_V(6); PG8_BAR; PG8_MMA(1, 1, At, B1); PG8_BAR;
            PG8_LDB(B0, 1, 0); PG8_SCHED; PG8_LDA(At, 1, 0); PG8_STAGE(PG8_SA(0, 1), a2 + hstepA, voffA);
            PG8_WAIT_L(8); PG8_BAR; PG8_WAIT_L(0); PG8_MMA(0, 0, At, B0); PG8_BAR; PG8_SCHED;
            PG8_LDB(B1, 1, 1); PG8_STAGE(PG8_SB(1, 0), b3, voffB);
            PG8_BAR; PG8_WAIT_L(0); PG8_MMA(0, 1, At, B1); PG8_BAR;
            PG8_LDA(At, 1, 1); PG8_STAGE(PG8_SA(1, 0), a3, voffA);
            PG8_BAR; PG8_WAIT_L(0); PG8_MMA(1, 0, At, B0); PG8_BAR; PG8_SCHED;
            PG8_STAGE(PG8_SB(1, 1), b3 + hstepB, voffB);
            PG8_WAIT_V(6); PG8_BAR; PG8_MMA(1, 1, At, B1); PG8_BAR;
            }
        }
        if constexpr (ALIGN_EPI) { if (wr == 0) PG8_BAR; }
        if constexpr (!Epi::AFTER_DRAIN) { if constexpr (Epi::PROBE_BIT == 29) E(acc, cur, wr, wc, fr, fq, ui); else E(acc, cur, wr, wc, fr, fq); if (DUPL(Epi::PROBE_BIT)) E(acc, cur, wr, wc, fr, fq); S.done(cur); }
        if (!has_next) break;
#pragma unroll
        for (int a = 0; a < 2; ++a)
#pragma unroll
            for (int b = 0; b < 2; ++b)
#pragma unroll
                for (int m = 0; m < 4; ++m)
#pragma unroll
                    for (int n = 0; n < 2; ++n) acc[a][b][m][n] = (f32x4){0.f, 0.f, 0.f, 0.f};
        cur = nxt; cA = nA; cB = nB; ++ui;
        if constexpr (ALIGN_EPI) { if (wr == 1) PG8_BAR; }
    }
    PG8_WAIT_V(0);
    if constexpr (!ALIGN_EPI) { if (wr == 0) PG8_BAR; }
    PG8_BAR;
    if constexpr (Epi::AFTER_DRAIN) { E.fused(acc, cur, wr, wc, fr, fq, lds, wid, lane); if (DUPL(Epi::PROBE_BIT)) { asm volatile("s_waitcnt lgkmcnt(0)" ::: "memory"); __builtin_amdgcn_s_barrier(); E.fused(acc, cur, wr, wc, fr, fq, lds, wid, lane); } S.done(cur); }
#undef PG8_SA
#undef PG8_SB
#undef PG8_STAGE
#undef PG8_LDA
#undef PG8_LDB
#undef PG8_MMA
#undef PG8_WAIT_V
#undef PG8_WAIT_L
#undef PG8_BAR
#undef PG8_SCHED
}
}

#define GAS __attribute__((address_space(1)))
#define LAS __attribute__((address_space(3)))
#define XB_TMO      128
#define XB_XCNT(j)  (256  + 64 * (j))
#define XB_XSUB(j)  (1280 + 64 * (j))
#define XB_XGEN(j)  (2304 + 64 * (j))
#define XB_TOP      3328
#define XB_TOPGEN   3392
#define XCD_BAR_WORDS 3456
#define XB_SPIN_CAP (1u << 18)
__device__ __forceinline__ unsigned xb_ld(unsigned* p)              { return __hip_atomic_load(p, __ATOMIC_RELAXED, __HIP_MEMORY_SCOPE_AGENT); }
__device__ __forceinline__ unsigned xb_add(unsigned* p, unsigned v) { return __hip_atomic_fetch_add(p, v, __ATOMIC_RELAXED, __HIP_MEMORY_SCOPE_AGENT); }
__device__ __forceinline__ unsigned xb_xcc_id() { return (unsigned)__builtin_amdgcn_s_getreg((3 << 11) | 20) & 0xFu; }
#define XB_SPIN(cond, bar) do { unsigned _sp = 0; while (cond) { __builtin_amdgcn_s_sleep(1); \
    if ((++_sp & 255u) == 0u) { if (xb_ld(&(bar)[XB_TMO])) break; if (_sp > XB_SPIN_CAP) { atomicAdd(&(bar)[XB_TMO], 1u); break; } } } } while (0)
struct XcdBarrier { unsigned* bar; unsigned x; volatile LAS unsigned* st; };
__device__ __forceinline__ XcdBarrier xcd_barrier_post(unsigned* bar, volatile LAS unsigned* st) {
    XcdBarrier b; b.bar = bar; b.x = xb_xcc_id(); b.st = st;
    if (threadIdx.x == 0) (void)xb_add(&bar[XB_XCNT(b.x)], 1u);
    return b;
}
__device__ __forceinline__ void xcd_barrier_complete(unsigned* bar, unsigned x, unsigned& nloc, unsigned& nx) {
    const unsigned G = gridDim.x * gridDim.y * gridDim.z;
    unsigned sum, cnt, mine, sp = 0u;
    for (;;) {
        sum = 0u; cnt = 0u; mine = 0u;
#pragma unroll
        for (unsigned j = 0; j < 16; ++j) { const unsigned c = xb_ld(&bar[XB_XCNT(j)]); sum += c; cnt += (c > 0u) ? 1u : 0u; mine = (j == x) ? c : mine; }
        if (sum == G) break;
        __builtin_amdgcn_s_sleep(1);
        if ((++sp & 255u) == 0u) { if (xb_ld(&bar[XB_TMO])) break; if (sp > XB_SPIN_CAP) { atomicAdd(&bar[XB_TMO], 1u); break; } }
    }
    nloc = mine > 0u ? mine : 1u; nx = cnt > 0u ? cnt : 1u;
}
__device__ __forceinline__ void xcd_barrier(const XcdBarrier& b) {
    asm volatile("s_waitcnt vmcnt(0)" ::: "memory");
    __syncthreads();
    if (threadIdx.x == 0) {
        unsigned* bar = b.bar;
        __builtin_amdgcn_s_waitcnt(0);
        unsigned nloc = b.st[0], nx = b.st[1];
        if (nloc == 0u) { xcd_barrier_complete(bar, b.x, nloc, nx); b.st[0] = nloc; b.st[1] = nx; }
        const unsigned old = xb_add(&bar[XB_XSUB(b.x)], 1u);
        const unsigned gen = old / nloc;
        if (old + 1u == (gen + 1u) * nloc) {
            __builtin_amdgcn_fence(__ATOMIC_RELEASE, "agent");
            asm volatile("s_waitcnt vmcnt(0)" ::: "memory");
            const unsigned og = xb_add(&bar[XB_TOP], 1u);
            const unsigned tg = og / nx;
            asm volatile("buffer_inv sc1" ::: "memory");
            if (og + 1u == (tg + 1u) * nx) xb_add(&bar[XB_TOPGEN], 1u);
            else XB_SPIN(xb_ld(&bar[XB_TOPGEN]) == tg, bar);
            xb_add(&bar[XB_XGEN(b.x)], 1u);
            asm volatile("s_waitcnt vmcnt(0)" ::: "memory");
        } else {
            asm volatile("buffer_inv sc1" ::: "memory");
            XB_SPIN(xb_ld(&bar[XB_XGEN(b.x)]) == gen, bar);
            asm volatile("s_waitcnt vmcnt(0)" ::: "memory");
        }
    }
    __syncthreads();
}

constexpr int LDS_BYTES = 147456;
constexpr int MISC_OFF = 131072 + 320;
constexpr int CW_BAR = 4096;
#ifndef MK_SINGLE
#define MK_SINGLE 1
#endif
constexpr int NPHASE = 11;
struct Args { Ctx C; int ph_lo, ph_hi; };
__global__ void __launch_bounds__(NT, 2) fwd_mega(Args args) {
    extern __shared__ __attribute__((aligned(16))) unsigned char lds_raw[];
    float* lds = (float*)lds_raw;
    PG8_LAS unsigned char* L3 = (PG8_LAS unsigned char*)lds_raw;
    const Ctx& C = args.C;
    unsigned char* ws = C.ws;
    volatile LAS unsigned* MISC = (volatile LAS unsigned*)((LAS unsigned char*)lds_raw + MISC_OFF);
    if (threadIdx.x < 32) MISC[threadIdx.x] = 0u;
    __syncthreads();
    XcdBarrier bar; bar.bar = (unsigned*)(ws + WS_CTL) + CW_BAR; bar.x = 0; bar.st = nullptr;
    if (MK_SINGLE) bar = xcd_barrier_post((unsigned*)(ws + WS_CTL) + CW_BAR, MISC + 8);
    const int lo = args.ph_lo, hi = args.ph_hi;
#define IN(k) (lo <= (k) && (k) < hi)
#define SEAM(k) do { if (IN(k) && IN((k) + 1)) { xcd_barrier(bar); if (DUPL(31)) xcd_barrier(bar); } } while (0)
#define PH(k, BODY) do { if (IN(k)) { BODY; if (DUPL(k)) { BODY; } } } while (0)
#define GEMM_PH(EPI, EINIT, AP, BP, NN, KK, LDA, AL) GEMM_PH2(EPI, EINIT, AP, BP, NN, KK, LDA, AL, false)
#define GEMM_PH2(EPI, EINIT, AP, BP, NN, KK, LDA, AL, TA) do { pg8::Gemm g{(const bf16*)(AP), (const bf16*)(BP), M, NN, KK, LDA, TA, true}; pg8::StaticOrder S; S.init(M, NN, (int)gridDim.x, (int)blockIdx.x); \
        pg8::EPI E EINIT; pg8::gemm_phase<pg8::EPI, pg8::StaticOrder, AL, true>(L3, g, S, E); } while (0)
    const float* COS = (const float*)(ws + WS_COS); const float* SIN = (const float*)(ws + WS_SIN);
    PH(0, p0_prologue(C, lds));
    SEAM(0);
    PH(1, GEMM_PH(EpiZ, ({(bf16*)(ws + WS_Z), NZ, (float*)(ws + WS_SSQQ), (float*)(ws + WS_SSQKV), (float*)(ws + WS_SSQPE)}), ws + WS_A, ws + WS_WIN, NZ, DM, DM, true));
    SEAM(1);
    const bool p1_first = ((blockIdx.x >> 3) & 1) != 0;
    if (p1_first) { PH(4, gla::pass1(C, lds_raw)); }
    PH(2, GEMM_PH2(EpiQ, ({(const float*)(ws + WS_SSQQ), C.q_head_norm, COS, SIN, (bf16*)(ws + WS_QF), EPS, QSCALE}), (const bf16*)(ws + WS_Z) + (ZC_CQ >> 5) * 512, ws + WS_WUQ, 1024, QRANK, NZ, false, true));
    __syncthreads();
    PH(3, GEMM_PH2(EpiKV, ({(const float*)(ws + WS_SSQKV), (const float*)(ws + WS_SSQPE), C.k_head_norm, COS, SIN, (const bf16*)(ws + WS_Z), (bf16*)(ws + WS_KF), (bf16*)(ws + WS_VF), EPS}), (const bf16*)(ws + WS_Z) + (ZC_CKV >> 5) * 512, ws + WS_WUKV, 1024, KVRANK, NZ, false, true));
    __syncthreads();
    if (!p1_first) { PH(4, gla::pass1(C, lds_raw)); }
    SEAM(4);
    PH(5, (gla_scan(C), p0_late_weights(C, lds)));
    SEAM(5);
    PH(6, att::attn_phase(C, (char*)lds_raw));
    PH(7, gla::pass2(C, lds_raw));
    SEAM(7);
    PH(8, GEMM_PH2(EpiOutProjG, ({C.x, C.out, (bf16*)(ws + WS_A), (float*)(ws + WS_SSQ)}), ws + WS_B, ws + WS_WO, DM, DM, DM, true, true));
    SEAM(8);
    if (IN(9)) {
        PG8_LAS float* rtab = (PG8_LAS float*)(L3 + 131072 + 1024);
        pg8::StaticOrder So; So.init(M, DFF, (int)gridDim.x, (int)blockIdx.x);
        for (int idx = threadIdx.x; idx < 4 * 256; idx += NT) { pg8::Unit uu; const int i = idx >> 8, row = idx & 255;
            if (So.next(i, uu)) { const f32x4* sp = (const f32x4*)(ws + WS_SSQ) + (size_t)(uu.pm * 256 + row) * 4; const f32x4 s4 = (sp[0] + sp[1]) + (sp[2] + sp[3]);
                rtab[idx] = __builtin_amdgcn_rsqf(((s4[0] + s4[1]) + (s4[2] + s4[3])) * (1.0f / DM) + EPS); } }
        __syncthreads();
    }
    PH(9, GEMM_PH2(EpiUpG, ({(const PG8_LAS float*)(L3 + 131072 + 1024), (bf16*)(ws + WS_H)}), ws + WS_A, ws + WS_WUP, DFF, DM, DM, true, true));
    SEAM(9);
    PH(10, GEMM_PH2(EpiDownG, ({(const bf16*)(ws + WS_A), C.out}), ws + WS_H, ws + WS_WDN, DM, DFF, DFF, true, true));

#undef IN
#undef SEAM
}

extern "C" void kernel_launch(void* const* d_in, const int* in_sizes, int n_in, void* d_out, int out_size, void* d_ws, size_t ws_size, hipStream_t stream) {
    static int grid = 0;
    if (grid == 0) {
        if (n_in != 17 || in_sizes[0] != M * DM || out_size != M * DM || ws_size < WS_END) { fprintf(stderr, "kernel_launch: unexpected shapes (n_in %d in0 %d out %d ws %zu)\n", n_in, n_in > 0 ? in_sizes[0] : -1, out_size, ws_size); grid = -1; return; }
        int dev = 0, cus = 0, per_cu = 0;
        if (hipGetDevice(&dev) != hipSuccess || hipDeviceGetAttribute(&cus, hipDeviceAttributeMultiprocessorCount, dev) != hipSuccess) { fprintf(stderr, "kernel_launch: device query failed\n"); grid = -1; return; }
        if (hipFuncSetAttribute((const void*)fwd_mega, hipFuncAttributeMaxDynamicSharedMemorySize, LDS_BYTES) != hipSuccess) { fprintf(stderr, "kernel_launch: hipFuncSetAttribute failed\n"); grid = -1; return; }
        if (hipOccupancyMaxActiveBlocksPerMultiprocessor(&per_cu, (const void*)fwd_mega, NT, LDS_BYTES) != hipSuccess || per_cu < 1) fprintf(stderr, "kernel_launch: note: occupancy query reports %d workgroups per CU\n", per_cu);
        (void)hipGetLastError();
        grid = cus;
    }
    if (grid < 0) return;
    Args a{};
    Ctx& C = a.C;
    C.x = (const float*)d_in[0]; C.pos = (const int*)d_in[1]; C.attn_norm = (const float*)d_in[2]; C.w_in = (const float*)d_in[3]; C.w_gate_up = (const float*)d_in[4];
    C.b_gate = (const float*)d_in[5]; C.gla_out_norm = (const float*)d_in[6]; C.q_a_norm = (const float*)d_in[7]; C.w_uq = (const float*)d_in[8]; C.kv_a_norm = (const float*)d_in[9];
    C.w_ukv = (const float*)d_in[10]; C.q_head_norm = (const float*)d_in[11]; C.k_head_norm = (const float*)d_in[12]; C.w_out = (const float*)d_in[13]; C.mlp_norm = (const float*)d_in[14];
    C.w_up = (const float*)d_in[15]; C.w_down = (const float*)d_in[16]; C.out = (float*)d_out; C.ws = (unsigned char*)d_ws;
    if (MK_SINGLE) {
        if (hipMemsetAsync((char*)d_ws + WS_CTL, 0, CTL_ZERO_BYTES, stream) != hipSuccess) { fprintf(stderr, "kernel_launch: memset failed\n"); return; }
        a.ph_lo = 0; a.ph_hi = NPHASE;
        hipLaunchKernelGGL(fwd_mega, dim3(grid), dim3(NT), LDS_BYTES, stream, a);
        if (DUPL(23)) { (void)hipMemsetAsync((char*)d_ws + WS_CTL, 0, CTL_ZERO_BYTES, stream); hipLaunchKernelGGL(fwd_mega, dim3(grid), dim3(NT), LDS_BYTES, stream, a); }
    } else {
        for (int s = 0; s < NPHASE; ++s) { a.ph_lo = s; a.ph_hi = s + 1; hipLaunchKernelGGL(fwd_mega, dim3(grid), dim3(NT), LDS_BYTES, stream, a); }
    }
}
```

```cpp
#include <hip/hip_runtime.h>
#include <cstdio>
#include <cstdint>
#ifndef DUP_MASK
#define DUP_MASK 0u
#endif
#define DUPL(k) (((DUP_MASK) >> (k)) & 1u)

constexpr int BATCH = 2, SEQ = 8192, DM = 1024, M = BATCH * SEQ;
constexpr int DPROJ = 1968, NZ = 2048, DFF = 4096;
constexpr int GH = 4, GDK = 64, GDV = 128, GRANK = 16, NCH = SEQ / 64;
constexpr int MH = 8, QRANK = 256, KVRANK = 128, NOPE = 64, ROPE = 32, MV = 64, DQK = 96;
constexpr float EPS = 1e-6f;
constexpr float QSCALE = 0.10206207261596577f * 1.4426950408889634f;
constexpr int ZC_Q = 0, ZC_K = 256, ZC_V = 512, ZC_G = 1024, ZC_CQ = 1536, ZC_CKV = 1792, ZC_KPE = 1920, ZC_GATE = 1952;
__host__ __device__ __forceinline__ size_t ztile(size_t r, int c) { return ((r >> 4) * 64 + (size_t)(c >> 5)) * 512 + (r & 15) * 32 + (c & 31); }

constexpr size_t MiB = 1u << 20;
constexpr size_t WS_CTL = 0;
constexpr size_t WS_WIN = 1 * MiB, WS_WUQ = 5 * MiB, WS_WUKV = 6 * MiB, WS_WO = 7 * MiB, WS_WUP = 9 * MiB, WS_WDN = 17 * MiB;
constexpr size_t WS_SSQ = 25 * MiB, WS_DEC = 512 * 1024, WS_COS = 26 * MiB, WS_SIN = 27 * MiB;
constexpr size_t CTL_ZERO_BYTES = 64 * 1024;
constexpr size_t WS_SSQQ = 5 * MiB + 512 * 1024, WS_SSQKV = 5 * MiB + 768 * 1024, WS_SSQPE = 6 * MiB + 512 * 1024;
constexpr size_t WS_A = 28 * MiB;
constexpr size_t WS_B = 60 * MiB;
constexpr size_t WS_Z = 92 * MiB;
constexpr size_t WS_QF = 156 * MiB, WS_AQ = 156 * MiB, WS_AKV = 164 * MiB, WS_KF = 180 * MiB, WS_VF = 204 * MiB;
constexpr size_t WS_CKV = 220 * MiB;
constexpr size_t WS_H = 92 * MiB;
constexpr size_t WS_END = 252 * MiB;

typedef unsigned short bf16;
typedef float f32x4 __attribute__((ext_vector_type(4)));
typedef unsigned u32x2 __attribute__((ext_vector_type(2)));
typedef unsigned u32x4 __attribute__((ext_vector_type(4)));

__device__ __forceinline__ float bf2f(unsigned b) { return __uint_as_float(b << 16); }
__device__ __forceinline__ unsigned f2bf(float f) { unsigned u = __float_as_uint(f); return (u + 0x7fffu + ((u >> 16) & 1u)) >> 16; }
typedef float f32x2c_t __attribute__((ext_vector_type(2))); typedef __bf16 bf16x2c_t __attribute__((ext_vector_type(2)));
__device__ __forceinline__ unsigned pk2(float lo, float hi) { f32x2c_t v = {lo, hi}; bf16x2c_t b = __builtin_convertvector(v, bf16x2c_t); return __builtin_bit_cast(unsigned, b); }
__device__ __forceinline__ float wave_sum(float v) {
#pragma unroll
    for (int o = 1; o < 64; o <<= 1) v += __shfl_xor(v, o);
    return v;
}

__device__ __forceinline__ unsigned otid() { unsigned t = threadIdx.x; asm volatile("" : "+v"(t)); return t; }

struct Ctx {
    const float* x; const int* pos; const float* attn_norm; const float* w_in; const float* w_gate_up; const float* b_gate; const float* gla_out_norm;
    const float* q_a_norm; const float* w_uq; const float* kv_a_norm; const float* w_ukv; const float* q_head_norm; const float* k_head_norm;
    const float* w_out; const float* mlp_norm; const float* w_up; const float* w_down;
    float* out; unsigned char* ws;
};
constexpr int NT = 512;

__device__ __forceinline__ int win_src_col(int n) {
    if (n < 1024) return n;
    if (n < 1536) return n - 1024 + 1040;
    if (n < 1792) return n - 1536 + 1552;
    if (n < 1920) return n - 1792 + 1808;
    if (n < 1952) return n - 1920 + 1936;
    if (n < 1968) return n - 1952 + 1024;
    return -1;
}
struct MapWin { __device__ __forceinline__ int operator()(int n) const { return win_src_col(n); } };
struct MapUq  { __device__ __forceinline__ int operator()(int n) const { const int h = n >> 7, j = n & 127; return j < DQK ? h * DQK + j : -1; } };
struct MapId  { __device__ __forceinline__ int operator()(int n) const { return n; } };
template <bool GAIN, class CMap>
__device__ __forceinline__ void p0_transpose_item(const float* W, int K, int Nsrc, int N, bf16* WT, const float* kgain, float* scr, int item, int lane, const CMap& cmap) {
    const int nblk = N / 32, kb = item / nblk, nb = item % nblk, k0 = 64 * kb, n0 = 32 * nb;
    const int sc = cmap(n0 + (lane & 31)); const float keep = sc >= 0 ? 1.f : 0.f; const int scc = sc >= 0 ? sc : 0;
    const float* wp = W + (size_t)(k0 + (lane >> 5)) * Nsrc + scc;
    float v[32];
#pragma unroll
    for (int i = 0; i < 32; ++i) v[i] = wp[(size_t)(2 * i) * Nsrc];
#pragma unroll
    for (int i = 0; i < 32; ++i) { const int kk = 2 * i + (lane >> 5); float t = v[i] * keep; if (GAIN) t *= kgain[k0 + kk]; scr[kk * 33 + (lane & 31)] = t; }
    asm volatile("s_waitcnt lgkmcnt(0)" ::: "memory");
    const int c = lane & 7;
#pragma unroll
    for (int j = 0; j < 4; ++j) { const int n = (lane >> 3) + 8 * j; const float* s = scr + (8 * c) * 33 + n;
        u32x4 o; o.x = pk2(s[0 * 33], s[1 * 33]); o.y = pk2(s[2 * 33], s[3 * 33]); o.z = pk2(s[4 * 33], s[5 * 33]); o.w = pk2(s[6 * 33], s[7 * 33]);
        *(u32x4*)(WT + ((size_t)((n0 + n) >> 4) * (K >> 5) + ((k0 + 8 * c) >> 5)) * 512 + ((n0 + n) & 15) * 32 + ((k0 + 8 * c) & 31)) = o; }
    asm volatile("s_waitcnt lgkmcnt(0)" ::: "memory");
}
__device__ __forceinline__ void p0_prologue(const Ctx& C, float* lds) {
    const size_t gt = (size_t)blockIdx.x * NT + otid(), GT = (size_t)gridDim.x * NT;
    bf16* win = (bf16*)(C.ws + WS_WIN); bf16* wuq = (bf16*)(C.ws + WS_WUQ); bf16* wukv = (bf16*)(C.ws + WS_WUKV);
    bf16* wo = (bf16*)(C.ws + WS_WO); bf16* wup = (bf16*)(C.ws + WS_WUP); bf16* wdn = (bf16*)(C.ws + WS_WDN);
    {   const int lane_ = otid() & 63, wv = otid() >> 6; float* scr = lds + wv * (64 * 33 + 32);
        const int gw_ = (int)(gt >> 6), NGW_ = (int)(GT >> 6);
        constexpr int I_IN = (DM / 64) * (NZ / 32), I_UQ = (QRANK / 64) * (1024 / 32), I_UKV = (KVRANK / 64) * (1024 / 32), I_O = (DM / 64) * (DM / 32), I_UP = (DM / 64) * (DFF / 32), I_DN = (DFF / 64) * (DM / 32);
        constexpr int NITEMS = I_IN + I_UQ + I_UKV;
        (void)wo; (void)wup; (void)wdn; (void)I_O; (void)I_UP; (void)I_DN;
        for (int it = gw_; it < NITEMS; it += NGW_) {
            int r = it;
            if (r < I_IN) { p0_transpose_item<false>(C.w_in, DM, DPROJ, NZ, win, nullptr, scr, r, lane_, MapWin{}); continue; } r -= I_IN;
            if (r < I_UQ) { p0_transpose_item<true>(C.w_uq, QRANK, MH * DQK, 1024, wuq, C.q_a_norm, scr, r, lane_, MapUq{}); continue; } r -= I_UQ;
            p0_transpose_item<true>(C.w_ukv, KVRANK, 1024, 1024, wukv, C.kv_a_norm, scr, r, lane_, MapId{});
        }
    }
    const int lane = otid() & 63; const int gw = (int)(gt >> 6), NGW = (int)(GT >> 6);
    bf16* XN = (bf16*)(C.ws + WS_A); float* COS = (float*)(C.ws + WS_COS); float* SIN = (float*)(C.ws + WS_SIN);
    f32x4 gn[4];
#pragma unroll
    for (int j = 0; j < 4; ++j) gn[j] = ((const f32x4*)C.attn_norm)[lane + 64 * j];
    for (int m = gw; m < M; m += 2 * NGW) {
        const int m2 = m + NGW;
        const f32x4* xa = (const f32x4*)(C.x + (size_t)m * DM) + lane; const f32x4* xb = (const f32x4*)(C.x + (size_t)(m2 < M ? m2 : m) * DM) + lane;
        f32x4 va[4], vb[4]; float sa = 0.f, sb = 0.f;
#pragma unroll
        for (int j = 0; j < 4; ++j) { va[j] = xa[64 * j]; vb[j] = xb[64 * j]; }
#pragma unroll
        for (int j = 0; j < 4; ++j) { sa += (va[j].x * va[j].x + va[j].y * va[j].y) + (va[j].z * va[j].z + va[j].w * va[j].w); sb += (vb[j].x * vb[j].x + vb[j].y * vb[j].y) + (vb[j].z * vb[j].z + vb[j].w * vb[j].w); }
        const float ra = rsqrtf(wave_sum(sa) * (1.f / DM) + EPS), rb = rsqrtf(wave_sum(sb) * (1.f / DM) + EPS);
        u32x2* oa = (u32x2*)(XN + (size_t)m * DM) + lane; u32x2* ob = (u32x2*)(XN + (size_t)m2 * DM) + lane;
#pragma unroll
        for (int j = 0; j < 4; ++j) { u32x2 w; w.x = pk2(va[j].x * ra * gn[j].x, va[j].y * ra * gn[j].y); w.y = pk2(va[j].z * ra * gn[j].z, va[j].w * ra * gn[j].w); oa[64 * j] = w; }
        if (m2 < M) {
#pragma unroll
            for (int j = 0; j < 4; ++j) { u32x2 w; w.x = pk2(vb[j].x * rb * gn[j].x, vb[j].y * rb * gn[j].y); w.y = pk2(vb[j].z * rb * gn[j].z, vb[j].w * rb * gn[j].w); ob[64 * j] = w; } }
    }
    for (size_t i = gt; i < (size_t)M * 16; i += GT) { const int m = (int)(i >> 4), f = (int)(i & 15);
        const float invf = exp2f(-(float)(2 * f) * (1.f / 32.f) * 13.287712379549449f);
        const float ang = (float)C.pos[m] * invf; float sn, cs; sincosf(ang, &sn, &cs); COS[i] = cs; SIN[i] = sn; }
}

__device__ __forceinline__ void p0_late_weights(const Ctx& C, float* lds) {
    const unsigned t = otid(); if (t < 256) return;
    bf16* wo = (bf16*)(C.ws + WS_WO); bf16* wup = (bf16*)(C.ws + WS_WUP); bf16* wdn = (bf16*)(C.ws + WS_WDN);
    const int lane_ = t & 63, wv = (t >> 6) - 4; float* scr = lds + wv * (64 * 33 + 32);
    const int gw_ = (int)blockIdx.x * 4 + wv, NGW_ = (int)gridDim.x * 4;
    constexpr int I_O = (DM / 64) * (DM / 32), I_UP = (DM / 64) * (DFF / 32), I_DN = (DFF / 64) * (DM / 32);
    for (int it = gw_; it < I_O + I_UP + I_DN; it += NGW_) {
        int r = it;
        if (r < I_UP) { p0_transpose_item<true>(C.w_up, DM, DFF, DFF, wup, C.mlp_norm, scr, r, lane_, MapId{}); continue; } r -= I_UP;
        if (r < I_DN) { p0_transpose_item<false>(C.w_down, DFF, DM, DM, wdn, nullptr, scr, r, lane_, MapId{}); continue; } r -= I_DN;
        p0_transpose_item<false>(C.w_out, DM, DM, DM, wo, nullptr, scr, r, lane_, MapId{});
    }
}

__device__ __forceinline__ void unpack8(const u32x4 w, float (&v)[8]) { v[0] = bf2f(w.x & 0xffffu); v[1] = bf2f(w.x >> 16); v[2] = bf2f(w.y & 0xffffu); v[3] = bf2f(w.y >> 16);
    v[4] = bf2f(w.z & 0xffffu); v[5] = bf2f(w.z >> 16); v[6] = bf2f(w.w & 0xffffu); v[7] = bf2f(w.w >> 16); }
__device__ __forceinline__ u32x4 pack8(const float (&v)[8]) { u32x4 w; w.x = pk2(v[0], v[1]); w.y = pk2(v[2], v[3]); w.z = pk2(v[4], v[5]); w.w = pk2(v[6], v[7]); return w; }
constexpr float LOG2E = 1.4426950408889634f, LN2 = 0.6931471805599453f;
__device__ __forceinline__ float fexp(float x) { return __builtin_amdgcn_exp2f(x * LOG2E); }
__device__ __forceinline__ float log_gate(float gl) { const float ls = fminf(gl, 0.f) - LN2 * __builtin_amdgcn_logf(1.f + fexp(-fabsf(gl))); return fmaxf(ls * (1.f / 16.f), -1.f); }
__device__ __forceinline__ float silu_f(float g) { return g * __builtin_amdgcn_rcpf(1.f + fexp(-g)); }
__device__ __forceinline__ void gla_scan(const Ctx& C) {
    const float* CKV = (const float*)(C.ws + WS_CKV); const float* DEC = (const float*)(C.ws + WS_DEC); bf16* PREV = (bf16*)(C.ws + WS_A);
    if (otid() >= 256) return;
    for (int e = blockIdx.x * 256 + otid(); e < BATCH * GH * 128 * 64; e += gridDim.x * 256) {
        const int d = e & 63, v = (e >> 6) & 127, bh = e >> 13; float st = 0.f;
        for (int n0 = 0; n0 < NCH; n0 += 16) {
            float cv[16], dv[16];
#pragma unroll
            for (int i = 0; i < 16; ++i) { const size_t u = (size_t)bh * NCH + n0 + i; cv[i] = CKV[(u * 128 + v) * 64 + d]; dv[i] = DEC[u * 64 + d]; }
#pragma unroll
            for (int i = 0; i < 16; ++i) { const size_t u = (size_t)bh * NCH + n0 + i; PREV[(u * 128 + v) * 64 + d] = (bf16)f2bf(st); st = dv[i] * st + cv[i]; }
        }
    }
}

namespace att {
typedef short bf16x8 __attribute__((ext_vector_type(8)));
typedef short s16x4 __attribute__((ext_vector_type(4)));
typedef float f32x16 __attribute__((ext_vector_type(16)));
typedef __attribute__((address_space(3))) const char* lds_cptr;
constexpr int KSLOT = 12288, VSLOT = 8192, LDS_K = 0, LDS_V = 3 * KSLOT, LDS_WS = LDS_V + 3 * VSLOT, LDS_OST = LDS_WS + 8 * 256, LDS_TOTAL = LDS_OST + 8 * 4096;
constexpr int QP = MH * DQK, VP = MH * MV;
#define ATT_SBAR() __builtin_amdgcn_sched_barrier(0)
__device__ __forceinline__ int crow(int r, int hi) { return (r & 3) + 8 * (r >> 2) + 4 * hi; }
__device__ __forceinline__ void glds16(const void* gsrc, unsigned lds_dst) { unsigned keep;
    asm volatile("s_mov_b32 %0, m0\n\ts_mov_b32 m0, %2\n\ts_nop 0\n\tglobal_load_lds_dwordx4 %1, off\n\ts_mov_b32 m0, %0" : "=&s"(keep) : "v"(gsrc), "s"(lds_dst) : "memory"); }
typedef float f32x2_t __attribute__((ext_vector_type(2))); typedef __bf16 bf16x2_t __attribute__((ext_vector_type(2)));
__device__ __forceinline__ unsigned cvtpk_s(float lo, float hi) { f32x2_t v = {lo, hi}; bf16x2_t b = __builtin_convertvector(v, bf16x2_t); return __builtin_bit_cast(unsigned, b); }
typedef short att_v4i16 __attribute__((ext_vector_type(4)));
__device__ __forceinline__ s16x4 vtr(lds_cptr p) { return __builtin_bit_cast(s16x4, __builtin_amdgcn_ds_read_tr16_b64_v4i16((__attribute__((address_space(3))) att_v4i16*)p)); }
#define ATT_MX3(a, b, c) __builtin_fmaxf(__builtin_fmaxf((a), (b)), (c))
__device__ __forceinline__ float rowmax(const f32x16& p0, const f32x16& p1) {
    float a = ATT_MX3(p0[0], p0[1], p1[0]), b = ATT_MX3(p0[2], p0[3], p1[1]); a = ATT_MX3(a, p1[2], p1[3]);
#pragma unroll
    for (int r = 4; r < 16; r += 4) { a = ATT_MX3(a, p0[r], p0[r + 1]); b = ATT_MX3(b, p0[r + 2], p0[r + 3]); a = ATT_MX3(a, p1[r], p1[r + 1]); b = ATT_MX3(b, p1[r + 2], p1[r + 3]); }
    float m = __builtin_fmaxf(a, b); auto rr = __builtin_amdgcn_permlane32_swap(__float_as_uint(m), __float_as_uint(m), false, false);
    return __builtin_fmaxf(__uint_as_float(rr[0]), __uint_as_float(rr[1])); }
__device__ __forceinline__ void pv(f32x16* o, int vb, bf16x8 pa0, bf16x8 pa1, bf16x8 pa2, bf16x8 pa3) {
#pragma unroll
    for (int d0 = 0; d0 < 2; ++d0) { s16x4 lo[4], hi[4];
#pragma unroll
        for (int ks = 0; ks < 4; ++ks) {
            asm volatile("ds_read_b64_tr_b16 %0,%1 offset:%c2" : "=&v"(lo[ks]) : "v"(vb), "i"(d0 * 4096 + ks * 1024) : "memory");
            asm volatile("ds_read_b64_tr_b16 %0,%1 offset:%c2" : "=&v"(hi[ks]) : "v"(vb), "i"(d0 * 4096 + ks * 1024 + 512) : "memory"); }
        asm volatile("s_waitcnt lgkmcnt(0)" ::: "memory"); ATT_SBAR();
#define ATT_PK(k) (bf16x8){lo[k][0], lo[k][1], lo[k][2], lo[k][3], hi[k][0], hi[k][1], hi[k][2], hi[k][3]}
        o[d0] = __builtin_amdgcn_mfma_f32_32x32x16_bf16(pa0, ATT_PK(0), o[d0], 0, 0, 0);
        o[d0] = __builtin_amdgcn_mfma_f32_32x32x16_bf16(pa1, ATT_PK(1), o[d0], 0, 0, 0);
        o[d0] = __builtin_amdgcn_mfma_f32_32x32x16_bf16(pa2, ATT_PK(2), o[d0], 0, 0, 0);
        o[d0] = __builtin_amdgcn_mfma_f32_32x32x16_bf16(pa3, ATT_PK(3), o[d0], 0, 0, 0);
#undef ATT_PK
    }
}
#define ATT_WAIT_BAR0() asm volatile("s_waitcnt vmcnt(0) lgkmcnt(0)\n\ts_barrier" ::: "memory")
template <int THRL>
__device__ __forceinline__ void attn_unit(int b, int h, int qb, const bf16* Q, const bf16* K, const bf16* V, bf16* O, char* shm) {
    const int tid = threadIdx.x, lane = tid & 63, r32 = lane & 31, hi = lane >> 5; const int wid = __builtin_amdgcn_readfirstlane(tid >> 6);
    const long rowbase = (long)b * SEQ; const int q0 = qb * 256; const int NTL = 4 * qb + 4, tmax = 4 * qb + (wid >> 1);
    const bf16* Qw = Q + (rowbase + q0 + wid * 32) * QP + h * DQK;
    const long bh = (long)b * MH + h;
    const bf16* ksrc0 = K + (bh * 128 * 12 + wid) * 512 + lane * 8;
    const bf16* ksrc1 = K + (bh * 128 * 12 + 8 + (wid & 3)) * 512 + lane * 8;
    const bf16* vsrc = V + (bh * 128 * 2 + (wid >> 2)) * 2048 + (16 * (wid & 3) + (lane >> 2)) * 32 + (lane & 3) * 8;
    const unsigned lds0 = (unsigned)(uintptr_t)shm;
    const unsigned kdst0 = lds0 + LDS_K + wid * 1024, kdst1 = lds0 + LDS_K + (8 + (wid & 3)) * 1024, vdst = lds0 + LDS_V + wid * 1024;
    float* wsf = (float*)(shm + LDS_WS) + wid * 64;
#define ATT_DMA(t, s) do { glds16(ksrc0 + (long)(t) * 6144, (unsigned)__builtin_amdgcn_readfirstlane(kdst0 + (s) * KSLOT)); \
        if (wid < 4) glds16(ksrc1 + (long)(t) * 6144, (unsigned)__builtin_amdgcn_readfirstlane(kdst1 + (s) * KSLOT)); \
        glds16(vsrc + (long)(t) * 4096, (unsigned)__builtin_amdgcn_readfirstlane(vdst + (s) * VSLOT)); } while (0)
    ATT_DMA(0, 0);
    bf16x8 qr[6];
#pragma unroll
    for (int d0 = 0; d0 < 6; ++d0) qr[d0] = *reinterpret_cast<const bf16x8*>(&Qw[(long)r32 * QP + d0 * 16 + hi * 8]);
    float mhat = 0.f, l_reg = 0.f; f32x16 o[2]; o[0] = f32x16{}; o[1] = f32x16{}; f32x16 negm = f32x16{}; asm volatile("" : "+v"(negm));
    const lds_cptr shm3 = (lds_cptr)shm;
    const int vlane = ((lane >> 4) & 1) * 32 + (lane & 3) * 8 + (4 * hi + ((lane & 15) >> 2)) * 64;
    u32x4 pw0 = (u32x4){0u, 0u, 0u, 0u}, pw1 = pw0, pw2 = pw0, pw3 = pw0;
    s16x4 vlo[8], vhi[8];
#define ATT_KRD(slot, d0) do { ka[slot] = *(const __attribute__((address_space(3))) bf16x8*)(kp + (d0) * 2048); kb[slot] = *(const __attribute__((address_space(3))) bf16x8*)(kp + (d0) * 2048 + 512); } while (0)
#define ATT_VRD(i) do { vlo[i] = vtr(vp + (((i) >> 2) * 4096 + ((i) & 3) * 1024)); vhi[i] = vtr(vp + (((i) >> 2) * 4096 + ((i) & 3) * 1024 + 512)); } while (0)
#define ATT_QKSM(t, s) do { \
        const lds_cptr kp = shm3 + LDS_K + (s) * KSLOT + hi * 1024 + r32 * 16; const lds_cptr vp = shm3 + LDS_V + (s) * VSLOT + vlane; \
        f32x16 p0, p1; bf16x8 ka[3], kb[3]; \
        ATT_KRD(0, 0); ATT_KRD(1, 1); ATT_SBAR(); \
        ATT_KRD(2, 2); p0 = __builtin_amdgcn_mfma_f32_32x32x16_bf16(ka[0], qr[0], negm, 0, 0, 0); p1 = __builtin_amdgcn_mfma_f32_32x32x16_bf16(kb[0], qr[0], negm, 0, 0, 0); ATT_VRD(0); ATT_VRD(1); ATT_SBAR(); \
        ATT_KRD(0, 3); p0 = __builtin_amdgcn_mfma_f32_32x32x16_bf16(ka[1], qr[1], p0, 0, 0, 0); p1 = __builtin_amdgcn_mfma_f32_32x32x16_bf16(kb[1], qr[1], p1, 0, 0, 0); ATT_VRD(2); ATT_VRD(3); ATT_SBAR(); \
        ATT_KRD(1, 4); p0 = __builtin_amdgcn_mfma_f32_32x32x16_bf16(ka[2], qr[2], p0, 0, 0, 0); p1 = __builtin_amdgcn_mfma_f32_32x32x16_bf16(kb[2], qr[2], p1, 0, 0, 0); ATT_VRD(4); ATT_VRD(5); ATT_SBAR(); \
        ATT_KRD(2, 5); p0 = __builtin_amdgcn_mfma_f32_32x32x16_bf16(ka[0], qr[3], p0, 0, 0, 0); p1 = __builtin_amdgcn_mfma_f32_32x32x16_bf16(kb[0], qr[3], p1, 0, 0, 0); ATT_VRD(6); ATT_VRD(7); ATT_SBAR(); \
        p0 = __builtin_amdgcn_mfma_f32_32x32x16_bf16(ka[1], qr[4], p0, 0, 0, 0); p1 = __builtin_amdgcn_mfma_f32_32x32x16_bf16(kb[1], qr[4], p1, 0, 0, 0); ATT_SBAR(); \
        p0 = __builtin_amdgcn_mfma_f32_32x32x16_bf16(ka[2], qr[5], p0, 0, 0, 0); p1 = __builtin_amdgcn_mfma_f32_32x32x16_bf16(kb[2], qr[5], p1, 0, 0, 0); ATT_SBAR(); \
        const float rm = rowmax(p0, p1); \
        if ((t) == 0) { mhat = rm; \
            _Pragma("unroll") for (int r = 0; r < 16; ++r) { p0[r] -= rm; p1[r] -= rm; } \
            _Pragma("unroll") for (int r = 0; r < 16; ++r) negm[r] = -mhat; \
            asm volatile("" : "+v"(negm)); \
        } else if (__any(rm > (float)THRL)) { const float dl = __builtin_fmaxf(rm, 0.f); mhat += dl; \
            _Pragma("unroll") for (int r = 0; r < 16; ++r) { p0[r] -= dl; p1[r] -= dl; } \
            _Pragma("unroll") for (int r = 0; r < 16; ++r) negm[r] = -mhat; \
            asm volatile("" : "+v"(negm)); \
            const float f = __builtin_amdgcn_exp2f(-dl); l_reg *= f; if (hi == 0) wsf[r32] = f; \
            asm volatile("s_waitcnt lgkmcnt(0)" ::: "memory"); \
            _Pragma("unroll") for (int d_ = 0; d_ < 2; ++d_) _Pragma("unroll") for (int r = 0; r < 16; ++r) o[d_][r] *= wsf[crow(r, hi)]; } \
        float sa0, sa1, sa2, sa3;        \
        p0[0] = __builtin_amdgcn_exp2f(p0[0]); p1[0] = __builtin_amdgcn_exp2f(p1[0]); p0[1] = __builtin_amdgcn_exp2f(p0[1]); p1[1] = __builtin_amdgcn_exp2f(p1[1]); \
        _Pragma("unroll") for (int r = 2; r < 16; r += 2) { p0[r] = __builtin_amdgcn_exp2f(p0[r]); p1[r] = __builtin_amdgcn_exp2f(p1[r]); p0[r + 1] = __builtin_amdgcn_exp2f(p0[r + 1]); p1[r + 1] = __builtin_amdgcn_exp2f(p1[r + 1]); \
            if (r == 2) { asm("v_add_f32 %0, %1, %2" : "=v"(sa0) : "v"(p0[0]), "v"(p0[2])); asm("v_add_f32 %0, %1, %2" : "=v"(sa1) : "v"(p1[0]), "v"(p1[2])); asm("v_add_f32 %0, %1, %2" : "=v"(sa2) : "v"(p0[1]), "v"(p0[3])); asm("v_add_f32 %0, %1, %2" : "=v"(sa3) : "v"(p1[1]), "v"(p1[3])); } \
            else { asm("v_add_f32 %0, %0, %1" : "+v"(sa0) : "v"(p0[r])); asm("v_add_f32 %0, %0, %1" : "+v"(sa1) : "v"(p1[r])); asm("v_add_f32 %0, %0, %1" : "+v"(sa2) : "v"(p0[r + 1])); asm("v_add_f32 %0, %0, %1" : "+v"(sa3) : "v"(p1[r + 1])); } } \
        l_reg += (sa0 + sa1) + (sa2 + sa3); \
        pw0 = (u32x4){cvtpk_s(p0[0], p0[1]), cvtpk_s(p0[2], p0[3]), cvtpk_s(p0[4], p0[5]), cvtpk_s(p0[6], p0[7])}; \
        pw1 = (u32x4){cvtpk_s(p0[8], p0[9]), cvtpk_s(p0[10], p0[11]), cvtpk_s(p0[12], p0[13]), cvtpk_s(p0[14], p0[15])}; \
        pw2 = (u32x4){cvtpk_s(p1[0], p1[1]), cvtpk_s(p1[2], p1[3]), cvtpk_s(p1[4], p1[5]), cvtpk_s(p1[6], p1[7])}; \
        pw3 = (u32x4){cvtpk_s(p1[8], p1[9]), cvtpk_s(p1[10], p1[11]), cvtpk_s(p1[12], p1[13]), cvtpk_s(p1[14], p1[15])}; \
    } while (0)
#define ATT_VFR(i) (bf16x8){vlo[i][0], vlo[i][1], vlo[i][2], vlo[i][3], vhi[i][0], vhi[i][1], vhi[i][2], vhi[i][3]}
#define ATT_PV(s) do { ATT_SBAR(); \
        o[0] = __builtin_amdgcn_mfma_f32_32x32x16_bf16(__builtin_bit_cast(bf16x8, pw0), ATT_VFR(0), o[0], 0, 0, 0); o[1] = __builtin_amdgcn_mfma_f32_32x32x16_bf16(__builtin_bit_cast(bf16x8, pw0), ATT_VFR(4), o[1], 0, 0, 0); \
        o[0] = __builtin_amdgcn_mfma_f32_32x32x16_bf16(__builtin_bit_cast(bf16x8, pw1), ATT_VFR(1), o[0], 0, 0, 0); o[1] = __builtin_amdgcn_mfma_f32_32x32x16_bf16(__builtin_bit_cast(bf16x8, pw1), ATT_VFR(5), o[1], 0, 0, 0); \
        o[0] = __builtin_amdgcn_mfma_f32_32x32x16_bf16(__builtin_bit_cast(bf16x8, pw2), ATT_VFR(2), o[0], 0, 0, 0); o[1] = __builtin_amdgcn_mfma_f32_32x32x16_bf16(__builtin_bit_cast(bf16x8, pw2), ATT_VFR(6), o[1], 0, 0, 0); \
        o[0] = __builtin_amdgcn_mfma_f32_32x32x16_bf16(__builtin_bit_cast(bf16x8, pw3), ATT_VFR(3), o[0], 0, 0, 0); o[1] = __builtin_amdgcn_mfma_f32_32x32x16_bf16(__builtin_bit_cast(bf16x8, pw3), ATT_VFR(7), o[1], 0, 0, 0); \
    } while (0)
    int s_cur = 0, s_prev = 2;
    if (wid < 4) __builtin_amdgcn_s_setprio(1);
    if (wid < 4) {
        for (int t = 0; t < NTL; ++t) {
            ATT_WAIT_BAR0();
            const int s_next = (s_cur == 2) ? 0 : s_cur + 1;
            if (t + 1 < NTL) ATT_DMA(t + 1, s_next);
            if (t <= tmax) { ATT_QKSM(t, s_cur); ATT_PV(s_cur); }
            s_prev = s_cur; s_cur = s_next;
        }
    } else {
        for (int t = 0; t < NTL; ++t) {
            ATT_WAIT_BAR0();
            const int s_next = (s_cur == 2) ? 0 : s_cur + 1;
            if (t + 1 < NTL) ATT_DMA(t + 1, s_next);
            if (t >= 1 && t - 1 <= tmax) ATT_PV(s_prev);
            if (t <= tmax) ATT_QKSM(t, s_cur);
            s_prev = s_cur; s_cur = s_next;
        }
        if (NTL - 1 <= tmax) ATT_PV(s_prev);
    }
    __builtin_amdgcn_s_setprio(0);
    { auto rr = __builtin_amdgcn_permlane32_swap(__float_as_uint(l_reg), __float_as_uint(l_reg), false, false); l_reg = __uint_as_float(rr[0]) + __uint_as_float(rr[1]); }
    if (hi == 0) wsf[32 + r32] = l_reg;
    asm volatile("s_waitcnt lgkmcnt(0)" ::: "memory");
    float rli[16];
#pragma unroll
    for (int r = 0; r < 16; ++r) rli[r] = __builtin_amdgcn_rcpf(wsf[32 + crow(r, hi)]);
    const long orow0 = rowbase + q0 + wid * 32; const int ocol0 = 512 + h * MV;
    { bf16* stg = (bf16*)(shm + LDS_OST) + wid * 2048;
#pragma unroll
        for (int r = 0; r < 16; ++r) { const int orow = crow(r, hi);
#pragma unroll
            for (int d0 = 0; d0 < 2; ++d0) stg[orow * 64 + d0 * 32 + r32] = (bf16)f2bf(o[d0][r] * rli[r]); }
        asm volatile("s_waitcnt lgkmcnt(0)" ::: "memory");
#pragma unroll
        for (int i = 0; i < 4; ++i) { const int row = i * 8 + (lane >> 3), ch = lane & 7; const u32x4 v = *(const u32x4*)(stg + row * 64 + ch * 8); const long r = orow0 + row; const int c = ocol0 + ch * 8;
            *(u32x4*)(O + ((r >> 4) * 32 + (c >> 5)) * 512 + (r & 15) * 32 + (c & 31)) = v; } }
    asm volatile("s_waitcnt lgkmcnt(0)\n\ts_barrier" ::: "memory");
#undef ATT_DMA
#undef ATT_QKSM
#undef ATT_KRD
#undef ATT_VRD
#undef ATT_VFR
#undef ATT_PV
}
__device__ __forceinline__ void attn_phase(const Ctx& C, char* lds) {
    const bf16* QF = (const bf16*)(C.ws + WS_QF); const bf16* KF = (const bf16*)(C.ws + WS_KF); const bf16* VF = (const bf16*)(C.ws + WS_VF); bf16* O = (bf16*)(C.ws + WS_B);
    const int G = (int)gridDim.x, bx = (int)blockIdx.x; const int vcu = (G % 8 == 0) ? (bx % 8) * (G / 8) + bx / 8 : bx;
    for (int i = vcu; i < BATCH * MH * 32; i += G) { const int bh = (i & 255) >> 4, s = i & 15, qb = (i < 256) ? 31 - s : s;
        attn_unit<8>(bh >> 3, bh & 7, qb, QF, KF, VF, O, lds); }
    __syncthreads();
}
}

namespace gla {
using att::bf16x8; using att::s16x4; using att::f32x16; using att::lds_cptr; using att::crow; using att::cvtpk_s;
constexpr int L_VIMG = 0, L_QIMG = 16384, L_KIMG = 24576, L_WT = 32768, L_OBUF = 36864, OLD = 132, L_WG = 73728, L_BG = L_WG + 16384;
#define GLA_BAR() asm volatile("s_waitcnt lgkmcnt(0)\n\ts_barrier" ::: "memory")
__device__ __forceinline__ void stage_gate(const Ctx& C, unsigned char* lds) {
    const int tid = threadIdx.x;
#pragma unroll
    for (int i = 0; i < 2; ++i) *(f32x4*)(lds + L_WG + (tid + NT * i) * 16) = *(const f32x4*)(C.w_gate_up + (tid + NT * i) * 4);
    if (tid < 64) *(f32x4*)(lds + L_BG + tid * 16) = *(const f32x4*)(C.b_gate + tid * 4);
}
__device__ __forceinline__ void cum_rows(const u32x4 g0, const u32x4 g1, int h, const unsigned char* lds, float (&cum)[8], float (&tot)[8]) {
    const int tid = threadIdx.x, lane = tid & 63; const int wv = __builtin_amdgcn_readfirstlane(tid >> 6);
    float zg[16];
    { float a[8], b[8]; unpack8(g0, a); unpack8(g1, b);
#pragma unroll
      for (int j = 0; j < 8; ++j) { zg[j] = a[j]; zg[8 + j] = b[j]; } }
    float x[8];
    { const f32x4 b0 = *(const f32x4*)(lds + L_BG + (h * 64 + 8 * wv) * 4), b1 = *(const f32x4*)(lds + L_BG + (h * 64 + 8 * wv + 4) * 4);
      x[0] = b0.x; x[1] = b0.y; x[2] = b0.z; x[3] = b0.w; x[4] = b1.x; x[5] = b1.y; x[6] = b1.z; x[7] = b1.w; }
#pragma unroll
    for (int gh = 0; gh < 2; ++gh) { f32x4 w0[8], w1[8];
#pragma unroll
        for (int g = 0; g < 8; ++g) { w0[g] = *(const f32x4*)(lds + L_WG + ((gh * 8 + g) * 256 + h * 64 + 8 * wv) * 4); w1[g] = *(const f32x4*)(lds + L_WG + ((gh * 8 + g) * 256 + h * 64 + 8 * wv + 4) * 4); }
#pragma unroll
        for (int g = 0; g < 8; ++g) { const float z = zg[gh * 8 + g];
            x[0] += z * w0[g].x; x[1] += z * w0[g].y; x[2] += z * w0[g].z; x[3] += z * w0[g].w; x[4] += z * w1[g].x; x[5] += z * w1[g].y; x[6] += z * w1[g].z; x[7] += z * w1[g].w; } }
#pragma unroll
    for (int j = 0; j < 8; ++j) x[j] = log_gate(x[j]);
#define GLA_DPP(v, ctrl, rmask) __builtin_bit_cast(float, __builtin_amdgcn_update_dpp(0, __builtin_bit_cast(int, (v)), (ctrl), (rmask), 0xF, true))
#pragma unroll
    for (int j = 0; j < 8; ++j) { float v = x[j];
        v += GLA_DPP(v, 0x111, 0xF); v += GLA_DPP(v, 0x112, 0xF); v += GLA_DPP(v, 0x114, 0xF); v += GLA_DPP(v, 0x118, 0xF);
        v += GLA_DPP(v, 0x142, 0xA); v += GLA_DPP(v, 0x143, 0xC);
        cum[j] = v; tot[j] = __builtin_bit_cast(float, __builtin_amdgcn_readlane(__builtin_bit_cast(int, v), 63)); }
#undef GLA_DPP
}
__device__ __forceinline__ void trfrag4(int base, bf16x8 (&f)[4]) {
    s16x4 lo[4], hi[4];
#pragma unroll
    for (int ks = 0; ks < 4; ++ks) {
        asm volatile("ds_read_b64_tr_b16 %0,%1 offset:%c2" : "=&v"(lo[ks]) : "v"(base), "i"(ks * 1024) : "memory");
        asm volatile("ds_read_b64_tr_b16 %0,%1 offset:%c2" : "=&v"(hi[ks]) : "v"(base), "i"(ks * 1024 + 512) : "memory"); }
    asm volatile("s_waitcnt lgkmcnt(0)" ::: "memory"); __builtin_amdgcn_sched_barrier(0);
#pragma unroll
    for (int ks = 0; ks < 4; ++ks) f[ks] = (bf16x8){lo[ks][0], lo[ks][1], lo[ks][2], lo[ks][3], hi[ks][0], hi[ks][1], hi[ks][2], hi[ks][3]};
}
struct Raw { u32x4 q, k, v0, v1, g0, g1, z0, z1; bf16x8 pf[4]; };
template <bool P2>
__device__ __forceinline__ void load_raw(const Ctx& C, int u, Raw& R) {
    const bf16* Z = (const bf16*)(C.ws + WS_Z); const bf16* PREV = (const bf16*)(C.ws + WS_A);
    const int tid = threadIdx.x, lane = tid & 63, r32 = lane & 31, hi = lane >> 5, c = tid >> 3, dc = tid & 7; const int wv = __builtin_amdgcn_readfirstlane(tid >> 6);
    const int n = u % NCH, h = (u / NCH) % GH, b = u / (NCH * GH); const int row0 = b * SEQ + n * 64;
    const size_t rl_ = (size_t)(row0 + lane);
    R.k = *(const u32x4*)(Z + ztile(rl_, ZC_K + h * 64 + 8 * wv)); R.g0 = *(const u32x4*)(Z + ztile(rl_, ZC_GATE)); R.g1 = *(const u32x4*)(Z + ztile(rl_, ZC_GATE + 8));
    { const int j = tid >> 4, cc = tid & 15; R.v0 = *(const u32x4*)(Z + ztile((size_t)(row0 + j), ZC_V + h * 128 + cc * 8)); R.v1 = *(const u32x4*)(Z + ztile((size_t)(row0 + 32 + j), ZC_V + h * 128 + cc * 8)); }
    if (P2) { R.q = *(const u32x4*)(Z + ztile(rl_, ZC_Q + h * 64 + 8 * wv)); const size_t rc_ = (size_t)(row0 + c); R.z0 = *(const u32x4*)(Z + ztile(rc_, ZC_G + h * 128 + 16 * dc)); R.z1 = *(const u32x4*)(Z + ztile(rc_, ZC_G + h * 128 + 16 * dc + 8));
        const int cb = wv & 3;
#pragma unroll
        for (int s = 0; s < 4; ++s) R.pf[s] = *(const bf16x8*)(PREV + ((size_t)u * 128 + 32 * cb + r32) * 64 + 16 * s + 8 * hi); }
}
__device__ __forceinline__ void store_vimg(const Raw& R, unsigned char* lds) {
    const int tid = threadIdx.x, j = tid >> 4, cc = tid & 15;
    *(u32x4*)(lds + L_VIMG + (cc >> 2) * 4096 + j * 64 + (cc & 3) * 16) = R.v0; *(u32x4*)(lds + L_VIMG + (cc >> 2) * 4096 + (32 + j) * 64 + (cc & 3) * 16) = R.v1;
}
__device__ __forceinline__ void pass1(const Ctx& C, unsigned char* lds) {
    float* CKV = (float*)(C.ws + WS_CKV); float* DEC = (float*)(C.ws + WS_DEC);
    const int tid = threadIdx.x, lane = tid & 63, r32 = lane & 31, hi = lane >> 5, c = tid >> 3, dc = tid & 7; const int wv = __builtin_amdgcn_readfirstlane(tid >> 6);
    const unsigned lds0 = (unsigned)(uintptr_t)lds; const int lpart = ((lane >> 4) & 1) * 32 + (lane & 3) * 8 + (4 * hi + ((lane & 15) >> 2)) * 64;
    const int NU = BATCH * GH * NCH, G = (int)gridDim.x;
    __syncthreads(); stage_gate(C, lds);
    Raw cur; if ((int)blockIdx.x < NU) load_raw<false>(C, (int)blockIdx.x, cur);
    for (int u = blockIdx.x; u < NU; u += G) {
        const int h = (u / NCH) % GH;
        Raw nxt = cur; if (u + G < NU) load_raw<false>(C, u + G, nxt);
        GLA_BAR();
        store_vimg(cur, lds);
        float kv[8]; unpack8(cur.k, kv);
        float cum[8], tot[8]; cum_rows(cur.g0, cur.g1, h, lds, cum, tot);
#pragma unroll
        for (int j = 0; j < 8; ++j) kv[j] *= fexp(tot[j] - cum[j]);
        *(u32x4*)(lds + L_QIMG + (wv >> 2) * 4096 + lane * 64 + (wv & 3) * 16) = pack8(kv);
        if (lane == 63) {
#pragma unroll
            for (int j = 0; j < 8; ++j) DEC[(size_t)u * 64 + 8 * wv + j] = fexp(tot[j]); }
        GLA_BAR();
        const int vb = wv >> 1, db = wv & 1;
        bf16x8 af[4], bfr[4]; trfrag4((int)(lds0 + L_VIMG + vb * 4096) + lpart, af); trfrag4((int)(lds0 + L_QIMG + db * 4096) + lpart, bfr);
        f32x16 o = f32x16{};
#pragma unroll
        for (int ks = 0; ks < 4; ++ks) o = __builtin_amdgcn_mfma_f32_32x32x16_bf16(af[ks], bfr[ks], o, 0, 0, 0);
#pragma unroll
        for (int r = 0; r < 16; ++r) CKV[((size_t)u * 128 + 32 * vb + crow(r, hi)) * 64 + 32 * db + r32] = o[r];
        cur = nxt;
    }
    __syncthreads();
}
__device__ __forceinline__ void pass2(const Ctx& C, unsigned char* lds) {
    bf16* MIX = (bf16*)(C.ws + WS_B);
    const int tid = threadIdx.x, lane = tid & 63, r32 = lane & 31, hi = lane >> 5, c = tid >> 3, dc = tid & 7; const int wv = __builtin_amdgcn_readfirstlane(tid >> 6);
    const unsigned lds0 = (unsigned)(uintptr_t)lds; const int lpart = ((lane >> 4) & 1) * 32 + (lane & 3) * 8 + (4 * hi + ((lane & 15) >> 2)) * 64;
    const lds_cptr L3 = (lds_cptr)lds; float* obuf = (float*)(lds + L_OBUF);
    const int rb = wv >> 2, cb = wv & 3;
    const int NU = BATCH * GH * NCH, G = (int)gridDim.x;
    f32x4 gn[4];
#pragma unroll
    for (int i = 0; i < 4; ++i) gn[i] = *(const f32x4*)(C.gla_out_norm + 16 * dc + 4 * i);
    __syncthreads(); stage_gate(C, lds);
    Raw cur; if ((int)blockIdx.x < NU) load_raw<true>(C, (int)blockIdx.x, cur);
    for (int u = blockIdx.x; u < NU; u += G) {
        const int n = u % NCH, h = (u / NCH) % GH, b = u / (NCH * GH); const int row0 = b * SEQ + n * 64;
        Raw nxt = cur; if (u + G < NU) load_raw<true>(C, u + G, nxt);
        GLA_BAR();
        store_vimg(cur, lds);
        float qv[8], kv[8]; unpack8(cur.q, qv); unpack8(cur.k, kv);
        float cum[8], tot[8]; cum_rows(cur.g0, cur.g1, h, lds, cum, tot);
#pragma unroll
        for (int j = 0; j < 8; ++j) { qv[j] *= 0.125f * fexp(cum[j]); kv[j] *= fexp(-cum[j]); }
        *(u32x4*)(lds + L_QIMG + wv * 1024 + lane * 16) = pack8(qv); *(u32x4*)(lds + L_KIMG + wv * 1024 + lane * 16) = pack8(kv);
        GLA_BAR();
        bf16x8 qr[4];
#pragma unroll
        for (int s = 0; s < 4; ++s) qr[s] = *(const __attribute__((address_space(3))) bf16x8*)(L3 + L_QIMG + (2 * s + hi) * 1024 + (32 * rb + r32) * 16);
        f32x16 p0 = f32x16{}, p1 = f32x16{};
#pragma unroll
        for (int s = 0; s < 4; ++s) { const lds_cptr kp = L3 + L_KIMG + (2 * s + hi) * 1024 + r32 * 16;
            const bf16x8 a0 = *(const __attribute__((address_space(3))) bf16x8*)(kp), a1 = *(const __attribute__((address_space(3))) bf16x8*)(kp + 512);
            p0 = __builtin_amdgcn_mfma_f32_32x32x16_bf16(a0, qr[s], p0, 0, 0, 0); p1 = __builtin_amdgcn_mfma_f32_32x32x16_bf16(a1, qr[s], p1, 0, 0, 0); }
        const int cq = 32 * rb + r32;
#pragma unroll
        for (int r = 0; r < 16; ++r) { const int j = crow(r, hi); p0[r] = (j <= cq) ? p0[r] : 0.f; p1[r] = (j + 32 <= cq) ? p1[r] : 0.f; }
        u32x4 pw0, pw1, pw2, pw3;
        pw0 = (u32x4){cvtpk_s(p0[0], p0[1]), cvtpk_s(p0[2], p0[3]), cvtpk_s(p0[4], p0[5]), cvtpk_s(p0[6], p0[7])};
        pw1 = (u32x4){cvtpk_s(p0[8], p0[9]), cvtpk_s(p0[10], p0[11]), cvtpk_s(p0[12], p0[13]), cvtpk_s(p0[14], p0[15])};
        pw2 = (u32x4){cvtpk_s(p1[0], p1[1]), cvtpk_s(p1[2], p1[3]), cvtpk_s(p1[4], p1[5]), cvtpk_s(p1[6], p1[7])};
        pw3 = (u32x4){cvtpk_s(p1[8], p1[9]), cvtpk_s(p1[10], p1[11]), cvtpk_s(p1[12], p1[13]), cvtpk_s(p1[14], p1[15])};
        __builtin_amdgcn_sched_barrier(0);
        bf16x8 vf[4]; trfrag4((int)(lds0 + L_VIMG + cb * 4096) + lpart, vf);
        f32x16 o = f32x16{};
        o = __builtin_amdgcn_mfma_f32_32x32x16_bf16(__builtin_bit_cast(bf16x8, pw0), vf[0], o, 0, 0, 0);
        o = __builtin_amdgcn_mfma_f32_32x32x16_bf16(__builtin_bit_cast(bf16x8, pw1), vf[1], o, 0, 0, 0);
        o = __builtin_amdgcn_mfma_f32_32x32x16_bf16(__builtin_bit_cast(bf16x8, pw2), vf[2], o, 0, 0, 0);
        o = __builtin_amdgcn_mfma_f32_32x32x16_bf16(__builtin_bit_cast(bf16x8, pw3), vf[3], o, 0, 0, 0);
#pragma unroll
        for (int s = 0; s < 4; ++s) o = __builtin_amdgcn_mfma_f32_32x32x16_bf16(qr[s], cur.pf[s], o, 0, 0, 0);
#pragma unroll
        for (int r = 0; r < 16; ++r) obuf[(32 * rb + crow(r, hi)) * OLD + 32 * cb + r32] = o[r];
        GLA_BAR();
        { float ov[16];
#pragma unroll
            for (int i = 0; i < 4; ++i) { const f32x4 t = *(const f32x4*)(obuf + c * OLD + 16 * dc + 4 * i); ov[4 * i] = t.x; ov[4 * i + 1] = t.y; ov[4 * i + 2] = t.z; ov[4 * i + 3] = t.w; }
            float ss = 0.f;
#pragma unroll
            for (int i = 0; i < 16; ++i) ss += ov[i] * ov[i];
            ss += __shfl_xor(ss, 1); ss += __shfl_xor(ss, 2); ss += __shfl_xor(ss, 4);
            const float rn = rsqrtf(ss * (1.f / GDV) + EPS); const size_t row = (size_t)(row0 + c);
            float g0[8], g1[8]; unpack8(cur.z0, g0); unpack8(cur.z1, g1);
            const float gv[16] = {gn[0].x, gn[0].y, gn[0].z, gn[0].w, gn[1].x, gn[1].y, gn[1].z, gn[1].w, gn[2].x, gn[2].y, gn[2].z, gn[2].w, gn[3].x, gn[3].y, gn[3].z, gn[3].w};
            float w0[8], w1[8];
#pragma unroll
            for (int i = 0; i < 8; ++i) { w0[i] = ov[i] * rn * gv[i] * silu_f(g0[i]); w1[i] = ov[8 + i] * rn * gv[8 + i] * silu_f(g1[i]); }
            { const int c0 = h * 128 + 16 * dc; bf16* mp = MIX + ((row >> 4) * 32 + (c0 >> 5)) * 512 + (row & 15) * 32 + (c0 & 31);
              *(u32x4*)mp = pack8(w0); *(u32x4*)(mp + 8) = pack8(w1); } }
        cur = nxt;
    }
    __syncthreads();
}
#undef GLA_BAR
}

namespace pg8 {
#define PG8_LAS __attribute__((address_space(3)))
typedef unsigned short bf16_t;
typedef short bf16x8 __attribute__((ext_vector_type(8)));
typedef float f32x4 __attribute__((ext_vector_type(4)));
typedef unsigned u32x4 __attribute__((ext_vector_type(4)));
constexpr int BM = 256, BK = 64, HALF = 128, HTB = HALF * BK * 2  , STAGE_BYTES = 8 * HTB, NXCD = 8, WGM = 8;

__host__ __device__ __forceinline__ int lds_byte(int r, int c) { const int st = (r >> 4) * 2 + (c >> 5), rr = r & 15, cc = c & 31, ob = rr * 64 + cc * 2; return st * 1024 + (ob ^ (((ob >> 9) & 1) << 5)); }
__host__ __device__ __forceinline__ void stage_rc(int b, int& R, int& C) { const int st = b / 1024, sb = b % 1024, swz = sb ^ (((sb >> 9) & 1) << 5); R = (st >> 1) * 16 + swz / 64; C = (st & 1) * 32 + (swz % 64) / 2; }
__host__ __device__ __forceinline__ int perm32(int rho) { const int n = rho >> 4, i = rho & 15; return 8 * (i >> 2) + 4 * n + (i & 3); }

struct Unit { int pm, pn; };
struct Gemm { const bf16_t* A; const bf16_t* Bt; int M, N, K, lda; bool ta, tb; };

struct StaticOrder {
    int nM, nN, nwg, G, c;
    __host__ __device__ void init(int M, int N, int G_, int c_) { nM = M / BM; nN = N / BM; nwg = nM * nN; G = G_; c = c_; }
    __host__ __device__ bool next(int i, Unit& u) const {
        const long L = (long)i * G + c; if (L >= nwg) return false;
        int wgid = (int)L; { const int q = nwg / NXCD, r = nwg % NXCD, xcd = wgid % NXCD, off = wgid / NXCD; wgid = (xcd < r ? xcd * (q + 1) : r * (q + 1) + (xcd - r) * q) + off; }
        const int nig = WGM * nN, gid = wgid / nig, fm = gid * WGM, gsz = (nM - fm) < WGM ? (nM - fm) : WGM;
        u.pm = fm + ((wgid % nig) % gsz); u.pn = (wgid % nig) / gsz; return true;
    }
    __device__ __forceinline__ void a_ready(const Unit&) const {}
    __device__ __forceinline__ void done(const Unit&) const {}
};

__device__ __forceinline__ unsigned cvt_pk_bf16(float lo, float hi) { unsigned r; asm volatile("v_cvt_pk_bf16_f32 %0, %1, %2" : "=v"(r) : "v"(lo), "v"(hi)); return r; }
typedef float f32x2 __attribute__((ext_vector_type(2)));
__device__ __forceinline__ void st16_wt(void* p, u32x4 v) { asm volatile("global_store_dwordx4 %0, %1, off sc1\n\ts_nop 1" :: "v"(p), "v"(v) : "memory"); }
typedef unsigned u32x2v __attribute__((ext_vector_type(2)));
struct EpiBf16 {
    static constexpr bool PERM = true, AFTER_DRAIN = false; static constexpr int PROBE_BIT = 26;
    bf16_t* O; int ldc;
    __device__ __forceinline__ void operator()(const f32x4 (&acc)[2][2][4][2], const Unit& u, int wr, int wc, int fr, int fq) const {
        const int row0 = u.pm * BM + wr * 64 + fr, col0 = u.pn * BM + wc * 32 + 8 * fq;
#pragma unroll
        for (int ai = 0; ai < 2; ++ai)
#pragma unroll
            for (int m = 0; m < 4; ++m) { bf16_t* rowp = O + (size_t)(row0 + ai * HALF + m * 16) * ldc + col0;
#pragma unroll
                for (int bj = 0; bj < 2; ++bj) { const f32x4 v0 = acc[ai][bj][m][0], v1 = acc[ai][bj][m][1];
                    u32x4 w; w.x = cvt_pk_bf16(v0[0], v0[1]); w.y = cvt_pk_bf16(v0[2], v0[3]); w.z = cvt_pk_bf16(v1[0], v1[1]); w.w = cvt_pk_bf16(v1[2], v1[3]);
                    *(u32x4*)(rowp + bj * HALF) = w; } }
    }
};
struct EpiZ {
    static constexpr bool PERM = true, AFTER_DRAIN = false; static constexpr int PROBE_BIT = 27;
    bf16_t* O; int ldc; float* ssqq; float* ssqkv; float* ssqpe;
    __device__ __forceinline__ void operator()(const f32x4 (&acc)[2][2][4][2], const Unit& u, int wr, int wc, int fr, int fq) const {
        const int row0 = u.pm * BM + wr * 64 + fr, col0 = u.pn * BM + wc * 32 + 8 * fq;
#pragma unroll
        for (int ai = 0; ai < 2; ++ai)
#pragma unroll
            for (int m = 0; m < 4; ++m) { const int r = row0 + ai * HALF + m * 16; bf16_t* rowp = O + ((size_t)(r >> 4) * (ldc >> 5) + (col0 >> 5)) * 512 + (r & 15) * 32 + (col0 & 31); float sq[2];
#pragma unroll
                for (int bj = 0; bj < 2; ++bj) { const f32x4 v0 = acc[ai][bj][m][0], v1 = acc[ai][bj][m][1];
                    u32x4 w; w.x = cvt_pk_bf16(v0[0], v0[1]); w.y = cvt_pk_bf16(v0[2], v0[3]); w.z = cvt_pk_bf16(v1[0], v1[1]); w.w = cvt_pk_bf16(v1[2], v1[3]);
                    st16_wt(rowp + bj * 4 * 512, w);
                    sq[bj] = ((v0[0] * v0[0] + v0[1] * v0[1]) + (v0[2] * v0[2] + v0[3] * v0[3])) + ((v1[0] * v1[0] + v1[1] * v1[1]) + (v1[2] * v1[2] + v1[3] * v1[3])); }
                if (u.pn == 6) { float s = sq[0] + sq[1]; s += __shfl_xor(s, 16); s += __shfl_xor(s, 32); if (fq == 0) ssqq[(size_t)r * 4 + wc] = s; }
                else if (u.pn == 7) { float s = sq[0]; s += __shfl_xor(s, 16); s += __shfl_xor(s, 32); if (fq == 0) ssqkv[(size_t)r * 4 + wc] = s;
                    if (wc == 0) { float t = sq[1]; t += __shfl_xor(t, 16); t += __shfl_xor(t, 32); if (fq == 0) ssqpe[r] = t; } } }
    }
};
struct EpiQ {
    static constexpr bool PERM = false, AFTER_DRAIN = true; static constexpr int PROBE_BIT = 25;
    const float* ssqq; const float* gq; const float* cosT; const float* sinT; bf16_t* QF; float eps, qscale;
    __device__ __forceinline__ void fused(f32x4 (&acc)[2][2][4][2], const Unit& u, int wr, int wc, int fr, int fq, PG8_LAS unsigned char* lds, int wid, int lane) const {
        PG8_LAS float* P = (PG8_LAS float*)lds;
        f32x4 s4A[2][4];
#pragma unroll
        for (int ai = 0; ai < 2; ++ai)
#pragma unroll
            for (int m = 0; m < 4; ++m) s4A[ai][m] = *(const f32x4*)(ssqq + (size_t)(u.pm * BM + ai * HALF + wr * 64 + m * 16 + fr) * 4);
        __builtin_amdgcn_sched_barrier(0);
#pragma unroll
        for (int ai = 0; ai < 2; ++ai)
#pragma unroll
            for (int m = 0; m < 4; ++m) { const int rl = ai * HALF + wr * 64 + m * 16 + fr; const f32x4 s4 = s4A[ai][m];
                const float ra = __builtin_amdgcn_rsqf(((s4[0] + s4[1]) + (s4[2] + s4[3])) * (1.0f / 256.0f) + eps);
#pragma unroll
                for (int bj = 0; bj < 2; ++bj) { float s = 0.f;
#pragma unroll
                    for (int n = 0; n < 2; ++n) { const f32x4 v = acc[ai][bj][m][n] * ra; acc[ai][bj][m][n] = v; s += (v[0] * v[0] + v[1] * v[1]) + (v[2] * v[2] + v[3] * v[3]); }
                    s += __shfl_xor(s, 16); s += __shfl_xor(s, 32);
                    if (fq == 0) P[(rl * 2 + bj) * 4 + wc] = s; } }
        asm volatile("s_waitcnt lgkmcnt(0)" ::: "memory"); __builtin_amdgcn_s_barrier(); asm volatile("" ::: "memory");
        PG8_LAS unsigned char* ST = lds + 8192;
        if (wc < 3) {
            const int j0 = wc * 32 + 4 * fq; const f32x4 g0 = *(const f32x4*)(gq + j0), g1 = *(const f32x4*)(gq + j0 + 16);
            f32x4 csA[2][4], snA[2][4];
#pragma unroll
            for (int ai = 0; ai < 2; ++ai)
#pragma unroll
                for (int m = 0; m < 4; ++m) { const size_t r = (size_t)(u.pm * BM + ai * HALF + wr * 64 + m * 16 + fr); csA[ai][m] = (f32x4){1.f, 1.f, 1.f, 1.f}; snA[ai][m] = (f32x4){0.f, 0.f, 0.f, 0.f};
                    if (wc == 2) { csA[ai][m] = *(const f32x4*)(cosT + r * 16 + 4 * fq); snA[ai][m] = *(const f32x4*)(sinT + r * 16 + 4 * fq); } }
            __builtin_amdgcn_sched_barrier(0);
#pragma unroll
            for (int ai = 0; ai < 2; ++ai)
#pragma unroll
                for (int m = 0; m < 4; ++m) { const int rl = ai * HALF + wr * 64 + m * 16 + fr; const f32x4 cs = csA[ai][m], sn = snA[ai][m];
#pragma unroll
                    for (int bj = 0; bj < 2; ++bj) { const f32x4 p = *(const PG8_LAS f32x4*)(P + (rl * 2 + bj) * 4);
                        const float rh = qscale * __builtin_amdgcn_rsqf(((p[0] + p[1]) + (p[2] + p[3])) * (1.0f / 96.0f) + eps);
                        const f32x4 a = acc[ai][bj][m][0] * rh * g0, b = acc[ai][bj][m][1] * rh * g1;
                        f32x4 o0 = a, o1 = b; if (wc == 2) { o0 = a * cs - b * sn; o1 = a * sn + b * cs; }
                        PG8_LAS unsigned char* dst = ST + rl * 400 + (bj * 96 + j0) * 2;
                        u32x2v w0, w1; w0.x = cvt_pk_bf16(o0[0], o0[1]); w0.y = cvt_pk_bf16(o0[2], o0[3]); w1.x = cvt_pk_bf16(o1[0], o1[1]); w1.y = cvt_pk_bf16(o1[2], o1[3]);
                        *(PG8_LAS u32x2v*)dst = w0; *(PG8_LAS u32x2v*)(dst + 32) = w1; }
                    }
        }
        asm volatile("s_waitcnt lgkmcnt(0)" ::: "memory"); __builtin_amdgcn_s_barrier(); asm volatile("" ::: "memory");
        { const int tid = wid * 64 + lane;
#pragma unroll
            for (int i = 0; i < 12; ++i) { const int idx = tid + 512 * i, row = idx / 24, ch = idx - row * 24;
                st16_wt(QF + (size_t)(u.pm * BM + row) * 768 + (2 * u.pn) * 96 + ch * 8, *(const PG8_LAS u32x4*)(ST + row * 400 + ch * 16)); } }
    }
};
struct EpiKV {
    static constexpr bool PERM = false, AFTER_DRAIN = true; static constexpr int PROBE_BIT = 24;
    const float* ssqkv; const float* ssqpe; const float* gk; const float* cosT; const float* sinT; const bf16_t* Z; bf16_t* KF; bf16_t* VF; float eps;
    __device__ __forceinline__ void fused(f32x4 (&acc)[2][2][4][2], const Unit& u, int wr, int wc, int fr, int fq, PG8_LAS unsigned char* lds, int wid, int lane) const {
        PG8_LAS float* P = (PG8_LAS float*)lds;
        f32x4 s4A[2][4];
#pragma unroll
        for (int ai = 0; ai < 2; ++ai)
#pragma unroll
            for (int m = 0; m < 4; ++m) s4A[ai][m] = *(const f32x4*)(ssqkv + (size_t)(u.pm * BM + ai * HALF + wr * 64 + m * 16 + fr) * 4);
        __builtin_amdgcn_sched_barrier(0);
#pragma unroll
        for (int ai = 0; ai < 2; ++ai)
#pragma unroll
            for (int m = 0; m < 4; ++m) { const int rl = ai * HALF + wr * 64 + m * 16 + fr; const f32x4 s4 = s4A[ai][m];
                const float ra = __builtin_amdgcn_rsqf(((s4[0] + s4[1]) + (s4[2] + s4[3])) * (1.0f / 128.0f) + eps);
#pragma unroll
                for (int bj = 0; bj < 2; ++bj) { float s = 0.f;
#pragma unroll
                    for (int n = 0; n < 2; ++n) { const f32x4 v = acc[ai][bj][m][n] * ra; acc[ai][bj][m][n] = v; s += (v[0] * v[0] + v[1] * v[1]) + (v[2] * v[2] + v[3] * v[3]); }
                    if (wc < 2) { s += __shfl_xor(s, 16); s += __shfl_xor(s, 32); if (fq == 0) P[(rl * 2 + bj) * 2 + wc] = s; } } }
        asm volatile("s_waitcnt lgkmcnt(0)" ::: "memory"); __builtin_amdgcn_s_barrier(); asm volatile("" ::: "memory");
        const int j0 = wc * 32 + 4 * fq;
        PG8_LAS unsigned char* ST = lds + 8192;
        if (wc < 2) {
            const f32x4 g0 = *(const f32x4*)(gk + j0), g1 = *(const f32x4*)(gk + j0 + 16);
            float pesA[2][4];
#pragma unroll
            for (int ai = 0; ai < 2; ++ai)
#pragma unroll
                for (int m = 0; m < 4; ++m) pesA[ai][m] = ssqpe[(size_t)(u.pm * BM + ai * HALF + wr * 64 + m * 16 + fr)];
            __builtin_amdgcn_sched_barrier(0);
#pragma unroll
            for (int ai = 0; ai < 2; ++ai)
#pragma unroll
                for (int m = 0; m < 4; ++m) { const int rl = ai * HALF + wr * 64 + m * 16 + fr; const float pes = pesA[ai][m];
#pragma unroll
                    for (int bj = 0; bj < 2; ++bj) { const float rk = __builtin_amdgcn_rsqf((P[(rl * 2 + bj) * 2] + P[(rl * 2 + bj) * 2 + 1] + pes) * (1.0f / 96.0f) + eps);
                        const f32x4 o0 = acc[ai][bj][m][0] * rk * g0, o1 = acc[ai][bj][m][1] * rk * g1; PG8_LAS unsigned char* dst = ST + rl * 400 + (bj * 96 + j0) * 2;
                        u32x2v w0, w1; w0.x = cvt_pk_bf16(o0[0], o0[1]); w0.y = cvt_pk_bf16(o0[2], o0[3]); w1.x = cvt_pk_bf16(o1[0], o1[1]); w1.y = cvt_pk_bf16(o1[2], o1[3]);
                        *(PG8_LAS u32x2v*)dst = w0; *(PG8_LAS u32x2v*)(dst + 32) = w1; }
                    asm volatile("" ::: "memory"); }
        } else {
#pragma unroll
            for (int ai = 0; ai < 2; ++ai)
#pragma unroll
                for (int m = 0; m < 4; ++m) { const int rl = ai * HALF + wr * 64 + m * 16 + fr; const size_t r = (size_t)(u.pm * BM + rl);
#pragma unroll
                    for (int bj = 0; bj < 2; ++bj) { const f32x4 o0 = acc[ai][bj][m][0], o1 = acc[ai][bj][m][1];
                        bf16_t* dst = VF + (((((size_t)(u.pm >> 5) * 8 + 2 * u.pn + bj) * 128 + (u.pm & 31) * 4 + (rl >> 6)) * 2 + (wc - 2)) * 64 + (rl & 63)) * 32 + 4 * fq;
                        u32x2v w0, w1; w0.x = cvt_pk_bf16(o0[0], o0[1]); w0.y = cvt_pk_bf16(o0[2], o0[3]); w1.x = cvt_pk_bf16(o1[0], o1[1]); w1.y = cvt_pk_bf16(o1[2], o1[3]);
                        *(u32x2v*)dst = w0; *(u32x2v*)(dst + 16) = w1; }
                    asm volatile("" ::: "memory"); }
            if (wc == 2) {
                const f32x4 g0 = *(const f32x4*)(gk + 64 + 4 * fq), g1 = *(const f32x4*)(gk + 80 + 4 * fq);
#pragma unroll
                for (int ai = 0; ai < 2; ++ai) {
                    float pesB[4]; u32x2v xaB[4], xbB[4]; f32x4 csB[4], snB[4];
#pragma unroll
                    for (int m = 0; m < 4; ++m) { const size_t r = (size_t)(u.pm * BM + ai * HALF + wr * 64 + m * 16 + fr); pesB[m] = ssqpe[r];
                        xaB[m] = *(const u32x2v*)(Z + ((r >> 4) * 64 + 60) * 512 + (r & 15) * 32 + 4 * fq); xbB[m] = *(const u32x2v*)(Z + ((r >> 4) * 64 + 60) * 512 + (r & 15) * 32 + 16 + 4 * fq);
                        csB[m] = *(const f32x4*)(cosT + r * 16 + 4 * fq); snB[m] = *(const f32x4*)(sinT + r * 16 + 4 * fq); }
                    __builtin_amdgcn_sched_barrier(0);
#pragma unroll
                    for (int m = 0; m < 4; ++m) { const int rl = ai * HALF + wr * 64 + m * 16 + fr; const float pes = pesB[m];
                        const u32x2v xa = xaB[m], xb = xbB[m];
                        const f32x4 x1 = (f32x4){__uint_as_float(xa.x << 16), __uint_as_float(xa.x & 0xffff0000u), __uint_as_float(xa.y << 16), __uint_as_float(xa.y & 0xffff0000u)};
                        const f32x4 x2 = (f32x4){__uint_as_float(xb.x << 16), __uint_as_float(xb.x & 0xffff0000u), __uint_as_float(xb.y << 16), __uint_as_float(xb.y & 0xffff0000u)};
                        const f32x4 cs = csB[m], sn = snB[m];
#pragma unroll
                        for (int bj = 0; bj < 2; ++bj) { const float rk = __builtin_amdgcn_rsqf((P[(rl * 2 + bj) * 2] + P[(rl * 2 + bj) * 2 + 1] + pes) * (1.0f / 96.0f) + eps);
                            const f32x4 a = x1 * rk * g0, b = x2 * rk * g1, o0 = a * cs - b * sn, o1 = a * sn + b * cs; PG8_LAS unsigned char* dst = ST + rl * 400 + (bj * 96 + 64 + 4 * fq) * 2;
                            u32x2v w0, w1; w0.x = cvt_pk_bf16(o0[0], o0[1]); w0.y = cvt_pk_bf16(o0[2], o0[3]); w1.x = cvt_pk_bf16(o1[0], o1[1]); w1.y = cvt_pk_bf16(o1[2], o1[3]);
                            *(PG8_LAS u32x2v*)dst = w0; *(PG8_LAS u32x2v*)(dst + 32) = w1; } }
                    asm volatile("" ::: "memory"); }
            }
        }
        asm volatile("s_waitcnt lgkmcnt(0)" ::: "memory"); __builtin_amdgcn_s_barrier(); asm volatile("" ::: "memory");
        { const int tid = wid * 64 + lane;
#pragma unroll
            for (int i = 0; i < 12; ++i) { const int idx = tid + 512 * i, ch = idx >> 8, row = idx & 255, hd = 2 * u.pn + (ch >= 12 ? 1 : 0), c = ch >= 12 ? ch - 12 : ch;
                st16_wt(KF + (((((size_t)(u.pm >> 5) * 8 + hd) * 128 + (u.pm & 31) * 4 + (row >> 6)) * 12 + c) * 64 + (row & 63)) * 8, *(const PG8_LAS u32x4*)(ST + row * 400 + ch * 16)); } }
    }
};
struct EpiOutProjG {
    static constexpr bool PERM = false, AFTER_DRAIN = false; static constexpr int PROBE_BIT = 28;
    const float* x; float* x1; bf16_t* x1b; float* ssq;
    __device__ __forceinline__ void operator()(const f32x4 (&acc)[2][2][4][2], const Unit& u, int wr, int wc, int fr, int fq) const {
        const int col0 = u.pn * BM + wc * 32 + 4 * fq;
#pragma unroll
        for (int ai = 0; ai < 2; ++ai) {
            f32x4 xr[4][2][2];
#pragma unroll
            for (int m = 0; m < 4; ++m) { const size_t off = (size_t)(u.pm * BM + ai * HALF + wr * 64 + m * 16 + fr) * 1024 + col0;
#pragma unroll
                for (int bj = 0; bj < 2; ++bj)
#pragma unroll
                    for (int n = 0; n < 2; ++n) xr[m][bj][n] = *(const f32x4*)(x + off + bj * HALF + n * 16); }
            __builtin_amdgcn_sched_barrier(0);
#pragma unroll
            for (int m = 0; m < 4; ++m) { const int r = u.pm * BM + ai * HALF + wr * 64 + m * 16 + fr; const size_t off = (size_t)r * 1024 + col0; float s = 0.f;
#pragma unroll
                for (int bj = 0; bj < 2; ++bj)
#pragma unroll
                    for (int n = 0; n < 2; ++n) { const f32x4 t = xr[m][bj][n] + acc[ai][bj][m][n];
                        u32x2v w; w.x = cvt_pk_bf16(t[0], t[1]); w.y = cvt_pk_bf16(t[2], t[3]);
                        *(u32x2v*)(x1b + ((size_t)(r >> 4) * 32 + ((col0 >> 5) + 4 * bj)) * 512 + (r & 15) * 32 + (col0 & 31) + 16 * n) = w;
                        s += (t[0] * t[0] + t[1] * t[1]) + (t[2] * t[2] + t[3] * t[3]); }
                s += __shfl_xor(s, 16); s += __shfl_xor(s, 32);
                if (fq == 0) ssq[(size_t)r * 16 + u.pn * 4 + wc] = s; }
            asm volatile("" ::: "memory"); }
    }
};
struct EpiUpG {
    static constexpr bool PERM = true, AFTER_DRAIN = false; static constexpr int PROBE_BIT = 29;
    const PG8_LAS float* rtab; bf16_t* H;
    __device__ __forceinline__ void operator()(const f32x4 (&acc)[2][2][4][2], const Unit& u, int wr, int wc, int fr, int fq) const { (*this)(acc, u, wr, wc, fr, fq, 0); }
    __device__ __forceinline__ void operator()(const f32x4 (&acc)[2][2][4][2], const Unit& u, int wr, int wc, int fr, int fq, int ui) const {
        const int row0 = u.pm * BM + wr * 64 + fr, col0 = u.pn * BM + wc * 32 + 8 * fq;
#pragma unroll
        for (int ai = 0; ai < 2; ++ai)
#pragma unroll
            for (int m = 0; m < 4; ++m) { const int r = row0 + ai * HALF + m * 16;
                const float rstd = rtab[(ui & 3) * 256 + wr * 64 + fr + ai * HALF + m * 16];
                bf16_t* rowp = H + ((size_t)(r >> 4) * 128 + (col0 >> 5)) * 512 + (r & 15) * 32 + (col0 & 31);
#pragma unroll
                for (int bj = 0; bj < 2; ++bj) { f32x4 v0 = acc[ai][bj][m][0] * rstd, v1 = acc[ai][bj][m][1] * rstd;
#pragma unroll
                    for (int e = 0; e < 4; ++e) { v0[e] = __builtin_fmaxf(v0[e], 0.f); v1[e] = __builtin_fmaxf(v1[e], 0.f); }
                    v0 = v0 * v0; v1 = v1 * v1;
                    u32x4 w; w.x = cvt_pk_bf16(v0[0], v0[1]); w.y = cvt_pk_bf16(v0[2], v0[3]); w.z = cvt_pk_bf16(v1[0], v1[1]); w.w = cvt_pk_bf16(v1[2], v1[3]);
                    st16_wt(rowp + bj * 4 * 512, w); } }
    }
};
struct EpiDownG {
    static constexpr bool PERM = false, AFTER_DRAIN = false; static constexpr int PROBE_BIT = 30;
    const bf16_t* x1b; float* out;
    __device__ __forceinline__ void operator()(const f32x4 (&acc)[2][2][4][2], const Unit& u, int wr, int wc, int fr, int fq) const {
        const int col0 = u.pn * BM + wc * 32 + 4 * fq;
        u32x2v xw[2][4][2][2];
#pragma unroll
        for (int ai = 0; ai < 2; ++ai)
#pragma unroll
            for (int m = 0; m < 4; ++m) { const size_t off = (size_t)(u.pm * BM + ai * HALF + wr * 64 + m * 16 + fr) * 1024 + col0;
#pragma unroll
                for (int bj = 0; bj < 2; ++bj)
#pragma unroll
                    for (int n = 0; n < 2; ++n) { const int r_ = u.pm * BM + ai * HALF + wr * 64 + m * 16 + fr; xw[ai][m][bj][n] = *(const u32x2v*)(x1b + ((size_t)(r_ >> 4) * 32 + ((col0 >> 5) + 4 * bj)) * 512 + (r_ & 15) * 32 + (col0 & 31) + 16 * n); } }
        __builtin_amdgcn_sched_barrier(0);
#pragma unroll
        for (int ai = 0; ai < 2; ++ai)
#pragma unroll
            for (int m = 0; m < 4; ++m) { const size_t off = (size_t)(u.pm * BM + ai * HALF + wr * 64 + m * 16 + fr) * 1024 + col0;
#pragma unroll
                for (int bj = 0; bj < 2; ++bj)
#pragma unroll
                    for (int n = 0; n < 2; ++n) { const u32x2v w = xw[ai][m][bj][n];
                        const f32x4 xr = (f32x4){__uint_as_float(w.x << 16), __uint_as_float(w.x & 0xffff0000u), __uint_as_float(w.y << 16), __uint_as_float(w.y & 0xffff0000u)};
                        *(f32x4*)(out + off + bj * HALF + n * 16) = xr + acc[ai][bj][m][n]; } }
    }
};
template <class Epi, class Sched, bool ALIGN_EPI = false, bool SP2 = false>
__device__ __forceinline__ void gemm_phase(PG8_LAS unsigned char* lds, const Gemm g, const Sched& S, const Epi& E) {
    const int tid = threadIdx.x, wid = __builtin_amdgcn_readfirstlane(tid >> 6), lane = tid & 63, wr = wid >> 2, wc = wid & 3, fr = lane & 15, fq = lane >> 4;
    const int K = g.K, nt = K / BK;
    unsigned voffA[2], voffB[2];
#pragma unroll
    for (int i = 0; i < 2; ++i) { int R, C; stage_rc(tid * 16 + i * 8192, R, C); const int Rb = Epi::PERM ? ((R & ~31) + perm32(R & 31)) : R;
        voffA[i] = g.ta ? (unsigned)(((R >> 4) * (g.lda >> 5) + (C >> 5)) * 1024 + (R & 15) * 64 + (C & 31) * 2) : (unsigned)(R * g.lda + C) * 2u;
        voffB[i] = g.tb ? (unsigned)(((Rb >> 4) * (K >> 5) + (C >> 5)) * 1024 + (Rb & 15) * 64 + (C & 31) * 2) : (unsigned)(Rb * K + C) * 2u; }
    const size_t kstepA = g.ta ? (size_t)2048 : (size_t)(BK * 2), kstepB = g.tb ? (size_t)2048 : (size_t)(BK * 2);
    const size_t hstepB = (size_t)HALF * K * 2, hstepA = (size_t)HALF * g.lda * 2;
    const size_t tstepB = 2 * hstepB, tstepA = 2 * hstepA;
    const unsigned ldsw = (unsigned)wid * 1024u;
    const int aoff = lds_byte(wr * 64 + fr, fq * 8), boff = lds_byte(wc * 32 + fr, fq * 8);
#define PG8_SA(b, h) (((b) * 2 + (h)) * HTB)
#define PG8_SB(b, h) ((4 + (b) * 2 + (h)) * HTB)
#define PG8_STAGE(bufoff, gbase, voff) do { _Pragma("unroll") for (int _i = 0; _i < 2; ++_i) \
        __builtin_amdgcn_global_load_lds((const unsigned*)((const char*)(gbase) + (voff)[_i]), (PG8_LAS unsigned*)(lds + (bufoff) + ldsw + _i * 8192), 16, 0, 0); } while (0)
#define PG8_LDA(dst, b, h) do { _Pragma("unroll") for (int m = 0; m < 4; ++m) _Pragma("unroll") for (int k = 0; k < 2; ++k) dst[m][k] = *(const PG8_LAS bf16x8*)(lds + PG8_SA(b, h) + aoff + m * 2048 + k * 1024); } while (0)
#define PG8_LDB(dst, b, h) do { _Pragma("unroll") for (int n = 0; n < 2; ++n) _Pragma("unroll") for (int k = 0; k < 2; ++k) dst[n][k] = *(const PG8_LAS bf16x8*)(lds + PG8_SB(b, h) + boff + n * 2048 + k * 1024); } while (0)
#define PG8_MMA(ai, bj, At, Bt) do { __builtin_amdgcn_s_setprio(1); _Pragma("unroll") for (int m = 0; m < 4; ++m) _Pragma("unroll") for (int n = 0; n < 2; ++n) _Pragma("unroll") for (int k = 0; k < 2; ++k) \
        acc[ai][bj][m][n] = __builtin_amdgcn_mfma_f32_16x16x32_bf16(Bt[n][k], At[m][k], acc[ai][bj][m][n], 0, 0, 0); __builtin_amdgcn_s_setprio(0); } while (0)
#define PG8_WAIT_V(n) asm volatile("s_waitcnt vmcnt(" #n ")" ::: "memory")
#define PG8_WAIT_L(n) asm volatile("s_waitcnt lgkmcnt(" #n ")" ::: "memory")
#define PG8_BAR __builtin_amdgcn_s_barrier()
#define PG8_SCHED __builtin_amdgcn_sched_barrier(0)
    Unit cur, nxt; int ui = 0;
    if (!S.next(0, cur)) return;
    f32x4 acc[2][2][4][2];
#pragma unroll
    for (int a = 0; a < 2; ++a)
#pragma unroll
        for (int b = 0; b < 2; ++b)
#pragma unroll
            for (int m = 0; m < 4; ++m)
#pragma unroll
                for (int n = 0; n < 2; ++n) acc[a][b][m][n] = (f32x4){0.f, 0.f, 0.f, 0.f};
    bf16x8 At[4][2], B0[2][2], B1[2][2];
    const char* cA = (const char*)g.A + (size_t)cur.pm * tstepA; const char* cB = (const char*)g.Bt + (size_t)cur.pn * tstepB;
    S.a_ready(cur);
    if constexpr (SP2) {
        PG8_STAGE(PG8_SB(0, 0), cB, voffB); PG8_STAGE(PG8_SB(0, 1), cB + hstepB, voffB); PG8_STAGE(PG8_SA(0, 0), cA, voffA); PG8_STAGE(PG8_SA(0, 1), cA + hstepA, voffA);
        if (wr == 1) PG8_BAR;
        PG8_WAIT_V(2); PG8_BAR;
        PG8_STAGE(PG8_SB(1, 0), cB + kstepB, voffB); PG8_STAGE(PG8_SA(1, 0), cA + kstepA, voffA); PG8_STAGE(PG8_SB(1, 1), cB + hstepB + kstepB, voffB);
        PG8_WAIT_V(6); PG8_BAR;
    } else {
        PG8_STAGE(PG8_SB(0, 0), cB, voffB); PG8_STAGE(PG8_SA(0, 0), cA, voffA); PG8_STAGE(PG8_SB(0, 1), cB + hstepB, voffB); PG8_STAGE(PG8_SA(0, 1), cA + hstepA, voffA);
        if (wr == 1) PG8_BAR;
        PG8_WAIT_V(4); PG8_BAR;
        PG8_STAGE(PG8_SB(1, 0), cB + kstepB, voffB); PG8_STAGE(PG8_SA(1, 0), cA + kstepA, voffA); PG8_STAGE(PG8_SB(1, 1), cB + hstepB + kstepB, voffB);
        PG8_WAIT_V(6); PG8_BAR;
    }
    for (;;) {
        const bool has_next = S.next(ui + 1, nxt);
        const char* nA = has_next ? (const char*)g.A + (size_t)nxt.pm * tstepA : cA; const char* nB = has_next ? (const char*)g.Bt + (size_t)nxt.pn * tstepB : cB;
        for (int t = 0; t < nt; t += 2) {
            const bool last = (t == nt - 2);
            const char* a1 = cA + (size_t)(t + 1) * kstepA;
            const char* a2 = last ? nA : cA + (size_t)(t + 2) * kstepA; const char* b2 = last ? nB : cB + (size_t)(t + 2) * kstepB;
            const char* a3 = a2 + kstepA; const char* b3 = b2 + kstepB;
            if (last && has_next) S.a_ready(nxt);
            if constexpr (SP2) {
            PG8_LDB(B0, 0, 0); PG8_LDB(B1, 0, 1); PG8_SCHED; PG8_LDA(At, 0, 0); PG8_STAGE(PG8_SA(1, 1), a1 + hstepA, voffA);
            PG8_WAIT_V(8); PG8_WAIT_L(0); PG8_BAR; PG8_MMA(0, 0, At, B0); PG8_MMA(0, 1, At, B1); PG8_BAR; PG8_SCHED;
            PG8_LDA(At, 0, 1); PG8_STAGE(PG8_SB(0, 0), b2, voffB); PG8_STAGE(PG8_SB(0, 1), b2 + hstepB, voffB); PG8_STAGE(PG8_SA(0, 0), a2, voffA);
            PG8_WAIT_V(8); PG8_WAIT_L(0); PG8_BAR; PG8_MMA(1, 0, At, B0); PG8_MMA(1, 1, At, B1); PG8_BAR; PG8_SCHED;
            PG8_LDB(B0, 1, 0); PG8_LDB(B1, 1, 1); PG8_SCHED; PG8_LDA(At, 1, 0); PG8_STAGE(PG8_SA(0, 1), a2 + hstepA, voffA);
            PG8_WAIT_V(8); PG8_WAIT_L(0); PG8_BAR; PG8_MMA(0, 0, At, B0); PG8_MMA(0, 1, At, B1); PG8_BAR; PG8_SCHED;
            PG8_LDA(At, 1, 1); PG8_STAGE(PG8_SB(1, 0), b3, voffB); PG8_STAGE(PG8_SB(1, 1), b3 + hstepB, voffB); PG8_STAGE(PG8_SA(1, 0), a3, voffA);
            PG8_WAIT_V(8); PG8_WAIT_L(0); PG8_BAR; PG8_MMA(1, 0, At, B0); PG8_MMA(1, 1, At, B1); PG8_BAR; PG8_SCHED;
            } else {
            PG8_LDB(B0, 0, 0); PG8_SCHED; PG8_LDA(At, 0, 0); PG8_STAGE(PG8_SA(1, 1), a1 + hstepA, voffA);
            PG8_WAIT_L(8); PG8_BAR; PG8_WAIT_L(0); PG8_MMA(0, 0, At, B0); PG8_BAR; PG8_SCHED;
            PG8_LDB(B1, 0, 1); PG8_STAGE(PG8_SB(0, 0), b2, voffB);
            PG8_BAR; PG8_WAIT_L(0); PG8_MMA(0, 1, At, B1); PG8_BAR;
            PG8_LDA(At, 0, 1); PG8_STAGE(PG8_SA(0, 0), a2, voffA);
            PG8_BAR; PG8_WAIT_L(0); PG8_MMA(1, 0, At, B0); PG8_BAR; PG8_SCHED;
            PG8_STAGE(PG8_SB(0, 1), b2 + hstepB, voffB);
            PG8_WAIT_V(6); PG8_BAR; PG8_MMA(1, 1, At, B1); PG8_BAR;
            PG8_LDB(B0, 1, 0); PG8_SCHED; PG8_LDA(At, 1, 0); PG8_STAGE(PG8_SA(0, 1), a2 + hstepA, voffA);
            PG8_WAIT_L(8); PG8_BAR; PG8_WAIT_L(0); PG8_MMA(0, 0, At, B0); PG8_BAR; PG8_SCHED;
            PG8_LDB(B1, 1, 1); PG8_STAGE(PG8_SB(1, 0), b3, voffB);
            PG8_BAR; PG8_WAIT_L(0); PG8_MMA(0, 1, At, B1); PG8_BAR;
            PG8_LDA(At, 1, 1); PG8_STAGE(PG8_SA(1, 0), a3, voffA);
            PG8_BAR; PG8_WAIT_L(0); PG8_MMA(1, 0, At, B0); PG8_BAR; PG8_SCHED;
            PG8_STAGE(PG8_SB(1, 1), b3 + hstepB, voffB);
            PG8_WAIT_V(6); PG8_BAR; PG8_MMA(1, 1, At, B1); PG8_BAR;
            }
        }
        if constexpr (ALIGN_EPI) { if (wr == 0) PG8_BAR; }
        if constexpr (!Epi::AFTER_DRAIN) { if constexpr (Epi::PROBE_BIT == 29) E(acc, cur, wr, wc, fr, fq, ui); else E(acc, cur, wr, wc, fr, fq); if (DUPL(Epi::PROBE_BIT)) E(acc, cur, wr, wc, fr, fq); S.done(cur); }
        if (!has_next) break;
#pragma unroll
        for (int a = 0; a < 2; ++a)
#pragma unroll
            for (int b = 0; b < 2; ++b)
#pragma unroll
                for (int m = 0; m < 4; ++m)
#pragma unroll
                    for (int n = 0; n < 2; ++n) acc[a][b][m][n] = (f32x4){0.f, 0.f, 0.f, 0.f};
        cur = nxt; cA = nA; cB = nB; ++ui;
        if constexpr (ALIGN_EPI) { if (wr == 1) PG8_BAR; }
    }
    PG8_WAIT_V(0);
    if constexpr (!ALIGN_EPI) { if (wr == 0) PG8_BAR; }
    PG8_BAR;
    if constexpr (Epi::AFTER_DRAIN) { E.fused(acc, cur, wr, wc, fr, fq, lds, wid, lane); if (DUPL(Epi::PROBE_BIT)) { asm volatile("s_waitcnt lgkmcnt(0)" ::: "memory"); __builtin_amdgcn_s_barrier(); E.fused(acc, cur, wr, wc, fr, fq, lds, wid, lane); } S.done(cur); }
#undef PG8_SA
#undef PG8_SB
#undef PG8_STAGE
#undef PG8_LDA
#undef PG8_LDB
#undef PG8_MMA
#undef PG8_WAIT_V
#undef PG8_WAIT_L
#undef PG8_BAR
#undef PG8_SCHED
}
}

#define GAS __attribute__((address_space(1)))
#define LAS __attribute__((address_space(3)))
#define XB_TMO      128
#define XB_XCNT(j)  (256  + 64 * (j))
#define XB_XSUB(j)  (1280 + 64 * (j))
#define XB_XGEN(j)  (2304 + 64 * (j))
#define XB_TOP      3328
#define XB_TOPGEN   3392
#define XCD_BAR_WORDS 3456
#define XB_SPIN_CAP (1u << 18)
__device__ __forceinline__ unsigned xb_ld(unsigned* p)              { return __hip_atomic_load(p, __ATOMIC_RELAXED, __HIP_MEMORY_SCOPE_AGENT); }
__device__ __forceinline__ unsigned xb_add(unsigned* p, unsigned v) { return __hip_atomic_fetch_add(p, v, __ATOMIC_RELAXED, __HIP_MEMORY_SCOPE_AGENT); }
__device__ __forceinline__ unsigned xb_xcc_id() { return (unsigned)__builtin_amdgcn_s_getreg((3 << 11) | 20) & 0xFu; }
#define XB_SPIN(cond, bar) do { unsigned _sp = 0; while (cond) { __builtin_amdgcn_s_sleep(1); \
    if ((++_sp & 255u) == 0u) { if (xb_ld(&(bar)[XB_TMO])) break; if (_sp > XB_SPIN_CAP) { atomicAdd(&(bar)[XB_TMO], 1u); break; } } } } while (0)
struct XcdBarrier { unsigned* bar; unsigned x; volatile LAS unsigned* st; };
__device__ __forceinline__ XcdBarrier xcd_barrier_post(unsigned* bar, volatile LAS unsigned* st) {
    XcdBarrier b; b.bar = bar; b.x = xb_xcc_id(); b.st = st;
    if (threadIdx.x == 0) (void)xb_add(&bar[XB_XCNT(b.x)], 1u);
    return b;
}
__device__ __forceinline__ void xcd_barrier_complete(unsigned* bar, unsigned x, unsigned& nloc, unsigned& nx) {
    const unsigned G = gridDim.x * gridDim.y * gridDim.z;
    unsigned sum, cnt, mine, sp = 0u;
    for (;;) {
        sum = 0u; cnt = 0u; mine = 0u;
#pragma unroll
        for (unsigned j = 0; j < 16; ++j) { const unsigned c = xb_ld(&bar[XB_XCNT(j)]); sum += c; cnt += (c > 0u) ? 1u : 0u; mine = (j == x) ? c : mine; }
        if (sum == G) break;
        __builtin_amdgcn_s_sleep(1);
        if ((++sp & 255u) == 0u) { if (xb_ld(&bar[XB_TMO])) break; if (sp > XB_SPIN_CAP) { atomicAdd(&bar[XB_TMO], 1u); break; } }
    }
    nloc = mine > 0u ? mine : 1u; nx = cnt > 0u ? cnt : 1u;
}
__device__ __forceinline__ void xcd_barrier(const XcdBarrier& b) {
    asm volatile("s_waitcnt vmcnt(0)" ::: "memory");
    __syncthreads();
    if (threadIdx.x == 0) {
        unsigned* bar = b.bar;
        __builtin_amdgcn_s_waitcnt(0);
        unsigned nloc = b.st[0], nx = b.st[1];
        if (nloc == 0u) { xcd_barrier_complete(bar, b.x, nloc, nx); b.st[0] = nloc; b.st[1] = nx; }
        const unsigned old = xb_add(&bar[XB_XSUB(b.x)], 1u);
        const unsigned gen = old / nloc;
        if (old + 1u == (gen + 1u) * nloc) {
            __builtin_amdgcn_fence(__ATOMIC_RELEASE, "agent");
            asm volatile("s_waitcnt vmcnt(0)" ::: "memory");
            const unsigned og = xb_add(&bar[XB_TOP], 1u);
            const unsigned tg = og / nx;
            asm volatile("buffer_inv sc1" ::: "memory");
            if (og + 1u == (tg + 1u) * nx) xb_add(&bar[XB_TOPGEN], 1u);
            else XB_SPIN(xb_ld(&bar[XB_TOPGEN]) == tg, bar);
            xb_add(&bar[XB_XGEN(b.x)], 1u);
            asm volatile("s_waitcnt vmcnt(0)" ::: "memory");
        } else {
            asm volatile("buffer_inv sc1" ::: "memory");
            XB_SPIN(xb_ld(&bar[XB_XGEN(b.x)]) == gen, bar);
            asm volatile("s_waitcnt vmcnt(0)" ::: "memory");
        }
    }
    __syncthreads();
}

constexpr int LDS_BYTES = 147456;
constexpr int MISC_OFF = 131072 + 320;
constexpr int CW_BAR = 4096;
#ifndef MK_SINGLE
#define MK_SINGLE 1
#endif
constexpr int NPHASE = 11;
struct Args { Ctx C; int ph_lo, ph_hi; };
__global__ void __launch_bounds__(NT, 2) fwd_mega(Args args) {
    extern __shared__ __attribute__((aligned(16))) unsigned char lds_raw[];
    float* lds = (float*)lds_raw;
    PG8_LAS unsigned char* L3 = (PG8_LAS unsigned char*)lds_raw;
    const Ctx& C = args.C;
    unsigned char* ws = C.ws;
    volatile LAS unsigned* MISC = (volatile LAS unsigned*)((LAS unsigned char*)lds_raw + MISC_OFF);
    if (threadIdx.x < 32) MISC[threadIdx.x] = 0u;
    __syncthreads();
    XcdBarrier bar; bar.bar = (unsigned*)(ws + WS_CTL) + CW_BAR; bar.x = 0; bar.st = nullptr;
    if (MK_SINGLE) bar = xcd_barrier_post((unsigned*)(ws + WS_CTL) + CW_BAR, MISC + 8);
    const int lo = args.ph_lo, hi = args.ph_hi;
#define IN(k) (lo <= (k) && (k) < hi)
#define SEAM(k) do { if (IN(k) && IN((k) + 1)) { xcd_barrier(bar); if (DUPL(31)) xcd_barrier(bar); } } while (0)
#define PH(k, BODY) do { if (IN(k)) { BODY; if (DUPL(k)) { BODY; } } } while (0)
#define GEMM_PH(EPI, EINIT, AP, BP, NN, KK, LDA, AL) GEMM_PH2(EPI, EINIT, AP, BP, NN, KK, LDA, AL, false)
#define GEMM_PH2(EPI, EINIT, AP, BP, NN, KK, LDA, AL, TA) do { pg8::Gemm g{(const bf16*)(AP), (const bf16*)(BP), M, NN, KK, LDA, TA, true}; pg8::StaticOrder S; S.init(M, NN, (int)gridDim.x, (int)blockIdx.x); \
        pg8::EPI E EINIT; pg8::gemm_phase<pg8::EPI, pg8::StaticOrder, AL, true>(L3, g, S, E); } while (0)
    const float* COS = (const float*)(ws + WS_COS); const float* SIN = (const float*)(ws + WS_SIN);
    PH(0, p0_prologue(C, lds));
    SEAM(0);
    PH(1, GEMM_PH(EpiZ, ({(bf16*)(ws + WS_Z), NZ, (float*)(ws + WS_SSQQ), (float*)(ws + WS_SSQKV), (float*)(ws + WS_SSQPE)}), ws + WS_A, ws + WS_WIN, NZ, DM, DM, true));
    SEAM(1);
    const bool p1_first = ((blockIdx.x >> 3) & 1) != 0;
    if (p1_first) { PH(4, gla::pass1(C, lds_raw)); }
    PH(2, GEMM_PH2(EpiQ, ({(const float*)(ws + WS_SSQQ), C.q_head_norm, COS, SIN, (bf16*)(ws + WS_QF), EPS, QSCALE}), (const bf16*)(ws + WS_Z) + (ZC_CQ >> 5) * 512, ws + WS_WUQ, 1024, QRANK, NZ, false, true));
    __syncthreads();
    PH(3, GEMM_PH2(EpiKV, ({(const float*)(ws + WS_SSQKV), (const float*)(ws + WS_SSQPE), C.k_head_norm, COS, SIN, (const bf16*)(ws + WS_Z), (bf16*)(ws + WS_KF), (bf16*)(ws + WS_VF), EPS}), (const bf16*)(ws + WS_Z) + (ZC_CKV >> 5) * 512, ws + WS_WUKV, 1024, KVRANK, NZ, false, true));
    __syncthreads();
    if (!p1_first) { PH(4, gla::pass1(C, lds_raw)); }
    SEAM(4);
    PH(5, (gla_scan(C), p0_late_weights(C, lds)));
    SEAM(5);
    PH(6, att::attn_phase(C, (char*)lds_raw));
    PH(7, gla::pass2(C, lds_raw));
    SEAM(7);
    PH(8, GEMM_PH2(EpiOutProjG, ({C.x, C.out, (bf16*)(ws + WS_A), (float*)(ws + WS_SSQ)}), ws + WS_B, ws + WS_WO, DM, DM, DM, true, true));
    SEAM(8);
    if (IN(9)) {
        PG8_LAS float* rtab = (PG8_LAS float*)(L3 + 131072 + 1024);
        pg8::StaticOrder So; So.init(M, DFF, (int)gridDim.x, (int)blockIdx.x);
        for (int idx = threadIdx.x; idx < 4 * 256; idx += NT) { pg8::Unit uu; const int i = idx >> 8, row = idx & 255;
            if (So.next(i, uu)) { const f32x4* sp = (const f32x4*)(ws + WS_SSQ) + (size_t)(uu.pm * 256 + row) * 4; const f32x4 s4 = (sp[0] + sp[1]) + (sp[2] + sp[3]);
                rtab[idx] = __builtin_amdgcn_rsqf(((s4[0] + s4[1]) + (s4[2] + s4[3])) * (1.0f / DM) + EPS); } }
        __syncthreads();
    }
    PH(9, GEMM_PH2(EpiUpG, ({(const PG8_LAS float*)(L3 + 131072 + 1024), (bf16*)(ws + WS_H)}), ws + WS_A, ws + WS_WUP, DFF, DM, DM, true, true));
    SEAM(9);
    PH(10, GEMM_PH2(EpiDownG, ({(const bf16*)(ws + WS_A), C.out}), ws + WS_H, ws + WS_WDN, DM, DFF, DFF, true, true));

#undef IN
#undef SEAM
}

extern "C" void kernel_launch(void* const* d_in, const int* in_sizes, int n_in, void* d_out, int out_size, void* d_ws, size_t ws_size, hipStream_t stream) {
    static int grid = 0;
    if (grid == 0) {
        if (n_in != 17 || in_sizes[0] != M * DM || out_size != M * DM || ws_size < WS_END) { fprintf(stderr, "kernel_launch: unexpected shapes (n_in %d in0 %d out %d ws %zu)\n", n_in, n_in > 0 ? in_sizes[0] : -1, out_size, ws_size); grid = -1; return; }
        int dev = 0, cus = 0, per_cu = 0;
        if (hipGetDevice(&dev) != hipSuccess || hipDeviceGetAttribute(&cus, hipDeviceAttributeMultiprocessorCount, dev) != hipSuccess) { fprintf(stderr, "kernel_launch: device query failed\n"); grid = -1; return; }
        if (hipFuncSetAttribute((const void*)fwd_mega, hipFuncAttributeMaxDynamicSharedMemorySize, LDS_BYTES) != hipSuccess) { fprintf(stderr, "kernel_launch: hipFuncSetAttribute failed\n"); grid = -1; return; }
        if (hipOccupancyMaxActiveBlocksPerMultiprocessor(&per_cu, (const void*)fwd_mega, NT, LDS_BYTES) != hipSuccess || per_cu < 1) fprintf(stderr, "kernel_launch: note: occupancy query reports %d workgroups per CU\n", per_cu);
        (void)hipGetLastError();
        grid = cus;
    }
    if (grid < 0) return;
    Args a{};
    Ctx& C = a.C;
    C.x = (const float*)d_in[0]; C.pos = (const int*)d_in[1]; C.attn_norm = (const float*)d_in[2]; C.w_in = (const float*)d_in[3]; C.w_gate_up = (const float*)d_in[4];
    C.b_gate = (const float*)d_in[5]; C.gla_out_norm = (const float*)d_in[6]; C.q_a_norm = (const float*)d_in[7]; C.w_uq = (const float*)d_in[8]; C.kv_a_norm = (const float*)d_in[9];
    C.w_ukv = (const float*)d_in[10]; C.q_head_norm = (const float*)d_in[11]; C.k_head_norm = (const float*)d_in[12]; C.w_out = (const float*)d_in[13]; C.mlp_norm = (const float*)d_in[14];
    C.w_up = (const float*)d_in[15]; C.w_down = (const float*)d_in[16]; C.out = (float*)d_out; C.ws = (unsigned char*)d_ws;
    if (MK_SINGLE) {
        if (hipMemsetAsync((char*)d_ws + WS_CTL, 0, CTL_ZERO_BYTES, stream) != hipSuccess) { fprintf(stderr, "kernel_launch: memset failed\n"); return; }
        a.ph_lo = 0; a.ph_hi = NPHASE;
        hipLaunchKernelGGL(fwd_mega, dim3(grid), dim3(NT), LDS_BYTES, stream, a);
        if (DUPL(23)) { (void)hipMemsetAsync((char*)d_ws + WS_CTL, 0, CTL_ZERO_BYTES, stream); hipLaunchKernelGGL(fwd_mega, dim3(grid), dim3(NT), LDS_BYTES, stream, a); }
    } else {
        for (int s = 0; s < NPHASE; ++s) { a.ph_lo = s; a.ph_hi = s + 1; hipLaunchKernelGGL(fwd_mega, dim3(grid), dim3(NT), LDS_BYTES, stream, a); }
    }
}
```

```cpp
#include <hip/hip_runtime.h>
#include <cstdio>
#include <cstdint>
#ifndef DUP_MASK
#define DUP_MASK 0u
#endif
#define DUPL(k) (((DUP_MASK) >> (k)) & 1u)

constexpr int BATCH = 2, SEQ = 8192, DM = 1024, M = BATCH * SEQ;
constexpr int DPROJ = 1968, NZ = 2048, DFF = 4096;
constexpr int GH = 4, GDK = 64, GDV = 128, GRANK = 16, NCH = SEQ / 64;
constexpr int MH = 8, QRANK = 256, KVRANK = 128, NOPE = 64, ROPE = 32, MV = 64, DQK = 96;
constexpr float EPS = 1e-6f;
constexpr float QSCALE = 0.10206207261596577f * 1.4426950408889634f;
constexpr int ZC_Q = 0, ZC_K = 256, ZC_V = 512, ZC_G = 1024, ZC_CQ = 1536, ZC_CKV = 1792, ZC_KPE = 1920, ZC_GATE = 1952;
__host__ __device__ __forceinline__ size_t ztile(size_t r, int c) { return ((r >> 4) * 64 + (size_t)(c >> 5)) * 512 + (r & 15) * 32 + (c & 31); }

constexpr size_t MiB = 1u << 20;
constexpr size_t WS_CTL = 0;
constexpr size_t WS_WIN = 1 * MiB, WS_WUQ = 5 * MiB, WS_WUKV = 6 * MiB, WS_WO = 7 * MiB, WS_WUP = 9 * MiB, WS_WDN = 17 * MiB;
constexpr size_t WS_SSQ = 25 * MiB, WS_DEC = 512 * 1024, WS_COS = 26 * MiB, WS_SIN = 27 * MiB;
constexpr size_t CTL_ZERO_BYTES = 64 * 1024;
constexpr size_t WS_SSQQ = 5 * MiB + 512 * 1024, WS_SSQKV = 5 * MiB + 768 * 1024, WS_SSQPE = 6 * MiB + 512 * 1024;
constexpr size_t WS_A = 28 * MiB;
constexpr size_t WS_B = 60 * MiB;
constexpr size_t WS_Z = 92 * MiB;
constexpr size_t WS_QF = 156 * MiB, WS_AQ = 156 * MiB, WS_AKV = 164 * MiB, WS_KF = 180 * MiB, WS_VF = 204 * MiB;
constexpr size_t WS_CKV = 220 * MiB;
constexpr size_t WS_H = 92 * MiB;
constexpr size_t WS_END = 252 * MiB;

typedef unsigned short bf16;
typedef float f32x4 __attribute__((ext_vector_type(4)));
typedef unsigned u32x2 __attribute__((ext_vector_type(2)));
typedef unsigned u32x4 __attribute__((ext_vector_type(4)));

__device__ __forceinline__ float bf2f(unsigned b) { return __uint_as_float(b << 16); }
__device__ __forceinline__ unsigned f2bf(float f) { unsigned u = __float_as_uint(f); return (u + 0x7fffu + ((u >> 16) & 1u)) >> 16; }
typedef float f32x2c_t __attribute__((ext_vector_type(2))); typedef __bf16 bf16x2c_t __attribute__((ext_vector_type(2)));
__device__ __forceinline__ unsigned pk2(float lo, float hi) { f32x2c_t v = {lo, hi}; bf16x2c_t b = __builtin_convertvector(v, bf16x2c_t); return __builtin_bit_cast(unsigned, b); }
__device__ __forceinline__ float wave_sum(float v) {
#pragma unroll
    for (int o = 1; o < 64; o <<= 1) v += __shfl_xor(v, o);
    return v;
}

__device__ __forceinline__ unsigned otid() { unsigned t = threadIdx.x; asm volatile("" : "+v"(t)); return t; }

struct Ctx {
    const float* x; const int* pos; const float* attn_norm; const float* w_in; const float* w_gate_up; const float* b_gate; const float* gla_out_norm;
    const float* q_a_norm; const float* w_uq; const float* kv_a_norm; const float* w_ukv; const float* q_head_norm; const float* k_head_norm;
    const float* w_out; const float* mlp_norm; const float* w_up; const float* w_down;
    float* out; unsigned char* ws;
};
constexpr int NT = 512;

__device__ __forceinline__ int win_src_col(int n) {
    if (n < 1024) return n;
    if (n < 1536) return n - 1024 + 1040;
    if (n < 1792) return n - 1536 + 1552;
    if (n < 1920) return n - 1792 + 1808;
    if (n < 1952) return n - 1920 + 1936;
    if (n < 1968) return n - 1952 + 1024;
    return -1;
}
struct MapWin { __device__ __forceinline__ int operator()(int n) const { return win_src_col(n); } };
struct MapUq  { __device__ __forceinline__ int operator()(int n) const { const int h = n >> 7, j = n & 127; return j < DQK ? h * DQK + j : -1; } };
struct MapId  { __device__ __forceinline__ int operator()(int n) const { return n; } };
template <bool GAIN, class CMap>
__device__ __forceinline__ void p0_transpose_item(const float* W, int K, int Nsrc, int N, bf16* WT, const float* kgain, float* scr, int item, int lane, const CMap& cmap) {
    const int nblk = N / 32, kb = item / nblk, nb = item % nblk, k0 = 64 * kb, n0 = 32 * nb;
    const int sc = cmap(n0 + (lane & 31)); const float keep = sc >= 0 ? 1.f : 0.f; const int scc = sc >= 0 ? sc : 0;
    const float* wp = W + (size_t)(k0 + (lane >> 5)) * Nsrc + scc;
    float v[32];
#pragma unroll
    for (int i = 0; i < 32; ++i) v[i] = wp[(size_t)(2 * i) * Nsrc];
#pragma unroll
    for (int i = 0; i < 32; ++i) { const int kk = 2 * i + (lane >> 5); float t = v[i] * keep; if (GAIN) t *= kgain[k0 + kk]; scr[kk * 33 + (lane & 31)] = t; }
    asm volatile("s_waitcnt lgkmcnt(0)" ::: "memory");
    const int c = lane & 7;
#pragma unroll
    for (int j = 0; j < 4; ++j) { const int n = (lane >> 3) + 8 * j; const float* s = scr + (8 * c) * 33 + n;
        u32x4 o; o.x = pk2(s[0 * 33], s[1 * 33]); o.y = pk2(s[2 * 33], s[3 * 33]); o.z = pk2(s[4 * 33], s[5 * 33]); o.w = pk2(s[6 * 33], s[7 * 33]);
        *(u32x4*)(WT + ((size_t)((n0 + n) >> 4) * (K >> 5) + ((k0 + 8 * c) >> 5)) * 512 + ((n0 + n) & 15) * 32 + ((k0 + 8 * c) & 31)) = o; }
    asm volatile("s_waitcnt lgkmcnt(0)" ::: "memory");
}
__device__ __forceinline__ void p0_prologue(const Ctx& C, float* lds) {
    const size_t gt = (size_t)blockIdx.x * NT + otid(), GT = (size_t)gridDim.x * NT;
    bf16* win = (bf16*)(C.ws + WS_WIN); bf16* wuq = (bf16*)(C.ws + WS_WUQ); bf16* wukv = (bf16*)(C.ws + WS_WUKV);
    bf16* wo = (bf16*)(C.ws + WS_WO); bf16* wup = (bf16*)(C.ws + WS_WUP); bf16* wdn = (bf16*)(C.ws + WS_WDN);
    {   const int lane_ = otid() & 63, wv = otid() >> 6; float* scr = lds + wv * (64 * 33 + 32);
        const int gw_ = (int)(gt >> 6), NGW_ = (int)(GT >> 6);
        constexpr int I_IN = (DM / 64) * (NZ / 32), I_UQ = (QRANK / 64) * (1024 / 32), I_UKV = (KVRANK / 64) * (1024 / 32), I_O = (DM / 64) * (DM / 32), I_UP = (DM / 64) * (DFF / 32), I_DN = (DFF / 64) * (DM / 32);
        constexpr int NITEMS = I_IN + I_UQ + I_UKV;
        (void)wo; (void)wup; (void)wdn; (void)I_O; (void)I_UP; (void)I_DN;
        for (int it = gw_; it < NITEMS; it += NGW_) {
            int r = it;
            if (r < I_IN) { p0_transpose_item<false>(C.w_in, DM, DPROJ, NZ, win, nullptr, scr, r, lane_, MapWin{}); continue; } r -= I_IN;
            if (r < I_UQ) { p0_transpose_item<true>(C.w_uq, QRANK, MH * DQK, 1024, wuq, C.q_a_norm, scr, r, lane_, MapUq{}); continue; } r -= I_UQ;
            p0_transpose_item<true>(C.w_ukv, KVRANK, 1024, 1024, wukv, C.kv_a_norm, scr, r, lane_, MapId{});
        }
    }
    const int lane = otid() & 63; const int gw = (int)(gt >> 6), NGW = (int)(GT >> 6);
    bf16* XN = (bf16*)(C.ws + WS_A); float* COS = (float*)(C.ws + WS_COS); float* SIN = (float*)(C.ws + WS_SIN);
    f32x4 gn[4];
#pragma unroll
    for (int j = 0; j < 4; ++j) gn[j] = ((const f32x4*)C.attn_norm)[lane + 64 * j];
    for (int m = gw; m < M; m += 2 * NGW) {
        const int m2 = m + NGW;
        const f32x4* xa = (const f32x4*)(C.x + (size_t)m * DM) + lane; const f32x4* xb = (const f32x4*)(C.x + (size_t)(m2 < M ? m2 : m) * DM) + lane;
        f32x4 va[4], vb[4]; float sa = 0.f, sb = 0.f;
#pragma unroll
        for (int j = 0; j < 4; ++j) { va[j] = xa[64 * j]; vb[j] = xb[64 * j]; }
#pragma unroll
        for (int j = 0; j < 4; ++j) { sa += (va[j].x * va[j].x + va[j].y * va[j].y) + (va[j].z * va[j].z + va[j].w * va[j].w); sb += (vb[j].x * vb[j].x + vb[j].y * vb[j].y) + (vb[j].z * vb[j].z + vb[j].w * vb[j].w); }
        const float ra = rsqrtf(wave_sum(sa) * (1.f / DM) + EPS), rb = rsqrtf(wave_sum(sb) * (1.f / DM) + EPS);
        u32x2* oa = (u32x2*)(XN + (size_t)m * DM) + lane; u32x2* ob = (u32x2*)(XN + (size_t)m2 * DM) + lane;
#pragma unroll
        for (int j = 0; j < 4; ++j) { u32x2 w; w.x = pk2(va[j].x * ra * gn[j].x, va[j].y * ra * gn[j].y); w.y = pk2(va[j].z * ra * gn[j].z, va[j].w * ra * gn[j].w); oa[64 * j] = w; }
        if (m2 < M) {
#pragma unroll
            for (int j = 0; j < 4; ++j) { u32x2 w; w.x = pk2(vb[j].x * rb * gn[j].x, vb[j].y * rb * gn[j].y); w.y = pk2(vb[j].z * rb * gn[j].z, vb[j].w * rb * gn[j].w); ob[64 * j] = w; } }
    }
    for (size_t i = gt; i < (size_t)M * 16; i += GT) { const int m = (int)(i >> 4), f = (int)(i & 15);
        const float invf = exp2f(-(float)(2 * f) * (1.f / 32.f) * 13.287712379549449f);
        const float ang = (float)C.pos[m] * invf; float sn, cs; sincosf(ang, &sn, &cs); COS[i] = cs; SIN[i] = sn; }
}

__device__ __forceinline__ void p0_late_weights(const Ctx& C, float* lds) {
    const unsigned t = otid(); if (t < 256) return;
    bf16* wo = (bf16*)(C.ws + WS_WO); bf16* wup = (bf16*)(C.ws + WS_WUP); bf16* wdn = (bf16*)(C.ws + WS_WDN);
    const int lane_ = t & 63, wv = (t >> 6) - 4; float* scr = lds + wv * (64 * 33 + 32);
    const int gw_ = (int)blockIdx.x * 4 + wv, NGW_ = (int)gridDim.x * 4;
    constexpr int I_O = (DM / 64) * (DM / 32), I_UP = (DM / 64) * (DFF / 32), I_DN = (DFF / 64) * (DM / 32);
    for (int it = gw_; it < I_O + I_UP + I_DN; it += NGW_) {
        int r = it;
        if (r < I_UP) { p0_transpose_item<true>(C.w_up, DM, DFF, DFF, wup, C.mlp_norm, scr, r, lane_, MapId{}); continue; } r -= I_UP;
        if (r < I_DN) { p0_transpose_item<false>(C.w_down, DFF, DM, DM, wdn, nullptr, scr, r, lane_, MapId{}); continue; } r -= I_DN;
        p0_transpose_item<false>(C.w_out, DM, DM, DM, wo, nullptr, scr, r, lane_, MapId{});
    }
}

__device__ __forceinline__ void unpack8(const u32x4 w, float (&v)[8]) { v[0] = bf2f(w.x & 0xffffu); v[1] = bf2f(w.x >> 16); v[2] = bf2f(w.y & 0xffffu); v[3] = bf2f(w.y >> 16);
    v[4] = bf2f(w.z & 0xffffu); v[5] = bf2f(w.z >> 16); v[6] = bf2f(w.w & 0xffffu); v[7] = bf2f(w.w >> 16); }
__device__ __forceinline__ u32x4 pack8(const float (&v)[8]) { u32x4 w; w.x = pk2(v[0], v[1]); w.y = pk2(v[2], v[3]); w.z = pk2(v[4], v[5]); w.w = pk2(v[6], v[7]); return w; }
constexpr float LOG2E = 1.4426950408889634f, LN2 = 0.6931471805599453f;
__device__ __forceinline__ float fexp(float x) { return __builtin_amdgcn_exp2f(x * LOG2E); }
__device__ __forceinline__ float log_gate(float gl) { const float ls = fminf(gl, 0.f) - LN2 * __builtin_amdgcn_logf(1.f + fexp(-fabsf(gl))); return fmaxf(ls * (1.f / 16.f), -1.f); }
__device__ __forceinline__ float silu_f(float g) { return g * __builtin_amdgcn_rcpf(1.f + fexp(-g)); }
__device__ __forceinline__ void gla_scan(const Ctx& C) {
    const float* CKV = (const float*)(C.ws + WS_CKV); const float* DEC = (const float*)(C.ws + WS_DEC); bf16* PREV = (bf16*)(C.ws + WS_A);
    if (otid() >= 256) return;
    for (int e = blockIdx.x * 256 + otid(); e < BATCH * GH * 128 * 64; e += gridDim.x * 256) {
        const int d = e & 63, v = (e >> 6) & 127, bh = e >> 13; float st = 0.f;
        for (int n0 = 0; n0 < NCH; n0 += 16) {
            float cv[16], dv[16];
#pragma unroll
            for (int i = 0; i < 16; ++i) { const size_t u = (size_t)bh * NCH + n0 + i; cv[i] = CKV[(u * 128 + v) * 64 + d]; dv[i] = DEC[u * 64 + d]; }
#pragma unroll
            for (int i = 0; i < 16; ++i) { const size_t u = (size_t)bh * NCH + n0 + i; PREV[(u * 128 + v) * 64 + d] = (bf16)f2bf(st); st = dv[i] * st + cv[i]; }
        }
    }
}

namespace att {
typedef short bf16x8 __attribute__((ext_vector_type(8)));
typedef short s16x4 __attribute__((ext_vector_type(4)));
typedef float f32x16 __attribute__((ext_vector_type(16)));
typedef __attribute__((address_space(3))) const char* lds_cptr;
constexpr int KSLOT = 12288, VSLOT = 8192, LDS_K = 0, LDS_V = 3 * KSLOT, LDS_WS = LDS_V + 3 * VSLOT, LDS_OST = LDS_WS + 8 * 256, LDS_TOTAL = LDS_OST + 8 * 4096;
constexpr int QP = MH * DQK, VP = MH * MV;
#define ATT_SBAR() __builtin_amdgcn_sched_barrier(0)
__device__ __forceinline__ int crow(int r, int hi) { return (r & 3) + 8 * (r >> 2) + 4 * hi; }
__device__ __forceinline__ void glds16(const void* gsrc, unsigned lds_dst) { unsigned keep;
    asm volatile("s_mov_b32 %0, m0\n\ts_mov_b32 m0, %2\n\ts_nop 0\n\tglobal_load_lds_dwordx4 %1, off\n\ts_mov_b32 m0, %0" : "=&s"(keep) : "v"(gsrc), "s"(lds_dst) : "memory"); }
typedef float f32x2_t __attribute__((ext_vector_type(2))); typedef __bf16 bf16x2_t __attribute__((ext_vector_type(2)));
__device__ __forceinline__ unsigned cvtpk_s(float lo, float hi) { f32x2_t v = {lo, hi}; bf16x2_t b = __builtin_convertvector(v, bf16x2_t); return __builtin_bit_cast(unsigned, b); }
typedef short att_v4i16 __attribute__((ext_vector_type(4)));
__device__ __forceinline__ s16x4 vtr(lds_cptr p) { return __builtin_bit_cast(s16x4, __builtin_amdgcn_ds_read_tr16_b64_v4i16((__attribute__((address_space(3))) att_v4i16*)p)); }
#define ATT_MX3(a, b, c) __builtin_fmaxf(__builtin_fmaxf((a), (b)), (c))
__device__ __forceinline__ float rowmax(const f32x16& p0, const f32x16& p1) {
    float a = ATT_MX3(p0[0], p0[1], p1[0]), b = ATT_MX3(p0[2], p0[3], p1[1]); a = ATT_MX3(a, p1[2], p1[3]);
#pragma unroll
    for (int r = 4; r < 16; r += 4) { a = ATT_MX3(a, p0[r], p0[r + 1]); b = ATT_MX3(b, p0[r + 2], p0[r + 3]); a = ATT_MX3(a, p1[r], p1[r + 1]); b = ATT_MX3(b, p1[r + 2], p1[r + 3]); }
    float m = __builtin_fmaxf(a, b); auto rr = __builtin_amdgcn_permlane32_swap(__float_as_uint(m), __float_as_uint(m), false, false);
    return __builtin_fmaxf(__uint_as_float(rr[0]), __uint_as_float(rr[1])); }
__device__ __forceinline__ void pv(f32x16* o, int vb, bf16x8 pa0, bf16x8 pa1, bf16x8 pa2, bf16x8 pa3) {
#pragma unroll
    for (int d0 = 0; d0 < 2; ++d0) { s16x4 lo[4], hi[4];
#pragma unroll
        for (int ks = 0; ks < 4; ++ks) {
            asm volatile("ds_read_b64_tr_b16 %0,%1 offset:%c2" : "=&v"(lo[ks]) : "v"(vb), "i"(d0 * 4096 + ks * 1024) : "memory");
            asm volatile("ds_read_b64_tr_b16 %0,%1 offset:%c2" : "=&v"(hi[ks]) : "v"(vb), "i"(d0 * 4096 + ks * 1024 + 512) : "memory"); }
        asm volatile("s_waitcnt lgkmcnt(0)" ::: "memory"); ATT_SBAR();
#define ATT_PK(k) (bf16x8){lo[k][0], lo[k][1], lo[k][2], lo[k][3], hi[k][0], hi[k][1], hi[k][2], hi[k][3]}
        o[d0] = __builtin_amdgcn_mfma_f32_32x32x16_bf16(pa0, ATT_PK(0), o[d0], 0, 0, 0);
        o[d0] = __builtin_amdgcn_mfma_f32_32x32x16_bf16(pa1, ATT_PK(1), o[d0], 0, 0, 0);
        o[d0] = __builtin_amdgcn_mfma_f32_32x32x16_bf16(pa2, ATT_PK(2), o[d0], 0, 0, 0);
        o[d0] = __builtin_amdgcn_mfma_f32_32x32x16_bf16(pa3, ATT_PK(3), o[d0], 0, 0, 0);
#undef ATT_PK
    }
}
#define ATT_WAIT_BAR0() asm volatile("s_waitcnt vmcnt(0) lgkmcnt(0)\n\ts_barrier" ::: "memory")
template <int THRL, bool NOMAX>
__device__ __forceinline__ void attn_unit(int b, int h, int qb, const bf16* Q, const bf16* K, const bf16* V, bf16* O, char* shm) {
    const int tid = threadIdx.x, lane = tid & 63, r32 = lane & 31, hi = lane >> 5; const int wid = __builtin_amdgcn_readfirstlane(tid >> 6);
    const long rowbase = (long)b * SEQ; const int q0 = qb * 256; const int NTL = 4 * qb + 4, tmax = 4 * qb + (wid >> 1);
    const bf16* Qw = Q + (rowbase + q0 + wid * 32) * QP + h * DQK;
    const long bh = (long)b * MH + h;
    const bf16* ksrc0 = K + (bh * 128 * 12 + wid) * 512 + lane * 8;
    const bf16* ksrc1 = K + (bh * 128 * 12 + 8 + (wid & 3)) * 512 + lane * 8;
    const bf16* vsrc = V + (bh * 128 * 2 + (wid >> 2)) * 2048 + (16 * (wid & 3) + (lane >> 2)) * 32 + (lane & 3) * 8;
    const unsigned lds0 = (unsigned)(uintptr_t)shm;
    const unsigned kdst0 = lds0 + LDS_K + wid * 1024, kdst1 = lds0 + LDS_K + (8 + (wid & 3)) * 1024, vdst = lds0 + LDS_V + wid * 1024;
    float* wsf = (float*)(shm + LDS_WS) + wid * 64;
#define ATT_DMA(t, s) do { glds16(ksrc0 + (long)(t) * 6144, (unsigned)__builtin_amdgcn_readfirstlane(kdst0 + (s) * KSLOT)); \
        if (wid < 4) glds16(ksrc1 + (long)(t) * 6144, (unsigned)__builtin_amdgcn_readfirstlane(kdst1 + (s) * KSLOT)); \
        glds16(vsrc + (long)(t) * 4096, (unsigned)__builtin_amdgcn_readfirstlane(vdst + (s) * VSLOT)); } while (0)
    ATT_DMA(0, 0);
    bf16x8 qr[6];
#pragma unroll
    for (int d0 = 0; d0 < 6; ++d0) qr[d0] = *reinterpret_cast<const bf16x8*>(&Qw[(long)r32 * QP + d0 * 16 + hi * 8]);
    asm volatile("" :: "v"(qr[0]), "v"(qr[1]), "v"(qr[2]), "v"(qr[3]), "v"(qr[4]), "v"(qr[5]));
    float mhat = 0.f, l_reg = 0.f; f32x16 o[2]; o[0] = f32x16{}; o[1] = f32x16{}; f32x16 negm = f32x16{}; if constexpr (!NOMAX) asm volatile("" : "+v"(negm));
    const lds_cptr shm3 = (lds_cptr)shm;
    const int vlane = ((lane >> 4) & 1) * 32 + (lane & 3) * 8 + (4 * hi + ((lane & 15) >> 2)) * 64;
    u32x4 pw0 = (u32x4){0u, 0u, 0u, 0u}, pw1 = pw0, pw2 = pw0, pw3 = pw0;
    s16x4 vlo[8], vhi[8]; f32x16 p0 = f32x16{}, p1 = f32x16{};
#define ATT_KRD(slot, d0) do { ka[slot] = *(const __attribute__((address_space(3))) bf16x8*)(kp + (d0) * 2048); kb[slot] = *(const __attribute__((address_space(3))) bf16x8*)(kp + (d0) * 2048 + 512); } while (0)
#define ATT_VRD(i) do { vlo[i] = vtr(vp + (((i) >> 2) * 4096 + ((i) & 3) * 1024)); vhi[i] = vtr(vp + (((i) >> 2) * 4096 + ((i) & 3) * 1024 + 512)); } while (0)
#define ATT_QK(s) do { \
        const lds_cptr kp = shm3 + LDS_K + (s) * KSLOT + hi * 1024 + r32 * 16; const lds_cptr vp = shm3 + LDS_V + (s) * VSLOT + vlane; \
        bf16x8 ka[3], kb[3]; \
        ATT_KRD(0, 0); ATT_KRD(1, 1); ATT_SBAR(); \
        ATT_KRD(2, 2); p0 = __builtin_amdgcn_mfma_f32_32x32x16_bf16(ka[0], qr[0], negm, 0, 0, 0); p1 = __builtin_amdgcn_mfma_f32_32x32x16_bf16(kb[0], qr[0], negm, 0, 0, 0); ATT_VRD(0); ATT_VRD(1); ATT_SBAR(); \
        ATT_KRD(0, 3); p0 = __builtin_amdgcn_mfma_f32_32x32x16_bf16(ka[1], qr[1], p0, 0, 0, 0); p1 = __builtin_amdgcn_mfma_f32_32x32x16_bf16(kb[1], qr[1], p1, 0, 0, 0); ATT_VRD(2); ATT_VRD(3); ATT_SBAR(); \
        ATT_KRD(1, 4); p0 = __builtin_amdgcn_mfma_f32_32x32x16_bf16(ka[2], qr[2], p0, 0, 0, 0); p1 = __builtin_amdgcn_mfma_f32_32x32x16_bf16(kb[2], qr[2], p1, 0, 0, 0); ATT_VRD(4); ATT_VRD(5); ATT_SBAR(); \
        ATT_KRD(2, 5); p0 = __builtin_amdgcn_mfma_f32_32x32x16_bf16(ka[0], qr[3], p0, 0, 0, 0); p1 = __builtin_amdgcn_mfma_f32_32x32x16_bf16(kb[0], qr[3], p1, 0, 0, 0); ATT_VRD(6); ATT_VRD(7); ATT_SBAR(); \
        p0 = __builtin_amdgcn_mfma_f32_32x32x16_bf16(ka[1], qr[4], p0, 0, 0, 0); p1 = __builtin_amdgcn_mfma_f32_32x32x16_bf16(kb[1], qr[4], p1, 0, 0, 0); ATT_SBAR(); \
        p0 = __builtin_amdgcn_mfma_f32_32x32x16_bf16(ka[2], qr[5], p0, 0, 0, 0); p1 = __builtin_amdgcn_mfma_f32_32x32x16_bf16(kb[2], qr[5], p1, 0, 0, 0); ATT_SBAR(); \
    } while (0)
#define ATT_SM(t) do { \
        if constexpr (!NOMAX) { const float rm = rowmax(p0, p1); \
        if ((t) == 0) { mhat = rm; \
            _Pragma("unroll") for (int r = 0; r < 16; ++r) { p0[r] -= rm; p1[r] -= rm; } \
            _Pragma("unroll") for (int r = 0; r < 16; ++r) negm[r] = -mhat; \
            asm volatile("" : "+v"(negm)); \
        } else if (__any(rm > (float)THRL)) { const float dl = __builtin_fmaxf(rm, 0.f); mhat += dl; \
            _Pragma("unroll") for (int r = 0; r < 16; ++r) { p0[r] -= dl; p1[r] -= dl; } \
            _Pragma("unroll") for (int r = 0; r < 16; ++r) negm[r] = -mhat; \
            asm volatile("" : "+v"(negm)); \
            const float f = __builtin_amdgcn_exp2f(-dl); l_reg *= f; if (hi == 0) wsf[r32] = f; \
            asm volatile("s_waitcnt lgkmcnt(0)" ::: "memory"); \
            _Pragma("unroll") for (int d_ = 0; d_ < 2; ++d_) _Pragma("unroll") for (int r = 0; r < 16; ++r) o[d_][r] *= wsf[crow(r, hi)]; } } \
        float sa0, sa1, sa2, sa3;        \
        p0[0] = __builtin_amdgcn_exp2f(p0[0]); p1[0] = __builtin_amdgcn_exp2f(p1[0]); p0[1] = __builtin_amdgcn_exp2f(p0[1]); p1[1] = __builtin_amdgcn_exp2f(p1[1]); \
        _Pragma("unroll") for (int r = 2; r < 16; r += 2) { p0[r] = __builtin_amdgcn_exp2f(p0[r]); p1[r] = __builtin_amdgcn_exp2f(p1[r]); p0[r + 1] = __builtin_amdgcn_exp2f(p0[r + 1]); p1[r + 1] = __builtin_amdgcn_exp2f(p1[r + 1]); \
            if (r == 2) { asm("v_add_f32 %0, %1, %2" : "=v"(sa0) : "v"(p0[0]), "v"(p0[2])); asm("v_add_f32 %0, %1, %2" : "=v"(sa1) : "v"(p1[0]), "v"(p1[2])); asm("v_add_f32 %0, %1, %2" : "=v"(sa2) : "v"(p0[1]), "v"(p0[3])); asm("v_add_f32 %0, %1, %2" : "=v"(sa3) : "v"(p1[1]), "v"(p1[3])); } \
            else { asm("v_add_f32 %0, %0, %1" : "+v"(sa0) : "v"(p0[r])); asm("v_add_f32 %0, %0, %1" : "+v"(sa1) : "v"(p1[r])); asm("v_add_f32 %0, %0, %1" : "+v"(sa2) : "v"(p0[r + 1])); asm("v_add_f32 %0, %0, %1" : "+v"(sa3) : "v"(p1[r + 1])); } } \
        l_reg += (sa0 + sa1) + (sa2 + sa3); \
        pw0 = (u32x4){cvtpk_s(p0[0], p0[1]), cvtpk_s(p0[2], p0[3]), cvtpk_s(p0[4], p0[5]), cvtpk_s(p0[6], p0[7])}; \
        pw1 = (u32x4){cvtpk_s(p0[8], p0[9]), cvtpk_s(p0[10], p0[11]), cvtpk_s(p0[12], p0[13]), cvtpk_s(p0[14], p0[15])}; \
        pw2 = (u32x4){cvtpk_s(p1[0], p1[1]), cvtpk_s(p1[2], p1[3]), cvtpk_s(p1[4], p1[5]), cvtpk_s(p1[6], p1[7])}; \
        pw3 = (u32x4){cvtpk_s(p1[8], p1[9]), cvtpk_s(p1[10], p1[11]), cvtpk_s(p1[12], p1[13]), cvtpk_s(p1[14], p1[15])}; \
    } while (0)
#define ATT_VFR(i) (bf16x8){vlo[i][0], vlo[i][1], vlo[i][2], vlo[i][3], vhi[i][0], vhi[i][1], vhi[i][2], vhi[i][3]}
#define ATT_PV(s) do { ATT_SBAR(); \
        o[0] = __builtin_amdgcn_mfma_f32_32x32x16_bf16(__builtin_bit_cast(bf16x8, pw0), ATT_VFR(0), o[0], 0, 0, 0); o[1] = __builtin_amdgcn_mfma_f32_32x32x16_bf16(__builtin_bit_cast(bf16x8, pw0), ATT_VFR(4), o[1], 0, 0, 0); \
        o[0] = __builtin_amdgcn_mfma_f32_32x32x16_bf16(__builtin_bit_cast(bf16x8, pw1), ATT_VFR(1), o[0], 0, 0, 0); o[1] = __builtin_amdgcn_mfma_f32_32x32x16_bf16(__builtin_bit_cast(bf16x8, pw1), ATT_VFR(5), o[1], 0, 0, 0); \
        o[0] = __builtin_amdgcn_mfma_f32_32x32x16_bf16(__builtin_bit_cast(bf16x8, pw2), ATT_VFR(2), o[0], 0, 0, 0); o[1] = __builtin_amdgcn_mfma_f32_32x32x16_bf16(__builtin_bit_cast(bf16x8, pw2), ATT_VFR(6), o[1], 0, 0, 0); \
        o[0] = __builtin_amdgcn_mfma_f32_32x32x16_bf16(__builtin_bit_cast(bf16x8, pw3), ATT_VFR(3), o[0], 0, 0, 0); o[1] = __builtin_amdgcn_mfma_f32_32x32x16_bf16(__builtin_bit_cast(bf16x8, pw3), ATT_VFR(7), o[1], 0, 0, 0); \
    } while (0)
    int s_cur = 0, s_prev = 2;
    if (wid < 4) __builtin_amdgcn_s_setprio(1);
    if (wid < 4) {
        for (int t = 0; t < NTL; ++t) {
            ATT_WAIT_BAR0();
            const int s_next = (s_cur == 2) ? 0 : s_cur + 1;
            if (t + 1 < NTL) ATT_DMA(t + 1, s_next);
            if (t >= 1 && t - 1 <= tmax) { ATT_SM(t - 1); ATT_PV(s_prev); }
            if (t <= tmax) ATT_QK(s_cur);
            asm volatile("" : "+v"(o[0]), "+v"(o[1]), "+v"(p0), "+v"(p1));
            s_prev = s_cur; s_cur = s_next;
        }
        if (NTL - 1 <= tmax) { ATT_SM(NTL - 1); ATT_PV(s_prev); }
    } else {
        for (int t = 0; t < NTL; ++t) {
            ATT_WAIT_BAR0();
            const int s_next = (s_cur == 2) ? 0 : s_cur + 1;
            if (t + 1 < NTL) ATT_DMA(t + 1, s_next);
            if (t >= 1 && t - 1 <= tmax) ATT_PV(s_prev);
            if (t <= tmax) { ATT_QK(s_cur); ATT_SM(t); }
            asm volatile("" : "+v"(o[0]), "+v"(o[1]));
            s_prev = s_cur; s_cur = s_next;
        }
        if (NTL - 1 <= tmax) ATT_PV(s_prev);
    }
    __builtin_amdgcn_s_setprio(0);
    { auto rr = __builtin_amdgcn_permlane32_swap(__float_as_uint(l_reg), __float_as_uint(l_reg), false, false); l_reg = __uint_as_float(rr[0]) + __uint_as_float(rr[1]); }
    if (hi == 0) wsf[32 + r32] = l_reg;
    asm volatile("s_waitcnt lgkmcnt(0)" ::: "memory");
    float rli[16];
#pragma unroll
    for (int r = 0; r < 16; ++r) rli[r] = __builtin_amdgcn_rcpf(wsf[32 + crow(r, hi)]);
    const long orow0 = rowbase + q0 + wid * 32; const int ocol0 = 512 + h * MV;
    { bf16* stg = (bf16*)(shm + LDS_OST) + wid * 2048;
#pragma unroll
        for (int r = 0; r < 16; ++r) { const int orow = crow(r, hi);
#pragma unroll
            for (int d0 = 0; d0 < 2; ++d0) stg[orow * 64 + d0 * 32 + r32] = (bf16)f2bf(o[d0][r] * rli[r]); }
        asm volatile("s_waitcnt lgkmcnt(0)" ::: "memory");
#pragma unroll
        for (int i = 0; i < 4; ++i) { const int row = i * 8 + (lane >> 3), ch = lane & 7; const u32x4 v = *(const u32x4*)(stg + row * 64 + ch * 8); const long r = orow0 + row; const int c = ocol0 + ch * 8;
            *(u32x4*)(O + ((r >> 4) * 32 + (c >> 5)) * 512 + (r & 15) * 32 + (c & 31)) = v; } }
    asm volatile("s_waitcnt lgkmcnt(0)\n\ts_barrier" ::: "memory");
#undef ATT_DMA
#undef ATT_QK
#undef ATT_SM
#undef ATT_KRD
#undef ATT_VRD
#undef ATT_VFR
#undef ATT_PV
}
__device__ __forceinline__ void attn_phase(const Ctx& C, char* lds) {
    const bf16* QF = (const bf16*)(C.ws + WS_QF); const bf16* KF = (const bf16*)(C.ws + WS_KF); const bf16* VF = (const bf16*)(C.ws + WS_VF); bf16* O = (bf16*)(C.ws + WS_B);
    const int G = (int)gridDim.x, bx = (int)blockIdx.x; const int vcu = (G % 8 == 0) ? (bx % 8) * (G / 8) + bx / 8 : bx;
    float gq = 0.f, gk = 0.f;
    for (int i = (int)(threadIdx.x & 63); i < DQK; i += 64) { gq = __builtin_fmaxf(gq, __builtin_fabsf(C.q_head_norm[i])); gk = __builtin_fmaxf(gk, __builtin_fabsf(C.k_head_norm[i])); }
#pragma unroll
    for (int o = 32; o >= 1; o >>= 1) { gq = __builtin_fmaxf(gq, __shfl_xor(gq, o)); gk = __builtin_fmaxf(gk, __shfl_xor(gk, o)); }
    const float sbound = 9.7980f * 1.4427f * 1.02f * gq * gk;
    const bool nomax = __builtin_amdgcn_readfirstlane((int)(sbound < 64.f)) != 0;
    for (int i = vcu; i < BATCH * MH * 32; i += G) { const int bh = (i & 255) >> 4, s = i & 15, qb = (i < 256) ? 31 - s : s;
        if (nomax) attn_unit<8, true>(bh >> 3, bh & 7, qb, QF, KF, VF, O, lds); else attn_unit<8, false>(bh >> 3, bh & 7, qb, QF, KF, VF, O, lds); }
    __syncthreads();
}
}

namespace gla {
using att::bf16x8; using att::s16x4; using att::f32x16; using att::lds_cptr; using att::crow; using att::cvtpk_s;
constexpr int L_VIMG = 0, L_QIMG = 16384, L_KIMG = 24576, L_WT = 32768, L_OBUF = 36864, OLD = 132, L_WG = 73728, L_BG = L_WG + 16384;
#define GLA_BAR() asm volatile("s_waitcnt lgkmcnt(0)\n\ts_barrier" ::: "memory")
__device__ __forceinline__ void stage_gate(const Ctx& C, unsigned char* lds) {
    const int tid = threadIdx.x;
#pragma unroll
    for (int i = 0; i < 2; ++i) *(f32x4*)(lds + L_WG + (tid + NT * i) * 16) = *(const f32x4*)(C.w_gate_up + (tid + NT * i) * 4);
    if (tid < 64) *(f32x4*)(lds + L_BG + tid * 16) = *(const f32x4*)(C.b_gate + tid * 4);
}
__device__ __forceinline__ void cum_rows(const u32x4 g0, const u32x4 g1, int h, const unsigned char* lds, float (&cum)[8], float (&tot)[8]) {
    const int tid = threadIdx.x, lane = tid & 63; const int wv = __builtin_amdgcn_readfirstlane(tid >> 6);
    float zg[16];
    { float a[8], b[8]; unpack8(g0, a); unpack8(g1, b);
#pragma unroll
      for (int j = 0; j < 8; ++j) { zg[j] = a[j]; zg[8 + j] = b[j]; } }
    float x[8];
    { const f32x4 b0 = *(const f32x4*)(lds + L_BG + (h * 64 + 8 * wv) * 4), b1 = *(const f32x4*)(lds + L_BG + (h * 64 + 8 * wv + 4) * 4);
      x[0] = b0.x; x[1] = b0.y; x[2] = b0.z; x[3] = b0.w; x[4] = b1.x; x[5] = b1.y; x[6] = b1.z; x[7] = b1.w; }
#pragma unroll
    for (int gh = 0; gh < 2; ++gh) { f32x4 w0[8], w1[8];
#pragma unroll
        for (int g = 0; g < 8; ++g) { w0[g] = *(const f32x4*)(lds + L_WG + ((gh * 8 + g) * 256 + h * 64 + 8 * wv) * 4); w1[g] = *(const f32x4*)(lds + L_WG + ((gh * 8 + g) * 256 + h * 64 + 8 * wv + 4) * 4); }
#pragma unroll
        for (int g = 0; g < 8; ++g) { const float z = zg[gh * 8 + g];
            x[0] += z * w0[g].x; x[1] += z * w0[g].y; x[2] += z * w0[g].z; x[3] += z * w0[g].w; x[4] += z * w1[g].x; x[5] += z * w1[g].y; x[6] += z * w1[g].z; x[7] += z * w1[g].w; } }
#pragma unroll
    for (int j = 0; j < 8; ++j) x[j] = log_gate(x[j]);
#define GLA_DPP(v, ctrl, rmask) __builtin_bit_cast(float, __builtin_amdgcn_update_dpp(0, __builtin_bit_cast(int, (v)), (ctrl), (rmask), 0xF, true))
#pragma unroll
    for (int j = 0; j < 8; ++j) { float v = x[j];
        v += GLA_DPP(v, 0x111, 0xF); v += GLA_DPP(v, 0x112, 0xF); v += GLA_DPP(v, 0x114, 0xF); v += GLA_DPP(v, 0x118, 0xF);
        v += GLA_DPP(v, 0x142, 0xA); v += GLA_DPP(v, 0x143, 0xC);
        cum[j] = v; tot[j] = __builtin_bit_cast(float, __builtin_amdgcn_readlane(__builtin_bit_cast(int, v), 63)); }
#undef GLA_DPP
}
__device__ __forceinline__ void trfrag4(int base, bf16x8 (&f)[4]) {
    s16x4 lo[4], hi[4];
#pragma unroll
    for (int ks = 0; ks < 4; ++ks) {
        asm volatile("ds_read_b64_tr_b16 %0,%1 offset:%c2" : "=&v"(lo[ks]) : "v"(base), "i"(ks * 1024) : "memory");
        asm volatile("ds_read_b64_tr_b16 %0,%1 offset:%c2" : "=&v"(hi[ks]) : "v"(base), "i"(ks * 1024 + 512) : "memory"); }
    asm volatile("s_waitcnt lgkmcnt(0)" ::: "memory"); __builtin_amdgcn_sched_barrier(0);
#pragma unroll
    for (int ks = 0; ks < 4; ++ks) f[ks] = (bf16x8){lo[ks][0], lo[ks][1], lo[ks][2], lo[ks][3], hi[ks][0], hi[ks][1], hi[ks][2], hi[ks][3]};
}
struct Raw { u32x4 q, k, v0, v1, g0, g1, z0, z1; bf16x8 pf[4]; };
template <bool P2>
__device__ __forceinline__ void load_raw(const Ctx& C, int u, Raw& R) {
    const bf16* Z = (const bf16*)(C.ws + WS_Z); const bf16* PREV = (const bf16*)(C.ws + WS_A);
    const int tid = threadIdx.x, lane = tid & 63, r32 = lane & 31, hi = lane >> 5, c = tid >> 3, dc = tid & 7; const int wv = __builtin_amdgcn_readfirstlane(tid >> 6);
    const int n = u % NCH, h = (u / NCH) % GH, b = u / (NCH * GH); const int row0 = b * SEQ + n * 64;
    const size_t rl_ = (size_t)(row0 + lane);
    R.k = *(const u32x4*)(Z + ztile(rl_, ZC_K + h * 64 + 8 * wv)); R.g0 = *(const u32x4*)(Z + ztile(rl_, ZC_GATE)); R.g1 = *(const u32x4*)(Z + ztile(rl_, ZC_GATE + 8));
    { const int j = tid >> 4, cc = tid & 15; R.v0 = *(const u32x4*)(Z + ztile((size_t)(row0 + j), ZC_V + h * 128 + cc * 8)); R.v1 = *(const u32x4*)(Z + ztile((size_t)(row0 + 32 + j), ZC_V + h * 128 + cc * 8)); }
    if (P2) { R.q = *(const u32x4*)(Z + ztile(rl_, ZC_Q + h * 64 + 8 * wv)); const size_t rc_ = (size_t)(row0 + c); R.z0 = *(const u32x4*)(Z + ztile(rc_, ZC_G + h * 128 + 16 * dc)); R.z1 = *(const u32x4*)(Z + ztile(rc_, ZC_G + h * 128 + 16 * dc + 8));
        const int cb = wv & 3;
#pragma unroll
        for (int s = 0; s < 4; ++s) R.pf[s] = *(const bf16x8*)(PREV + ((size_t)u * 128 + 32 * cb + r32) * 64 + 16 * s + 8 * hi); }
}
__device__ __forceinline__ void store_vimg(const Raw& R, unsigned char* lds) {
    const int tid = threadIdx.x, j = tid >> 4, cc = tid & 15;
    *(u32x4*)(lds + L_VIMG + (cc >> 2) * 4096 + j * 64 + (cc & 3) * 16) = R.v0; *(u32x4*)(lds + L_VIMG + (cc >> 2) * 4096 + (32 + j) * 64 + (cc & 3) * 16) = R.v1;
}
__device__ __forceinline__ void pass1(const Ctx& C, unsigned char* lds) {
    float* CKV = (float*)(C.ws + WS_CKV); float* DEC = (float*)(C.ws + WS_DEC);
    const int tid = threadIdx.x, lane = tid & 63, r32 = lane & 31, hi = lane >> 5, c = tid >> 3, dc = tid & 7; const int wv = __builtin_amdgcn_readfirstlane(tid >> 6);
    const unsigned lds0 = (unsigned)(uintptr_t)lds; const int lpart = ((lane >> 4) & 1) * 32 + (lane & 3) * 8 + (4 * hi + ((lane & 15) >> 2)) * 64;
    const int NU = BATCH * GH * NCH, G = (int)gridDim.x;
    __syncthreads(); stage_gate(C, lds);
    Raw cur; if ((int)blockIdx.x < NU) load_raw<false>(C, (int)blockIdx.x, cur);
    for (int u = blockIdx.x; u < NU; u += G) {
        const int h = (u / NCH) % GH;
        Raw nxt = cur; if (u + G < NU) load_raw<false>(C, u + G, nxt);
        GLA_BAR();
        store_vimg(cur, lds);
        float kv[8]; unpack8(cur.k, kv);
        float cum[8], tot[8]; cum_rows(cur.g0, cur.g1, h, lds, cum, tot);
#pragma unroll
        for (int j = 0; j < 8; ++j) kv[j] *= fexp(tot[j] - cum[j]);
        *(u32x4*)(lds + L_QIMG + (wv >> 2) * 4096 + lane * 64 + (wv & 3) * 16) = pack8(kv);
        if (lane == 63) {
#pragma unroll
            for (int j = 0; j < 8; ++j) DEC[(size_t)u * 64 + 8 * wv + j] = fexp(tot[j]); }
        GLA_BAR();
        const int vb = wv >> 1, db = wv & 1;
        bf16x8 af[4], bfr[4]; trfrag4((int)(lds0 + L_VIMG + vb * 4096) + lpart, af); trfrag4((int)(lds0 + L_QIMG + db * 4096) + lpart, bfr);
        f32x16 o = f32x16{};
#pragma unroll
        for (int ks = 0; ks < 4; ++ks) o = __builtin_amdgcn_mfma_f32_32x32x16_bf16(af[ks], bfr[ks], o, 0, 0, 0);
#pragma unroll
        for (int r = 0; r < 16; ++r) CKV[((size_t)u * 128 + 32 * vb + crow(r, hi)) * 64 + 32 * db + r32] = o[r];
        cur = nxt;
    }
    __syncthreads();
}
__device__ __forceinline__ void pass2(const Ctx& C, unsigned char* lds) {
    bf16* MIX = (bf16*)(C.ws + WS_B);
    const int tid = threadIdx.x, lane = tid & 63, r32 = lane & 31, hi = lane >> 5, c = tid >> 3, dc = tid & 7; const int wv = __builtin_amdgcn_readfirstlane(tid >> 6);
    const unsigned lds0 = (unsigned)(uintptr_t)lds; const int lpart = ((lane >> 4) & 1) * 32 + (lane & 3) * 8 + (4 * hi + ((lane & 15) >> 2)) * 64;
    const lds_cptr L3 = (lds_cptr)lds; float* obuf = (float*)(lds + L_OBUF);
    const int rb = wv >> 2, cb = wv & 3;
    const int NU = BATCH * GH * NCH, G = (int)gridDim.x;
    f32x4 gn[4];
#pragma unroll
    for (int i = 0; i < 4; ++i) gn[i] = *(const f32x4*)(C.gla_out_norm + 16 * dc + 4 * i);
    __syncthreads(); stage_gate(C, lds);
    Raw cur; if ((int)blockIdx.x < NU) load_raw<true>(C, (int)blockIdx.x, cur);
    for (int u = blockIdx.x; u < NU; u += G) {
        const int n = u % NCH, h = (u / NCH) % GH, b = u / (NCH * GH); const int row0 = b * SEQ + n * 64;
        Raw nxt = cur; if (u + G < NU) load_raw<true>(C, u + G, nxt);
        GLA_BAR();
        store_vimg(cur, lds);
        float qv[8], kv[8]; unpack8(cur.q, qv); unpack8(cur.k, kv);
        float cum[8], tot[8]; cum_rows(cur.g0, cur.g1, h, lds, cum, tot);
#pragma unroll
        for (int j = 0; j < 8; ++j) { qv[j] *= 0.125f * fexp(cum[j]); kv[j] *= fexp(-cum[j]); }
        *(u32x4*)(lds + L_QIMG + wv * 1024 + lane * 16) = pack8(qv); *(u32x4*)(lds + L_KIMG + wv * 1024 + lane * 16) = pack8(kv);
        GLA_BAR();
        bf16x8 qr[4];
#pragma unroll
        for (int s = 0; s < 4; ++s) qr[s] = *(const __attribute__((address_space(3))) bf16x8*)(L3 + L_QIMG + (2 * s + hi) * 1024 + (32 * rb + r32) * 16);
        f32x16 p0 = f32x16{}, p1 = f32x16{};
#pragma unroll
        for (int s = 0; s < 4; ++s) { const lds_cptr kp = L3 + L_KIMG + (2 * s + hi) * 1024 + r32 * 16;
            const bf16x8 a0 = *(const __attribute__((address_space(3))) bf16x8*)(kp), a1 = *(const __attribute__((address_space(3))) bf16x8*)(kp + 512);
            p0 = __builtin_amdgcn_mfma_f32_32x32x16_bf16(a0, qr[s], p0, 0, 0, 0); p1 = __builtin_amdgcn_mfma_f32_32x32x16_bf16(a1, qr[s], p1, 0, 0, 0); }
        const int cq = 32 * rb + r32;
#pragma unroll
        for (int r = 0; r < 16; ++r) { const int j = crow(r, hi); p0[r] = (j <= cq) ? p0[r] : 0.f; p1[r] = (j + 32 <= cq) ? p1[r] : 0.f; }
        u32x4 pw0, pw1, pw2, pw3;
        pw0 = (u32x4){cvtpk_s(p0[0], p0[1]), cvtpk_s(p0[2], p0[3]), cvtpk_s(p0[4], p0[5]), cvtpk_s(p0[6], p0[7])};
        pw1 = (u32x4){cvtpk_s(p0[8], p0[9]), cvtpk_s(p0[10], p0[11]), cvtpk_s(p0[12], p0[13]), cvtpk_s(p0[14], p0[15])};
        pw2 = (u32x4){cvtpk_s(p1[0], p1[1]), cvtpk_s(p1[2], p1[3]), cvtpk_s(p1[4], p1[5]), cvtpk_s(p1[6], p1[7])};
        pw3 = (u32x4){cvtpk_s(p1[8], p1[9]), cvtpk_s(p1[10], p1[11]), cvtpk_s(p1[12], p1[13]), cvtpk_s(p1[14], p1[15])};
        __builtin_amdgcn_sched_barrier(0);
        bf16x8 vf[4]; trfrag4((int)(lds0 + L_VIMG + cb * 4096) + lpart, vf);
        f32x16 o = f32x16{};
        o = __builtin_amdgcn_mfma_f32_32x32x16_bf16(__builtin_bit_cast(bf16x8, pw0), vf[0], o, 0, 0, 0);
        o = __builtin_amdgcn_mfma_f32_32x32x16_bf16(__builtin_bit_cast(bf16x8, pw1), vf[1], o, 0, 0, 0);
        o = __builtin_amdgcn_mfma_f32_32x32x16_bf16(__builtin_bit_cast(bf16x8, pw2), vf[2], o, 0, 0, 0);
        o = __builtin_amdgcn_mfma_f32_32x32x16_bf16(__builtin_bit_cast(bf16x8, pw3), vf[3], o, 0, 0, 0);
#pragma unroll
        for (int s = 0; s < 4; ++s) o = __builtin_amdgcn_mfma_f32_32x32x16_bf16(qr[s], cur.pf[s], o, 0, 0, 0);
#pragma unroll
        for (int r = 0; r < 16; ++r) obuf[(32 * rb + crow(r, hi)) * OLD + 32 * cb + r32] = o[r];
        GLA_BAR();
        { float ov[16];
#pragma unroll
            for (int i = 0; i < 4; ++i) { const f32x4 t = *(const f32x4*)(obuf + c * OLD + 16 * dc + 4 * i); ov[4 * i] = t.x; ov[4 * i + 1] = t.y; ov[4 * i + 2] = t.z; ov[4 * i + 3] = t.w; }
            float ss = 0.f;
#pragma unroll
            for (int i = 0; i < 16; ++i) ss += ov[i] * ov[i];
            ss += __shfl_xor(ss, 1); ss += __shfl_xor(ss, 2); ss += __shfl_xor(ss, 4);
            const float rn = rsqrtf(ss * (1.f / GDV) + EPS); const size_t row = (size_t)(row0 + c);
            float g0[8], g1[8]; unpack8(cur.z0, g0); unpack8(cur.z1, g1);
            const float gv[16] = {gn[0].x, gn[0].y, gn[0].z, gn[0].w, gn[1].x, gn[1].y, gn[1].z, gn[1].w, gn[2].x, gn[2].y, gn[2].z, gn[2].w, gn[3].x, gn[3].y, gn[3].z, gn[3].w};
            float w0[8], w1[8];
#pragma unroll
            for (int i = 0; i < 8; ++i) { w0[i] = ov[i] * rn * gv[i] * silu_f(g0[i]); w1[i] = ov[8 + i] * rn * gv[8 + i] * silu_f(g1[i]); }
            { const int c0 = h * 128 + 16 * dc; bf16* mp = MIX + ((row >> 4) * 32 + (c0 >> 5)) * 512 + (row & 15) * 32 + (c0 & 31);
              *(u32x4*)mp = pack8(w0); *(u32x4*)(mp + 8) = pack8(w1); } }
        cur = nxt;
    }
    __syncthreads();
}
#undef GLA_BAR
}

namespace pg8 {
#define PG8_LAS __attribute__((address_space(3)))
typedef unsigned short bf16_t;
typedef short bf16x8 __attribute__((ext_vector_type(8)));
typedef float f32x4 __attribute__((ext_vector_type(4)));
typedef unsigned u32x4 __attribute__((ext_vector_type(4)));
constexpr int BM = 256, BK = 64, HALF = 128, HTB = HALF * BK * 2  , STAGE_BYTES = 8 * HTB, NXCD = 8, WGM = 8;

__host__ __device__ __forceinline__ int lds_byte(int r, int c) { const int st = (r >> 4) * 2 + (c >> 5), rr = r & 15, cc = c & 31, ob = rr * 64 + cc * 2; return st * 1024 + (ob ^ (((ob >> 9) & 1) << 5)); }
__host__ __device__ __forceinline__ void stage_rc(int b, int& R, int& C) { const int st = b / 1024, sb = b % 1024, swz = sb ^ (((sb >> 9) & 1) << 5); R = (st >> 1) * 16 + swz / 64; C = (st & 1) * 32 + (swz % 64) / 2; }
__host__ __device__ __forceinline__ int perm32(int rho) { const int n = rho >> 4, i = rho & 15; return 8 * (i >> 2) + 4 * n + (i & 3); }

struct Unit { int pm, pn; };
struct Gemm { const bf16_t* A; const bf16_t* Bt; int M, N, K, lda; bool ta, tb; };

struct StaticOrder {
    int nM, nN, nwg, G, c;
    __host__ __device__ void init(int M, int N, int G_, int c_) { nM = M / BM; nN = N / BM; nwg = nM * nN; G = G_; c = c_; }
    __host__ __device__ bool next(int i, Unit& u) const {
        const long L = (long)i * G + c; if (L >= nwg) return false;
        int wgid = (int)L; { const int q = nwg / NXCD, r = nwg % NXCD, xcd = wgid % NXCD, off = wgid / NXCD; wgid = (xcd < r ? xcd * (q + 1) : r * (q + 1) + (xcd - r) * q) + off; }
        const int nig = WGM * nN, gid = wgid / nig, fm = gid * WGM, gsz = (nM - fm) < WGM ? (nM - fm) : WGM;
        u.pm = fm + ((wgid % nig) % gsz); u.pn = (wgid % nig) / gsz; return true;
    }
    __device__ __forceinline__ void a_ready(const Unit&) const {}
    __device__ __forceinline__ void done(const Unit&) const {}
};

__device__ __forceinline__ unsigned cvt_pk_bf16(float lo, float hi) { unsigned r; asm volatile("v_cvt_pk_bf16_f32 %0, %1, %2" : "=v"(r) : "v"(lo), "v"(hi)); return r; }
typedef float f32x2 __attribute__((ext_vector_type(2)));
__device__ __forceinline__ void st16_wt(void* p, u32x4 v) { asm volatile("global_store_dwordx4 %0, %1, off sc1\n\ts_nop 1" :: "v"(p), "v"(v) : "memory"); }
typedef unsigned u32x2v __attribute__((ext_vector_type(2)));
struct EpiBf16 {
    static constexpr bool PERM = true, AFTER_DRAIN = false; static constexpr int PROBE_BIT = 26;
    bf16_t* O; int ldc;
    __device__ __forceinline__ void operator()(const f32x4 (&acc)[2][2][4][2], const Unit& u, int wr, int wc, int fr, int fq) const {
        const int row0 = u.pm * BM + wr * 64 + fr, col0 = u.pn * BM + wc * 32 + 8 * fq;
#pragma unroll
        for (int ai = 0; ai < 2; ++ai)
#pragma unroll
            for (int m = 0; m < 4; ++m) { bf16_t* rowp = O + (size_t)(row0 + ai * HALF + m * 16) * ldc + col0;
#pragma unroll
                for (int bj = 0; bj < 2; ++bj) { const f32x4 v0 = acc[ai][bj][m][0], v1 = acc[ai][bj][m][1];
                    u32x4 w; w.x = cvt_pk_bf16(v0[0], v0[1]); w.y = cvt_pk_bf16(v0[2], v0[3]); w.z = cvt_pk_bf16(v1[0], v1[1]); w.w = cvt_pk_bf16(v1[2], v1[3]);
                    *(u32x4*)(rowp + bj * HALF) = w; } }
    }
};
struct EpiZ {
    static constexpr bool PERM = true, AFTER_DRAIN = false; static constexpr int PROBE_BIT = 27;
    bf16_t* O; int ldc; float* ssqq; float* ssqkv; float* ssqpe;
    __device__ __forceinline__ void operator()(const f32x4 (&acc)[2][2][4][2], const Unit& u, int wr, int wc, int fr, int fq) const {
        const int row0 = u.pm * BM + wr * 64 + fr, col0 = u.pn * BM + wc * 32 + 8 * fq;
#pragma unroll
        for (int ai = 0; ai < 2; ++ai)
#pragma unroll
            for (int m = 0; m < 4; ++m) { const int r = row0 + ai * HALF + m * 16; bf16_t* rowp = O + ((size_t)(r >> 4) * (ldc >> 5) + (col0 >> 5)) * 512 + (r & 15) * 32 + (col0 & 31); float sq[2];
#pragma unroll
                for (int bj = 0; bj < 2; ++bj) { const f32x4 v0 = acc[ai][bj][m][0], v1 = acc[ai][bj][m][1];
                    u32x4 w; w.x = cvt_pk_bf16(v0[0], v0[1]); w.y = cvt_pk_bf16(v0[2], v0[3]); w.z = cvt_pk_bf16(v1[0], v1[1]); w.w = cvt_pk_bf16(v1[2], v1[3]);
                    st16_wt(rowp + bj * 4 * 512, w);
                    sq[bj] = ((v0[0] * v0[0] + v0[1] * v0[1]) + (v0[2] * v0[2] + v0[3] * v0[3])) + ((v1[0] * v1[0] + v1[1] * v1[1]) + (v1[2] * v1[2] + v1[3] * v1[3])); }
                if (u.pn == 6) { float s = sq[0] + sq[1]; s += __shfl_xor(s, 16); s += __shfl_xor(s, 32); if (fq == 0) ssqq[(size_t)r * 4 + wc] = s; }
                else if (u.pn == 7) { float s = sq[0]; s += __shfl_xor(s, 16); s += __shfl_xor(s, 32); if (fq == 0) ssqkv[(size_t)r * 4 + wc] = s;
                    if (wc == 0) { float t = sq[1]; t += __shfl_xor(t, 16); t += __shfl_xor(t, 32); if (fq == 0) ssqpe[r] = t; } } }
    }
};
struct EpiQ {
    static constexpr bool PERM = false, AFTER_DRAIN = true; static constexpr int PROBE_BIT = 25;
    const float* ssqq; const float* gq; const float* cosT; const float* sinT; bf16_t* QF; float eps, qscale;
    __device__ __forceinline__ void fused(f32x4 (&acc)[2][2][4][2], const Unit& u, int wr, int wc, int fr, int fq, PG8_LAS unsigned char* lds, int wid, int lane) const {
        PG8_LAS float* P = (PG8_LAS float*)lds;
        f32x4 s4A[2][4];
#pragma unroll
        for (int ai = 0; ai < 2; ++ai)
#pragma unroll
            for (int m = 0; m < 4; ++m) s4A[ai][m] = *(const f32x4*)(ssqq + (size_t)(u.pm * BM + ai * HALF + wr * 64 + m * 16 + fr) * 4);
        __builtin_amdgcn_sched_barrier(0);
#pragma unroll
        for (int ai = 0; ai < 2; ++ai)
#pragma unroll
            for (int m = 0; m < 4; ++m) { const int rl = ai * HALF + wr * 64 + m * 16 + fr; const f32x4 s4 = s4A[ai][m];
                const float ra = __builtin_amdgcn_rsqf(((s4[0] + s4[1]) + (s4[2] + s4[3])) * (1.0f / 256.0f) + eps);
#pragma unroll
                for (int bj = 0; bj < 2; ++bj) { float s = 0.f;
#pragma unroll
                    for (int n = 0; n < 2; ++n) { const f32x4 v = acc[ai][bj][m][n] * ra; acc[ai][bj][m][n] = v; s += (v[0] * v[0] + v[1] * v[1]) + (v[2] * v[2] + v[3] * v[3]); }
                    s += __shfl_xor(s, 16); s += __shfl_xor(s, 32);
                    if (fq == 0) P[(rl * 2 + bj) * 4 + wc] = s; } }
        asm volatile("s_waitcnt lgkmcnt(0)" ::: "memory"); __builtin_amdgcn_s_barrier(); asm volatile("" ::: "memory");
        PG8_LAS unsigned char* ST = lds + 8192;
        if (wc < 3) {
            const int j0 = wc * 32 + 4 * fq; const f32x4 g0 = *(const f32x4*)(gq + j0), g1 = *(const f32x4*)(gq + j0 + 16);
            f32x4 csA[2][4], snA[2][4];
#pragma unroll
            for (int ai = 0; ai < 2; ++ai)
#pragma unroll
                for (int m = 0; m < 4; ++m) { const size_t r = (size_t)(u.pm * BM + ai * HALF + wr * 64 + m * 16 + fr); csA[ai][m] = (f32x4){1.f, 1.f, 1.f, 1.f}; snA[ai][m] = (f32x4){0.f, 0.f, 0.f, 0.f};
                    if (wc == 2) { csA[ai][m] = *(const f32x4*)(cosT + r * 16 + 4 * fq); snA[ai][m] = *(const f32x4*)(sinT + r * 16 + 4 * fq); } }
            __builtin_amdgcn_sched_barrier(0);
#pragma unroll
            for (int ai = 0; ai < 2; ++ai)
#pragma unroll
                for (int m = 0; m < 4; ++m) { const int rl = ai * HALF + wr * 64 + m * 16 + fr; const f32x4 cs = csA[ai][m], sn = snA[ai][m];
#pragma unroll
                    for (int bj = 0; bj < 2; ++bj) { const f32x4 p = *(const PG8_LAS f32x4*)(P + (rl * 2 + bj) * 4);
                        const float rh = qscale * __builtin_amdgcn_rsqf(((p[0] + p[1]) + (p[2] + p[3])) * (1.0f / 96.0f) + eps);
                        const f32x4 a = acc[ai][bj][m][0] * rh * g0, b = acc[ai][bj][m][1] * rh * g1;
                        f32x4 o0 = a, o1 = b; if (wc == 2) { o0 = a * cs - b * sn; o1 = a * sn + b * cs; }
                        PG8_LAS unsigned char* dst = ST + rl * 400 + (bj * 96 + j0) * 2;
                        u32x2v w0, w1; w0.x = cvt_pk_bf16(o0[0], o0[1]); w0.y = cvt_pk_bf16(o0[2], o0[3]); w1.x = cvt_pk_bf16(o1[0], o1[1]); w1.y = cvt_pk_bf16(o1[2], o1[3]);
                        *(PG8_LAS u32x2v*)dst = w0; *(PG8_LAS u32x2v*)(dst + 32) = w1; }
                    }
        }
        asm volatile("s_waitcnt lgkmcnt(0)" ::: "memory"); __builtin_amdgcn_s_barrier(); asm volatile("" ::: "memory");
        { const int tid = wid * 64 + lane;
#pragma unroll
            for (int i = 0; i < 12; ++i) { const int idx = tid + 512 * i, row = idx / 24, ch = idx - row * 24;
                st16_wt(QF + (size_t)(u.pm * BM + row) * 768 + (2 * u.pn) * 96 + ch * 8, *(const PG8_LAS u32x4*)(ST + row * 400 + ch * 16)); } }
    }
};
struct EpiKV {
    static constexpr bool PERM = false, AFTER_DRAIN = true; static constexpr int PROBE_BIT = 24;
    const float* ssqkv; const float* ssqpe; const float* gk; const float* cosT; const float* sinT; const bf16_t* Z; bf16_t* KF; bf16_t* VF; float eps;
    __device__ __forceinline__ void fused(f32x4 (&acc)[2][2][4][2], const Unit& u, int wr, int wc, int fr, int fq, PG8_LAS unsigned char* lds, int wid, int lane) const {
        PG8_LAS float* P = (PG8_LAS float*)lds;
        f32x4 s4A[2][4];
#pragma unroll
        for (int ai = 0; ai < 2; ++ai)
#pragma unroll
            for (int m = 0; m < 4; ++m) s4A[ai][m] = *(const f32x4*)(ssqkv + (size_t)(u.pm * BM + ai * HALF + wr * 64 + m * 16 + fr) * 4);
        __builtin_amdgcn_sched_barrier(0);
#pragma unroll
        for (int ai = 0; ai < 2; ++ai)
#pragma unroll
            for (int m = 0; m < 4; ++m) { const int rl = ai * HALF + wr * 64 + m * 16 + fr; const f32x4 s4 = s4A[ai][m];
                const float ra = __builtin_amdgcn_rsqf(((s4[0] + s4[1]) + (s4[2] + s4[3])) * (1.0f / 128.0f) + eps);
#pragma unroll
                for (int bj = 0; bj < 2; ++bj) { float s = 0.f;
#pragma unroll
                    for (int n = 0; n < 2; ++n) { const f32x4 v = acc[ai][bj][m][n] * ra; acc[ai][bj][m][n] = v; s += (v[0] * v[0] + v[1] * v[1]) + (v[2] * v[2] + v[3] * v[3]); }
                    if (wc < 2) { s += __shfl_xor(s, 16); s += __shfl_xor(s, 32); if (fq == 0) P[(rl * 2 + bj) * 2 + wc] = s; } } }
        asm volatile("s_waitcnt lgkmcnt(0)" ::: "memory"); __builtin_amdgcn_s_barrier(); asm volatile("" ::: "memory");
        const int j0 = wc * 32 + 4 * fq;
        PG8_LAS unsigned char* ST = lds + 8192;
        if (wc < 2) {
            const f32x4 g0 = *(const f32x4*)(gk + j0), g1 = *(const f32x4*)(gk + j0 + 16);
            float pesA[2][4];
#pragma unroll
            for (int ai = 0; ai < 2; ++ai)
#pragma unroll
                for (int m = 0; m < 4; ++m) pesA[ai][m] = ssqpe[(size_t)(u.pm * BM + ai * HALF + wr * 64 + m * 16 + fr)];
            __builtin_amdgcn_sched_barrier(0);
#pragma unroll
            for (int ai = 0; ai < 2; ++ai)
#pragma unroll
                for (int m = 0; m < 4; ++m) { const int rl = ai * HALF + wr * 64 + m * 16 + fr; const float pes = pesA[ai][m];
#pragma unroll
                    for (int bj = 0; bj < 2; ++bj) { const float rk = __builtin_amdgcn_rsqf((P[(rl * 2 + bj) * 2] + P[(rl * 2 + bj) * 2 + 1] + pes) * (1.0f / 96.0f) + eps);
                        const f32x4 o0 = acc[ai][bj][m][0] * rk * g0, o1 = acc[ai][bj][m][1] * rk * g1; PG8_LAS unsigned char* dst = ST + rl * 400 + (bj * 96 + j0) * 2;
                        u32x2v w0, w1; w0.x = cvt_pk_bf16(o0[0], o0[1]); w0.y = cvt_pk_bf16(o0[2], o0[3]); w1.x = cvt_pk_bf16(o1[0], o1[1]); w1.y = cvt_pk_bf16(o1[2], o1[3]);
                        *(PG8_LAS u32x2v*)dst = w0; *(PG8_LAS u32x2v*)(dst + 32) = w1; }
                    asm volatile("" ::: "memory"); }
        } else {
#pragma unroll
            for (int ai = 0; ai < 2; ++ai)
#pragma unroll
                for (int m = 0; m < 4; ++m) { const int rl = ai * HALF + wr * 64 + m * 16 + fr; const size_t r = (size_t)(u.pm * BM + rl);
#pragma unroll
                    for (int bj = 0; bj < 2; ++bj) { const f32x4 o0 = acc[ai][bj][m][0], o1 = acc[ai][bj][m][1];
                        bf16_t* dst = VF + (((((size_t)(u.pm >> 5) * 8 + 2 * u.pn + bj) * 128 + (u.pm & 31) * 4 + (rl >> 6)) * 2 + (wc - 2)) * 64 + (rl & 63)) * 32 + 4 * fq;
                        u32x2v w0, w1; w0.x = cvt_pk_bf16(o0[0], o0[1]); w0.y = cvt_pk_bf16(o0[2], o0[3]); w1.x = cvt_pk_bf16(o1[0], o1[1]); w1.y = cvt_pk_bf16(o1[2], o1[3]);
                        *(u32x2v*)dst = w0; *(u32x2v*)(dst + 16) = w1; }
                    asm volatile("" ::: "memory"); }
            if (wc == 2) {
                const f32x4 g0 = *(const f32x4*)(gk + 64 + 4 * fq), g1 = *(const f32x4*)(gk + 80 + 4 * fq);
#pragma unroll
                for (int ai = 0; ai < 2; ++ai) {
                    float pesB[4]; u32x2v xaB[4], xbB[4]; f32x4 csB[4], snB[4];
#pragma unroll
                    for (int m = 0; m < 4; ++m) { const size_t r = (size_t)(u.pm * BM + ai * HALF + wr * 64 + m * 16 + fr); pesB[m] = ssqpe[r];
                        xaB[m] = *(const u32x2v*)(Z + ((r >> 4) * 64 + 60) * 512 + (r & 15) * 32 + 4 * fq); xbB[m] = *(const u32x2v*)(Z + ((r >> 4) * 64 + 60) * 512 + (r & 15) * 32 + 16 + 4 * fq);
                        csB[m] = *(const f32x4*)(cosT + r * 16 + 4 * fq); snB[m] = *(const f32x4*)(sinT + r * 16 + 4 * fq); }
                    __builtin_amdgcn_sched_barrier(0);
#pragma unroll
                    for (int m = 0; m < 4; ++m) { const int rl = ai * HALF + wr * 64 + m * 16 + fr; const float pes = pesB[m];
                        const u32x2v xa = xaB[m], xb = xbB[m];
                        const f32x4 x1 = (f32x4){__uint_as_float(xa.x << 16), __uint_as_float(xa.x & 0xffff0000u), __uint_as_float(xa.y << 16), __uint_as_float(xa.y & 0xffff0000u)};
                        const f32x4 x2 = (f32x4){__uint_as_float(xb.x << 16), __uint_as_float(xb.x & 0xffff0000u), __uint_as_float(xb.y << 16), __uint_as_float(xb.y & 0xffff0000u)};
                        const f32x4 cs = csB[m], sn = snB[m];
#pragma unroll
                        for (int bj = 0; bj < 2; ++bj) { const float rk = __builtin_amdgcn_rsqf((P[(rl * 2 + bj) * 2] + P[(rl * 2 + bj) * 2 + 1] + pes) * (1.0f / 96.0f) + eps);
                            const f32x4 a = x1 * rk * g0, b = x2 * rk * g1, o0 = a * cs - b * sn, o1 = a * sn + b * cs; PG8_LAS unsigned char* dst = ST + rl * 400 + (bj * 96 + 64 + 4 * fq) * 2;
                            u32x2v w0, w1; w0.x = cvt_pk_bf16(o0[0], o0[1]); w0.y = cvt_pk_bf16(o0[2], o0[3]); w1.x = cvt_pk_bf16(o1[0], o1[1]); w1.y = cvt_pk_bf16(o1[2], o1[3]);
                            *(PG8_LAS u32x2v*)dst = w0; *(PG8_LAS u32x2v*)(dst + 32) = w1; } }
                    asm volatile("" ::: "memory"); }
            }
        }
        asm volatile("s_waitcnt lgkmcnt(0)" ::: "memory"); __builtin_amdgcn_s_barrier(); asm volatile("" ::: "memory");
        { const int tid = wid * 64 + lane;
#pragma unroll
            for (int i = 0; i < 12; ++i) { const int idx = tid + 512 * i, ch = idx >> 8, row = idx & 255, hd = 2 * u.pn + (ch >= 12 ? 1 : 0), c = ch >= 12 ? ch - 12 : ch;
                st16_wt(KF + (((((size_t)(u.pm >> 5) * 8 + hd) * 128 + (u.pm & 31) * 4 + (row >> 6)) * 12 + c) * 64 + (row & 63)) * 8, *(const PG8_LAS u32x4*)(ST + row * 400 + ch * 16)); } }
    }
};
struct EpiOutProjG {
    static constexpr bool PERM = false, AFTER_DRAIN = false; static constexpr int PROBE_BIT = 28;
    const float* x; float* x1; bf16_t* x1b; float* ssq;
    __device__ __forceinline__ void operator()(const f32x4 (&acc)[2][2][4][2], const Unit& u, int wr, int wc, int fr, int fq) const {
        const int col0 = u.pn * BM + wc * 32 + 4 * fq;
#pragma unroll
        for (int ai = 0; ai < 2; ++ai) {
            f32x4 xr[4][2][2];
#pragma unroll
            for (int m = 0; m < 4; ++m) { const size_t off = (size_t)(u.pm * BM + ai * HALF + wr * 64 + m * 16 + fr) * 1024 + col0;
#pragma unroll
                for (int bj = 0; bj < 2; ++bj)
#pragma unroll
                    for (int n = 0; n < 2; ++n) xr[m][bj][n] = *(const f32x4*)(x + off + bj * HALF + n * 16); }
            __builtin_amdgcn_sched_barrier(0);
#pragma unroll
            for (int m = 0; m < 4; ++m) { const int r = u.pm * BM + ai * HALF + wr * 64 + m * 16 + fr; const size_t off = (size_t)r * 1024 + col0; float s = 0.f;
#pragma unroll
                for (int bj = 0; bj < 2; ++bj)
#pragma unroll
                    for (int n = 0; n < 2; ++n) { const f32x4 t = xr[m][bj][n] + acc[ai][bj][m][n];
                        u32x2v w; w.x = cvt_pk_bf16(t[0], t[1]); w.y = cvt_pk_bf16(t[2], t[3]);
                        *(u32x2v*)(x1b + ((size_t)(r >> 4) * 32 + ((col0 >> 5) + 4 * bj)) * 512 + (r & 15) * 32 + (col0 & 31) + 16 * n) = w;
                        s += (t[0] * t[0] + t[1] * t[1]) + (t[2] * t[2] + t[3] * t[3]); }
                s += __shfl_xor(s, 16); s += __shfl_xor(s, 32);
                if (fq == 0) ssq[(size_t)r * 16 + u.pn * 4 + wc] = s; }
            asm volatile("" ::: "memory"); }
    }
};
struct EpiUpG {
    static constexpr bool PERM = true, AFTER_DRAIN = false; static constexpr int PROBE_BIT = 29;
    const PG8_LAS float* rtab; bf16_t* H;
    __device__ __forceinline__ void operator()(const f32x4 (&acc)[2][2][4][2], const Unit& u, int wr, int wc, int fr, int fq) const { (*this)(acc, u, wr, wc, fr, fq, 0); }
    __device__ __forceinline__ void operator()(const f32x4 (&acc)[2][2][4][2], const Unit& u, int wr, int wc, int fr, int fq, int ui) const {
        const int row0 = u.pm * BM + wr * 64 + fr, col0 = u.pn * BM + wc * 32 + 8 * fq;
#pragma unroll
        for (int ai = 0; ai < 2; ++ai)
#pragma unroll
            for (int m = 0; m < 4; ++m) { const int r = row0 + ai * HALF + m * 16;
                const float rstd = rtab[(ui & 3) * 256 + wr * 64 + fr + ai * HALF + m * 16];
                bf16_t* rowp = H + ((size_t)(r >> 4) * 128 + (col0 >> 5)) * 512 + (r & 15) * 32 + (col0 & 31);
#pragma unroll
                for (int bj = 0; bj < 2; ++bj) { f32x4 v0 = acc[ai][bj][m][0] * rstd, v1 = acc[ai][bj][m][1] * rstd;
#pragma unroll
                    for (int e = 0; e < 4; ++e) { v0[e] = __builtin_fmaxf(v0[e], 0.f); v1[e] = __builtin_fmaxf(v1[e], 0.f); }
                    v0 = v0 * v0; v1 = v1 * v1;
                    u32x4 w; w.x = cvt_pk_bf16(v0[0], v0[1]); w.y = cvt_pk_bf16(v0[2], v0[3]); w.z = cvt_pk_bf16(v1[0], v1[1]); w.w = cvt_pk_bf16(v1[2], v1[3]);
                    st16_wt(rowp + bj * 4 * 512, w); } }
    }
};
struct EpiDownG {
    static constexpr bool PERM = false, AFTER_DRAIN = false; static constexpr int PROBE_BIT = 30;
    const bf16_t* x1b; float* out;
    __device__ __forceinline__ void operator()(const f32x4 (&acc)[2][2][4][2], const Unit& u, int wr, int wc, int fr, int fq) const {
        const int col0 = u.pn * BM + wc * 32 + 4 * fq;
        u32x2v xw[2][4][2][2];
#pragma unroll
        for (int ai = 0; ai < 2; ++ai)
#pragma unroll
            for (int m = 0; m < 4; ++m) { const size_t off = (size_t)(u.pm * BM + ai * HALF + wr * 64 + m * 16 + fr) * 1024 + col0;
#pragma unroll
                for (int bj = 0; bj < 2; ++bj)
#pragma unroll
                    for (int n = 0; n < 2; ++n) { const int r_ = u.pm * BM + ai * HALF + wr * 64 + m * 16 + fr; xw[ai][m][bj][n] = *(const u32x2v*)(x1b + ((size_t)(r_ >> 4) * 32 + ((col0 >> 5) + 4 * bj)) * 512 + (r_ & 15) * 32 + (col0 & 31) + 16 * n); } }
        __builtin_amdgcn_sched_barrier(0);
#pragma unroll
        for (int ai = 0; ai < 2; ++ai)
#pragma unroll
            for (int m = 0; m < 4; ++m) { const size_t off = (size_t)(u.pm * BM + ai * HALF + wr * 64 + m * 16 + fr) * 1024 + col0;
#pragma unroll
                for (int bj = 0; bj < 2; ++bj)
#pragma unroll
                    for (int n = 0; n < 2; ++n) { const u32x2v w = xw[ai][m][bj][n];
                        const f32x4 xr = (f32x4){__uint_as_float(w.x << 16), __uint_as_float(w.x & 0xffff0000u), __uint_as_float(w.y << 16), __uint_as_float(w.y & 0xffff0000u)};
                        *(f32x4*)(out + off + bj * HALF + n * 16) = xr + acc[ai][bj][m][n]; } }
    }
};
template <class Epi, class Sched, bool ALIGN_EPI = false, bool SP2 = false>
__device__ __forceinline__ void gemm_phase(PG8_LAS unsigned char* lds, const Gemm g, const Sched& S, const Epi& E) {
    const int tid = threadIdx.x, wid = __builtin_amdgcn_readfirstlane(tid >> 6), lane = tid & 63, wr = wid >> 2, wc = wid & 3, fr = lane & 15, fq = lane >> 4;
    const int K = g.K, nt = K / BK;
    unsigned voffA[2], voffB[2];
#pragma unroll
    for (int i = 0; i < 2; ++i) { int R, C; stage_rc(tid * 16 + i * 8192, R, C); const int Rb = Epi::PERM ? ((R & ~31) + perm32(R & 31)) : R;
        voffA[i] = g.ta ? (unsigned)(((R >> 4) * (g.lda >> 5) + (C >> 5)) * 1024 + (R & 15) * 64 + (C & 31) * 2) : (unsigned)(R * g.lda + C) * 2u;
        voffB[i] = g.tb ? (unsigned)(((Rb >> 4) * (K >> 5) + (C >> 5)) * 1024 + (Rb & 15) * 64 + (C & 31) * 2) : (unsigned)(Rb * K + C) * 2u; }
    const size_t kstepA = g.ta ? (size_t)2048 : (size_t)(BK * 2), kstepB = g.tb ? (size_t)2048 : (size_t)(BK * 2);
    const size_t hstepB = (size_t)HALF * K * 2, hstepA = (size_t)HALF * g.lda * 2;
    const size_t tstepB = 2 * hstepB, tstepA = 2 * hstepA;
    const unsigned ldsw = (unsigned)wid * 1024u;
    const int aoff = lds_byte(wr * 64 + fr, fq * 8), boff = lds_byte(wc * 32 + fr, fq * 8);
#define PG8_SA(b, h) (((b) * 2 + (h)) * HTB)
#define PG8_SB(b, h) ((4 + (b) * 2 + (h)) * HTB)
#define PG8_STAGE(bufoff, gbase, voff) do { _Pragma("unroll") for (int _i = 0; _i < 2; ++_i) \
        __builtin_amdgcn_global_load_lds((const unsigned*)((const char*)(gbase) + (voff)[_i]), (PG8_LAS unsigned*)(lds + (bufoff) + ldsw + _i * 8192), 16, 0, 0); } while (0)
#define PG8_LDA(dst, b, h) do { _Pragma("unroll") for (int m = 0; m < 4; ++m) _Pragma("unroll") for (int k = 0; k < 2; ++k) dst[m][k] = *(const PG8_LAS bf16x8*)(lds + PG8_SA(b, h) + aoff + m * 2048 + k * 1024); } while (0)
#define PG8_LDB(dst, b, h) do { _Pragma("unroll") for (int n = 0; n < 2; ++n) _Pragma("unroll") for (int k = 0; k < 2; ++k) dst[n][k] = *(const PG8_LAS bf16x8*)(lds + PG8_SB(b, h) + boff + n * 2048 + k * 1024); } while (0)
#define PG8_MMA(ai, bj, At, Bt) do { __builtin_amdgcn_s_setprio(1); _Pragma("unroll") for (int m = 0; m < 4; ++m) _Pragma("unroll") for (int n = 0; n < 2; ++n) _Pragma("unroll") for (int k = 0; k < 2; ++k) \
        acc[ai][bj][m][n] = __builtin_amdgcn_mfma_f32_16x16x32_bf16(Bt[n][k], At[m][k], acc[ai][bj][m][n], 0, 0, 0); __builtin_amdgcn_s_setprio(0); } while (0)
#define PG8_WAIT_V(n) asm volatile("s_waitcnt vmcnt(" #n ")" ::: "memory")
#define PG8_WAIT_L(n) asm volatile("s_waitcnt lgkmcnt(" #n ")" ::: "memory")
#define PG8_BAR __builtin_amdgcn_s_barrier()
#define PG8_SCHED __builtin_amdgcn_sched_barrier(0)
    Unit cur, nxt; int ui = 0;
    if (!S.next(0, cur)) return;
    f32x4 acc[2][2][4][2];
#pragma unroll
    for (int a = 0; a < 2; ++a)
#pragma unroll
        for (int b = 0; b < 2; ++b)
#pragma unroll
            for (int m = 0; m < 4; ++m)
#pragma unroll
                for (int n = 0; n < 2; ++n) acc[a][b][m][n] = (f32x4){0.f, 0.f, 0.f, 0.f};
    bf16x8 At[4][2], B0[2][2], B1[2][2];
    const char* cA = (const char*)g.A + (size_t)cur.pm * tstepA; const char* cB = (const char*)g.Bt + (size_t)cur.pn * tstepB;
    S.a_ready(cur);
    if constexpr (SP2) {
        PG8_STAGE(PG8_SB(0, 0), cB, voffB); PG8_STAGE(PG8_SB(0, 1), cB + hstepB, voffB); PG8_STAGE(PG8_SA(0, 0), cA, voffA); PG8_STAGE(PG8_SA(0, 1), cA + hstepA, voffA);
        if (wr == 1) PG8_BAR;
        PG8_WAIT_V(2); PG8_BAR;
        PG8_STAGE(PG8_SB(1, 0), cB + kstepB, voffB); PG8_STAGE(PG8_SA(1, 0), cA + kstepA, voffA); PG8_STAGE(PG8_SB(1, 1), cB + hstepB + kstepB, voffB);
        PG8_WAIT_V(6); PG8_BAR;
    } else {
        PG8_STAGE(PG8_SB(0, 0), cB, voffB); PG8_STAGE(PG8_SA(0, 0), cA, voffA); PG8_STAGE(PG8_SB(0, 1), cB + hstepB, voffB); PG8_STAGE(PG8_SA(0, 1), cA + hstepA, voffA);
        if (wr == 1) PG8_BAR;
        PG8_WAIT_V(4); PG8_BAR;
        PG8_STAGE(PG8_SB(1, 0), cB + kstepB, voffB); PG8_STAGE(PG8_SA(1, 0), cA + kstepA, voffA); PG8_STAGE(PG8_SB(1, 1), cB + hstepB + kstepB, voffB);
        PG8_WAIT_V(6); PG8_BAR;
    }
    for (;;) {
        const bool has_next = S.next(ui + 1, nxt);
        const char* nA = has_next ? (const char*)g.A + (size_t)nxt.pm * tstepA : cA; const char* nB = has_next ? (const char*)g.Bt + (size_t)nxt.pn * tstepB : cB;
        for (int t = 0; t < nt; t += 2) {
            const bool last = (t == nt - 2);
            const char* a1 = cA + (size_t)(t + 1) * kstepA;
            const char* a2 = last ? nA : cA + (size_t)(t + 2) * kstepA; const char* b2 = last ? nB : cB + (size_t)(t + 2) * kstepB;
            const char* a3 = a2 + kstepA; const char* b3 = b2 + kstepB;
            if (last && has_next) S.a_ready(nxt);
            if constexpr (SP2) {
            PG8_LDB(B0, 0, 0); PG8_LDB(B1, 0, 1); PG8_SCHED; PG8_LDA(At, 0, 0); PG8_STAGE(PG8_SA(1, 1), a1 + hstepA, voffA);
            PG8_WAIT_V(8); PG8_WAIT_L(0); PG8_BAR; PG8_MMA(0, 0, At, B0); PG8_MMA(0, 1, At, B1); PG8_BAR; PG8_SCHED;
            PG8_LDA(At, 0, 1); PG8_STAGE(PG8_SB(0, 0), b2, voffB); PG8_STAGE(PG8_SB(0, 1), b2 + hstepB, voffB); PG8_STAGE(PG8_SA(0, 0), a2, voffA);
            PG8_WAIT_V(8); PG8_WAIT_L(0); PG8_BAR; PG8_MMA(1, 0, At, B0); PG8_MMA(1, 1, At, B1); PG8_BAR; PG8_SCHED;
            PG8_LDB(B0, 1, 0); PG8_LDB(B1, 1, 1); PG8_SCHED; PG8_LDA(At, 1, 0); PG8_STAGE(PG8_SA(0, 1), a2 + hstepA, voffA);
            PG8_WAIT_V(8); PG8_WAIT_L(0); PG8_BAR; PG8_MMA(0, 0, At, B0); PG8_MMA(0, 1, At, B1); PG8_BAR; PG8_SCHED;
            PG8_LDA(At, 1, 1); PG8_STAGE(PG8_SB(1, 0), b3, voffB); PG8_STAGE(PG8_SB(1, 1), b3 + hstepB, voffB); PG8_STAGE(PG8_SA(1, 0), a3, voffA);
            PG8_WAIT_V(8); PG8_WAIT_L(0); PG8_BAR; PG8_MMA(1, 0, At, B0); PG8_MMA(1, 1, At, B1); PG8_BAR; PG8_SCHED;
            } else {
            PG8_LDB(B0, 0, 0); PG8_SCHED; PG8_LDA(At, 0, 0); PG8_STAGE(PG8_SA(1, 1), a1 + hstepA, voffA);
            PG8_WAIT_L(8); PG8_BAR; PG8_WAIT_L(0); PG8_MMA(0, 0, At, B0); PG8_BAR; PG8_SCHED;
            PG8_LDB(B1, 0, 1); PG8_STAGE(PG8_SB(0, 0), b2, voffB);
            PG8_BAR; PG8_WAIT_L(0); PG8_MMA(0, 1, At, B1); PG8_BAR;
            PG8_LDA(At, 0, 1); PG8_STAGE(PG8_SA(0, 0), a2, voffA);
            PG8_BAR; PG8_WAIT_L(0); PG8_MMA(1, 0, At, B0); PG8_BAR; PG8_SCHED;
            PG8_STAGE(PG8_SB(0, 1), b2 + hstepB, voffB);
            PG8_WAIT_V(6); PG8_BAR; PG8_MMA(1, 1, At, B1); PG8_BAR;
            PG8_LDB(B0, 1, 0); PG8_SCHED; PG8_LDA(At, 1, 0); PG8_STAGE(PG8_SA(0, 1), a2 + hstepA, voffA);
            PG8_WAIT_L(8); PG8_BAR; PG8_WAIT_L(0); PG8_MMA(0, 0, At, B0); PG8_BAR; PG8_SCHED;
            PG8_LDB(B1, 1, 1); PG8_STAGE(PG8_SB(1, 0), b3, voffB);
            PG8_BAR; PG8_WAIT_L(0); PG8_MMA(0, 1, At, B1); PG8_BAR;
            PG8_LDA(At, 1, 1); PG8_STAGE(PG8_SA(1, 0), a3, voffA);
            PG8_BAR; PG8_WAIT_L(0); PG8_MMA(1, 0, At, B0); PG8_BAR; PG8_SCHED;
            PG8_STAGE(PG8_SB(1, 1), b3 + hstepB, voffB);
            PG8_WAIT_V(6); PG8_BAR; PG8_MMA(1, 1, At, B1); PG8_BAR;
            }
        }
        if constexpr (ALIGN_EPI) { if (wr == 0) PG8_BAR; }
        if constexpr (!Epi::AFTER_DRAIN) { if constexpr (Epi::PROBE_BIT == 29) E(acc, cur, wr, wc, fr, fq, ui); else E(acc, cur, wr, wc, fr, fq); if (DUPL(Epi::PROBE_BIT)) E(acc, cur, wr, wc, fr, fq); S.done(cur); }
        if (!has_next) break;
#pragma unroll
        for (int a = 0; a < 2; ++a)
#pragma unroll
            for (int b = 0; b < 2; ++b)
#pragma unroll
                for (int m = 0; m < 4; ++m)
#pragma unroll
                    for (int n = 0; n < 2; ++n) acc[a][b][m][n] = (f32x4){0.f, 0.f, 0.f, 0.f};
        cur = nxt; cA = nA; cB = nB; ++ui;
        if constexpr (ALIGN_EPI) { if (wr == 1) PG8_BAR; }
    }
    PG8_WAIT_V(0);
    if constexpr (!ALIGN_EPI) { if (wr == 0) PG8_BAR; }
    PG8_BAR;
    if constexpr (Epi::AFTER_DRAIN) { E.fused(acc, cur, wr, wc, fr, fq, lds, wid, lane); if (DUPL(Epi::PROBE_BIT)) { asm volatile("s_waitcnt lgkmcnt(0)" ::: "memory"); __builtin_amdgcn_s_barrier(); E.fused(acc, cur, wr, wc, fr, fq, lds, wid, lane); } S.done(cur); }
#undef PG8_SA
#undef PG8_SB
#undef PG8_STAGE
#undef PG8_LDA
#undef PG8_LDB
#undef PG8_MMA
#undef PG8_WAIT_V
#undef PG8_WAIT_L
#undef PG8_BAR
#undef PG8_SCHED
}
}

#define GAS __attribute__((address_space(1)))
#define LAS __attribute__((address_space(3)))
#define XB_TMO      128
#define XB_XCNT(j)  (256  + 64 * (j))
#define XB_XSUB(j)  (1280 + 64 * (j))
#define XB_XGEN(j)  (2304 + 64 * (j))
#define XB_TOP      3328
#define XB_TOPGEN   3392
#define XCD_BAR_WORDS 3456
#define XB_SPIN_CAP (1u << 18)
__device__ __forceinline__ unsigned xb_ld(unsigned* p)              { return __hip_atomic_load(p, __ATOMIC_RELAXED, __HIP_MEMORY_SCOPE_AGENT); }
__device__ __forceinline__ unsigned xb_add(unsigned* p, unsigned v) { return __hip_atomic_fetch_add(p, v, __ATOMIC_RELAXED, __HIP_MEMORY_SCOPE_AGENT); }
__device__ __forceinline__ unsigned xb_xcc_id() { return (unsigned)__builtin_amdgcn_s_getreg((3 << 11) | 20) & 0xFu; }
#define XB_SPIN(cond, bar) do { unsigned _sp = 0; while (cond) { __builtin_amdgcn_s_sleep(1); \
    if ((++_sp & 255u) == 0u) { if (xb_ld(&(bar)[XB_TMO])) break; if (_sp > XB_SPIN_CAP) { atomicAdd(&(bar)[XB_TMO], 1u); break; } } } } while (0)
struct XcdBarrier { unsigned* bar; unsigned x; volatile LAS unsigned* st; };
__device__ __forceinline__ XcdBarrier xcd_barrier_post(unsigned* bar, volatile LAS unsigned* st) {
    XcdBarrier b; b.bar = bar; b.x = xb_xcc_id(); b.st = st;
    if (threadIdx.x == 0) (void)xb_add(&bar[XB_XCNT(b.x)], 1u);
    return b;
}
__device__ __forceinline__ void xcd_barrier_complete(unsigned* bar, unsigned x, unsigned& nloc, unsigned& nx) {
    const unsigned G = gridDim.x * gridDim.y * gridDim.z;
    unsigned sum, cnt, mine, sp = 0u;
    for (;;) {
        sum = 0u; cnt = 0u; mine = 0u;
#pragma unroll
        for (unsigned j = 0; j < 16; ++j) { const unsigned c = xb_ld(&bar[XB_XCNT(j)]); sum += c; cnt += (c > 0u) ? 1u : 0u; mine = (j == x) ? c : mine; }
        if (sum == G) break;
        __builtin_amdgcn_s_sleep(1);
        if ((++sp & 255u) == 0u) { if (xb_ld(&bar[XB_TMO])) break; if (sp > XB_SPIN_CAP) { atomicAdd(&bar[XB_TMO], 1u); break; } }
    }
    nloc = mine > 0u ? mine : 1u; nx = cnt > 0u ? cnt : 1u;
}
__device__ __forceinline__ void xcd_barrier(const XcdBarrier& b) {
    asm volatile("s_waitcnt vmcnt(0)" ::: "memory");
    __syncthreads();
    if (threadIdx.x == 0) {
        unsigned* bar = b.bar;
        __builtin_amdgcn_s_waitcnt(0);
        unsigned nloc = b.st[0], nx = b.st[1];
        if (nloc == 0u) { xcd_barrier_complete(bar, b.x, nloc, nx); b.st[0] = nloc; b.st[1] = nx; }
        const unsigned old = xb_add(&bar[XB_XSUB(b.x)], 1u);
        const unsigned gen = old / nloc;
        if (old + 1u == (gen + 1u) * nloc) {
            __builtin_amdgcn_fence(__ATOMIC_RELEASE, "agent");
            asm volatile("s_waitcnt vmcnt(0)" ::: "memory");
            const unsigned og = xb_add(&bar[XB_TOP], 1u);
            const unsigned tg = og / nx;
            asm volatile("buffer_inv sc1" ::: "memory");
            if (og + 1u == (tg + 1u) * nx) xb_add(&bar[XB_TOPGEN], 1u);
            else XB_SPIN(xb_ld(&bar[XB_TOPGEN]) == tg, bar);
            xb_add(&bar[XB_XGEN(b.x)], 1u);
            asm volatile("s_waitcnt vmcnt(0)" ::: "memory");
        } else {
            asm volatile("buffer_inv sc1" ::: "memory");
            XB_SPIN(xb_ld(&bar[XB_XGEN(b.x)]) == gen, bar);
            asm volatile("s_waitcnt vmcnt(0)" ::: "memory");
        }
    }
    __syncthreads();
}

constexpr int LDS_BYTES = 147456;
constexpr int MISC_OFF = 131072 + 320;
constexpr int CW_BAR = 4096;
#ifndef MK_SINGLE
#define MK_SINGLE 1
#endif
constexpr int NPHASE = 11;
struct Args { Ctx C; int ph_lo, ph_hi; };
__global__ void __launch_bounds__(NT, 2) fwd_mega(Args args) {
    extern __shared__ __attribute__((aligned(16))) unsigned char lds_raw[];
    float* lds = (float*)lds_raw;
    PG8_LAS unsigned char* L3 = (PG8_LAS unsigned char*)lds_raw;
    const Ctx& C = args.C;
    unsigned char* ws = C.ws;
    volatile LAS unsigned* MISC = (volatile LAS unsigned*)((LAS unsigned char*)lds_raw + MISC_OFF);
    if (threadIdx.x < 32) MISC[threadIdx.x] = 0u;
    __syncthreads();
    XcdBarrier bar; bar.bar = (unsigned*)(ws + WS_CTL) + CW_BAR; bar.x = 0; bar.st = nullptr;
    if (MK_SINGLE) bar = xcd_barrier_post((unsigned*)(ws + WS_CTL) + CW_BAR, MISC + 8);
    const int lo = args.ph_lo, hi = args.ph_hi;
#define IN(k) (lo <= (k) && (k) < hi)
#define SEAM(k) do { if (IN(k) && IN((k) + 1)) { xcd_barrier(bar); if (DUPL(31)) xcd_barrier(bar); } } while (0)
#define PH(k, BODY) do { if (IN(k)) { BODY; if (DUPL(k)) { BODY; } } } while (0)
#define GEMM_PH(EPI, EINIT, AP, BP, NN, KK, LDA, AL) GEMM_PH2(EPI, EINIT, AP, BP, NN, KK, LDA, AL, false)
#define GEMM_PH2(EPI, EINIT, AP, BP, NN, KK, LDA, AL, TA) do { pg8::Gemm g{(const bf16*)(AP), (const bf16*)(BP), M, NN, KK, LDA, TA, true}; pg8::StaticOrder S; S.init(M, NN, (int)gridDim.x, (int)blockIdx.x); \
        pg8::EPI E EINIT; pg8::gemm_phase<pg8::EPI, pg8::StaticOrder, AL, true>(L3, g, S, E); } while (0)
    const float* COS = (const float*)(ws + WS_COS); const float* SIN = (const float*)(ws + WS_SIN);
    PH(0, p0_prologue(C, lds));
    SEAM(0);
    PH(1, GEMM_PH(EpiZ, ({(bf16*)(ws + WS_Z), NZ, (float*)(ws + WS_SSQQ), (float*)(ws + WS_SSQKV), (float*)(ws + WS_SSQPE)}), ws + WS_A, ws + WS_WIN, NZ, DM, DM, true));
    SEAM(1);
    const bool p1_first = ((blockIdx.x >> 3) & 1) != 0;
    if (p1_first) { PH(4, gla::pass1(C, lds_raw)); }
    PH(2, GEMM_PH2(EpiQ, ({(const float*)(ws + WS_SSQQ), C.q_head_norm, COS, SIN, (bf16*)(ws + WS_QF), EPS, QSCALE}), (const bf16*)(ws + WS_Z) + (ZC_CQ >> 5) * 512, ws + WS_WUQ, 1024, QRANK, NZ, false, true));
    __syncthreads();
    PH(3, GEMM_PH2(EpiKV, ({(const float*)(ws + WS_SSQKV), (const float*)(ws + WS_SSQPE), C.k_head_norm, COS, SIN, (const bf16*)(ws + WS_Z), (bf16*)(ws + WS_KF), (bf16*)(ws + WS_VF), EPS}), (const bf16*)(ws + WS_Z) + (ZC_CKV >> 5) * 512, ws + WS_WUKV, 1024, KVRANK, NZ, false, true));
    __syncthreads();
    if (!p1_first) { PH(4, gla::pass1(C, lds_raw)); }
    SEAM(4);
    PH(5, (gla_scan(C), p0_late_weights(C, lds)));
    SEAM(5);
    PH(6, att::attn_phase(C, (char*)lds_raw));
    PH(7, gla::pass2(C, lds_raw));
    SEAM(7);
    PH(8, GEMM_PH2(EpiOutProjG, ({C.x, C.out, (bf16*)(ws + WS_A), (float*)(ws + WS_SSQ)}), ws + WS_B, ws + WS_WO, DM, DM, DM, true, true));
    SEAM(8);
    if (IN(9)) {
        PG8_LAS float* rtab = (PG8_LAS float*)(L3 + 131072 + 1024);
        pg8::StaticOrder So; So.init(M, DFF, (int)gridDim.x, (int)blockIdx.x);
        for (int idx = threadIdx.x; idx < 4 * 256; idx += NT) { pg8::Unit uu; const int i = idx >> 8, row = idx & 255;
            if (So.next(i, uu)) { const f32x4* sp = (const f32x4*)(ws + WS_SSQ) + (size_t)(uu.pm * 256 + row) * 4; const f32x4 s4 = (sp[0] + sp[1]) + (sp[2] + sp[3]);
                rtab[idx] = __builtin_amdgcn_rsqf(((s4[0] + s4[1]) + (s4[2] + s4[3])) * (1.0f / DM) + EPS); } }
        __syncthreads();
    }
    PH(9, GEMM_PH2(EpiUpG, ({(const PG8_LAS float*)(L3 + 131072 + 1024), (bf16*)(ws + WS_H)}), ws + WS_A, ws + WS_WUP, DFF, DM, DM, true, true));
    SEAM(9);
    PH(10, GEMM_PH2(EpiDownG, ({(const bf16*)(ws + WS_A), C.out}), ws + WS_H, ws + WS_WDN, DM, DFF, DFF, true, true));

#undef IN
#undef SEAM
}

extern "C" void kernel_launch(void* const* d_in, const int* in_sizes, int n_in, void* d_out, int out_size, void* d_ws, size_t ws_size, hipStream_t stream) {
    static int grid = 0;
    if (grid == 0) {
        if (n_in != 17 || in_sizes[0] != M * DM || out_size != M * DM || ws_size < WS_END) { fprintf(stderr, "kernel_launch: unexpected shapes (n_in %d in0 %d out %d ws %zu)\n", n_in, n_in > 0 ? in_sizes[0] : -1, out_size, ws_size); grid = -1; return; }
        int dev = 0, cus = 0, per_cu = 0;
        if (hipGetDevice(&dev) != hipSuccess || hipDeviceGetAttribute(&cus, hipDeviceAttributeMultiprocessorCount, dev) != hipSuccess) { fprintf(stderr, "kernel_launch: device query failed\n"); grid = -1; return; }
        if (hipFuncSetAttribute((const void*)fwd_mega, hipFuncAttributeMaxDynamicSharedMemorySize, LDS_BYTES) != hipSuccess) { fprintf(stderr, "kernel_launch: hipFuncSetAttribute failed\n"); grid = -1; return; }
        if (hipOccupancyMaxActiveBlocksPerMultiprocessor(&per_cu, (const void*)fwd_mega, NT, LDS_BYTES) != hipSuccess || per_cu < 1) fprintf(stderr, "kernel_launch: note: occupancy query reports %d workgroups per CU\n", per_cu);
        (void)hipGetLastError();
        grid = cus;
    }
    if (grid < 0) return;
    Args a{};
    Ctx& C = a.C;
    C.x = (const float*)d_in[0]; C.pos = (const int*)d_in[1]; C.attn_norm = (const float*)d_in[2]; C.w_in = (const float*)d_in[3]; C.w_gate_up = (const float*)d_in[4];
    C.b_gate = (const float*)d_in[5]; C.gla_out_norm = (const float*)d_in[6]; C.q_a_norm = (const float*)d_in[7]; C.w_uq = (const float*)d_in[8]; C.kv_a_norm = (const float*)d_in[9];
    C.w_ukv = (const float*)d_in[10]; C.q_head_norm = (const float*)d_in[11]; C.k_head_norm = (const float*)d_in[12]; C.w_out = (const float*)d_in[13]; C.mlp_norm = (const float*)d_in[14];
    C.w_up = (const float*)d_in[15]; C.w_down = (const float*)d_in[16]; C.out = (float*)d_out; C.ws = (unsigned char*)d_ws;
    if (MK_SINGLE) {
        if (hipMemsetAsync((char*)d_ws + WS_CTL, 0, CTL_ZERO_BYTES, stream) != hipSuccess) { fprintf(stderr, "kernel_launch: memset failed\n"); return; }
        a.ph_lo = 0; a.ph_hi = NPHASE;
        hipLaunchKernelGGL(fwd_mega, dim3(grid), dim3(NT), LDS_BYTES, stream, a);
        if (DUPL(23)) { (void)hipMemsetAsync((char*)d_ws + WS_CTL, 0, CTL_ZERO_BYTES, stream); hipLaunchKernelGGL(fwd_mega, dim3(grid), dim3(NT), LDS_BYTES, stream, a); }
    } else {
        for (int s = 0; s < NPHASE; ++s) { a.ph_lo = s; a.ph_hi = s + 1; hipLaunchKernelGGL(fwd_mega, dim3(grid), dim3(NT), LDS_BYTES, stream, a); }
    }
}
```

```cpp
#include <hip/hip_runtime.h>
#include <cstdio>
#include <cstdint>
#ifndef DUP_MASK
#define DUP_MASK 0u
#endif
#define DUPL(k) (((DUP_MASK) >> (k)) & 1u)

constexpr int BATCH = 2, SEQ = 8192, DM = 1024, M = BATCH * SEQ;
constexpr int DPROJ = 1968, NZ = 2048, DFF = 4096;
constexpr int GH = 4, GDK = 64, GDV = 128, GRANK = 16, NCH = SEQ / 64;
constexpr int MH = 8, QRANK = 256, KVRANK = 128, NOPE = 64, ROPE = 32, MV = 64, DQK = 96;
constexpr float EPS = 1e-6f;
constexpr float QSCALE = 0.10206207261596577f * 1.4426950408889634f;
constexpr int ZC_Q = 0, ZC_K = 256, ZC_V = 512, ZC_G = 1024, ZC_CQ = 1536, ZC_CKV = 1792, ZC_KPE = 1920, ZC_GATE = 1952;
__host__ __device__ __forceinline__ size_t ztile(size_t r, int c) { return ((r >> 4) * 64 + (size_t)(c >> 5)) * 512 + (r & 15) * 32 + (c & 31); }

constexpr size_t MiB = 1u << 20;
constexpr size_t WS_CTL = 0;
constexpr size_t WS_WIN = 1 * MiB, WS_WUQ = 5 * MiB, WS_WUKV = 6 * MiB, WS_WO = 7 * MiB, WS_WUP = 9 * MiB, WS_WDN = 17 * MiB;
constexpr size_t WS_RS = 768 * 1024;
constexpr size_t WS_CUM = 236 * MiB;
constexpr size_t WS_SSQ = 25 * MiB, WS_DEC = 512 * 1024, WS_COS = 26 * MiB, WS_SIN = 27 * MiB;
constexpr size_t CTL_ZERO_BYTES = 64 * 1024;
constexpr size_t WS_SSQQ = 5 * MiB + 512 * 1024, WS_SSQKV = 5 * MiB + 768 * 1024, WS_SSQPE = 6 * MiB + 512 * 1024;
constexpr size_t WS_A = 28 * MiB;
constexpr size_t WS_B = 60 * MiB;
constexpr size_t WS_Z = 92 * MiB;
constexpr size_t WS_QF = 156 * MiB, WS_AQ = 156 * MiB, WS_AKV = 164 * MiB, WS_KF = 180 * MiB, WS_VF = 204 * MiB;
constexpr size_t WS_CKV = 220 * MiB;
constexpr size_t WS_H = 92 * MiB;
constexpr size_t WS_END = 252 * MiB;

typedef unsigned short bf16;
typedef float f32x4 __attribute__((ext_vector_type(4)));
typedef unsigned u32x2 __attribute__((ext_vector_type(2)));
typedef unsigned u32x4 __attribute__((ext_vector_type(4)));

__device__ __forceinline__ float bf2f(unsigned b) { return __uint_as_float(b << 16); }
__device__ __forceinline__ unsigned f2bf(float f) { unsigned u = __float_as_uint(f); return (u + 0x7fffu + ((u >> 16) & 1u)) >> 16; }
typedef float f32x2c_t __attribute__((ext_vector_type(2))); typedef __bf16 bf16x2c_t __attribute__((ext_vector_type(2)));
__device__ __forceinline__ unsigned pk2(float lo, float hi) { f32x2c_t v = {lo, hi}; bf16x2c_t b = __builtin_convertvector(v, bf16x2c_t); return __builtin_bit_cast(unsigned, b); }
__device__ __forceinline__ float wave_sum(float v) {
#pragma unroll
    for (int o = 1; o < 64; o <<= 1) v += __shfl_xor(v, o);
    return v;
}

__device__ __forceinline__ unsigned otid() { unsigned t = threadIdx.x; asm volatile("" : "+v"(t)); return t; }

struct Ctx {
    const float* x; const int* pos; const float* attn_norm; const float* w_in; const float* w_gate_up; const float* b_gate; const float* gla_out_norm;
    const float* q_a_norm; const float* w_uq; const float* kv_a_norm; const float* w_ukv; const float* q_head_norm; const float* k_head_norm;
    const float* w_out; const float* mlp_norm; const float* w_up; const float* w_down;
    float* out; unsigned char* ws;
};
constexpr int NT = 512;

__device__ __forceinline__ int win_src_col(int n) {
    if (n < 1024) return n;
    if (n < 1536) return n - 1024 + 1040;
    if (n < 1792) return n - 1536 + 1552;
    if (n < 1920) return n - 1792 + 1808;
    if (n < 1952) return n - 1920 + 1936;
    if (n < 1968) return n - 1952 + 1024;
    return -1;
}
struct MapWin { __device__ __forceinline__ int operator()(int n) const { return win_src_col(n); } };
struct MapUq  { __device__ __forceinline__ int operator()(int n) const { const int h = n >> 7, j = n & 127; return j < DQK ? h * DQK + j : -1; } };
struct MapId  { __device__ __forceinline__ int operator()(int n) const { return n; } };
template <bool GAIN, class CMap>
__device__ __forceinline__ void p0_transpose_item(const float* W, int K, int Nsrc, int N, bf16* WT, const float* kgain, float* scr, int item, int lane, const CMap& cmap) {
    const int nblk = N / 32, kb = item / nblk, nb = item % nblk, k0 = 64 * kb, n0 = 32 * nb;
    const int sc = cmap(n0 + (lane & 31)); const float keep = sc >= 0 ? 1.f : 0.f; const int scc = sc >= 0 ? sc : 0;
    const float* wp = W + (size_t)(k0 + (lane >> 5)) * Nsrc + scc;
    float v[32];
#pragma unroll
    for (int i = 0; i < 32; ++i) v[i] = __builtin_nontemporal_load(&wp[(size_t)(2 * i) * Nsrc]);
#pragma unroll
    for (int i = 0; i < 32; ++i) { const int kk = 2 * i + (lane >> 5); float t = v[i] * keep; if (GAIN) t *= kgain[k0 + kk]; scr[kk * 33 + (lane & 31)] = t; }
    asm volatile("s_waitcnt lgkmcnt(0)" ::: "memory");
    const int c = lane & 7;
#pragma unroll
    for (int j = 0; j < 4; ++j) { const int n = (lane >> 3) + 8 * j; const float* s = scr + (8 * c) * 33 + n;
        u32x4 o; o.x = pk2(s[0 * 33], s[1 * 33]); o.y = pk2(s[2 * 33], s[3 * 33]); o.z = pk2(s[4 * 33], s[5 * 33]); o.w = pk2(s[6 * 33], s[7 * 33]);
        *(u32x4*)(WT + ((size_t)((n0 + n) >> 4) * (K >> 5) + ((k0 + 8 * c) >> 5)) * 512 + ((n0 + n) & 15) * 32 + ((k0 + 8 * c) & 31)) = o; }
    asm volatile("s_waitcnt lgkmcnt(0)" ::: "memory");
}
__device__ __forceinline__ void p0_prologue(const Ctx& C, float* lds) {
    const size_t gt = (size_t)blockIdx.x * NT + otid(), GT = (size_t)gridDim.x * NT;
    bf16* win = (bf16*)(C.ws + WS_WIN); bf16* wuq = (bf16*)(C.ws + WS_WUQ); bf16* wukv = (bf16*)(C.ws + WS_WUKV);
    bf16* wo = (bf16*)(C.ws + WS_WO); bf16* wup = (bf16*)(C.ws + WS_WUP); bf16* wdn = (bf16*)(C.ws + WS_WDN);
    {   const int lane_ = otid() & 63, wv = otid() >> 6; float* scr = lds + wv * (64 * 33 + 32);
        const int gw_ = (int)(gt >> 6), NGW_ = (int)(GT >> 6);
        constexpr int I_IN = (DM / 64) * (NZ / 32), I_UQ = (QRANK / 64) * (1024 / 32), I_UKV = (KVRANK / 64) * (1024 / 32), I_O = (DM / 64) * (DM / 32), I_UP = (DM / 64) * (DFF / 32), I_DN = (DFF / 64) * (DM / 32);
        constexpr int NITEMS = I_IN + I_UQ + I_UKV;
        (void)wo; (void)wup; (void)wdn; (void)I_O; (void)I_UP; (void)I_DN;
        for (int it = gw_; it < NITEMS; it += NGW_) {
            int r = it;
            if (r < I_IN) { p0_transpose_item<true>(C.w_in, DM, DPROJ, NZ, win, C.attn_norm, scr, r, lane_, MapWin{}); continue; } r -= I_IN;
            if (r < I_UQ) { p0_transpose_item<true>(C.w_uq, QRANK, MH * DQK, 1024, wuq, C.q_a_norm, scr, r, lane_, MapUq{}); continue; } r -= I_UQ;
            p0_transpose_item<true>(C.w_ukv, KVRANK, 1024, 1024, wukv, C.kv_a_norm, scr, r, lane_, MapId{});
        }
    }
    const int lane = otid() & 63; const int gw = (int)(gt >> 6), NGW = (int)(GT >> 6);
    bf16* XN = (bf16*)(C.ws + WS_A); float* RS = (float*)(C.ws + WS_RS); float* COS = (float*)(C.ws + WS_COS); float* SIN = (float*)(C.ws + WS_SIN);
    for (int m = gw; m < M; m += 2 * NGW) {
        const int m2 = m + NGW;
        const f32x4* xa = (const f32x4*)(C.x + (size_t)m * DM) + lane; const f32x4* xb = (const f32x4*)(C.x + (size_t)(m2 < M ? m2 : m) * DM) + lane;
        f32x4 va[4], vb[4]; float sa = 0.f, sb = 0.f;
#pragma unroll
        for (int j = 0; j < 4; ++j) { va[j] = __builtin_nontemporal_load(&xa[64 * j]); vb[j] = __builtin_nontemporal_load(&xb[64 * j]); }
#pragma unroll
        for (int j = 0; j < 4; ++j) { sa += (va[j].x * va[j].x + va[j].y * va[j].y) + (va[j].z * va[j].z + va[j].w * va[j].w); sb += (vb[j].x * vb[j].x + vb[j].y * vb[j].y) + (vb[j].z * vb[j].z + vb[j].w * vb[j].w); }
        const float ra = rsqrtf(wave_sum(sa) * (1.f / DM) + EPS), rb = rsqrtf(wave_sum(sb) * (1.f / DM) + EPS);
        bf16* oa = XN + ((size_t)(m >> 4) * 32 + (lane >> 3)) * 512 + (m & 15) * 32 + 4 * (lane & 7); bf16* ob = XN + ((size_t)(m2 >> 4) * 32 + (lane >> 3)) * 512 + (m2 & 15) * 32 + 4 * (lane & 7);
#pragma unroll
        for (int j = 0; j < 4; ++j) { u32x2 w; w.x = pk2(va[j].x, va[j].y); w.y = pk2(va[j].z, va[j].w); *(u32x2*)(oa + j * 8 * 512) = w; }
        if (lane == 0) RS[m] = ra;
        if (m2 < M) { if (lane == 0) RS[m2] = rb;
#pragma unroll
            for (int j = 0; j < 4; ++j) { u32x2 w; w.x = pk2(vb[j].x, vb[j].y); w.y = pk2(vb[j].z, vb[j].w); *(u32x2*)(ob + j * 8 * 512) = w; } }
    }
    for (size_t i = gt; i < (size_t)M * 16; i += GT) { const int m = (int)(i >> 4), f = (int)(i & 15);
        const float invf = exp2f(-(float)(2 * f) * (1.f / 32.f) * 13.287712379549449f);
        const float ang = (float)C.pos[m] * invf; float sn, cs; sincosf(ang, &sn, &cs); COS[i] = cs; SIN[i] = sn; }
}

__device__ __forceinline__ void p0_late_weights(const Ctx& C, float* lds) {
    const unsigned t = otid(); if (t < 256) return;
    bf16* wo = (bf16*)(C.ws + WS_WO); bf16* wup = (bf16*)(C.ws + WS_WUP); bf16* wdn = (bf16*)(C.ws + WS_WDN);
    const int lane_ = t & 63, wv = (t >> 6) - 4; float* scr = lds + wv * (64 * 33 + 32);
    const int gw_ = (int)blockIdx.x * 4 + wv, NGW_ = (int)gridDim.x * 4;
    constexpr int I_O = (DM / 64) * (DM / 32), I_UP = (DM / 64) * (DFF / 32), I_DN = (DFF / 64) * (DM / 32);
    for (int it = gw_; it < I_O + I_UP + I_DN; it += NGW_) {
        int r = it;
        if (r < I_UP) { p0_transpose_item<true>(C.w_up, DM, DFF, DFF, wup, C.mlp_norm, scr, r, lane_, MapId{}); continue; } r -= I_UP;
        if (r < I_DN) { p0_transpose_item<false>(C.w_down, DFF, DM, DM, wdn, nullptr, scr, r, lane_, MapId{}); continue; } r -= I_DN;
        p0_transpose_item<false>(C.w_out, DM, DM, DM, wo, nullptr, scr, r, lane_, MapId{});
    }
}

__device__ __forceinline__ void unpack8(const u32x4 w, float (&v)[8]) { v[0] = bf2f(w.x & 0xffffu); v[1] = bf2f(w.x >> 16); v[2] = bf2f(w.y & 0xffffu); v[3] = bf2f(w.y >> 16);
    v[4] = bf2f(w.z & 0xffffu); v[5] = bf2f(w.z >> 16); v[6] = bf2f(w.w & 0xffffu); v[7] = bf2f(w.w >> 16); }
__device__ __forceinline__ u32x4 pack8(const float (&v)[8]) { u32x4 w; w.x = pk2(v[0], v[1]); w.y = pk2(v[2], v[3]); w.z = pk2(v[4], v[5]); w.w = pk2(v[6], v[7]); return w; }
constexpr float LOG2E = 1.4426950408889634f, LN2 = 0.6931471805599453f;
__device__ __forceinline__ float fexp(float x) { return __builtin_amdgcn_exp2f(x * LOG2E); }
__device__ __forceinline__ float log_gate(float gl) { const float ls = fminf(gl, 0.f) - LN2 * __builtin_amdgcn_logf(1.f + fexp(-fabsf(gl))); return fmaxf(ls * (1.f / 16.f), -1.f); }
__device__ __forceinline__ float silu_f(float g) { return g * __builtin_amdgcn_rcpf(1.f + fexp(-g)); }
__device__ __forceinline__ void gla_scan(const Ctx& C) {
    const bf16* CKV = (const bf16*)(C.ws + WS_CKV); const float* DEC = (const float*)(C.ws + WS_DEC); bf16* PREV = (bf16*)C.out;
    if (otid() >= 256) return;
    for (int e = blockIdx.x * 256 + otid(); e < BATCH * GH * 128 * 64; e += gridDim.x * 256) {
        const int d = e & 63, v = (e >> 6) & 127, bh = e >> 13; float st = 0.f;
        for (int n0 = 0; n0 < NCH; n0 += 32) {
            float cv[32], dv[32];
#pragma unroll
            for (int i = 0; i < 32; ++i) { const size_t u = (size_t)bh * NCH + n0 + i; cv[i] = bf2f(__builtin_nontemporal_load(&CKV[(u * 128 + v) * 64 + d])); dv[i] = DEC[u * 64 + d]; }
#pragma unroll
            for (int i = 0; i < 32; ++i) { const size_t u = (size_t)bh * NCH + n0 + i; PREV[(u * 128 + v) * 64 + d] = (bf16)f2bf(st); st = dv[i] * st + cv[i]; }
        }
    }
}

namespace att {
typedef short bf16x8 __attribute__((ext_vector_type(8)));
typedef short s16x4 __attribute__((ext_vector_type(4)));
typedef float f32x16 __attribute__((ext_vector_type(16)));
typedef __attribute__((address_space(3))) const char* lds_cptr;
constexpr int KSLOT = 12288, VSLOT = 8192, LDS_K = 0, LDS_V = 3 * KSLOT, LDS_WS = LDS_V + 3 * VSLOT, LDS_OST = LDS_WS + 8 * 256, LDS_TOTAL = LDS_OST + 8 * 4096;
constexpr int QP = MH * DQK, VP = MH * MV;
#define ATT_SBAR() __builtin_amdgcn_sched_barrier(0)
__device__ __forceinline__ int crow(int r, int hi) { return (r & 3) + 8 * (r >> 2) + 4 * hi; }
__device__ __forceinline__ void glds16(const void* gsrc, unsigned lds_dst) { unsigned keep;
    asm volatile("s_mov_b32 %0, m0\n\ts_mov_b32 m0, %2\n\ts_nop 0\n\tglobal_load_lds_dwordx4 %1, off\n\ts_mov_b32 m0, %0" : "=&s"(keep) : "v"(gsrc), "s"(lds_dst) : "memory"); }
typedef float f32x2_t __attribute__((ext_vector_type(2))); typedef __bf16 bf16x2_t __attribute__((ext_vector_type(2)));
__device__ __forceinline__ unsigned cvtpk_s(float lo, float hi) { f32x2_t v = {lo, hi}; bf16x2_t b = __builtin_convertvector(v, bf16x2_t); return __builtin_bit_cast(unsigned, b); }
typedef short att_v4i16 __attribute__((ext_vector_type(4)));
__device__ __forceinline__ s16x4 vtr(lds_cptr p) { return __builtin_bit_cast(s16x4, __builtin_amdgcn_ds_read_tr16_b64_v4i16((__attribute__((address_space(3))) att_v4i16*)p)); }
#define ATT_MX3(a, b, c) __builtin_fmaxf(__builtin_fmaxf((a), (b)), (c))
__device__ __forceinline__ float rowmax(const f32x16& p0, const f32x16& p1) {
    float a = ATT_MX3(p0[0], p0[1], p1[0]), b = ATT_MX3(p0[2], p0[3], p1[1]); a = ATT_MX3(a, p1[2], p1[3]);
#pragma unroll
    for (int r = 4; r < 16; r += 4) { a = ATT_MX3(a, p0[r], p0[r + 1]); b = ATT_MX3(b, p0[r + 2], p0[r + 3]); a = ATT_MX3(a, p1[r], p1[r + 1]); b = ATT_MX3(b, p1[r + 2], p1[r + 3]); }
    float m = __builtin_fmaxf(a, b); auto rr = __builtin_amdgcn_permlane32_swap(__float_as_uint(m), __float_as_uint(m), false, false);
    return __builtin_fmaxf(__uint_as_float(rr[0]), __uint_as_float(rr[1])); }
__device__ __forceinline__ void pv(f32x16* o, int vb, bf16x8 pa0, bf16x8 pa1, bf16x8 pa2, bf16x8 pa3) {
#pragma unroll
    for (int d0 = 0; d0 < 2; ++d0) { s16x4 lo[4], hi[4];
#pragma unroll
        for (int ks = 0; ks < 4; ++ks) {
            asm volatile("ds_read_b64_tr_b16 %0,%1 offset:%c2" : "=&v"(lo[ks]) : "v"(vb), "i"(d0 * 4096 + ks * 1024) : "memory");
            asm volatile("ds_read_b64_tr_b16 %0,%1 offset:%c2" : "=&v"(hi[ks]) : "v"(vb), "i"(d0 * 4096 + ks * 1024 + 512) : "memory"); }
        asm volatile("s_waitcnt lgkmcnt(0)" ::: "memory"); ATT_SBAR();
#define ATT_PK(k) (bf16x8){lo[k][0], lo[k][1], lo[k][2], lo[k][3], hi[k][0], hi[k][1], hi[k][2], hi[k][3]}
        o[d0] = __builtin_amdgcn_mfma_f32_32x32x16_bf16(pa0, ATT_PK(0), o[d0], 0, 0, 0);
        o[d0] = __builtin_amdgcn_mfma_f32_32x32x16_bf16(pa1, ATT_PK(1), o[d0], 0, 0, 0);
        o[d0] = __builtin_amdgcn_mfma_f32_32x32x16_bf16(pa2, ATT_PK(2), o[d0], 0, 0, 0);
        o[d0] = __builtin_amdgcn_mfma_f32_32x32x16_bf16(pa3, ATT_PK(3), o[d0], 0, 0, 0);
#undef ATT_PK
    }
}
#define ATT_WAIT_BAR0() asm volatile("s_waitcnt vmcnt(0) lgkmcnt(0)\n\ts_barrier" ::: "memory")
template <int THRL, bool NOMAX>
__device__ __forceinline__ void attn_unit(int b, int h, int qb, const bf16* Q, const bf16* K, const bf16* V, bf16* O, char* shm) {
    const int tid = threadIdx.x, lane = tid & 63, r32 = lane & 31, hi = lane >> 5; const int wid = __builtin_amdgcn_readfirstlane(tid >> 6);
    const long rowbase = (long)b * SEQ; const int q0 = qb * 256; const int NTL = 4 * qb + 4, tmax = 4 * qb + (wid >> 1);
    const bf16* Qw = Q + (rowbase + q0 + wid * 32) * QP + h * DQK;
    const long bh = (long)b * MH + h;
    const bf16* ksrc0 = K + (bh * 128 * 12 + wid) * 512 + lane * 8;
    const bf16* ksrc1 = K + (bh * 128 * 12 + 8 + (wid & 3)) * 512 + lane * 8;
    const bf16* vsrc = V + (bh * 128 * 2 + (wid >> 2)) * 2048 + (16 * (wid & 3) + (lane >> 2)) * 32 + (lane & 3) * 8;
    const unsigned lds0 = (unsigned)(uintptr_t)shm;
    const unsigned kdst0 = lds0 + LDS_K + wid * 1024, kdst1 = lds0 + LDS_K + (8 + (wid & 3)) * 1024, vdst = lds0 + LDS_V + wid * 1024;
    float* wsf = (float*)(shm + LDS_WS) + wid * 64;
#define ATT_DMA(t, s) do { glds16(ksrc0 + (long)(t) * 6144, (unsigned)__builtin_amdgcn_readfirstlane(kdst0 + (s) * KSLOT)); \
        if (wid < 4) glds16(ksrc1 + (long)(t) * 6144, (unsigned)__builtin_amdgcn_readfirstlane(kdst1 + (s) * KSLOT)); \
        glds16(vsrc + (long)(t) * 4096, (unsigned)__builtin_amdgcn_readfirstlane(vdst + (s) * VSLOT)); } while (0)
    ATT_DMA(0, 0); ATT_DMA(1, 1);
    bf16x8 qr[6];
#pragma unroll
    for (int d0 = 0; d0 < 6; ++d0) qr[d0] = *reinterpret_cast<const bf16x8*>(&Qw[(long)r32 * QP + d0 * 16 + hi * 8]);
    asm volatile("" :: "v"(qr[0]), "v"(qr[1]), "v"(qr[2]), "v"(qr[3]), "v"(qr[4]), "v"(qr[5]));
    float mhat = 0.f, l_reg = 0.f; f32x16 o[2]; o[0] = f32x16{}; o[1] = f32x16{}; f32x16 negm = f32x16{}; if constexpr (!NOMAX) asm volatile("" : "+v"(negm));
    const lds_cptr shm3 = (lds_cptr)shm;
    const int vlane = ((lane >> 4) & 1) * 32 + (lane & 3) * 8 + (4 * hi + ((lane & 15) >> 2)) * 64;
    u32x4 pw0 = (u32x4){0u, 0u, 0u, 0u}, pw1 = pw0, pw2 = pw0, pw3 = pw0;
    s16x4 vlo[8], vhi[8]; f32x16 p0 = f32x16{}, p1 = f32x16{};
#pragma unroll
    for (int i = 0; i < 8; ++i) { vlo[i] = (s16x4){0, 0, 0, 0}; vhi[i] = vlo[i]; }
#define ATT_KRD(slot, d0) do { ka[slot] = *(const __attribute__((address_space(3))) bf16x8*)(kp + (d0) * 2048); kb[slot] = *(const __attribute__((address_space(3))) bf16x8*)(kp + (d0) * 2048 + 512); } while (0)
#define ATT_VRD(i) do { vlo[i] = vtr(vp + (((i) >> 2) * 4096 + ((i) & 3) * 1024)); vhi[i] = vtr(vp + (((i) >> 2) * 4096 + ((i) & 3) * 1024 + 512)); } while (0)
#define ATT_QK(s) do { \
        const lds_cptr kp = shm3 + LDS_K + (s) * KSLOT + hi * 1024 + r32 * 16; const lds_cptr vp = shm3 + LDS_V + (s) * VSLOT + vlane; \
        bf16x8 ka[3], kb[3]; \
        ATT_KRD(0, 0); ATT_KRD(1, 1); ATT_SBAR(); \
        ATT_KRD(2, 2); p0 = __builtin_amdgcn_mfma_f32_32x32x16_bf16(ka[0], qr[0], negm, 0, 0, 0); p1 = __builtin_amdgcn_mfma_f32_32x32x16_bf16(kb[0], qr[0], negm, 0, 0, 0); ATT_VRD(0); ATT_VRD(1); ATT_SBAR(); \
        ATT_KRD(0, 3); p0 = __builtin_amdgcn_mfma_f32_32x32x16_bf16(ka[1], qr[1], p0, 0, 0, 0); p1 = __builtin_amdgcn_mfma_f32_32x32x16_bf16(kb[1], qr[1], p1, 0, 0, 0); ATT_VRD(2); ATT_VRD(3); ATT_SBAR(); \
        ATT_KRD(1, 4); p0 = __builtin_amdgcn_mfma_f32_32x32x16_bf16(ka[2], qr[2], p0, 0, 0, 0); p1 = __builtin_amdgcn_mfma_f32_32x32x16_bf16(kb[2], qr[2], p1, 0, 0, 0); ATT_VRD(4); ATT_VRD(5); ATT_SBAR(); \
        ATT_KRD(2, 5); p0 = __builtin_amdgcn_mfma_f32_32x32x16_bf16(ka[0], qr[3], p0, 0, 0, 0); p1 = __builtin_amdgcn_mfma_f32_32x32x16_bf16(kb[0], qr[3], p1, 0, 0, 0); ATT_VRD(6); ATT_VRD(7); ATT_SBAR(); \
        p0 = __builtin_amdgcn_mfma_f32_32x32x16_bf16(ka[1], qr[4], p0, 0, 0, 0); p1 = __builtin_amdgcn_mfma_f32_32x32x16_bf16(kb[1], qr[4], p1, 0, 0, 0); ATT_SBAR(); \
        p0 = __builtin_amdgcn_mfma_f32_32x32x16_bf16(ka[2], qr[5], p0, 0, 0, 0); p1 = __builtin_amdgcn_mfma_f32_32x32x16_bf16(kb[2], qr[5], p1, 0, 0, 0); ATT_SBAR(); \
    } while (0)
#define ATT_SM(t) do { \
        if constexpr (!NOMAX) { const float rm = rowmax(p0, p1); \
        if ((t) == 0) { mhat = rm; \
            _Pragma("unroll") for (int r = 0; r < 16; ++r) { p0[r] -= rm; p1[r] -= rm; } \
            _Pragma("unroll") for (int r = 0; r < 16; ++r) negm[r] = -mhat; \
            asm volatile("" : "+v"(negm)); \
        } else if (__any(rm > (float)THRL)) { const float dl = __builtin_fmaxf(rm, 0.f); mhat += dl; \
            _Pragma("unroll") for (int r = 0; r < 16; ++r) { p0[r] -= dl; p1[r] -= dl; } \
            _Pragma("unroll") for (int r = 0; r < 16; ++r) negm[r] = -mhat; \
            asm volatile("" : "+v"(negm)); \
            const float f = __builtin_amdgcn_exp2f(-dl); l_reg *= f; if (hi == 0) wsf[r32] = f; \
            asm volatile("s_waitcnt lgkmcnt(0)" ::: "memory"); \
            _Pragma("unroll") for (int d_ = 0; d_ < 2; ++d_) _Pragma("unroll") for (int r = 0; r < 16; ++r) o[d_][r] *= wsf[crow(r, hi)]; } } \
        float sa0, sa1, sa2, sa3;        \
        p0[0] = __builtin_amdgcn_exp2f(p0[0]); p1[0] = __builtin_amdgcn_exp2f(p1[0]); p0[1] = __builtin_amdgcn_exp2f(p0[1]); p1[1] = __builtin_amdgcn_exp2f(p1[1]); \
        _Pragma("unroll") for (int r = 2; r < 16; r += 2) { p0[r] = __builtin_amdgcn_exp2f(p0[r]); p1[r] = __builtin_amdgcn_exp2f(p1[r]); p0[r + 1] = __builtin_amdgcn_exp2f(p0[r + 1]); p1[r + 1] = __builtin_amdgcn_exp2f(p1[r + 1]); \
            if (r == 2) { asm("v_add_f32 %0, %1, %2" : "=v"(sa0) : "v"(p0[0]), "v"(p0[2])); asm("v_add_f32 %0, %1, %2" : "=v"(sa1) : "v"(p1[0]), "v"(p1[2])); asm("v_add_f32 %0, %1, %2" : "=v"(sa2) : "v"(p0[1]), "v"(p0[3])); asm("v_add_f32 %0, %1, %2" : "=v"(sa3) : "v"(p1[1]), "v"(p1[3])); } \
            else { asm("v_add_f32 %0, %0, %1" : "+v"(sa0) : "v"(p0[r])); asm("v_add_f32 %0, %0, %1" : "+v"(sa1) : "v"(p1[r])); asm("v_add_f32 %0, %0, %1" : "+v"(sa2) : "v"(p0[r + 1])); asm("v_add_f32 %0, %0, %1" : "+v"(sa3) : "v"(p1[r + 1])); } } \
        l_reg += (sa0 + sa1) + (sa2 + sa3); \
        pw0 = (u32x4){cvtpk_s(p0[0], p0[1]), cvtpk_s(p0[2], p0[3]), cvtpk_s(p0[4], p0[5]), cvtpk_s(p0[6], p0[7])}; \
        pw1 = (u32x4){cvtpk_s(p0[8], p0[9]), cvtpk_s(p0[10], p0[11]), cvtpk_s(p0[12], p0[13]), cvtpk_s(p0[14], p0[15])}; \
        pw2 = (u32x4){cvtpk_s(p1[0], p1[1]), cvtpk_s(p1[2], p1[3]), cvtpk_s(p1[4], p1[5]), cvtpk_s(p1[6], p1[7])}; \
        pw3 = (u32x4){cvtpk_s(p1[8], p1[9]), cvtpk_s(p1[10], p1[11]), cvtpk_s(p1[12], p1[13]), cvtpk_s(p1[14], p1[15])}; \
    } while (0)
#define ATT_VFR(i) (bf16x8){vlo[i][0], vlo[i][1], vlo[i][2], vlo[i][3], vhi[i][0], vhi[i][1], vhi[i][2], vhi[i][3]}
#define ATT_PV(s) do { ATT_SBAR(); \
        o[0] = __builtin_amdgcn_mfma_f32_32x32x16_bf16(__builtin_bit_cast(bf16x8, pw0), ATT_VFR(0), o[0], 0, 0, 0); o[1] = __builtin_amdgcn_mfma_f32_32x32x16_bf16(__builtin_bit_cast(bf16x8, pw0), ATT_VFR(4), o[1], 0, 0, 0); \
        o[0] = __builtin_amdgcn_mfma_f32_32x32x16_bf16(__builtin_bit_cast(bf16x8, pw1), ATT_VFR(1), o[0], 0, 0, 0); o[1] = __builtin_amdgcn_mfma_f32_32x32x16_bf16(__builtin_bit_cast(bf16x8, pw1), ATT_VFR(5), o[1], 0, 0, 0); \
        o[0] = __builtin_amdgcn_mfma_f32_32x32x16_bf16(__builtin_bit_cast(bf16x8, pw2), ATT_VFR(2), o[0], 0, 0, 0); o[1] = __builtin_amdgcn_mfma_f32_32x32x16_bf16(__builtin_bit_cast(bf16x8, pw2), ATT_VFR(6), o[1], 0, 0, 0); \
        o[0] = __builtin_amdgcn_mfma_f32_32x32x16_bf16(__builtin_bit_cast(bf16x8, pw3), ATT_VFR(3), o[0], 0, 0, 0); o[1] = __builtin_amdgcn_mfma_f32_32x32x16_bf16(__builtin_bit_cast(bf16x8, pw3), ATT_VFR(7), o[1], 0, 0, 0); \
    } while (0)
#define ATT_MM(acc, a, b) acc = __builtin_amdgcn_mfma_f32_32x32x16_bf16(a, b, acc, 0, 0, 0)
#define ATT_PWV(k) __builtin_bit_cast(bf16x8, pw##k)
#define ATT_PVQK(s) do { \
        const lds_cptr kp = shm3 + LDS_K + (s) * KSLOT + hi * 1024 + r32 * 16; const lds_cptr vp = shm3 + LDS_V + (s) * VSLOT + vlane; \
        bf16x8 ka[3], kb[3]; \
        ATT_KRD(0, 0); ATT_KRD(1, 1); ATT_SBAR(); \
        ATT_KRD(2, 2); p0 = __builtin_amdgcn_mfma_f32_32x32x16_bf16(ka[0], qr[0], negm, 0, 0, 0); p1 = __builtin_amdgcn_mfma_f32_32x32x16_bf16(kb[0], qr[0], negm, 0, 0, 0); \
        ATT_MM(o[0], ATT_PWV(0), ATT_VFR(0)); ATT_SBAR(); \
        ATT_KRD(0, 3); ATT_MM(p0, ka[1], qr[1]); ATT_MM(p1, kb[1], qr[1]); \
        ATT_MM(o[1], ATT_PWV(0), ATT_VFR(4)); ATT_SBAR(); ATT_VRD(0); ATT_VRD(4); ATT_SBAR(); \
        ATT_KRD(1, 4); ATT_MM(p0, ka[2], qr[2]); ATT_MM(p1, kb[2], qr[2]); \
        ATT_MM(o[0], ATT_PWV(1), ATT_VFR(1)); ATT_MM(o[1], ATT_PWV(1), ATT_VFR(5)); ATT_SBAR(); ATT_VRD(1); ATT_VRD(5); ATT_SBAR(); \
        ATT_KRD(2, 5); ATT_MM(p0, ka[0], qr[3]); ATT_MM(p1, kb[0], qr[3]); \
        ATT_MM(o[0], ATT_PWV(2), ATT_VFR(2)); ATT_MM(o[1], ATT_PWV(2), ATT_VFR(6)); ATT_SBAR(); ATT_VRD(2); ATT_VRD(6); ATT_SBAR(); \
        ATT_MM(p0, ka[1], qr[4]); ATT_MM(p1, kb[1], qr[4]); ATT_MM(o[0], ATT_PWV(3), ATT_VFR(3)); ATT_SBAR(); \
        ATT_MM(p0, ka[2], qr[5]); ATT_MM(p1, kb[2], qr[5]); ATT_MM(o[1], ATT_PWV(3), ATT_VFR(7)); ATT_SBAR(); ATT_VRD(3); ATT_VRD(7); ATT_SBAR(); \
    } while (0)
    int s_cur = 0, s_prev = 2;
    if (wid < 4) __builtin_amdgcn_s_setprio(1);
    if (wid < 4) {
        for (int t = 0; t < NTL; ++t) {
            ATT_WAIT_BAR0();
            const int s_next = (s_cur == 2) ? 0 : s_cur + 1;
            if (t >= 1 && t + 1 < NTL) ATT_DMA(t + 1, s_next);
            if (t >= 1 && t - 1 <= tmax) ATT_SM(t - 1);
            if (t <= tmax + 1) ATT_PVQK(s_cur);
            asm volatile("" : "+v"(o[0]), "+v"(o[1]), "+v"(p0), "+v"(p1));
            s_prev = s_cur; s_cur = s_next;
        }
        if (NTL - 1 <= tmax) { ATT_SM(NTL - 1); ATT_PV(s_prev); }
    } else {
        for (int t = 0; t < NTL; ++t) {
            ATT_WAIT_BAR0();
            const int s_next = (s_cur == 2) ? 0 : s_cur + 1;
            if (t >= 1 && t + 1 < NTL) ATT_DMA(t + 1, s_next);
            if (t <= tmax + 1) ATT_PVQK(s_cur);
            if (t <= tmax) ATT_SM(t);
            asm volatile("" : "+v"(o[0]), "+v"(o[1]));
            s_prev = s_cur; s_cur = s_next;
        }
        if (NTL - 1 <= tmax) ATT_PV(s_prev);
    }
    __builtin_amdgcn_s_setprio(0);
    { auto rr = __builtin_amdgcn_permlane32_swap(__float_as_uint(l_reg), __float_as_uint(l_reg), false, false); l_reg = __uint_as_float(rr[0]) + __uint_as_float(rr[1]); }
    if (hi == 0) wsf[32 + r32] = l_reg;
    asm volatile("s_waitcnt lgkmcnt(0)" ::: "memory");
    float rli[16];
#pragma unroll
    for (int r = 0; r < 16; ++r) rli[r] = __builtin_amdgcn_rcpf(wsf[32 + crow(r, hi)]);
    const long orow0 = rowbase + q0 + wid * 32; const int ocol0 = 512 + h * MV;
    { bf16* stg = (bf16*)(shm + LDS_OST) + wid * 2048;
#pragma unroll
        for (int r = 0; r < 16; ++r) { const int orow = crow(r, hi);
#pragma unroll
            for (int d0 = 0; d0 < 2; ++d0) stg[orow * 64 + d0 * 32 + r32] = (bf16)f2bf(o[d0][r] * rli[r]); }
        asm volatile("s_waitcnt lgkmcnt(0)" ::: "memory");
#pragma unroll
        for (int i = 0; i < 4; ++i) { const int row = i * 8 + (lane >> 3), ch = lane & 7; const u32x4 v = *(const u32x4*)(stg + row * 64 + ch * 8); const long r = orow0 + row; const int c = ocol0 + ch * 8;
            *(u32x4*)(O + ((r >> 4) * 32 + (c >> 5)) * 512 + (r & 15) * 32 + (c & 31)) = v; } }
    asm volatile("s_waitcnt lgkmcnt(0)\n\ts_barrier" ::: "memory");
#undef ATT_DMA
#undef ATT_QK
#undef ATT_SM
#undef ATT_KRD
#undef ATT_VRD
#undef ATT_VFR
#undef ATT_PV
#undef ATT_PVQK
#undef ATT_MM
#undef ATT_PWV
}

__device__ __forceinline__ void attn_unit16(int b, int h, int qb, const bf16* Q, const bf16* K, const bf16* V, bf16* O, char* shm) {
    const int tid = threadIdx.x, lane = tid & 63, li = lane & 15, g = lane >> 4; const int wid = __builtin_amdgcn_readfirstlane(tid >> 6);
    const long rowbase = (long)b * SEQ; const int q0 = qb * 256; const int NTL = 4 * qb + 4, tmax = 4 * qb + (wid >> 1);
    const bf16* Qw = Q + (rowbase + q0 + wid * 32) * QP + h * DQK;
    const long bh = (long)b * MH + h;
    const bf16* ksrc0 = K + (bh * 128 * 12 + wid) * 512 + lane * 8;
    const bf16* ksrc1 = K + (bh * 128 * 12 + 8 + (wid & 3)) * 512 + lane * 8;
    const bf16* vsrc = V + (bh * 128 * 2 + (wid >> 2)) * 2048 + (16 * (wid & 3) + (lane >> 2)) * 32 + (lane & 3) * 8;
    const unsigned lds0 = (unsigned)(uintptr_t)shm;
    const unsigned kdst0 = lds0 + LDS_K + wid * 1024, kdst1 = lds0 + LDS_K + (8 + (wid & 3)) * 1024, vdst = lds0 + LDS_V + wid * 1024;
#define ATT_DMA(t, s) do { glds16(ksrc0 + (long)(t) * 6144, (unsigned)__builtin_amdgcn_readfirstlane(kdst0 + (s) * KSLOT)); \
        if (wid < 4) glds16(ksrc1 + (long)(t) * 6144, (unsigned)__builtin_amdgcn_readfirstlane(kdst1 + (s) * KSLOT)); \
        glds16(vsrc + (long)(t) * 4096, (unsigned)__builtin_amdgcn_readfirstlane(vdst + (s) * VSLOT)); } while (0)
    ATT_DMA(0, 0); ATT_DMA(1, 1);
    bf16x8 qf[2][3];
#pragma unroll
    for (int qt = 0; qt < 2; ++qt)
#pragma unroll
        for (int ks = 0; ks < 3; ++ks) qf[qt][ks] = *reinterpret_cast<const bf16x8*>(&Qw[(long)(16 * qt + li) * QP + 32 * ks + 8 * g]);
    asm volatile("" :: "v"(qf[0][0]), "v"(qf[0][1]), "v"(qf[0][2]), "v"(qf[1][0]), "v"(qf[1][1]), "v"(qf[1][2]));
    const f32x4 zf = {0.f, 0.f, 0.f, 0.f};
    f32x4 s[2][4], o[2][4]; u32x4 pw[2][2]; s16x4 vlo[2][4], vhi[2][4];
#pragma unroll
    for (int i = 0; i < 2; ++i)
#pragma unroll
        for (int j = 0; j < 4; ++j) { s[i][j] = zf; o[i][j] = zf; vlo[i][j] = (s16x4){0, 0, 0, 0}; vhi[i][j] = vlo[i][j]; }
    pw[0][0] = (u32x4){0u, 0u, 0u, 0u}; pw[0][1] = pw[0][0]; pw[1][0] = pw[0][0]; pw[1][1] = pw[0][0];
    float la0 = 0.f, la1 = 0.f, la2 = 0.f, la3 = 0.f;
    const lds_cptr shm3 = (lds_cptr)shm;
    const int koff = li * 16 + g * 1024, voff = (4 * g + (li >> 2)) * 64 + (li & 3) * 8;
#define A16_VF(b_, d_) (bf16x8){vlo[b_][d_][0], vlo[b_][d_][1], vlo[b_][d_][2], vlo[b_][d_][3], vhi[b_][d_][0], vhi[b_][d_][1], vhi[b_][d_][2], vhi[b_][d_][3]}
#define A16_P(q_, b_) __builtin_bit_cast(bf16x8, pw[q_][b_])
#define A16_VRD(b_, d_) do { vlo[b_][d_] = vtr(vp + ((2 * (b_)) * 1024 + ((d_) >> 1) * 4096 + ((d_) & 1) * 32)); vhi[b_][d_] = vtr(vp + ((2 * (b_) + 1) * 1024 + ((d_) >> 1) * 4096 + ((d_) & 1) * 32)); } while (0)
#define A16_PVQK(sl) do { \
        const lds_cptr kp = shm3 + LDS_K + (sl) * KSLOT + koff; const lds_cptr vp = shm3 + LDS_V + (sl) * VSLOT + voff; \
        bf16x8 kf[5]; \
        kf[0] = *(const __attribute__((address_space(3))) bf16x8*)(kp + 0); kf[1] = *(const __attribute__((address_space(3))) bf16x8*)(kp + 256); kf[2] = *(const __attribute__((address_space(3))) bf16x8*)(kp + 512); kf[3] = *(const __attribute__((address_space(3))) bf16x8*)(kp + 768); ATT_SBAR(); \
        kf[4] = *(const __attribute__((address_space(3))) bf16x8*)(kp + 4096); s[0][0] = __builtin_amdgcn_mfma_f32_16x16x32_bf16(kf[0], qf[0][0], zf, 0, 0, 0); s[1][0] = __builtin_amdgcn_mfma_f32_16x16x32_bf16(kf[0], qf[1][0], zf, 0, 0, 0); o[0][0] = __builtin_amdgcn_mfma_f32_16x16x32_bf16(A16_VF(0, 0), A16_P(0, 0), o[0][0], 0, 0, 0); o[1][0] = __builtin_amdgcn_mfma_f32_16x16x32_bf16(A16_VF(0, 0), A16_P(1, 0), o[1][0], 0, 0, 0); ATT_SBAR(); \
        kf[0] = *(const __attribute__((address_space(3))) bf16x8*)(kp + 4352); s[0][1] = __builtin_amdgcn_mfma_f32_16x16x32_bf16(kf[1], qf[0][0], zf, 0, 0, 0); s[1][1] = __builtin_amdgcn_mfma_f32_16x16x32_bf16(kf[1], qf[1][0], zf, 0, 0, 0); o[0][0] = __builtin_amdgcn_mfma_f32_16x16x32_bf16(A16_VF(1, 0), A16_P(0, 1), o[0][0], 0, 0, 0); o[1][0] = __builtin_amdgcn_mfma_f32_16x16x32_bf16(A16_VF(1, 0), A16_P(1, 1), o[1][0], 0, 0, 0); ATT_SBAR(); A16_VRD(0, 0); A16_VRD(1, 0); ATT_SBAR(); \
        kf[1] = *(const __attribute__((address_space(3))) bf16x8*)(kp + 4608); s[0][2] = __builtin_amdgcn_mfma_f32_16x16x32_bf16(kf[2], qf[0][0], zf, 0, 0, 0); s[1][2] = __builtin_amdgcn_mfma_f32_16x16x32_bf16(kf[2], qf[1][0], zf, 0, 0, 0); o[0][1] = __builtin_amdgcn_mfma_f32_16x16x32_bf16(A16_VF(0, 1), A16_P(0, 0), o[0][1], 0, 0, 0); o[1][1] = __builtin_amdgcn_mfma_f32_16x16x32_bf16(A16_VF(0, 1), A16_P(1, 0), o[1][1], 0, 0, 0); ATT_SBAR(); \
        kf[2] = *(const __attribute__((address_space(3))) bf16x8*)(kp + 4864); s[0][3] = __builtin_amdgcn_mfma_f32_16x16x32_bf16(kf[3], qf[0][0], zf, 0, 0, 0); s[1][3] = __builtin_amdgcn_mfma_f32_16x16x32_bf16(kf[3], qf[1][0], zf, 0, 0, 0); o[0][1] = __builtin_amdgcn_mfma_f32_16x16x32_bf16(A16_VF(1, 1), A16_P(0, 1), o[0][1], 0, 0, 0); o[1][1] = __builtin_amdgcn_mfma_f32_16x16x32_bf16(A16_VF(1, 1), A16_P(1, 1), o[1][1], 0, 0, 0); ATT_SBAR(); A16_VRD(0, 1); A16_VRD(1, 1); ATT_SBAR(); \
        kf[3] = *(const __attribute__((address_space(3))) bf16x8*)(kp + 8192); s[0][0] = __builtin_amdgcn_mfma_f32_16x16x32_bf16(kf[4], qf[0][1], s[0][0], 0, 0, 0); s[1][0] = __builtin_amdgcn_mfma_f32_16x16x32_bf16(kf[4], qf[1][1], s[1][0], 0, 0, 0); o[0][2] = __builtin_amdgcn_mfma_f32_16x16x32_bf16(A16_VF(0, 2), A16_P(0, 0), o[0][2], 0, 0, 0); o[1][2] = __builtin_amdgcn_mfma_f32_16x16x32_bf16(A16_VF(0, 2), A16_P(1, 0), o[1][2], 0, 0, 0); ATT_SBAR(); \
        kf[4] = *(const __attribute__((address_space(3))) bf16x8*)(kp + 8448); s[0][1] = __builtin_amdgcn_mfma_f32_16x16x32_bf16(kf[0], qf[0][1], s[0][1], 0, 0, 0); s[1][1] = __builtin_amdgcn_mfma_f32_16x16x32_bf16(kf[0], qf[1][1], s[1][1], 0, 0, 0); o[0][2] = __builtin_amdgcn_mfma_f32_16x16x32_bf16(A16_VF(1, 2), A16_P(0, 1), o[0][2], 0, 0, 0); o[1][2] = __builtin_amdgcn_mfma_f32_16x16x32_bf16(A16_VF(1, 2), A16_P(1, 1), o[1][2], 0, 0, 0); ATT_SBAR(); A16_VRD(0, 2); A16_VRD(1, 2); ATT_SBAR(); \
        kf[0] = *(const __attribute__((address_space(3))) bf16x8*)(kp + 8704); s[0][2] = __builtin_amdgcn_mfma_f32_16x16x32_bf16(kf[1], qf[0][1], s[0][2], 0, 0, 0); s[1][2] = __builtin_amdgcn_mfma_f32_16x16x32_bf16(kf[1], qf[1][1], s[1][2], 0, 0, 0); o[0][3] = __builtin_amdgcn_mfma_f32_16x16x32_bf16(A16_VF(0, 3), A16_P(0, 0), o[0][3], 0, 0, 0); o[1][3] = __builtin_amdgcn_mfma_f32_16x16x32_bf16(A16_VF(0, 3), A16_P(1, 0), o[1][3], 0, 0, 0); ATT_SBAR(); \
        kf[1] = *(const __attribute__((address_space(3))) bf16x8*)(kp + 8960); s[0][3] = __builtin_amdgcn_mfma_f32_16x16x32_bf16(kf[2], qf[0][1], s[0][3], 0, 0, 0); s[1][3] = __builtin_amdgcn_mfma_f32_16x16x32_bf16(kf[2], qf[1][1], s[1][3], 0, 0, 0); o[0][3] = __builtin_amdgcn_mfma_f32_16x16x32_bf16(A16_VF(1, 3), A16_P(0, 1), o[0][3], 0, 0, 0); o[1][3] = __builtin_amdgcn_mfma_f32_16x16x32_bf16(A16_VF(1, 3), A16_P(1, 1), o[1][3], 0, 0, 0); ATT_SBAR(); A16_VRD(0, 3); A16_VRD(1, 3); ATT_SBAR(); \
        s[0][0] = __builtin_amdgcn_mfma_f32_16x16x32_bf16(kf[3], qf[0][2], s[0][0], 0, 0, 0); s[1][0] = __builtin_amdgcn_mfma_f32_16x16x32_bf16(kf[3], qf[1][2], s[1][0], 0, 0, 0); ATT_SBAR(); \
        s[0][1] = __builtin_amdgcn_mfma_f32_16x16x32_bf16(kf[4], qf[0][2], s[0][1], 0, 0, 0); s[1][1] = __builtin_amdgcn_mfma_f32_16x16x32_bf16(kf[4], qf[1][2], s[1][1], 0, 0, 0); ATT_SBAR(); \
        s[0][2] = __builtin_amdgcn_mfma_f32_16x16x32_bf16(kf[0], qf[0][2], s[0][2], 0, 0, 0); s[1][2] = __builtin_amdgcn_mfma_f32_16x16x32_bf16(kf[0], qf[1][2], s[1][2], 0, 0, 0); ATT_SBAR(); \
        s[0][3] = __builtin_amdgcn_mfma_f32_16x16x32_bf16(kf[1], qf[0][2], s[0][3], 0, 0, 0); s[1][3] = __builtin_amdgcn_mfma_f32_16x16x32_bf16(kf[1], qf[1][2], s[1][3], 0, 0, 0); ATT_SBAR(); \
    } while (0)
#define A16_PV() do { ATT_SBAR(); o[0][0] = __builtin_amdgcn_mfma_f32_16x16x32_bf16(A16_VF(0, 0), A16_P(0, 0), o[0][0], 0, 0, 0); o[1][0] = __builtin_amdgcn_mfma_f32_16x16x32_bf16(A16_VF(0, 0), A16_P(1, 0), o[1][0], 0, 0, 0); o[0][0] = __builtin_amdgcn_mfma_f32_16x16x32_bf16(A16_VF(1, 0), A16_P(0, 1), o[0][0], 0, 0, 0); o[1][0] = __builtin_amdgcn_mfma_f32_16x16x32_bf16(A16_VF(1, 0), A16_P(1, 1), o[1][0], 0, 0, 0); o[0][1] = __builtin_amdgcn_mfma_f32_16x16x32_bf16(A16_VF(0, 1), A16_P(0, 0), o[0][1], 0, 0, 0); o[1][1] = __builtin_amdgcn_mfma_f32_16x16x32_bf16(A16_VF(0, 1), A16_P(1, 0), o[1][1], 0, 0, 0); o[0][1] = __builtin_amdgcn_mfma_f32_16x16x32_bf16(A16_VF(1, 1), A16_P(0, 1), o[0][1], 0, 0, 0); o[1][1] = __builtin_amdgcn_mfma_f32_16x16x32_bf16(A16_VF(1, 1), A16_P(1, 1), o[1][1], 0, 0, 0); o[0][2] = __builtin_amdgcn_mfma_f32_16x16x32_bf16(A16_VF(0, 2), A16_P(0, 0), o[0][2], 0, 0, 0); o[1][2] = __builtin_amdgcn_mfma_f32_16x16x32_bf16(A16_VF(0, 2), A16_P(1, 0), o[1][2], 0, 0, 0); o[0][2] = __builtin_amdgcn_mfma_f32_16x16x32_bf16(A16_VF(1, 2), A16_P(0, 1), o[0][2], 0, 0, 0); o[1][2] = __builtin_amdgcn_mfma_f32_16x16x32_bf16(A16_VF(1, 2), A16_P(1, 1), o[1][2], 0, 0, 0); o[0][3] = __builtin_amdgcn_mfma_f32_16x16x32_bf16(A16_VF(0, 3), A16_P(0, 0), o[0][3], 0, 0, 0); o[1][3] = __builtin_amdgcn_mfma_f32_16x16x32_bf16(A16_VF(0, 3), A16_P(1, 0), o[1][3], 0, 0, 0); o[0][3] = __builtin_amdgcn_mfma_f32_16x16x32_bf16(A16_VF(1, 3), A16_P(0, 1), o[0][3], 0, 0, 0); o[1][3] = __builtin_amdgcn_mfma_f32_16x16x32_bf16(A16_VF(1, 3), A16_P(1, 1), o[1][3], 0, 0, 0); } while (0)
#define A16_SM() do { \
        { const float e0 = __builtin_amdgcn_exp2f(s[0][0][0]), e1 = __builtin_amdgcn_exp2f(s[0][0][1]), e2 = __builtin_amdgcn_exp2f(s[0][0][2]), e3 = __builtin_amdgcn_exp2f(s[0][0][3]); asm("v_add_f32 %0, %0, %1" : "+v"(la0) : "v"(e0)); asm("v_add_f32 %0, %0, %1" : "+v"(la1) : "v"(e1)); asm("v_add_f32 %0, %0, %1" : "+v"(la0) : "v"(e2)); asm("v_add_f32 %0, %0, %1" : "+v"(la1) : "v"(e3)); pw[0][0].x = cvtpk_s(e0, e1); pw[0][0].y = cvtpk_s(e2, e3); } \
        { const float e0 = __builtin_amdgcn_exp2f(s[0][1][0]), e1 = __builtin_amdgcn_exp2f(s[0][1][1]), e2 = __builtin_amdgcn_exp2f(s[0][1][2]), e3 = __builtin_amdgcn_exp2f(s[0][1][3]); asm("v_add_f32 %0, %0, %1" : "+v"(la0) : "v"(e0)); asm("v_add_f32 %0, %0, %1" : "+v"(la1) : "v"(e1)); asm("v_add_f32 %0, %0, %1" : "+v"(la0) : "v"(e2)); asm("v_add_f32 %0, %0, %1" : "+v"(la1) : "v"(e3)); pw[0][0].z = cvtpk_s(e0, e1); pw[0][0].w = cvtpk_s(e2, e3); } \
        { const float e0 = __builtin_amdgcn_exp2f(s[0][2][0]), e1 = __builtin_amdgcn_exp2f(s[0][2][1]), e2 = __builtin_amdgcn_exp2f(s[0][2][2]), e3 = __builtin_amdgcn_exp2f(s[0][2][3]); asm("v_add_f32 %0, %0, %1" : "+v"(la0) : "v"(e0)); asm("v_add_f32 %0, %0, %1" : "+v"(la1) : "v"(e1)); asm("v_add_f32 %0, %0, %1" : "+v"(la0) : "v"(e2)); asm("v_add_f32 %0, %0, %1" : "+v"(la1) : "v"(e3)); pw[0][1].x = cvtpk_s(e0, e1); pw[0][1].y = cvtpk_s(e2, e3); } \
        { const float e0 = __builtin_amdgcn_exp2f(s[0][3][0]), e1 = __builtin_amdgcn_exp2f(s[0][3][1]), e2 = __builtin_amdgcn_exp2f(s[0][3][2]), e3 = __builtin_amdgcn_exp2f(s[0][3][3]); asm("v_add_f32 %0, %0, %1" : "+v"(la0) : "v"(e0)); asm("v_add_f32 %0, %0, %1" : "+v"(la1) : "v"(e1)); asm("v_add_f32 %0, %0, %1" : "+v"(la0) : "v"(e2)); asm("v_add_f32 %0, %0, %1" : "+v"(la1) : "v"(e3)); pw[0][1].z = cvtpk_s(e0, e1); pw[0][1].w = cvtpk_s(e2, e3); } \
        { const float e0 = __builtin_amdgcn_exp2f(s[1][0][0]), e1 = __builtin_amdgcn_exp2f(s[1][0][1]), e2 = __builtin_amdgcn_exp2f(s[1][0][2]), e3 = __builtin_amdgcn_exp2f(s[1][0][3]); asm("v_add_f32 %0, %0, %1" : "+v"(la2) : "v"(e0)); asm("v_add_f32 %0, %0, %1" : "+v"(la3) : "v"(e1)); asm("v_add_f32 %0, %0, %1" : "+v"(la2) : "v"(e2)); asm("v_add_f32 %0, %0, %1" : "+v"(la3) : "v"(e3)); pw[1][0].x = cvtpk_s(e0, e1); pw[1][0].y = cvtpk_s(e2, e3); } \
        { const float e0 = __builtin_amdgcn_exp2f(s[1][1][0]), e1 = __builtin_amdgcn_exp2f(s[1][1][1]), e2 = __builtin_amdgcn_exp2f(s[1][1][2]), e3 = __builtin_amdgcn_exp2f(s[1][1][3]); asm("v_add_f32 %0, %0, %1" : "+v"(la2) : "v"(e0)); asm("v_add_f32 %0, %0, %1" : "+v"(la3) : "v"(e1)); asm("v_add_f32 %0, %0, %1" : "+v"(la2) : "v"(e2)); asm("v_add_f32 %0, %0, %1" : "+v"(la3) : "v"(e3)); pw[1][0].z = cvtpk_s(e0, e1); pw[1][0].w = cvtpk_s(e2, e3); } \
        { const float e0 = __builtin_amdgcn_exp2f(s[1][2][0]), e1 = __builtin_amdgcn_exp2f(s[1][2][1]), e2 = __builtin_amdgcn_exp2f(s[1][2][2]), e3 = __builtin_amdgcn_exp2f(s[1][2][3]); asm("v_add_f32 %0, %0, %1" : "+v"(la2) : "v"(e0)); asm("v_add_f32 %0, %0, %1" : "+v"(la3) : "v"(e1)); asm("v_add_f32 %0, %0, %1" : "+v"(la2) : "v"(e2)); asm("v_add_f32 %0, %0, %1" : "+v"(la3) : "v"(e3)); pw[1][1].x = cvtpk_s(e0, e1); pw[1][1].y = cvtpk_s(e2, e3); } \
        { const float e0 = __builtin_amdgcn_exp2f(s[1][3][0]), e1 = __builtin_amdgcn_exp2f(s[1][3][1]), e2 = __builtin_amdgcn_exp2f(s[1][3][2]), e3 = __builtin_amdgcn_exp2f(s[1][3][3]); asm("v_add_f32 %0, %0, %1" : "+v"(la2) : "v"(e0)); asm("v_add_f32 %0, %0, %1" : "+v"(la3) : "v"(e1)); asm("v_add_f32 %0, %0, %1" : "+v"(la2) : "v"(e2)); asm("v_add_f32 %0, %0, %1" : "+v"(la3) : "v"(e3)); pw[1][1].z = cvtpk_s(e0, e1); pw[1][1].w = cvtpk_s(e2, e3); } \
    } while (0)
    int s_cur = 0, s_prev = 2; (void)s_prev;
    if (wid < 4) __builtin_amdgcn_s_setprio(1);
    if (wid < 4) {
        for (int t = 0; t < NTL; ++t) {
            ATT_WAIT_BAR0();
            const int s_next = (s_cur == 2) ? 0 : s_cur + 1;
            if (t >= 1 && t + 1 < NTL) ATT_DMA(t + 1, s_next);
            if (t >= 1 && t - 1 <= tmax) A16_SM();
            if (t <= tmax + 1) A16_PVQK(s_cur);
            s_prev = s_cur; s_cur = s_next;
        }
        if (NTL - 1 <= tmax) { A16_SM(); A16_PV(); }
    } else {
        for (int t = 0; t < NTL; ++t) {
            ATT_WAIT_BAR0();
            const int s_next = (s_cur == 2) ? 0 : s_cur + 1;
            if (t >= 1 && t + 1 < NTL) ATT_DMA(t + 1, s_next);
            if (t <= tmax + 1) A16_PVQK(s_cur);
            if (t <= tmax) A16_SM();
            s_prev = s_cur; s_cur = s_next;
        }
        if (NTL - 1 <= tmax) A16_PV();
    }
    __builtin_amdgcn_s_setprio(0);
    float l0 = la0 + la1, l1 = la2 + la3;
    l0 += __shfl_xor(l0, 16); l0 += __shfl_xor(l0, 32); l1 += __shfl_xor(l1, 16); l1 += __shfl_xor(l1, 32);
    const float ri0 = __builtin_amdgcn_rcpf(l0), ri1 = __builtin_amdgcn_rcpf(l1);
    const long orow0 = rowbase + q0 + wid * 32; const int ocol0 = 512 + h * MV;
    { bf16* stg = (bf16*)(shm + LDS_OST) + wid * 2048;
#pragma unroll
        for (int qt = 0; qt < 2; ++qt)
#pragma unroll
            for (int dvt = 0; dvt < 4; ++dvt) { const float ri = qt ? ri1 : ri0; u32x2 w; w.x = cvtpk_s(o[qt][dvt][0] * ri, o[qt][dvt][1] * ri); w.y = cvtpk_s(o[qt][dvt][2] * ri, o[qt][dvt][3] * ri);
                *(u32x2*)(stg + (16 * qt + li) * 64 + 16 * dvt + 4 * g) = w; }
        asm volatile("s_waitcnt lgkmcnt(0)" ::: "memory");
#pragma unroll
        for (int i = 0; i < 4; ++i) { const int row = i * 8 + (lane >> 3), ch = lane & 7; const u32x4 v = *(const u32x4*)(stg + row * 64 + ch * 8); const long r = orow0 + row; const int c = ocol0 + ch * 8;
            *(u32x4*)(O + ((r >> 4) * 32 + (c >> 5)) * 512 + (r & 15) * 32 + (c & 31)) = v; } }
    asm volatile("s_waitcnt lgkmcnt(0)\n\ts_barrier" ::: "memory");
#undef ATT_DMA
#undef A16_VF
#undef A16_P
#undef A16_VRD
#undef A16_PVQK
#undef A16_PV
#undef A16_SM
}
__device__ __forceinline__ void attn_phase(const Ctx& C, char* lds) {
    const bf16* QF = (const bf16*)(C.ws + WS_QF); const bf16* KF = (const bf16*)(C.ws + WS_KF); const bf16* VF = (const bf16*)(C.ws + WS_VF); bf16* O = (bf16*)(C.ws + WS_B);
    const int G = (int)gridDim.x, bx = (int)blockIdx.x; const int vcu = (G % 8 == 0) ? (bx % 8) * (G / 8) + bx / 8 : bx;
    float gq = 0.f, gk = 0.f;
    for (int i = (int)(threadIdx.x & 63); i < DQK; i += 64) { gq = __builtin_fmaxf(gq, __builtin_fabsf(C.q_head_norm[i])); gk = __builtin_fmaxf(gk, __builtin_fabsf(C.k_head_norm[i])); }
#pragma unroll
    for (int o = 32; o >= 1; o >>= 1) { gq = __builtin_fmaxf(gq, __shfl_xor(gq, o)); gk = __builtin_fmaxf(gk, __shfl_xor(gk, o)); }
    const float sbound = 9.7980f * 1.4427f * 1.02f * gq * gk;
    const bool nomax = __builtin_amdgcn_readfirstlane((int)(sbound < 64.f)) != 0;
    for (int i = vcu; i < BATCH * MH * 32; i += G) { const int bh = (i & 255) >> 4, s = i & 15, qb = (i < 256) ? 31 - s : s;
        if (nomax) attn_unit16(bh >> 3, bh & 7, qb, QF, KF, VF, O, lds); else attn_unit<8, false>(bh >> 3, bh & 7, qb, QF, KF, VF, O, lds); }
    __syncthreads();
}
}

namespace gla {
using att::bf16x8; using att::s16x4; using att::f32x16; using att::lds_cptr; using att::crow; using att::cvtpk_s;
constexpr int L_VIMG = 0, L_QIMG = 16384, L_KIMG = 24576, L_WT = 32768, L_OBUF = 36864, OLD = 132, L_WG = 73728, L_BG = L_WG + 16384;
#define GLA_BAR() asm volatile("s_waitcnt lgkmcnt(0)\n\ts_barrier" ::: "memory")
__device__ __forceinline__ void stage_gate(const Ctx& C, unsigned char* lds) {
    const int tid = threadIdx.x;
#pragma unroll
    for (int i = 0; i < 2; ++i) *(f32x4*)(lds + L_WG + (tid + NT * i) * 16) = *(const f32x4*)(C.w_gate_up + (tid + NT * i) * 4);
    if (tid < 64) *(f32x4*)(lds + L_BG + tid * 16) = *(const f32x4*)(C.b_gate + tid * 4);
}
__device__ __forceinline__ void cum_rows(const u32x4 g0, const u32x4 g1, int h, const unsigned char* lds, float (&cum)[8], float (&tot)[8]) {
    const int tid = threadIdx.x, lane = tid & 63; const int wv = __builtin_amdgcn_readfirstlane(tid >> 6);
    float zg[16];
    { float a[8], b[8]; unpack8(g0, a); unpack8(g1, b);
#pragma unroll
      for (int j = 0; j < 8; ++j) { zg[j] = a[j]; zg[8 + j] = b[j]; } }
    float x[8];
    { const f32x4 b0 = *(const f32x4*)(lds + L_BG + (h * 64 + 8 * wv) * 4), b1 = *(const f32x4*)(lds + L_BG + (h * 64 + 8 * wv + 4) * 4);
      x[0] = b0.x; x[1] = b0.y; x[2] = b0.z; x[3] = b0.w; x[4] = b1.x; x[5] = b1.y; x[6] = b1.z; x[7] = b1.w; }
#pragma unroll
    for (int gh = 0; gh < 2; ++gh) { f32x4 w0[8], w1[8];
#pragma unroll
        for (int g = 0; g < 8; ++g) { w0[g] = *(const f32x4*)(lds + L_WG + ((gh * 8 + g) * 256 + h * 64 + 8 * wv) * 4); w1[g] = *(const f32x4*)(lds + L_WG + ((gh * 8 + g) * 256 + h * 64 + 8 * wv + 4) * 4); }
#pragma unroll
        for (int g = 0; g < 8; ++g) { const float z = zg[gh * 8 + g];
            x[0] += z * w0[g].x; x[1] += z * w0[g].y; x[2] += z * w0[g].z; x[3] += z * w0[g].w; x[4] += z * w1[g].x; x[5] += z * w1[g].y; x[6] += z * w1[g].z; x[7] += z * w1[g].w; } }
#pragma unroll
    for (int j = 0; j < 8; ++j) x[j] = log_gate(x[j]);
#define GLA_DPP(v, ctrl, rmask) __builtin_bit_cast(float, __builtin_amdgcn_update_dpp(0, __builtin_bit_cast(int, (v)), (ctrl), (rmask), 0xF, true))
#pragma unroll
    for (int j = 0; j < 8; ++j) { float v = x[j];
        v += GLA_DPP(v, 0x111, 0xF); v += GLA_DPP(v, 0x112, 0xF); v += GLA_DPP(v, 0x114, 0xF); v += GLA_DPP(v, 0x118, 0xF);
        v += GLA_DPP(v, 0x142, 0xA); v += GLA_DPP(v, 0x143, 0xC);
        cum[j] = v; tot[j] = __builtin_bit_cast(float, __builtin_amdgcn_readlane(__builtin_bit_cast(int, v), 63)); }
#undef GLA_DPP
}
__device__ __forceinline__ void trfrag4(int base, bf16x8 (&f)[4]) {
    s16x4 lo[4], hi[4];
#pragma unroll
    for (int ks = 0; ks < 4; ++ks) {
        asm volatile("ds_read_b64_tr_b16 %0,%1 offset:%c2" : "=&v"(lo[ks]) : "v"(base), "i"(ks * 1024) : "memory");
        asm volatile("ds_read_b64_tr_b16 %0,%1 offset:%c2" : "=&v"(hi[ks]) : "v"(base), "i"(ks * 1024 + 512) : "memory"); }
    asm volatile("s_waitcnt lgkmcnt(0)" ::: "memory"); __builtin_amdgcn_sched_barrier(0);
#pragma unroll
    for (int ks = 0; ks < 4; ++ks) f[ks] = (bf16x8){lo[ks][0], lo[ks][1], lo[ks][2], lo[ks][3], hi[ks][0], hi[ks][1], hi[ks][2], hi[ks][3]};
}
struct Raw { u32x4 q, k, v0, v1, g0, g1, z0, z1; bf16x8 pf[4]; };
template <bool P2>
__device__ __forceinline__ void load_raw(const Ctx& C, int u, Raw& R) {
    const bf16* Z = (const bf16*)(C.ws + WS_Z); const bf16* PREV = (const bf16*)C.out;
    const int tid = threadIdx.x, lane = tid & 63, r32 = lane & 31, hi = lane >> 5, c = tid >> 3, dc = tid & 7; const int wv = __builtin_amdgcn_readfirstlane(tid >> 6);
    const int n = u % NCH, h = (u / NCH) % GH, b = u / (NCH * GH); const int row0 = b * SEQ + n * 64;
    const size_t rl_ = (size_t)(row0 + lane);
    R.k = *(const u32x4*)(Z + ztile(rl_, ZC_K + h * 64 + 8 * wv));
    if (!P2) { R.g0 = *(const u32x4*)(Z + ztile(rl_, ZC_GATE)); R.g1 = *(const u32x4*)(Z + ztile(rl_, ZC_GATE + 8)); }
    else { R.g0 = (u32x4){0u, 0u, 0u, 0u}; R.g1 = R.g0; }
    { const int j = tid >> 4, cc = tid & 15; R.v0 = *(const u32x4*)(Z + ztile((size_t)(row0 + j), ZC_V + h * 128 + cc * 8)); R.v1 = *(const u32x4*)(Z + ztile((size_t)(row0 + 32 + j), ZC_V + h * 128 + cc * 8)); }
    if (P2) { R.q = *(const u32x4*)(Z + ztile(rl_, ZC_Q + h * 64 + 8 * wv)); const size_t rc_ = (size_t)(row0 + c); R.z0 = *(const u32x4*)(Z + ztile(rc_, ZC_G + h * 128 + 16 * dc)); R.z1 = *(const u32x4*)(Z + ztile(rc_, ZC_G + h * 128 + 16 * dc + 8));
        const int cb = wv & 3;
#pragma unroll
        for (int s = 0; s < 4; ++s) R.pf[s] = *(const bf16x8*)(PREV + ((size_t)u * 128 + 32 * cb + r32) * 64 + 16 * s + 8 * hi); }
}
__device__ __forceinline__ void store_vimg(const Raw& R, unsigned char* lds) {
    const int tid = threadIdx.x, j = tid >> 4, cc = tid & 15;
    *(u32x4*)(lds + L_VIMG + (cc >> 2) * 4096 + j * 64 + (cc & 3) * 16) = R.v0; *(u32x4*)(lds + L_VIMG + (cc >> 2) * 4096 + (32 + j) * 64 + (cc & 3) * 16) = R.v1;
}
__device__ __forceinline__ void pass1(const Ctx& C, unsigned char* lds, int ustart, int ustep, int uend) {
    bf16* CKV = (bf16*)(C.ws + WS_CKV); float* DEC = (float*)(C.ws + WS_DEC);
    const int tid = threadIdx.x, lane = tid & 63, r32 = lane & 31, hi = lane >> 5, c = tid >> 3, dc = tid & 7; const int wv = __builtin_amdgcn_readfirstlane(tid >> 6);
    const unsigned lds0 = (unsigned)(uintptr_t)lds; const int lpart = ((lane >> 4) & 1) * 32 + (lane & 3) * 8 + (4 * hi + ((lane & 15) >> 2)) * 64;
    __syncthreads(); stage_gate(C, lds);
    Raw cur; if (ustart < uend) load_raw<false>(C, ustart, cur);
    for (int u = ustart; u < uend; u += ustep) {
        const int h = (u / NCH) % GH;
        Raw nxt = cur; if (u + ustep < uend) load_raw<false>(C, u + ustep, nxt);
        GLA_BAR();
        store_vimg(cur, lds);
        float kv[8]; unpack8(cur.k, kv);
        float cum[8], tot[8]; cum_rows(cur.g0, cur.g1, h, lds, cum, tot);
        { f32x4* cp = (f32x4*)(C.ws + WS_CUM) + ((size_t)u * 512 + wv * 64 + lane) * 2; cp[0] = (f32x4){cum[0], cum[1], cum[2], cum[3]}; cp[1] = (f32x4){cum[4], cum[5], cum[6], cum[7]}; }
#pragma unroll
        for (int j = 0; j < 8; ++j) kv[j] *= fexp(tot[j] - cum[j]);
        *(u32x4*)(lds + L_QIMG + (wv >> 2) * 4096 + lane * 64 + (wv & 3) * 16) = pack8(kv);
        if (lane == 63) {
#pragma unroll
            for (int j = 0; j < 8; ++j) DEC[(size_t)u * 64 + 8 * wv + j] = fexp(tot[j]); }
        GLA_BAR();
        const int vb = wv >> 1, db = wv & 1;
        bf16x8 af[4], bfr[4]; trfrag4((int)(lds0 + L_VIMG + vb * 4096) + lpart, af); trfrag4((int)(lds0 + L_QIMG + db * 4096) + lpart, bfr);
        f32x16 o = f32x16{};
#pragma unroll
        for (int ks = 0; ks < 4; ++ks) o = __builtin_amdgcn_mfma_f32_32x32x16_bf16(af[ks], bfr[ks], o, 0, 0, 0);
#pragma unroll
        for (int r = 0; r < 16; ++r) CKV[((size_t)u * 128 + 32 * vb + crow(r, hi)) * 64 + 32 * db + r32] = (bf16)f2bf(o[r]);
        cur = nxt;
    }
    __syncthreads();
}
__device__ __forceinline__ void pass2(const Ctx& C, unsigned char* lds) {
    bf16* MIX = (bf16*)(C.ws + WS_B);
    const int tid = threadIdx.x, lane = tid & 63, r32 = lane & 31, hi = lane >> 5, c = tid >> 3, dc = tid & 7; const int wv = __builtin_amdgcn_readfirstlane(tid >> 6);
    const unsigned lds0 = (unsigned)(uintptr_t)lds; const int lpart = ((lane >> 4) & 1) * 32 + (lane & 3) * 8 + (4 * hi + ((lane & 15) >> 2)) * 64;
    const lds_cptr L3 = (lds_cptr)lds; float* obuf = (float*)(lds + L_OBUF);
    const int rb = wv >> 2, cb = wv & 3;
    const int NU = BATCH * GH * NCH, G = (int)gridDim.x;
    f32x4 gn[4];
#pragma unroll
    for (int i = 0; i < 4; ++i) gn[i] = *(const f32x4*)(C.gla_out_norm + 16 * dc + 4 * i);
    __syncthreads();
    Raw cur; if ((int)blockIdx.x < NU) load_raw<true>(C, (int)blockIdx.x, cur);
    const f32x4* CUMP = (const f32x4*)(C.ws + WS_CUM) + (size_t)(wv * 64 + lane) * 2;
    f32x4 cc0 = (f32x4){0.f, 0.f, 0.f, 0.f}, cc1 = cc0; if ((int)blockIdx.x < NU) { cc0 = CUMP[(size_t)blockIdx.x * 1024]; cc1 = CUMP[(size_t)blockIdx.x * 1024 + 1]; }
    for (int u = blockIdx.x; u < NU; u += G) {
        const int n = u % NCH, h = (u / NCH) % GH, b = u / (NCH * GH); const int row0 = b * SEQ + n * 64;
        Raw nxt = cur; f32x4 nc0 = cc0, nc1 = cc1; if (u + G < NU) { load_raw<true>(C, u + G, nxt); nc0 = CUMP[(size_t)(u + G) * 1024]; nc1 = CUMP[(size_t)(u + G) * 1024 + 1]; }
        GLA_BAR();
        store_vimg(cur, lds);
        float qv[8], kv[8]; unpack8(cur.q, qv); unpack8(cur.k, kv);
        const float cum[8] = {cc0.x, cc0.y, cc0.z, cc0.w, cc1.x, cc1.y, cc1.z, cc1.w};
#pragma unroll
        for (int j = 0; j < 8; ++j) { qv[j] *= 0.125f * fexp(cum[j]); kv[j] *= fexp(-cum[j]); }
        *(u32x4*)(lds + L_QIMG + wv * 1024 + lane * 16) = pack8(qv); *(u32x4*)(lds + L_KIMG + wv * 1024 + lane * 16) = pack8(kv);
        GLA_BAR();
        bf16x8 qr[4];
#pragma unroll
        for (int s = 0; s < 4; ++s) qr[s] = *(const __attribute__((address_space(3))) bf16x8*)(L3 + L_QIMG + (2 * s + hi) * 1024 + (32 * rb + r32) * 16);
        f32x16 p0 = f32x16{}, p1 = f32x16{};
#pragma unroll
        for (int s = 0; s < 4; ++s) { const lds_cptr kp = L3 + L_KIMG + (2 * s + hi) * 1024 + r32 * 16;
            const bf16x8 a0 = *(const __attribute__((address_space(3))) bf16x8*)(kp), a1 = *(const __attribute__((address_space(3))) bf16x8*)(kp + 512);
            p0 = __builtin_amdgcn_mfma_f32_32x32x16_bf16(a0, qr[s], p0, 0, 0, 0); p1 = __builtin_amdgcn_mfma_f32_32x32x16_bf16(a1, qr[s], p1, 0, 0, 0); }
        const int cq = 32 * rb + r32;
#pragma unroll
        for (int r = 0; r < 16; ++r) { const int j = crow(r, hi); p0[r] = (j <= cq) ? p0[r] : 0.f; p1[r] = (j + 32 <= cq) ? p1[r] : 0.f; }
        u32x4 pw0, pw1, pw2, pw3;
        pw0 = (u32x4){cvtpk_s(p0[0], p0[1]), cvtpk_s(p0[2], p0[3]), cvtpk_s(p0[4], p0[5]), cvtpk_s(p0[6], p0[7])};
        pw1 = (u32x4){cvtpk_s(p0[8], p0[9]), cvtpk_s(p0[10], p0[11]), cvtpk_s(p0[12], p0[13]), cvtpk_s(p0[14], p0[15])};
        pw2 = (u32x4){cvtpk_s(p1[0], p1[1]), cvtpk_s(p1[2], p1[3]), cvtpk_s(p1[4], p1[5]), cvtpk_s(p1[6], p1[7])};
        pw3 = (u32x4){cvtpk_s(p1[8], p1[9]), cvtpk_s(p1[10], p1[11]), cvtpk_s(p1[12], p1[13]), cvtpk_s(p1[14], p1[15])};
        __builtin_amdgcn_sched_barrier(0);
        bf16x8 vf[4]; trfrag4((int)(lds0 + L_VIMG + cb * 4096) + lpart, vf);
        f32x16 o = f32x16{};
        o = __builtin_amdgcn_mfma_f32_32x32x16_bf16(__builtin_bit_cast(bf16x8, pw0), vf[0], o, 0, 0, 0);
        o = __builtin_amdgcn_mfma_f32_32x32x16_bf16(__builtin_bit_cast(bf16x8, pw1), vf[1], o, 0, 0, 0);
        o = __builtin_amdgcn_mfma_f32_32x32x16_bf16(__builtin_bit_cast(bf16x8, pw2), vf[2], o, 0, 0, 0);
        o = __builtin_amdgcn_mfma_f32_32x32x16_bf16(__builtin_bit_cast(bf16x8, pw3), vf[3], o, 0, 0, 0);
#pragma unroll
        for (int s = 0; s < 4; ++s) o = __builtin_amdgcn_mfma_f32_32x32x16_bf16(qr[s], cur.pf[s], o, 0, 0, 0);
#pragma unroll
        for (int r = 0; r < 16; ++r) obuf[(32 * rb + crow(r, hi)) * OLD + 32 * cb + r32] = o[r];
        GLA_BAR();
        { float ov[16];
#pragma unroll
            for (int i = 0; i < 4; ++i) { const f32x4 t = *(const f32x4*)(obuf + c * OLD + 16 * dc + 4 * i); ov[4 * i] = t.x; ov[4 * i + 1] = t.y; ov[4 * i + 2] = t.z; ov[4 * i + 3] = t.w; }
            float ss = 0.f;
#pragma unroll
            for (int i = 0; i < 16; ++i) ss += ov[i] * ov[i];
            ss += __shfl_xor(ss, 1); ss += __shfl_xor(ss, 2); ss += __shfl_xor(ss, 4);
            const float rn = rsqrtf(ss * (1.f / GDV) + EPS); const size_t row = (size_t)(row0 + c);
            float g0[8], g1[8]; unpack8(cur.z0, g0); unpack8(cur.z1, g1);
            const float gv[16] = {gn[0].x, gn[0].y, gn[0].z, gn[0].w, gn[1].x, gn[1].y, gn[1].z, gn[1].w, gn[2].x, gn[2].y, gn[2].z, gn[2].w, gn[3].x, gn[3].y, gn[3].z, gn[3].w};
            float w0[8], w1[8];
#pragma unroll
            for (int i = 0; i < 8; ++i) { w0[i] = ov[i] * rn * gv[i] * silu_f(g0[i]); w1[i] = ov[8 + i] * rn * gv[8 + i] * silu_f(g1[i]); }
            { const int c0 = h * 128 + 16 * dc; bf16* mp = MIX + ((row >> 4) * 32 + (c0 >> 5)) * 512 + (row & 15) * 32 + (c0 & 31);
              *(u32x4*)mp = pack8(w0); *(u32x4*)(mp + 8) = pack8(w1); } }
        cur = nxt; cc0 = nc0; cc1 = nc1;
    }
    __syncthreads();
}
#undef GLA_BAR
}

namespace pg8 {
#define PG8_LAS __attribute__((address_space(3)))
typedef unsigned short bf16_t;
typedef short bf16x8 __attribute__((ext_vector_type(8)));
typedef float f32x4 __attribute__((ext_vector_type(4)));
typedef unsigned u32x4 __attribute__((ext_vector_type(4)));
constexpr int BM = 256, BK = 64, HALF = 128, HTB = HALF * BK * 2  , STAGE_BYTES = 8 * HTB, NXCD = 8, WGM = 8;

__host__ __device__ __forceinline__ int lds_byte(int r, int c) { const int st = (r >> 4) * 2 + (c >> 5), rr = r & 15, cc = c & 31, ob = rr * 64 + cc * 2; return st * 1024 + (ob ^ (((ob >> 9) & 1) << 5)); }
__host__ __device__ __forceinline__ void stage_rc(int b, int& R, int& C) { const int st = b / 1024, sb = b % 1024, swz = sb ^ (((sb >> 9) & 1) << 5); R = (st >> 1) * 16 + swz / 64; C = (st & 1) * 32 + (swz % 64) / 2; }
__host__ __device__ __forceinline__ int perm32(int rho) { const int n = rho >> 4, i = rho & 15; return 8 * (i >> 2) + 4 * n + (i & 3); }

struct Unit { int pm, pn; };
struct Gemm { const bf16_t* A; const bf16_t* Bt; int M, N, K, lda; bool ta, tb; };

struct StaticOrder {
    int nM, nN, nwg, G, c;
    __host__ __device__ void init(int M, int N, int G_, int c_) { nM = M / BM; nN = N / BM; nwg = nM * nN; G = G_; c = c_; }
    __host__ __device__ bool next(int i, Unit& u) const {
        const long L = (long)i * G + c; if (L >= nwg) return false;
        int wgid = (int)L; { const int q = nwg / NXCD, r = nwg % NXCD, xcd = wgid % NXCD, off = wgid / NXCD; wgid = (xcd < r ? xcd * (q + 1) : r * (q + 1) + (xcd - r) * q) + off; }
        const int nig = WGM * nN, gid = wgid / nig, fm = gid * WGM, gsz = (nM - fm) < WGM ? (nM - fm) : WGM;
        u.pm = fm + ((wgid % nig) % gsz); u.pn = (wgid % nig) / gsz; return true;
    }
    __device__ __forceinline__ void a_ready(const Unit&) const {}
    __device__ __forceinline__ void done(const Unit&) const {}
};

__device__ __forceinline__ unsigned cvt_pk_bf16(float lo, float hi) { unsigned r; asm volatile("v_cvt_pk_bf16_f32 %0, %1, %2" : "=v"(r) : "v"(lo), "v"(hi)); return r; }
typedef float f32x2 __attribute__((ext_vector_type(2)));
__device__ __forceinline__ void st16_wt(void* p, u32x4 v) { asm volatile("global_store_dwordx4 %0, %1, off sc1\n\ts_nop 1" :: "v"(p), "v"(v) : "memory"); }
typedef unsigned u32x2v __attribute__((ext_vector_type(2)));
struct EpiBf16 {
    static constexpr bool PERM = true, AFTER_DRAIN = false; static constexpr int PROBE_BIT = 26;
    bf16_t* O; int ldc;
    __device__ __forceinline__ void operator()(const f32x4 (&acc)[2][2][4][2], const Unit& u, int wr, int wc, int fr, int fq) const {
        const int row0 = u.pm * BM + wr * 64 + fr, col0 = u.pn * BM + wc * 32 + 8 * fq;
#pragma unroll
        for (int ai = 0; ai < 2; ++ai)
#pragma unroll
            for (int m = 0; m < 4; ++m) { bf16_t* rowp = O + (size_t)(row0 + ai * HALF + m * 16) * ldc + col0;
#pragma unroll
                for (int bj = 0; bj < 2; ++bj) { const f32x4 v0 = acc[ai][bj][m][0], v1 = acc[ai][bj][m][1];
                    u32x4 w; w.x = cvt_pk_bf16(v0[0], v0[1]); w.y = cvt_pk_bf16(v0[2], v0[3]); w.z = cvt_pk_bf16(v1[0], v1[1]); w.w = cvt_pk_bf16(v1[2], v1[3]);
                    *(u32x4*)(rowp + bj * HALF) = w; } }
    }
};
struct EpiZ {
    static constexpr bool PERM = true, AFTER_DRAIN = false; static constexpr int PROBE_BIT = 27;
    bf16_t* O; int ldc; float* ssqq; float* ssqkv; float* ssqpe; const PG8_LAS float* rtz;
    __device__ __forceinline__ void operator()(const f32x4 (&acc)[2][2][4][2], const Unit& u, int wr, int wc, int fr, int fq) const { (*this)(acc, u, wr, wc, fr, fq, 0); }
    __device__ __forceinline__ void operator()(const f32x4 (&acc)[2][2][4][2], const Unit& u, int wr, int wc, int fr, int fq, int ui) const {
        const int row0 = u.pm * BM + wr * 64 + fr, col0 = u.pn * BM + wc * 32 + 8 * fq;
#pragma unroll
        for (int ai = 0; ai < 2; ++ai)
#pragma unroll
            for (int m = 0; m < 4; ++m) { const int r = row0 + ai * HALF + m * 16; bf16_t* rowp = O + ((size_t)(r >> 4) * (ldc >> 5) + (col0 >> 5)) * 512 + (r & 15) * 32 + (col0 & 31); float sq[2];
                const float rs = rtz[(ui & 3) * 256 + wr * 64 + fr + ai * HALF + m * 16];
#pragma unroll
                for (int bj = 0; bj < 2; ++bj) { const f32x4 v0 = acc[ai][bj][m][0] * rs, v1 = acc[ai][bj][m][1] * rs;
                    u32x4 w; w.x = cvt_pk_bf16(v0[0], v0[1]); w.y = cvt_pk_bf16(v0[2], v0[3]); w.z = cvt_pk_bf16(v1[0], v1[1]); w.w = cvt_pk_bf16(v1[2], v1[3]);
                    st16_wt(rowp + bj * 4 * 512, w);
                    sq[bj] = ((v0[0] * v0[0] + v0[1] * v0[1]) + (v0[2] * v0[2] + v0[3] * v0[3])) + ((v1[0] * v1[0] + v1[1] * v1[1]) + (v1[2] * v1[2] + v1[3] * v1[3])); }
                if (u.pn == 6) { float s = sq[0] + sq[1]; s += __shfl_xor(s, 16); s += __shfl_xor(s, 32); if (fq == 0) __hip_atomic_store(ssqq + (size_t)r * 4 + wc, s, __ATOMIC_RELAXED, __HIP_MEMORY_SCOPE_AGENT); }
                else if (u.pn == 7) { float s = sq[0]; s += __shfl_xor(s, 16); s += __shfl_xor(s, 32); if (fq == 0) __hip_atomic_store(ssqkv + (size_t)r * 4 + wc, s, __ATOMIC_RELAXED, __HIP_MEMORY_SCOPE_AGENT);
                    if (wc == 0) { float t = sq[1]; t += __shfl_xor(t, 16); t += __shfl_xor(t, 32); if (fq == 0) __hip_atomic_store(ssqpe + r, t, __ATOMIC_RELAXED, __HIP_MEMORY_SCOPE_AGENT); } } }
    }
};
struct EpiQ {
    static constexpr bool PERM = false, AFTER_DRAIN = true; static constexpr int PROBE_BIT = 25;
    const float* ssqq; const float* gq; const float* cosT; const float* sinT; bf16_t* QF; float eps, qscale;
    __device__ __forceinline__ void fused(f32x4 (&acc)[2][2][4][2], const Unit& u, int wr, int wc, int fr, int fq, PG8_LAS unsigned char* lds, int wid, int lane) const {
        PG8_LAS float* P = (PG8_LAS float*)lds;
        f32x4 s4A[2][4];
#pragma unroll
        for (int ai = 0; ai < 2; ++ai)
#pragma unroll
            for (int m = 0; m < 4; ++m) s4A[ai][m] = *(const f32x4*)(ssqq + (size_t)(u.pm * BM + ai * HALF + wr * 64 + m * 16 + fr) * 4);
        __builtin_amdgcn_sched_barrier(0);
#pragma unroll
        for (int ai = 0; ai < 2; ++ai)
#pragma unroll
            for (int m = 0; m < 4; ++m) { const int rl = ai * HALF + wr * 64 + m * 16 + fr; const f32x4 s4 = s4A[ai][m];
                const float ra = __builtin_amdgcn_rsqf(((s4[0] + s4[1]) + (s4[2] + s4[3])) * (1.0f / 256.0f) + eps);
#pragma unroll
                for (int bj = 0; bj < 2; ++bj) { float s = 0.f;
#pragma unroll
                    for (int n = 0; n < 2; ++n) { const f32x4 v = acc[ai][bj][m][n] * ra; acc[ai][bj][m][n] = v; s += (v[0] * v[0] + v[1] * v[1]) + (v[2] * v[2] + v[3] * v[3]); }
                    s += __shfl_xor(s, 16); s += __shfl_xor(s, 32);
                    if (fq == 0) P[(rl * 2 + bj) * 4 + wc] = s; } }
        asm volatile("s_waitcnt lgkmcnt(0)" ::: "memory"); __builtin_amdgcn_s_barrier(); asm volatile("" ::: "memory");
        PG8_LAS unsigned char* ST = lds + 8192;
        if (wc < 3) {
            const int j0 = wc * 32 + 4 * fq; const f32x4 g0 = *(const f32x4*)(gq + j0), g1 = *(const f32x4*)(gq + j0 + 16);
            f32x4 csA[2][4], snA[2][4];
#pragma unroll
            for (int ai = 0; ai < 2; ++ai)
#pragma unroll
                for (int m = 0; m < 4; ++m) { const size_t r = (size_t)(u.pm * BM + ai * HALF + wr * 64 + m * 16 + fr); csA[ai][m] = (f32x4){1.f, 1.f, 1.f, 1.f}; snA[ai][m] = (f32x4){0.f, 0.f, 0.f, 0.f};
                    if (wc == 2) { csA[ai][m] = *(const f32x4*)(cosT + r * 16 + 4 * fq); snA[ai][m] = *(const f32x4*)(sinT + r * 16 + 4 * fq); } }
            __builtin_amdgcn_sched_barrier(0);
#pragma unroll
            for (int ai = 0; ai < 2; ++ai)
#pragma unroll
                for (int m = 0; m < 4; ++m) { const int rl = ai * HALF + wr * 64 + m * 16 + fr; const f32x4 cs = csA[ai][m], sn = snA[ai][m];
#pragma unroll
                    for (int bj = 0; bj < 2; ++bj) { const f32x4 p = *(const PG8_LAS f32x4*)(P + (rl * 2 + bj) * 4);
                        const float rh = qscale * __builtin_amdgcn_rsqf(((p[0] + p[1]) + (p[2] + p[3])) * (1.0f / 96.0f) + eps);
                        const f32x4 a = acc[ai][bj][m][0] * rh * g0, b = acc[ai][bj][m][1] * rh * g1;
                        f32x4 o0 = a, o1 = b; if (wc == 2) { o0 = a * cs - b * sn; o1 = a * sn + b * cs; }
                        PG8_LAS unsigned char* dst = ST + rl * 400 + (bj * 96 + j0) * 2;
                        u32x2v w0, w1; w0.x = cvt_pk_bf16(o0[0], o0[1]); w0.y = cvt_pk_bf16(o0[2], o0[3]); w1.x = cvt_pk_bf16(o1[0], o1[1]); w1.y = cvt_pk_bf16(o1[2], o1[3]);
                        *(PG8_LAS u32x2v*)dst = w0; *(PG8_LAS u32x2v*)(dst + 32) = w1; }
                    }
        }
        asm volatile("s_waitcnt lgkmcnt(0)" ::: "memory"); __builtin_amdgcn_s_barrier(); asm volatile("" ::: "memory");
        { const int tid = wid * 64 + lane;
#pragma unroll
            for (int i = 0; i < 12; ++i) { const int idx = tid + 512 * i, row = idx / 24, ch = idx - row * 24;
                st16_wt(QF + (size_t)(u.pm * BM + row) * 768 + (2 * u.pn) * 96 + ch * 8, *(const PG8_LAS u32x4*)(ST + row * 400 + ch * 16)); } }
    }
};
struct EpiKV {
    static constexpr bool PERM = false, AFTER_DRAIN = true; static constexpr int PROBE_BIT = 24;
    const float* ssqkv; const float* ssqpe; const float* gk; const float* cosT; const float* sinT; const bf16_t* Z; bf16_t* KF; bf16_t* VF; float eps;
    __device__ __forceinline__ void fused(f32x4 (&acc)[2][2][4][2], const Unit& u, int wr, int wc, int fr, int fq, PG8_LAS unsigned char* lds, int wid, int lane) const {
        PG8_LAS float* P = (PG8_LAS float*)lds;
        f32x4 s4A[2][4];
#pragma unroll
        for (int ai = 0; ai < 2; ++ai)
#pragma unroll
            for (int m = 0; m < 4; ++m) s4A[ai][m] = *(const f32x4*)(ssqkv + (size_t)(u.pm * BM + ai * HALF + wr * 64 + m * 16 + fr) * 4);
        __builtin_amdgcn_sched_barrier(0);
#pragma unroll
        for (int ai = 0; ai < 2; ++ai)
#pragma unroll
            for (int m = 0; m < 4; ++m) { const int rl = ai * HALF + wr * 64 + m * 16 + fr; const f32x4 s4 = s4A[ai][m];
                const float ra = __builtin_amdgcn_rsqf(((s4[0] + s4[1]) + (s4[2] + s4[3])) * (1.0f / 128.0f) + eps);
#pragma unroll
                for (int bj = 0; bj < 2; ++bj) { float s = 0.f;
#pragma unroll
                    for (int n = 0; n < 2; ++n) { const f32x4 v = acc[ai][bj][m][n] * ra; acc[ai][bj][m][n] = v; s += (v[0] * v[0] + v[1] * v[1]) + (v[2] * v[2] + v[3] * v[3]); }
                    if (wc < 2) { s += __shfl_xor(s, 16); s += __shfl_xor(s, 32); if (fq == 0) P[(rl * 2 + bj) * 2 + wc] = s; } } }
        asm volatile("s_waitcnt lgkmcnt(0)" ::: "memory"); __builtin_amdgcn_s_barrier(); asm volatile("" ::: "memory");
        const int j0 = wc * 32 + 4 * fq;
        PG8_LAS unsigned char* ST = lds + 8192;
        if (wc < 2) {
            const f32x4 g0 = *(const f32x4*)(gk + j0), g1 = *(const f32x4*)(gk + j0 + 16);
            float pesA[2][4];
#pragma unroll
            for (int ai = 0; ai < 2; ++ai)
#pragma unroll
                for (int m = 0; m < 4; ++m) pesA[ai][m] = ssqpe[(size_t)(u.pm * BM + ai * HALF + wr * 64 + m * 16 + fr)];
            __builtin_amdgcn_sched_barrier(0);
#pragma unroll
            for (int ai = 0; ai < 2; ++ai)
#pragma unroll
                for (int m = 0; m < 4; ++m) { const int rl = ai * HALF + wr * 64 + m * 16 + fr; const float pes = pesA[ai][m];
#pragma unroll
                    for (int bj = 0; bj < 2; ++bj) { const float rk = __builtin_amdgcn_rsqf((P[(rl * 2 + bj) * 2] + P[(rl * 2 + bj) * 2 + 1] + pes) * (1.0f / 96.0f) + eps);
                        const f32x4 o0 = acc[ai][bj][m][0] * rk * g0, o1 = acc[ai][bj][m][1] * rk * g1; PG8_LAS unsigned char* dst = ST + rl * 400 + (bj * 96 + j0) * 2;
                        u32x2v w0, w1; w0.x = cvt_pk_bf16(o0[0], o0[1]); w0.y = cvt_pk_bf16(o0[2], o0[3]); w1.x = cvt_pk_bf16(o1[0], o1[1]); w1.y = cvt_pk_bf16(o1[2], o1[3]);
                        *(PG8_LAS u32x2v*)dst = w0; *(PG8_LAS u32x2v*)(dst + 32) = w1; }
                    asm volatile("" ::: "memory"); }
        } else {
#pragma unroll
            for (int ai = 0; ai < 2; ++ai)
#pragma unroll
                for (int m = 0; m < 4; ++m) { const int rl = ai * HALF + wr * 64 + m * 16 + fr; const size_t r = (size_t)(u.pm * BM + rl);
#pragma unroll
                    for (int bj = 0; bj < 2; ++bj) { const f32x4 o0 = acc[ai][bj][m][0], o1 = acc[ai][bj][m][1];
                        bf16_t* dst = VF + (((((size_t)(u.pm >> 5) * 8 + 2 * u.pn + bj) * 128 + (u.pm & 31) * 4 + (rl >> 6)) * 2 + (wc - 2)) * 64 + (rl & 63)) * 32 + 4 * fq;
                        u32x2v w0, w1; w0.x = cvt_pk_bf16(o0[0], o0[1]); w0.y = cvt_pk_bf16(o0[2], o0[3]); w1.x = cvt_pk_bf16(o1[0], o1[1]); w1.y = cvt_pk_bf16(o1[2], o1[3]);
                        *(u32x2v*)dst = w0; *(u32x2v*)(dst + 16) = w1; }
                    asm volatile("" ::: "memory"); }
            if (wc == 2) {
                const f32x4 g0 = *(const f32x4*)(gk + 64 + 4 * fq), g1 = *(const f32x4*)(gk + 80 + 4 * fq);
#pragma unroll
                for (int ai = 0; ai < 2; ++ai) {
                    float pesB[4]; u32x2v xaB[4], xbB[4]; f32x4 csB[4], snB[4];
#pragma unroll
                    for (int m = 0; m < 4; ++m) { const size_t r = (size_t)(u.pm * BM + ai * HALF + wr * 64 + m * 16 + fr); pesB[m] = ssqpe[r];
                        xaB[m] = *(const u32x2v*)(Z + ((r >> 4) * 64 + 60) * 512 + (r & 15) * 32 + 4 * fq); xbB[m] = *(const u32x2v*)(Z + ((r >> 4) * 64 + 60) * 512 + (r & 15) * 32 + 16 + 4 * fq);
                        csB[m] = *(const f32x4*)(cosT + r * 16 + 4 * fq); snB[m] = *(const f32x4*)(sinT + r * 16 + 4 * fq); }
                    __builtin_amdgcn_sched_barrier(0);
#pragma unroll
                    for (int m = 0; m < 4; ++m) { const int rl = ai * HALF + wr * 64 + m * 16 + fr; const float pes = pesB[m];
                        const u32x2v xa = xaB[m], xb = xbB[m];
                        const f32x4 x1 = (f32x4){__uint_as_float(xa.x << 16), __uint_as_float(xa.x & 0xffff0000u), __uint_as_float(xa.y << 16), __uint_as_float(xa.y & 0xffff0000u)};
                        const f32x4 x2 = (f32x4){__uint_as_float(xb.x << 16), __uint_as_float(xb.x & 0xffff0000u), __uint_as_float(xb.y << 16), __uint_as_float(xb.y & 0xffff0000u)};
                        const f32x4 cs = csB[m], sn = snB[m];
#pragma unroll
                        for (int bj = 0; bj < 2; ++bj) { const float rk = __builtin_amdgcn_rsqf((P[(rl * 2 + bj) * 2] + P[(rl * 2 + bj) * 2 + 1] + pes) * (1.0f / 96.0f) + eps);
                            const f32x4 a = x1 * rk * g0, b = x2 * rk * g1, o0 = a * cs - b * sn, o1 = a * sn + b * cs; PG8_LAS unsigned char* dst = ST + rl * 400 + (bj * 96 + 64 + 4 * fq) * 2;
                            u32x2v w0, w1; w0.x = cvt_pk_bf16(o0[0], o0[1]); w0.y = cvt_pk_bf16(o0[2], o0[3]); w1.x = cvt_pk_bf16(o1[0], o1[1]); w1.y = cvt_pk_bf16(o1[2], o1[3]);
                            *(PG8_LAS u32x2v*)dst = w0; *(PG8_LAS u32x2v*)(dst + 32) = w1; } }
                    asm volatile("" ::: "memory"); }
            }
        }
        asm volatile("s_waitcnt lgkmcnt(0)" ::: "memory"); __builtin_amdgcn_s_barrier(); asm volatile("" ::: "memory");
        { const int tid = wid * 64 + lane;
#pragma unroll
            for (int i = 0; i < 12; ++i) { const int idx = tid + 512 * i, ch = idx >> 8, row = idx & 255, hd = 2 * u.pn + (ch >= 12 ? 1 : 0), c = ch >= 12 ? ch - 12 : ch;
                st16_wt(KF + (((((size_t)(u.pm >> 5) * 8 + hd) * 128 + (u.pm & 31) * 4 + (row >> 6)) * 12 + c) * 64 + (row & 63)) * 8, *(const PG8_LAS u32x4*)(ST + row * 400 + ch * 16)); } }
    }
};
struct EpiOutProjG {
    static constexpr bool PERM = false, AFTER_DRAIN = false; static constexpr int PROBE_BIT = 28;
    const float* x; float* x1; bf16_t* x1b; float* ssq;
    __device__ __forceinline__ void operator()(const f32x4 (&acc)[2][2][4][2], const Unit& u, int wr, int wc, int fr, int fq) const {
        const int col0 = u.pn * BM + wc * 32 + 4 * fq;
        u32x2v xw[2][4][2][2];
#pragma unroll
        for (int ai = 0; ai < 2; ++ai)
#pragma unroll
            for (int m = 0; m < 4; ++m) { const int r = u.pm * BM + ai * HALF + wr * 64 + m * 16 + fr;
#pragma unroll
                for (int bj = 0; bj < 2; ++bj)
#pragma unroll
                    for (int n = 0; n < 2; ++n) xw[ai][m][bj][n] = *(const u32x2v*)(x1b + ((size_t)(r >> 4) * 32 + ((col0 >> 5) + 4 * bj)) * 512 + (r & 15) * 32 + (col0 & 31) + 16 * n); }
        __builtin_amdgcn_sched_barrier(0);
#pragma unroll
        for (int ai = 0; ai < 2; ++ai)
#pragma unroll
            for (int m = 0; m < 4; ++m) { const int r = u.pm * BM + ai * HALF + wr * 64 + m * 16 + fr; float s = 0.f;
#pragma unroll
                for (int bj = 0; bj < 2; ++bj)
#pragma unroll
                    for (int n = 0; n < 2; ++n) { const u32x2v xv = xw[ai][m][bj][n];
                        const f32x4 xf = {__uint_as_float(xv.x << 16), __uint_as_float(xv.x & 0xffff0000u), __uint_as_float(xv.y << 16), __uint_as_float(xv.y & 0xffff0000u)};
                        const f32x4 t = xf + acc[ai][bj][m][n];
                        u32x2v w; w.x = cvt_pk_bf16(t[0], t[1]); w.y = cvt_pk_bf16(t[2], t[3]);
                        *(u32x2v*)(x1b + ((size_t)(r >> 4) * 32 + ((col0 >> 5) + 4 * bj)) * 512 + (r & 15) * 32 + (col0 & 31) + 16 * n) = w;
                        s += (t[0] * t[0] + t[1] * t[1]) + (t[2] * t[2] + t[3] * t[3]); }
                s += __shfl_xor(s, 16); s += __shfl_xor(s, 32);
                if (fq == 0) ssq[(size_t)r * 16 + u.pn * 4 + wc] = s; }
    }
};
struct EpiUpG {
    static constexpr bool PERM = true, AFTER_DRAIN = false; static constexpr int PROBE_BIT = 29;
    const PG8_LAS float* rtab; bf16_t* H;
    __device__ __forceinline__ void operator()(const f32x4 (&acc)[2][2][4][2], const Unit& u, int wr, int wc, int fr, int fq) const { (*this)(acc, u, wr, wc, fr, fq, 0); }
    __device__ __forceinline__ void operator()(const f32x4 (&acc)[2][2][4][2], const Unit& u, int wr, int wc, int fr, int fq, int ui) const {
        const int row0 = u.pm * BM + wr * 64 + fr, col0 = u.pn * BM + wc * 32 + 8 * fq;
#pragma unroll
        for (int ai = 0; ai < 2; ++ai)
#pragma unroll
            for (int m = 0; m < 4; ++m) { const int r = row0 + ai * HALF + m * 16;
                const float rstd = rtab[(ui & 3) * 256 + wr * 64 + fr + ai * HALF + m * 16];
                bf16_t* rowp = H + ((size_t)(r >> 4) * 128 + (col0 >> 5)) * 512 + (r & 15) * 32 + (col0 & 31);
#pragma unroll
                for (int bj = 0; bj < 2; ++bj) { f32x4 v0 = acc[ai][bj][m][0] * rstd, v1 = acc[ai][bj][m][1] * rstd;
#pragma unroll
                    for (int e = 0; e < 4; ++e) { v0[e] = __builtin_fmaxf(v0[e], 0.f); v1[e] = __builtin_fmaxf(v1[e], 0.f); }
                    v0 = v0 * v0; v1 = v1 * v1;
                    u32x4 w; w.x = cvt_pk_bf16(v0[0], v0[1]); w.y = cvt_pk_bf16(v0[2], v0[3]); w.z = cvt_pk_bf16(v1[0], v1[1]); w.w = cvt_pk_bf16(v1[2], v1[3]);
                    st16_wt(rowp + bj * 4 * 512, w); } }
    }
};
struct EpiDownG {
    static constexpr bool PERM = false, AFTER_DRAIN = false; static constexpr int PROBE_BIT = 30;
    const bf16_t* x1b; float* out;
    __device__ __forceinline__ void operator()(const f32x4 (&acc)[2][2][4][2], const Unit& u, int wr, int wc, int fr, int fq) const {
        const int col0 = u.pn * BM + wc * 32 + 4 * fq;
        u32x2v xw[2][4][2][2];
#pragma unroll
        for (int ai = 0; ai < 2; ++ai)
#pragma unroll
            for (int m = 0; m < 4; ++m) { const size_t off = (size_t)(u.pm * BM + ai * HALF + wr * 64 + m * 16 + fr) * 1024 + col0;
#pragma unroll
                for (int bj = 0; bj < 2; ++bj)
#pragma unroll
                    for (int n = 0; n < 2; ++n) { const int r_ = u.pm * BM + ai * HALF + wr * 64 + m * 16 + fr; xw[ai][m][bj][n] = __builtin_nontemporal_load((const u32x2v*)(x1b + ((size_t)(r_ >> 4) * 32 + ((col0 >> 5) + 4 * bj)) * 512 + (r_ & 15) * 32 + (col0 & 31) + 16 * n)); } }
        __builtin_amdgcn_sched_barrier(0);
#pragma unroll
        for (int ai = 0; ai < 2; ++ai)
#pragma unroll
            for (int m = 0; m < 4; ++m) { const size_t off = (size_t)(u.pm * BM + ai * HALF + wr * 64 + m * 16 + fr) * 1024 + col0;
#pragma unroll
                for (int bj = 0; bj < 2; ++bj)
#pragma unroll
                    for (int n = 0; n < 2; ++n) { const u32x2v w = xw[ai][m][bj][n];
                        const f32x4 xr = (f32x4){__uint_as_float(w.x << 16), __uint_as_float(w.x & 0xffff0000u), __uint_as_float(w.y << 16), __uint_as_float(w.y & 0xffff0000u)};
                        *(f32x4*)(out + off + bj * HALF + n * 16) = xr + acc[ai][bj][m][n]; } }
    }
};
template <class Epi, class Sched, bool ALIGN_EPI = false, bool SP2 = false>
__device__ __forceinline__ void gemm_phase(PG8_LAS unsigned char* lds, const Gemm g, const Sched& S, const Epi& E) {
    const int tid = threadIdx.x, wid = __builtin_amdgcn_readfirstlane(tid >> 6), lane = tid & 63, wr = wid >> 2, wc = wid & 3, fr = lane & 15, fq = lane >> 4;
    const int K = g.K, nt = K / BK;
    unsigned voffA[2], voffB[2];
#pragma unroll
    for (int i = 0; i < 2; ++i) { int R, C; stage_rc(tid * 16 + i * 8192, R, C); const int Rb = Epi::PERM ? ((R & ~31) + perm32(R & 31)) : R;
        voffA[i] = g.ta ? (unsigned)(((R >> 4) * (g.lda >> 5) + (C >> 5)) * 1024 + (R & 15) * 64 + (C & 31) * 2) : (unsigned)(R * g.lda + C) * 2u;
        voffB[i] = g.tb ? (unsigned)(((Rb >> 4) * (K >> 5) + (C >> 5)) * 1024 + (Rb & 15) * 64 + (C & 31) * 2) : (unsigned)(Rb * K + C) * 2u; }
    const size_t kstepA = g.ta ? (size_t)2048 : (size_t)(BK * 2), kstepB = g.tb ? (size_t)2048 : (size_t)(BK * 2);
    const size_t hstepB = (size_t)HALF * K * 2, hstepA = (size_t)HALF * g.lda * 2;
    const size_t tstepB = 2 * hstepB, tstepA = 2 * hstepA;
    const unsigned ldsw = (unsigned)wid * 1024u;
    const int aoff = lds_byte(wr * 64 + fr, fq * 8), boff = lds_byte(wc * 32 + fr, fq * 8);
#define PG8_SA(b, h) (((b) * 2 + (h)) * HTB)
#define PG8_SB(b, h) ((4 + (b) * 2 + (h)) * HTB)
#define PG8_STAGE(bufoff, gbase, voff) do { _Pragma("unroll") for (int _i = 0; _i < 2; ++_i) \
        __builtin_amdgcn_global_load_lds((const unsigned*)((const char*)(gbase) + (voff)[_i]), (PG8_LAS unsigned*)(lds + (bufoff) + ldsw + _i * 8192), 16, 0, 0); } while (0)
#define PG8_LDA(dst, b, h) do { _Pragma("unroll") for (int m = 0; m < 4; ++m) _Pragma("unroll") for (int k = 0; k < 2; ++k) dst[m][k] = *(const PG8_LAS bf16x8*)(lds + PG8_SA(b, h) + aoff + m * 2048 + k * 1024); } while (0)
#define PG8_LDB(dst, b, h) do { _Pragma("unroll") for (int n = 0; n < 2; ++n) _Pragma("unroll") for (int k = 0; k < 2; ++k) dst[n][k] = *(const PG8_LAS bf16x8*)(lds + PG8_SB(b, h) + boff + n * 2048 + k * 1024); } while (0)
#define PG8_MMA(ai, bj, At, Bt) do { __builtin_amdgcn_s_setprio(1); _Pragma("unroll") for (int m = 0; m < 4; ++m) _Pragma("unroll") for (int n = 0; n < 2; ++n) _Pragma("unroll") for (int k = 0; k < 2; ++k) \
        acc[ai][bj][m][n] = __builtin_amdgcn_mfma_f32_16x16x32_bf16(Bt[n][k], At[m][k], acc[ai][bj][m][n], 0, 0, 0); __builtin_amdgcn_s_setprio(0); } while (0)
#define PG8_WAIT_V(n) asm volatile("s_waitcnt vmcnt(" #n ")" ::: "memory")
#define PG8_WAIT_L(n) asm volatile("s_waitcnt lgkmcnt(" #n ")" ::: "memory")
#define PG8_BAR __builtin_amdgcn_s_barrier()
#define PG8_SCHED __builtin_amdgcn_sched_barrier(0)
    Unit cur, nxt; int ui = 0;
    if (!S.next(0, cur)) return;
    f32x4 acc[2][2][4][2];
#pragma unroll
    for (int a = 0; a < 2; ++a)
#pragma unroll
        for (int b = 0; b < 2; ++b)
#pragma unroll
            for (int m = 0; m < 4; ++m)
#pragma unroll
                for (int n = 0; n < 2; ++n) acc[a][b][m][n] = (f32x4){0.f, 0.f, 0.f, 0.f};
    bf16x8 At[4][2], B0[2][2], B1[2][2];
    const char* cA = (const char*)g.A + (size_t)cur.pm * tstepA; const char* cB = (const char*)g.Bt + (size_t)cur.pn * tstepB;
    S.a_ready(cur);
    if constexpr (SP2) {
        PG8_STAGE(PG8_SB(0, 0), cB, voffB); PG8_STAGE(PG8_SB(0, 1), cB + hstepB, voffB); PG8_STAGE(PG8_SA(0, 0), cA, voffA); PG8_STAGE(PG8_SA(0, 1), cA + hstepA, voffA);
        if (wr == 1) PG8_BAR;
        PG8_WAIT_V(2); PG8_BAR;
        PG8_STAGE(PG8_SB(1, 0), cB + kstepB, voffB); PG8_STAGE(PG8_SA(1, 0), cA + kstepA, voffA); PG8_STAGE(PG8_SB(1, 1), cB + hstepB + kstepB, voffB);
        PG8_WAIT_V(6); PG8_BAR;
    } else {
        PG8_STAGE(PG8_SB(0, 0), cB, voffB); PG8_STAGE(PG8_SA(0, 0), cA, voffA); PG8_STAGE(PG8_SB(0, 1), cB + hstepB, voffB); PG8_STAGE(PG8_SA(0, 1), cA + hstepA, voffA);
        if (wr == 1) PG8_BAR;
        PG8_WAIT_V(4); PG8_BAR;
        PG8_STAGE(PG8_SB(1, 0), cB + kstepB, voffB); PG8_STAGE(PG8_SA(1, 0), cA + kstepA, voffA); PG8_STAGE(PG8_SB(1, 1), cB + hstepB + kstepB, voffB);
        PG8_WAIT_V(6); PG8_BAR;
    }
    for (;;) {
        const bool has_next = S.next(ui + 1, nxt);
        const char* nA = has_next ? (const char*)g.A + (size_t)nxt.pm * tstepA : cA; const char* nB = has_next ? (const char*)g.Bt + (size_t)nxt.pn * tstepB : cB;
        for (int t = 0; t < nt; t += 2) {
            const bool last = (t == nt - 2);
            const char* a1 = cA + (size_t)(t + 1) * kstepA;
            const char* a2 = last ? nA : cA + (size_t)(t + 2) * kstepA; const char* b2 = last ? nB : cB + (size_t)(t + 2) * kstepB;
            const char* a3 = a2 + kstepA; const char* b3 = b2 + kstepB;
            if (last && has_next) S.a_ready(nxt);
            if constexpr (SP2) {
            PG8_LDB(B0, 0, 0); PG8_LDB(B1, 0, 1); PG8_SCHED; PG8_LDA(At, 0, 0); PG8_STAGE(PG8_SA(1, 1), a1 + hstepA, voffA);
            PG8_WAIT_V(8); PG8_WAIT_L(0); PG8_BAR; PG8_MMA(0, 0, At, B0); PG8_MMA(0, 1, At, B1); PG8_BAR; PG8_SCHED;
            PG8_LDA(At, 0, 1); PG8_STAGE(PG8_SB(0, 0), b2, voffB); PG8_STAGE(PG8_SB(0, 1), b2 + hstepB, voffB); PG8_STAGE(PG8_SA(0, 0), a2, voffA);
            PG8_WAIT_V(8); PG8_WAIT_L(0); PG8_BAR; PG8_MMA(1, 0, At, B0); PG8_MMA(1, 1, At, B1); PG8_BAR; PG8_SCHED;
            PG8_LDB(B0, 1, 0); PG8_LDB(B1, 1, 1); PG8_SCHED; PG8_LDA(At, 1, 0); PG8_STAGE(PG8_SA(0, 1), a2 + hstepA, voffA);
            PG8_WAIT_V(8); PG8_WAIT_L(0); PG8_BAR; PG8_MMA(0, 0, At, B0); PG8_MMA(0, 1, At, B1); PG8_BAR; PG8_SCHED;
            PG8_LDA(At, 1, 1); PG8_STAGE(PG8_SB(1, 0), b3, voffB); PG8_STAGE(PG8_SB(1, 1), b3 + hstepB, voffB); PG8_STAGE(PG8_SA(1, 0), a3, voffA);
            PG8_WAIT_V(8); PG8_WAIT_L(0); PG8_BAR; PG8_MMA(1, 0, At, B0); PG8_MMA(1, 1, At, B1); PG8_BAR; PG8_SCHED;
            } else {
            PG8_LDB(B0, 0, 0); PG8_SCHED; PG8_LDA(At, 0, 0); PG8_STAGE(PG8_SA(1, 1), a1 + hstepA, voffA);
            PG8_WAIT_L(8); PG8_BAR; PG8_WAIT_L(0); PG8_MMA(0, 0, At, B0); PG8_BAR; PG8_SCHED;
            PG8_LDB(B1, 0, 1); PG8_STAGE(PG8_SB(0, 0), b2, voffB);
            PG8_BAR; PG8_WAIT_L(0); PG8_MMA(0, 1, At, B1); PG8_BAR;
            PG8_LDA(At, 0, 1); PG8_STAGE(PG8_SA(0, 0), a2, voffA);
            PG8_BAR; PG8_WAIT_L(0); PG8_MMA(1, 0, At, B0); PG8_BAR; PG8_SCHED;
            PG8_STAGE(PG8_SB(0, 1), b2 + hstepB, voffB);
            PG8_WAIT_V(6); PG8_BAR; PG8_MMA(1, 1, At, B1); PG8_BAR;
            PG8_LDB(B0, 1, 0); PG8_SCHED; PG8_LDA(At, 1, 0); PG8_STAGE(PG8_SA(0, 1), a2 + hstepA, voffA);
            PG8_WAIT_L(8); PG8_BAR; PG8_WAIT_L(0); PG8_MMA(0, 0, At, B0); PG8_BAR; PG8_SCHED;
            PG8_LDB(B1, 1, 1); PG8_STAGE(PG8_SB(1, 0), b3, voffB);
            PG8_BAR; PG8_WAIT_L(0); PG8_MMA(0, 1, At, B1); PG8_BAR;
            PG8_LDA(At, 1, 1); PG8_STAGE(PG8_SA(1, 0), a3, voffA);
            PG8_BAR; PG8_WAIT_L(0); PG8_MMA(1, 0, At, B0); PG8_BAR; PG8_SCHED;
            PG8_STAGE(PG8_SB(1, 1), b3 + hstepB, voffB);
            PG8_WAIT_V(6); PG8_BAR; PG8_MMA(1, 1, At, B1); PG8_BAR;
            }
        }
        if constexpr (ALIGN_EPI) { if (wr == 0) PG8_BAR; }
        if constexpr (!Epi::AFTER_DRAIN) { if constexpr (Epi::PROBE_BIT == 29 || Epi::PROBE_BIT == 27) E(acc, cur, wr, wc, fr, fq, ui); else E(acc, cur, wr, wc, fr, fq); if (DUPL(Epi::PROBE_BIT)) E(acc, cur, wr, wc, fr, fq); S.done(cur); }
        if (!has_next) break;
#pragma unroll
        for (int a = 0; a < 2; ++a)
#pragma unroll
            for (int b = 0; b < 2; ++b)
#pragma unroll
                for (int m = 0; m < 4; ++m)
#pragma unroll
                    for (int n = 0; n < 2; ++n) acc[a][b][m][n] = (f32x4){0.f, 0.f, 0.f, 0.f};
        cur = nxt; cA = nA; cB = nB; ++ui;
        if constexpr (ALIGN_EPI) { if (wr == 1) PG8_BAR; }
    }
    PG8_WAIT_V(0);
    if constexpr (!ALIGN_EPI) { if (wr == 0) PG8_BAR; }
    PG8_BAR;
    if constexpr (Epi::AFTER_DRAIN) { E.fused(acc, cur, wr, wc, fr, fq, lds, wid, lane); if (DUPL(Epi::PROBE_BIT)) { asm volatile("s_waitcnt lgkmcnt(0)" ::: "memory"); __builtin_amdgcn_s_barrier(); E.fused(acc, cur, wr, wc, fr, fq, lds, wid, lane); } S.done(cur); }
#undef PG8_SA
#undef PG8_SB
#undef PG8_STAGE
#undef PG8_LDA
#undef PG8_LDB
#undef PG8_MMA
#undef PG8_WAIT_V
#undef PG8_WAIT_L
#undef PG8_BAR
#undef PG8_SCHED
}
}

#define GAS __attribute__((address_space(1)))
#define LAS __attribute__((address_space(3)))
#define XB_TMO      128
#define XB_XCNT(j)  (256  + 64 * (j))
#define XB_XSUB(j)  (1280 + 64 * (j))
#define XB_XGEN(j)  (2304 + 64 * (j))
#define XB_TOP      3328
#define XB_TOPGEN   3392
#define XCD_BAR_WORDS 3456
#define XB_SPIN_CAP (1u << 18)
__device__ __forceinline__ unsigned xb_ld(unsigned* p)              { return __hip_atomic_load(p, __ATOMIC_RELAXED, __HIP_MEMORY_SCOPE_AGENT); }
__device__ __forceinline__ unsigned xb_add(unsigned* p, unsigned v) { return __hip_atomic_fetch_add(p, v, __ATOMIC_RELAXED, __HIP_MEMORY_SCOPE_AGENT); }
__device__ __forceinline__ unsigned xb_xcc_id() { return (unsigned)__builtin_amdgcn_s_getreg((3 << 11) | 20) & 0xFu; }
#define XB_SPIN(cond, bar) do { unsigned _sp = 0; while (cond) { __builtin_amdgcn_s_sleep(1); \
    if ((++_sp & 255u) == 0u) { if (xb_ld(&(bar)[XB_TMO])) break; if (_sp > XB_SPIN_CAP) { atomicAdd(&(bar)[XB_TMO], 1u); break; } } } } while (0)
struct XcdBarrier { unsigned* bar; unsigned x; volatile LAS unsigned* st; };
__device__ __forceinline__ XcdBarrier xcd_barrier_post(unsigned* bar, volatile LAS unsigned* st) {
    XcdBarrier b; b.bar = bar; b.x = xb_xcc_id(); b.st = st;
    if (threadIdx.x == 0) (void)xb_add(&bar[XB_XCNT(b.x)], 1u);
    return b;
}
__device__ __forceinline__ void xcd_barrier_complete(unsigned* bar, unsigned x, unsigned& nloc, unsigned& nx) {
    const unsigned G = gridDim.x * gridDim.y * gridDim.z;
    unsigned sum, cnt, mine, sp = 0u;
    for (;;) {
        sum = 0u; cnt = 0u; mine = 0u;
#pragma unroll
        for (unsigned j = 0; j < 16; ++j) { const unsigned c = xb_ld(&bar[XB_XCNT(j)]); sum += c; cnt += (c > 0u) ? 1u : 0u; mine = (j == x) ? c : mine; }
        if (sum == G) break;
        __builtin_amdgcn_s_sleep(1);
        if ((++sp & 255u) == 0u) { if (xb_ld(&bar[XB_TMO])) break; if (sp > XB_SPIN_CAP) { atomicAdd(&bar[XB_TMO], 1u); break; } }
    }
    nloc = mine > 0u ? mine : 1u; nx = cnt > 0u ? cnt : 1u;
}
__device__ __forceinline__ void xcd_barrier(const XcdBarrier& b) {
    asm volatile("s_waitcnt vmcnt(0)" ::: "memory");
    __syncthreads();
    if (threadIdx.x == 0) {
        unsigned* bar = b.bar;
        __builtin_amdgcn_s_waitcnt(0);
        unsigned nloc = b.st[0], nx = b.st[1];
        if (nloc == 0u) { xcd_barrier_complete(bar, b.x, nloc, nx); b.st[0] = nloc; b.st[1] = nx; }
        const unsigned old = xb_add(&bar[XB_XSUB(b.x)], 1u);
        const unsigned gen = old / nloc;
        if (old + 1u == (gen + 1u) * nloc) {
            __builtin_amdgcn_fence(__ATOMIC_RELEASE, "agent");
            asm volatile("s_waitcnt vmcnt(0)" ::: "memory");
            const unsigned og = xb_add(&bar[XB_TOP], 1u);
            const unsigned tg = og / nx;
            asm volatile("buffer_inv sc1" ::: "memory");
            if (og + 1u == (tg + 1u) * nx) xb_add(&bar[XB_TOPGEN], 1u);
            else XB_SPIN(xb_ld(&bar[XB_TOPGEN]) == tg, bar);
            xb_add(&bar[XB_XGEN(b.x)], 1u);
            asm volatile("s_waitcnt vmcnt(0)" ::: "memory");
        } else {
            asm volatile("buffer_inv sc1" ::: "memory");
            XB_SPIN(xb_ld(&bar[XB_TOPGEN]) == gen, bar);
            asm volatile("s_waitcnt vmcnt(0)" ::: "memory");
        }
    }
    __syncthreads();
}

constexpr int LDS_BYTES = 147456;
constexpr int MISC_OFF = 131072 + 320;
constexpr int CW_BAR = 4096;
#ifndef MK_SINGLE
#define MK_SINGLE 1
#endif
constexpr int NPHASE = 11;
struct Args { Ctx C; int ph_lo, ph_hi, grp_ok; };
__global__ void __launch_bounds__(NT, 2) fwd_mega(Args args) {
    extern __shared__ __attribute__((aligned(16))) unsigned char lds_raw[];
    float* lds = (float*)lds_raw;
    PG8_LAS unsigned char* L3 = (PG8_LAS unsigned char*)lds_raw;
    const Ctx& C = args.C;
    unsigned char* ws = C.ws;
    volatile LAS unsigned* MISC = (volatile LAS unsigned*)((LAS unsigned char*)lds_raw + MISC_OFF);
    if (threadIdx.x < 32) MISC[threadIdx.x] = 0u;
    __syncthreads();
    XcdBarrier bar; bar.bar = (unsigned*)(ws + WS_CTL) + CW_BAR; bar.x = 0; bar.st = nullptr;
    if (MK_SINGLE) bar = xcd_barrier_post((unsigned*)(ws + WS_CTL) + CW_BAR, MISC + 8);
    const int lo = args.ph_lo, hi = args.ph_hi;
#define IN(k) (lo <= (k) && (k) < hi)
#define SEAM(k) do { if (IN(k) && IN((k) + 1)) { xcd_barrier(bar); if (DUPL(31)) xcd_barrier(bar); } } while (0)
#define PH(k, BODY) do { if (IN(k)) { BODY; if (DUPL(k)) { BODY; } } } while (0)
#define GEMM_PH(EPI, EINIT, AP, BP, NN, KK, LDA, AL) GEMM_PH2(EPI, EINIT, AP, BP, NN, KK, LDA, AL, false)
#define GEMM_PH2(EPI, EINIT, AP, BP, NN, KK, LDA, AL, TA) do { pg8::Gemm g{(const bf16*)(AP), (const bf16*)(BP), M, NN, KK, LDA, TA, true}; pg8::StaticOrder S; S.init(M, NN, (int)gridDim.x, (int)blockIdx.x); \
        pg8::EPI E EINIT; pg8::gemm_phase<pg8::EPI, pg8::StaticOrder, AL, true>(L3, g, S, E); } while (0)
    const float* COS = (const float*)(ws + WS_COS); const float* SIN = (const float*)(ws + WS_SIN);
    PH(0, p0_prologue(C, lds));
    SEAM(0);
    if (IN(1)) {
        PG8_LAS float* rtz = (PG8_LAS float*)(L3 + 131072 + 1024);
        pg8::StaticOrder Sz; Sz.init(M, NZ, (int)gridDim.x, (int)blockIdx.x);
        for (int idx = threadIdx.x; idx < 4 * 256; idx += NT) { pg8::Unit uz; if (Sz.next(idx >> 8, uz)) rtz[idx] = ((const float*)(ws + WS_RS))[uz.pm * 256 + (idx & 255)]; }
        __syncthreads();
    }
    if (IN(1)) { const int slot_ = (((int)blockIdx.x >> 3) & 7) * 4; for (int i = 0; i < slot_; ++i) __builtin_amdgcn_s_sleep(3); __syncthreads(); }
    PH(1, GEMM_PH2(EpiZ, ({(bf16*)(ws + WS_Z), NZ, (float*)(ws + WS_SSQQ), (float*)(ws + WS_SSQKV), (float*)(ws + WS_SSQPE), (const PG8_LAS float*)(L3 + 131072 + 1024)}), ws + WS_A, ws + WS_WIN, NZ, DM, DM, true, true));
    int p1s = (int)blockIdx.x, p1d = (int)gridDim.x, p1e = BATCH * GH * NCH;
    if (args.grp_ok) { pg8::StaticOrder Sg; Sg.init(M, 1024, (int)gridDim.x, (int)blockIdx.x); pg8::Unit ug; (void)Sg.next(0, ug);
        p1s = ((ug.pm >> 5) * GH + ug.pn) * NCH + 4 * (ug.pm & 31); p1d = 1; p1e = p1s + 4; }
    if (IN(1) && IN(2)) {
        if (args.grp_ok) {
            asm volatile("s_waitcnt vmcnt(0)" ::: "memory");
            __syncthreads();
            if (threadIdx.x == 0) {
                pg8::StaticOrder Sg; Sg.init(M, 1024, (int)gridDim.x, (int)blockIdx.x); pg8::Unit ug; (void)Sg.next(0, ug);
                unsigned* gc = (unsigned*)(ws + WS_CTL) + 10240 + 1024 + ug.pm * 16;
                (void)xb_add(gc, 1u);
                asm volatile("buffer_inv sc1" ::: "memory");
                XB_SPIN(xb_ld(gc) < 4u, bar.bar);
                asm volatile("s_waitcnt vmcnt(0)" ::: "memory");
            }
            __syncthreads();
        } else xcd_barrier(bar);
    }
    const bool p1_first = ((blockIdx.x >> 3) & 1) != 0;
    if (p1_first) { PH(4, gla::pass1(C, lds_raw, p1s, p1d, p1e)); }
    PH(2, GEMM_PH2(EpiQ, ({(const float*)(ws + WS_SSQQ), C.q_head_norm, COS, SIN, (bf16*)(ws + WS_QF), EPS, QSCALE}), (const bf16*)(ws + WS_Z) + (ZC_CQ >> 5) * 512, ws + WS_WUQ, 1024, QRANK, NZ, false, true));
    __syncthreads();
    PH(3, GEMM_PH2(EpiKV, ({(const float*)(ws + WS_SSQKV), (const float*)(ws + WS_SSQPE), C.k_head_norm, COS, SIN, (const bf16*)(ws + WS_Z), (bf16*)(ws + WS_KF), (bf16*)(ws + WS_VF), EPS}), (const bf16*)(ws + WS_Z) + (ZC_CKV >> 5) * 512, ws + WS_WUKV, 1024, KVRANK, NZ, false, true));
    __syncthreads();
    if (!p1_first) { PH(4, gla::pass1(C, lds_raw, p1s, p1d, p1e)); }
    const bool split4 = IN(4) && IN(5) && !DUPL(31);
    if (split4) {
        asm volatile("s_waitcnt vmcnt(0)" ::: "memory");
        __syncthreads();
        if (threadIdx.x < 256) {
            if (threadIdx.x == 0) {
                unsigned* sb = (unsigned*)(ws + WS_CTL) + 14400;
                __builtin_amdgcn_s_waitcnt(0);
                unsigned nloc = bar.st[0], nx = bar.st[1];
                if (nloc == 0u) { xcd_barrier_complete(bar.bar, bar.x, nloc, nx); bar.st[0] = nloc; bar.st[1] = nx; }
                const unsigned old = xb_add(&sb[64 * bar.x], 1u);
                if (old + 1u == nloc) {
                    __builtin_amdgcn_fence(__ATOMIC_RELEASE, "agent");
                    asm volatile("s_waitcnt vmcnt(0)" ::: "memory");
                    (void)xb_add(&sb[1024], 1u);
                }
                asm volatile("buffer_inv sc1" ::: "memory");
                XB_SPIN(xb_ld(&sb[1024]) < nx, bar.bar);
                asm volatile("s_waitcnt vmcnt(0)" ::: "memory");
                MISC[16] = 1u;
            }
            while (MISC[16] == 0u) __builtin_amdgcn_s_sleep(1);
        }
    } else SEAM(4);
    PH(5, (gla_scan(C), p0_late_weights(C, lds)));
    const bool split5 = IN(5) && IN(6) && IN(7) && !DUPL(31);
    if (split5) {
        asm volatile("s_waitcnt vmcnt(0)" ::: "memory");
        __syncthreads();
        if (threadIdx.x == 0) {
            unsigned* sb = (unsigned*)(ws + WS_CTL) + 13312;
            __builtin_amdgcn_s_waitcnt(0);
            unsigned nloc = bar.st[0], nx = bar.st[1];
            if (nloc == 0u) { xcd_barrier_complete(bar.bar, bar.x, nloc, nx); bar.st[0] = nloc; bar.st[1] = nx; }
            const unsigned old = xb_add(&sb[64 * bar.x], 1u);
            if (old + 1u == nloc) {
                __builtin_amdgcn_fence(__ATOMIC_RELEASE, "agent");
                asm volatile("s_waitcnt vmcnt(0)" ::: "memory");
                (void)xb_add(&sb[1024], 1u);
            }
            asm volatile("buffer_inv sc1" ::: "memory");
        }
    } else SEAM(5);
    PH(6, att::attn_phase(C, (char*)lds_raw));
    if (split5) {
        __syncthreads();
        if (threadIdx.x == 0) {
            unsigned* sb = (unsigned*)(ws + WS_CTL) + 13312;
            const unsigned nx = bar.st[1];
            XB_SPIN(xb_ld(&sb[1024]) < nx, bar.bar);
            asm volatile("s_waitcnt vmcnt(0)" ::: "memory");
        }
        __syncthreads();
    }
    PH(7, gla::pass2(C, lds_raw));
    SEAM(7);
    PH(8, GEMM_PH2(EpiOutProjG, ({C.x, C.out, (bf16*)(ws + WS_A), (float*)(ws + WS_SSQ)}), ws + WS_B, ws + WS_WO, DM, DM, DM, true, true));
    SEAM(8);
    if (IN(9)) {
        PG8_LAS float* rtab = (PG8_LAS float*)(L3 + 131072 + 1024);
        pg8::StaticOrder So; So.init(M, DFF, (int)gridDim.x, (int)blockIdx.x);
        for (int idx = threadIdx.x; idx < 4 * 256; idx += NT) { pg8::Unit uu; const int i = idx >> 8, row = idx & 255;
            if (So.next(i, uu)) { const f32x4* sp = (const f32x4*)(ws + WS_SSQ) + (size_t)(uu.pm * 256 + row) * 4; const f32x4 s4 = (sp[0] + sp[1]) + (sp[2] + sp[3]);
                rtab[idx] = __builtin_amdgcn_rsqf(((s4[0] + s4[1]) + (s4[2] + s4[3])) * (1.0f / DM) + EPS); } }
        __syncthreads();
    }
    if (IN(9)) {
        const int slot = ((int)blockIdx.x >> 3) & 31;
        for (int i = 0; i < slot; ++i) __builtin_amdgcn_s_sleep(3);
        __syncthreads();
    }
    PH(9, GEMM_PH2(EpiUpG, ({(const PG8_LAS float*)(L3 + 131072 + 1024), (bf16*)(ws + WS_H)}), ws + WS_A, ws + WS_WUP, DFF, DM, DM, true, true));
    if (IN(9) && IN(10)) {
        if (args.grp_ok) {
            asm volatile("s_waitcnt vmcnt(0)" ::: "memory");
            __syncthreads();
            if (threadIdx.x == 0) {
                pg8::StaticOrder Sg; Sg.init(M, DM, (int)gridDim.x, (int)blockIdx.x); pg8::Unit ug; (void)Sg.next(0, ug);
                unsigned* gc = (unsigned*)(ws + WS_CTL) + 10240 + ug.pm * 16;
                (void)xb_add(gc, 1u);
                asm volatile("buffer_inv sc1" ::: "memory");
                XB_SPIN(xb_ld(gc) < 4u, bar.bar);
                asm volatile("s_waitcnt vmcnt(0)" ::: "memory");
            }
            __syncthreads();
        } else xcd_barrier(bar);
    }
    PH(10, GEMM_PH2(EpiDownG, ({(const bf16*)(ws + WS_A), C.out}), ws + WS_H, ws + WS_WDN, DM, DFF, DFF, true, true));

#undef IN
#undef SEAM
}

extern "C" void kernel_launch(void* const* d_in, const int* in_sizes, int n_in, void* d_out, int out_size, void* d_ws, size_t ws_size, hipStream_t stream) {
    static int grid = 0;
    if (grid == 0) {
        if (n_in != 17 || in_sizes[0] != M * DM || out_size != M * DM || ws_size < WS_END) { fprintf(stderr, "kernel_launch: unexpected shapes (n_in %d in0 %d out %d ws %zu)\n", n_in, n_in > 0 ? in_sizes[0] : -1, out_size, ws_size); grid = -1; return; }
        int dev = 0, cus = 0, per_cu = 0;
        if (hipGetDevice(&dev) != hipSuccess || hipDeviceGetAttribute(&cus, hipDeviceAttributeMultiprocessorCount, dev) != hipSuccess) { fprintf(stderr, "kernel_launch: device query failed\n"); grid = -1; return; }
        if (hipFuncSetAttribute((const void*)fwd_mega, hipFuncAttributeMaxDynamicSharedMemorySize, LDS_BYTES) != hipSuccess) { fprintf(stderr, "kernel_launch: hipFuncSetAttribute failed\n"); grid = -1; return; }
        if (hipOccupancyMaxActiveBlocksPerMultiprocessor(&per_cu, (const void*)fwd_mega, NT, LDS_BYTES) != hipSuccess || per_cu < 1) fprintf(stderr, "kernel_launch: note: occupancy query reports %d workgroups per CU\n", per_cu);
        (void)hipGetLastError();
        grid = cus;
    }
    if (grid < 0) return;
    Args a{};
    Ctx& C = a.C;
    C.x = (const float*)d_in[0]; C.pos = (const int*)d_in[1]; C.attn_norm = (const float*)d_in[2]; C.w_in = (const float*)d_in[3]; C.w_gate_up = (const float*)d_in[4];
    C.b_gate = (const float*)d_in[5]; C.gla_out_norm = (const float*)d_in[6]; C.q_a_norm = (const float*)d_in[7]; C.w_uq = (const float*)d_in[8]; C.kv_a_norm = (const float*)d_in[9];
    C.w_ukv = (const float*)d_in[10]; C.q_head_norm = (const float*)d_in[11]; C.k_head_norm = (const float*)d_in[12]; C.w_out = (const float*)d_in[13]; C.mlp_norm = (const float*)d_in[14];
    C.w_up = (const float*)d_in[15]; C.w_down = (const float*)d_in[16]; C.out = (float*)d_out; C.ws = (unsigned char*)d_ws;
    if (MK_SINGLE) {
        if (hipMemsetAsync((char*)d_ws + WS_CTL, 0, CTL_ZERO_BYTES, stream) != hipSuccess) { fprintf(stderr, "kernel_launch: memset failed\n"); return; }
        a.ph_lo = 0; a.ph_hi = NPHASE;
        {
            int ok = 1; int cnt[64] = {0};
            for (int c = 0; c < grid && ok; ++c) { pg8::StaticOrder Su, Sd; Su.init(M, DFF, grid, c); Sd.init(M, DM, grid, c); pg8::Unit ud, uu, u2;
                if (!Sd.next(0, ud) || Sd.next(1, u2) || ud.pm < 0 || ud.pm >= 64) { ok = 0; break; }
                cnt[ud.pm]++;
                for (int i = 0; Su.next(i, uu); ++i) if (uu.pm != ud.pm) { ok = 0; break; }
                pg8::StaticOrder Sz; Sz.init(M, NZ, grid, c); for (int i = 0; Sz.next(i, uu); ++i) if (uu.pm != ud.pm) { ok = 0; break; }
                if (ud.pn < 0 || ud.pn >= GH) ok = 0; }
            if (BATCH * GH * NCH != 4 * grid) ok = 0;
            for (int t = 0; t < 64 && ok; ++t) if (cnt[t] != 4) ok = 0;
            a.grp_ok = ok; }
        hipLaunchKernelGGL(fwd_mega, dim3(grid), dim3(NT), LDS_BYTES, stream, a);
        if (DUPL(23)) { (void)hipMemsetAsync((char*)d_ws + WS_CTL, 0, CTL_ZERO_BYTES, stream); hipLaunchKernelGGL(fwd_mega, dim3(grid), dim3(NT), LDS_BYTES, stream, a); }
    } else {
        for (int s = 0; s < NPHASE; ++s) { a.ph_lo = s; a.ph_hi = s + 1; hipLaunchKernelGGL(fwd_mega, dim3(grid), dim3(NT), LDS_BYTES, stream, a); }
    }
}
```
